# Optimizing an MI355X kernel written in HIP

```python
import jax, jax.numpy as jnp
from jax import lax
import numpy as np

D_MODEL = 1024
BATCH = 16
SEQ = 256
DEPTH = 2
DEC_BATCH = 4
DEC_SEQ = 4096
PAST_LEN = 256

GRID_W = 64
N_MIXERS = 2
N_FNET = (DEPTH + 1) // 2
N_HGRN = DEPTH // 2
FNET_GROUPS = 4
FNET_GROUP_DIM = D_MODEL // FNET_GROUPS
HGRN_EXPAND = 128
HGRN_HEADS = D_MODEL // HGRN_EXPAND
HGRN_DK = HGRN_EXPAND
HGRN_DV = D_MODEL // HGRN_HEADS
CHUNK = 32
D_FF = 4 * D_MODEL
N_MOD = 6
EPS = 1e-6
POS_BASE = 10000.0

kernel_name = "hybrid_fnet_hgrn2_diffusion_step"


def rmsnorm(x, g):
    xf = x.astype(jnp.float32)
    r = xf * lax.rsqrt(jnp.mean(xf * xf, axis=-1, keepdims=True) + EPS)
    return (r * g.astype(jnp.float32)).astype(x.dtype)


def grid_pos_embed(n_tok, d, dtype):
    rows = n_tok // GRID_W
    quarter = d // 4
    omega = 1.0 / (POS_BASE ** (jnp.arange(quarter, dtype=jnp.float32) / quarter))
    r = jnp.arange(rows, dtype=jnp.float32)[:, None] * omega[None, :]
    cl = jnp.arange(GRID_W, dtype=jnp.float32)[:, None] * omega[None, :]
    er = jnp.concatenate([jnp.sin(r), jnp.cos(r)], axis=-1)
    ec = jnp.concatenate([jnp.sin(cl), jnp.cos(cl)], axis=-1)
    emb = jnp.concatenate([jnp.broadcast_to(er[:, None, :], (rows, GRID_W, d // 2)),
                           jnp.broadcast_to(ec[None, :, :], (rows, GRID_W, d // 2))], axis=-1)
    return emb.reshape(n_tok, d).astype(dtype)


def fourier_mixer(h, w_o):
    b, l, d = h.shape
    hg = h.astype(jnp.float32).reshape(b, l, FNET_GROUPS, FNET_GROUP_DIM)
    mixed = jnp.fft.fft2(hg, axes=(1, 3), norm="ortho").real
    return mixed.reshape(b, l, d).astype(h.dtype) @ w_o


def gated_scan(q, k, v, logf, s0):
    dr, b, hh, l, dk = q.shape
    dv = v.shape[-1]
    n = l // CHUNK

    def to_chunks(a):
        return jnp.moveaxis(a.reshape(dr, b, hh, n, CHUNK, a.shape[-1]), 3, 0)

    tril = jnp.tril(jnp.ones((CHUNK, CHUNK), dtype=bool))

    def step(s, inp):
        qc, kc, vc, gc = inp
        bcum = jnp.cumsum(gc, axis=-2)
        o_inter = jnp.einsum('dbhtk,dbhkv->dbhtv', qc * jnp.exp(bcum), s)
        diff = bcum[..., :, None, :] - bcum[..., None, :, :]
        decay = jnp.exp(jnp.where(tril[:, :, None], diff, -jnp.inf))
        scores = jnp.einsum('dbhtk,dbhsk,dbhtsk->dbhts', qc, kc, decay)
        o_intra = jnp.einsum('dbhts,dbhsv->dbhtv', scores, vc)
        blast = bcum[..., -1:, :]
        s_new = jnp.exp(blast[..., 0, :])[..., None] * s + jnp.einsum(
            'dbhsk,dbhsv->dbhkv', kc * jnp.exp(blast - bcum), vc)
        return s_new, o_inter + o_intra

    s_fin, o = lax.scan(step, s0, (to_chunks(q), to_chunks(k), to_chunks(v), to_chunks(logf)))
    o = jnp.moveaxis(o, 0, 3).reshape(dr, b, hh, l, dv)
    return s_fin, o


def hgrn2_mixer(h, w_in, lb, g_norm, w_o, s0):
    b, l, d = h.shape
    proj = h @ w_in
    q, f_fw, f_bw, i_in, g = jnp.split(proj, 5, axis=-1)

    def heads(a, hd):
        return a.astype(jnp.float32).reshape(b, l, HGRN_HEADS, hd).transpose(0, 2, 1, 3)

    q = jax.nn.silu(heads(q, HGRN_DK))
    v = heads(i_in, HGRN_DV)
    lbh = lb.reshape(2, 1, HGRN_HEADS, 1, HGRN_DK)
    z = jnp.stack([heads(f_fw, HGRN_DK), heads(f_bw, HGRN_DK)])
    f = lbh + (1.0 - lbh) * jax.nn.sigmoid(z)
    k = 1.0 - f
    logf = jnp.log(f)
    flip = lambda a: jnp.flip(a, axis=2)
    q_s = jnp.stack([q, flip(q)])
    v_s = jnp.stack([v, flip(v)])
    k_s = jnp.stack([k[0], flip(k[1])])
    g_s = jnp.stack([logf[0], flip(logf[1])])
    s_fin, o = gated_scan(q_s, k_s, v_s, g_s, s0.astype(jnp.float32))
    o = o[0] + flip(o[1])
    o = o * lax.rsqrt(jnp.mean(o * o, axis=-1, keepdims=True) + EPS) * g_norm.astype(jnp.float32)
    o = o.transpose(0, 2, 1, 3).reshape(b, l, d) * jax.nn.silu(g.astype(jnp.float32))
    return o.astype(h.dtype) @ w_o, s_fin


def trunk(x, cond, states_in, ada_w, ada_b, norm_mix, norm_mlp, fnet_wo, hgrn_w_in, lb_all,
          hgrn_norm, hgrn_wo, mlp_w1, mlp_w2, norm_final):
    states_out = []
    sc = jax.nn.silu(cond)
    for i in range(DEPTH):
        mod = (sc @ ada_w[i] + ada_b[i]).reshape(-1, 1, N_MOD * D_MODEL)
        sh_m, sc_m, gt_m, sh_f, sc_f, gt_f = jnp.split(mod, N_MOD, axis=-1)
        h = rmsnorm(x, norm_mix[i]) * (1.0 + sc_m) + sh_m
        j = i // N_MIXERS
        if i % N_MIXERS == 0:
            y = fourier_mixer(h, fnet_wo[j])
        else:
            y, s_fin = hgrn2_mixer(h, hgrn_w_in[j], lb_all[:, i], hgrn_norm[j], hgrn_wo[j], states_in[j])
            states_out.append(s_fin)
        x = x + gt_m * y
        h = rmsnorm(x, norm_mlp[i]) * (1.0 + sc_f) + sh_f
        x = x + gt_f * (jnp.square(jax.nn.relu(h @ mlp_w1[i])) @ mlp_w2[i])
    return rmsnorm(x, norm_final), states_out


def setup_inputs(seed: int = 0) -> dict:
    key = jax.random.key(seed)
    ks = jax.random.split(key, 20)
    f32 = jnp.float32
    nrm = lambda k, s, sc: jax.random.normal(k, s, f32) * sc
    return {
        "x_prompt": nrm(ks[0], (BATCH, SEQ, D_MODEL), 1.0),
        "x_sample": nrm(ks[1], (DEC_BATCH, DEC_SEQ, D_MODEL), 1.0),
        "state_hgrn": nrm(ks[2], (DEC_BATCH, N_HGRN, 2, HGRN_HEADS, HGRN_DK, HGRN_DV), 0.5),
        "c": nrm(ks[3], (DEC_BATCH, D_MODEL), 1.0),
        "c_ctx": nrm(ks[4], (D_MODEL,), 1.0),
        "ada_w": nrm(ks[5], (DEPTH, D_MODEL, N_MOD * D_MODEL), 0.5 * D_MODEL ** -0.5),
        "ada_b": nrm(ks[6], (DEPTH, N_MOD * D_MODEL), 0.02),
        "norm_mix": 1.0 + nrm(ks[7], (DEPTH, D_MODEL), 0.05),
        "norm_mlp": 1.0 + nrm(ks[8], (DEPTH, D_MODEL), 0.05),
        "fnet_wo": nrm(ks[9], (N_FNET, D_MODEL, D_MODEL), D_MODEL ** -0.5),
        "hgrn_w_in": nrm(ks[10], (N_HGRN, D_MODEL, 5 * D_MODEL), D_MODEL ** -0.5),
        "hgrn_lb": nrm(ks[11], (2, DEPTH, D_MODEL), 1.0),
        "hgrn_norm": 1.0 + nrm(ks[12], (N_HGRN, HGRN_DV), 0.05),
        "hgrn_wo": nrm(ks[13], (N_HGRN, D_MODEL, D_MODEL), D_MODEL ** -0.5),
        "mlp_w1": nrm(ks[14], (DEPTH, D_MODEL, D_FF), D_MODEL ** -0.5),
        "mlp_w2": nrm(ks[15], (DEPTH, D_FF, D_MODEL), D_FF ** -0.5),
        "norm_final": 1.0 + nrm(ks[16], (D_MODEL,), 0.05),
    }


def reference(x_prompt, x_sample, state_hgrn, c, c_ctx, ada_w, ada_b, norm_mix, norm_mlp, fnet_wo,
              hgrn_w_in, hgrn_lb, hgrn_norm, hgrn_wo, mlp_w1, mlp_w2, norm_final):
    sm = jax.nn.softmax(hgrn_lb.astype(jnp.float32), axis=1)
    lb_all = jnp.cumsum(sm, axis=1) - sm[:, :1]
    weights = (ada_w, ada_b, norm_mix, norm_mlp, fnet_wo, hgrn_w_in, lb_all, hgrn_norm, hgrn_wo,
               mlp_w1, mlp_w2, norm_final)

    bp = x_prompt.shape[0]
    zero_states = [jnp.zeros((2, bp, HGRN_HEADS, HGRN_DK, HGRN_DV), jnp.float32) for _ in range(N_HGRN)]
    y_prompt, ctx_states = trunk(x_prompt, c_ctx, zero_states, *weights)
    new_state_hgrn = jnp.stack([s.transpose(1, 0, 2, 3, 4) for s in ctx_states], axis=1)

    xs = x_sample + grid_pos_embed(x_sample.shape[1], D_MODEL, x_sample.dtype)[None]
    cached = [state_hgrn[:, j].transpose(1, 0, 2, 3, 4) for j in range(N_HGRN)]
    y_sample, _ = trunk(xs, c, cached, *weights)
    return (y_prompt, y_sample, new_state_hgrn)
```

```cpp
#include <hip/hip_runtime.h>
#include <cstdint>
#include <cstdio>

constexpr int D = 1024, NB_CTX = 16, L_CTX = 256, NB_S = 4, L_S = 4096, FF = 4096;
constexpr int NTOK_CTX = NB_CTX * L_CTX, NTOK_S = NB_S * L_S, NTOK = NTOK_CTX + NTOK_S;
constexpr int NH = 8, DK = 128, DV = 128;
constexpr int CH = 4096;
constexpr float EPS = 1e-6f;

__device__ __forceinline__ float silu_f(float x) { return x / (1.f + __expf(-x)); }
__device__ __forceinline__ float sigmoid_f(float x) { return 1.f / (1.f + __expf(-x)); }

__device__ __forceinline__ float block_sum_256(float v, float* red) {
    for (int o = 32; o > 0; o >>= 1) v += __shfl_down(v, o);
    const int w = threadIdx.x >> 6, l = threadIdx.x & 63;
    __syncthreads();
    if (l == 0) red[w] = v;
    __syncthreads();
    return red[0] + red[1] + red[2] + red[3];
}

__global__ void k_mod(const float* c, const float* c_ctx, const float* ada_w, const float* ada_b, float* mod) {
    const int n = blockIdx.x * 256 + threadIdx.x;
    const int layer = blockIdx.y, cond = blockIdx.z;
    const float* cv = cond == 0 ? c_ctx : c + (size_t)(cond - 1) * D;
    const float* w = ada_w + (size_t)layer * D * 6 * D;
    float acc = 0.f;
    for (int k = 0; k < D; ++k) acc += silu_f(cv[k]) * w[(size_t)k * 6 * D + n];
    mod[((size_t)cond * 2 + layer) * 6 * D + n] = acc + ada_b[(size_t)layer * 6 * D + n];
}

__global__ void k_tab(float* tab, int L) {
    const int j = blockIdx.x * 256 + threadIdx.x;
    if (j < L) { tab[j] = cospif(2.f * (float)j / (float)L); tab[L + j] = sinpif(2.f * (float)j / (float)L); }
}
__global__ void k_dft256(const float* tab256, float* cosm, float* sinm) {
    const int i = blockIdx.x * 256 + threadIdx.x;
    const int a = i >> 8, b = i & 255, j = (a * b) & 255;
    cosm[i] = tab256[j]; sinm[i] = tab256[256 + j];
}

__global__ void k_embed(const float* xin, float* xout, int is_sample) {
    const int t = blockIdx.x;
    const float* xr = xin + (size_t)t * D; float* orow = xout + (size_t)t * D;
    for (int j = threadIdx.x; j < D; j += 256) {
        float v = xr[j];
        if (is_sample) {
            const int row = t / 64, col = t % 64;
            const int jj = j & 511, i = jj & 255;
            const float omega = 1.0f / powf(10000.0f, (float)i / 256.0f);
            const float p = (float)(j < 512 ? row : col) * omega;
            v += (jj < 256) ? sinf(p) : cosf(p);
        }
        orow[j] = v;
    }
}

__global__ void k_norm(const float* x, const float* g, const float* sh, const float* sc, float* h) {
    __shared__ float red[4];
    const float* xr = x + (size_t)blockIdx.x * D; float* hr = h + (size_t)blockIdx.x * D;
    float v[4]; float s = 0.f;
#pragma unroll
    for (int i = 0; i < 4; ++i) { v[i] = xr[threadIdx.x + 256 * i]; s += v[i] * v[i]; }
    const float tot = block_sum_256(s, red);
    const float r = rsqrtf(tot / (float)D + EPS);
#pragma unroll
    for (int i = 0; i < 4; ++i) { const int j = threadIdx.x + 256 * i; float o = v[i] * r * g[j]; if (sc) o = o * (1.f + sc[j]) + sh[j]; hr[j] = o; }
}

template <int AMODE>
__global__ void __launch_bounds__(256) k_gemm(const float* A, int lda, long sA, const float* B, int ldb, long sB, float* C, int ldc, long sC,
                                               int K, float alpha, int acc, const float* tab, int Lmask) {
    __shared__ float As[16][64 + 4], Bs[16][64 + 4];
    const int bz = blockIdx.z; A += (size_t)bz * sA; B += (size_t)bz * sB; C += (size_t)bz * sC;
    const int m0 = blockIdx.y * 64, n0 = blockIdx.x * 64, tx = threadIdx.x & 15, ty = threadIdx.x >> 4;
    float c[4][4] = {};
    for (int k0 = 0; k0 < K; k0 += 16) {
        for (int i = threadIdx.x; i < 64 * 16; i += 256) {
            const int m = i >> 4, k = i & 15;
            float a;
            if (AMODE == 0) a = A[(size_t)(m0 + m) * lda + k0 + k]; else a = tab[((m0 + m) * (k0 + k)) & Lmask];
            As[k][m] = a;
        }
        for (int i = threadIdx.x; i < 64 * 16; i += 256) { const int k = i >> 6, n = i & 63; Bs[k][n] = B[(size_t)(k0 + k) * ldb + n0 + n]; }
        __syncthreads();
#pragma unroll
        for (int k = 0; k < 16; ++k) {
            float a[4], b[4];
#pragma unroll
            for (int i = 0; i < 4; ++i) { a[i] = As[k][ty * 4 + i]; b[i] = Bs[k][tx * 4 + i]; }
#pragma unroll
            for (int i = 0; i < 4; ++i)
#pragma unroll
                for (int j = 0; j < 4; ++j) c[i][j] += a[i] * b[j];
        }
        __syncthreads();
    }
#pragma unroll
    for (int i = 0; i < 4; ++i)
#pragma unroll
    for (int j = 0; j < 4; ++j) {
        float* p = C + (size_t)(m0 + ty * 4 + i) * ldc + n0 + tx * 4 + j;
        const float v = alpha * c[i][j];
        *p = acc ? (*p + v) : v;
    }
}

__global__ void k_resid(float* x, const float* y, const float* gate, size_t n) {
    const size_t i = (size_t)blockIdx.x * 256 + threadIdx.x;
    if (i < n) x[i] += gate[i & (D - 1)] * y[i];
}
__global__ void k_relu2(float* h, size_t n) {
    const size_t i = (size_t)blockIdx.x * 256 + threadIdx.x;
    if (i < n) { const float v = fmaxf(h[i], 0.f); h[i] = v * v; }
}

__global__ void __launch_bounds__(128) k_scan(const float* proj, const float* lbraw, float* o, int L, const float* s0, float* sfin) {
    __shared__ float sq[128], sf[128], sk[128];
    const int h = blockIdx.x, b = blockIdx.y, dir = blockIdx.z, v = threadIdx.x;
    float S[128];
    const size_t sidx = ((((size_t)b * 2 + dir) * NH + h) * DK) * DV + v;
#pragma unroll
    for (int k = 0; k < 128; ++k) S[k] = s0 ? s0[sidx + (size_t)k * DV] : 0.f;
    const int chn = h * 128 + v;
    const float l0 = lbraw[((size_t)dir * 2 + 0) * D + chn], l1 = lbraw[((size_t)dir * 2 + 1) * D + chn];
    const float mx = fmaxf(l0, l1), e0 = __expf(l0 - mx), e1 = __expf(l1 - mx);
    const float lb = e1 / (e0 + e1);
    for (int step = 0; step < L; ++step) {
        const int t = dir == 0 ? step : L - 1 - step;
        const float* pr = proj + ((size_t)b * L + t) * (5 * D);
        const float qv = silu_f(pr[h * 128 + v]);
        const float z = pr[(1 + dir) * D + h * 128 + v];
        const float f = lb + (1.f - lb) * sigmoid_f(z);
        const float vv = pr[3 * D + h * 128 + v];
        __syncthreads();
        sq[v] = qv; sf[v] = f; sk[v] = 1.f - f;
        __syncthreads();
        float acc = 0.f;
#pragma unroll
        for (int k = 0; k < 128; ++k) { S[k] = sf[k] * S[k] + sk[k] * vv; acc += S[k] * sq[k]; }
        o[((size_t)dir * CH + (size_t)b * L + t) * D + h * 128 + v] = acc;
    }
    if (sfin) {
#pragma unroll
        for (int k = 0; k < 128; ++k) sfin[sidx + (size_t)k * DV] = S[k];
    }
}

__global__ void __launch_bounds__(128) k_hgrn_post(const float* o, const float* proj, const float* gnorm, float* a) {
    __shared__ float red[2];
    const int tok = blockIdx.x, h = blockIdx.y, v = threadIdx.x;
    const size_t idx = (size_t)tok * D + h * 128 + v;
    const float ov = o[idx] + o[(size_t)CH * D + idx];
    float s = ov * ov;
    for (int off = 32; off > 0; off >>= 1) s += __shfl_down(s, off);
    if ((v & 63) == 0) red[v >> 6] = s;
    __syncthreads();
    const float r = rsqrtf((red[0] + red[1]) / 128.f + EPS);
    const float g = proj[(size_t)tok * 5 * D + 4 * D + h * 128 + v];
    a[idx] = ov * r * gnorm[v] * silu_f(g);
}

extern "C" void kernel_launch(void* const* d_in, const int* in_sizes, int n_in, void* d_out, int out_size, void* d_ws, size_t ws_size, hipStream_t stream) {
    const float* x_prompt = (const float*)d_in[0]; const float* x_sample = (const float*)d_in[1]; const float* state = (const float*)d_in[2];
    const float* c = (const float*)d_in[3]; const float* c_ctx = (const float*)d_in[4]; const float* ada_w = (const float*)d_in[5]; const float* ada_b = (const float*)d_in[6];
    const float* norm_mix = (const float*)d_in[7]; const float* norm_mlp = (const float*)d_in[8]; const float* fnet_wo = (const float*)d_in[9];
    const float* w_in = (const float*)d_in[10]; const float* hgrn_lb = (const float*)d_in[11]; const float* hgrn_norm = (const float*)d_in[12];
    const float* hgrn_wo = (const float*)d_in[13]; const float* w1 = (const float*)d_in[14]; const float* w2 = (const float*)d_in[15]; const float* norm_final = (const float*)d_in[16];
    float* out = (float*)d_out;
    float* new_state = out + (size_t)NTOK * D;
    float* ws = (float*)d_ws; size_t off = 0;
    auto take = [&](size_t n) { float* p = ws + off; off += (n + 63) & ~(size_t)63; return p; };
    float* mod = take((size_t)5 * 2 * 6 * D);
    float* tab256 = take(512); float* tab4096 = take(8192); float* cosm = take(65536); float* sinm = take(65536);
    float* hbuf = take((size_t)CH * D);
    float* P = take((size_t)CH * D); float* Q = take((size_t)CH * D); float* mixed = take((size_t)CH * D); float* y = take((size_t)CH * D);
    float* big = take((size_t)CH * 5 * D);
    float* obuf = take((size_t)2 * CH * D);

    k_mod<<<dim3(6 * D / 256, 2, 5), 256, 0, stream>>>(c, c_ctx, ada_w, ada_b, mod);
    k_tab<<<1, 256, 0, stream>>>(tab256, 256);
    k_tab<<<16, 256, 0, stream>>>(tab4096, 4096);
    k_dft256<<<256, 256, 0, stream>>>(tab256, cosm, sinm);

    for (int chunk = 0; chunk < 5; ++chunk) {
        const bool smp = chunk > 0;
        const float* xin = smp ? x_sample + (size_t)(chunk - 1) * CH * D : x_prompt;
        float* x = out + (size_t)chunk * CH * D;
        const int nb = smp ? 1 : NB_CTX, L = smp ? L_S : L_CTX;
        const float* m0 = mod + ((size_t)chunk * 2 + 0) * 6 * D; const float* m1 = mod + ((size_t)chunk * 2 + 1) * 6 * D;
        k_embed<<<CH, 256, 0, stream>>>(xin, x, smp ? 1 : 0);
        k_norm<<<CH, 256, 0, stream>>>(x, norm_mix, m0 + 0 * D, m0 + 1 * D, hbuf);
        k_gemm<0><<<dim3(4, CH / 64, 4), 256, 0, stream>>>(hbuf, D, 256, cosm, 256, 0, P, D, 256, 256, 1.f, 0, nullptr, 0);
        k_gemm<0><<<dim3(4, CH / 64, 4), 256, 0, stream>>>(hbuf, D, 256, sinm, 256, 0, Q, D, 256, 256, 1.f, 0, nullptr, 0);
        const float scale = 1.0f / sqrtf((float)L * 256.f);
        const float* tab = smp ? tab4096 : tab256;
        k_gemm<1><<<dim3(D / 64, L / 64, nb), 256, 0, stream>>>(nullptr, 0, 0, P, D, (long)L * D, mixed, D, (long)L * D, L, scale, 0, tab, L - 1);
        k_gemm<1><<<dim3(D / 64, L / 64, nb), 256, 0, stream>>>(nullptr, 0, 0, Q, D, (long)L * D, mixed, D, (long)L * D, L, -scale, 1, tab + L, L - 1);
        k_gemm<0><<<dim3(D / 64, CH / 64, 1), 256, 0, stream>>>(mixed, D, 0, fnet_wo, D, 0, y, D, 0, D, 1.f, 0, nullptr, 0);
        k_resid<<<CH * D / 256, 256, 0, stream>>>(x, y, m0 + 2 * D, (size_t)CH * D);
        k_norm<<<CH, 256, 0, stream>>>(x, norm_mlp, m0 + 3 * D, m0 + 4 * D, hbuf);
        k_gemm<0><<<dim3(FF / 64, CH / 64, 1), 256, 0, stream>>>(hbuf, D, 0, w1, FF, 0, big, FF, 0, D, 1.f, 0, nullptr, 0);
        k_relu2<<<CH * FF / 256, 256, 0, stream>>>(big, (size_t)CH * FF);
        k_gemm<0><<<dim3(D / 64, CH / 64, 1), 256, 0, stream>>>(big, FF, 0, w2, D, 0, y, D, 0, FF, 1.f, 0, nullptr, 0);
        k_resid<<<CH * D / 256, 256, 0, stream>>>(x, y, m0 + 5 * D, (size_t)CH * D);
        k_norm<<<CH, 256, 0, stream>>>(x, norm_mix + D, m1 + 0 * D, m1 + 1 * D, hbuf);
        k_gemm<0><<<dim3(5 * D / 64, CH / 64, 1), 256, 0, stream>>>(hbuf, D, 0, w_in, 5 * D, 0, big, 5 * D, 0, D, 1.f, 0, nullptr, 0);
        const float* s0 = smp ? state + (size_t)(chunk - 1) * 2 * NH * DK * DV : nullptr;
        float* sfin = smp ? nullptr : new_state;
        k_scan<<<dim3(NH, nb, 2), 128, 0, stream>>>(big, hgrn_lb, obuf, L, s0, sfin);
        k_hgrn_post<<<dim3(CH, NH), 128, 0, stream>>>(obuf, big, hgrn_norm, hbuf);
        k_gemm<0><<<dim3(D / 64, CH / 64, 1), 256, 0, stream>>>(hbuf, D, 0, hgrn_wo, D, 0, y, D, 0, D, 1.f, 0, nullptr, 0);
        k_resid<<<CH * D / 256, 256, 0, stream>>>(x, y, m1 + 2 * D, (size_t)CH * D);
        k_norm<<<CH, 256, 0, stream>>>(x, norm_mlp + D, m1 + 3 * D, m1 + 4 * D, hbuf);
        k_gemm<0><<<dim3(FF / 64, CH / 64, 1), 256, 0, stream>>>(hbuf, D, 0, w1 + (size_t)D * FF, FF, 0, big, FF, 0, D, 1.f, 0, nullptr, 0);
        k_relu2<<<CH * FF / 256, 256, 0, stream>>>(big, (size_t)CH * FF);
        k_gemm<0><<<dim3(D / 64, CH / 64, 1), 256, 0, stream>>>(big, FF, 0, w2 + (size_t)FF * D, D, 0, y, D, 0, FF, 1.f, 0, nullptr, 0);
        k_resid<<<CH * D / 256, 256, 0, stream>>>(x, y, m1 + 5 * D, (size_t)CH * D);
        k_norm<<<CH, 256, 0, stream>>>(x, norm_final, nullptr, nullptr, x);
    }
}
```

```cpp
#include <hip/hip_runtime.h>
#include <cstdint>
#include <cstdio>

constexpr int D = 1024, NB_CTX = 16, L_CTX = 256, NB_S = 4, L_S = 4096, FF = 4096;
constexpr int NTOK_CTX = NB_CTX * L_CTX, NTOK_S = NB_S * L_S, NTOK = NTOK_CTX + NTOK_S;
constexpr int NH = 8, DK = 128, DV = 128;
constexpr int CH = 4096;
constexpr float EPS = 1e-6f;

namespace fk {
#define LAS __attribute__((address_space(3)))
#define GAS __attribute__((address_space(1)))
typedef unsigned short bf16_t;
typedef short bf16x8 __attribute__((ext_vector_type(8)));
typedef float f32x4 __attribute__((ext_vector_type(4)));
typedef float f32x2 __attribute__((ext_vector_type(2)));
typedef unsigned u32x4 __attribute__((ext_vector_type(4)));
typedef unsigned u32x2 __attribute__((ext_vector_type(2)));
constexpr int BM = 256, BK = 64, HALF = 128, HTB = HALF * BK * 2, STAGE_BYTES = 8 * HTB, NXCD = 8, WGM = 8;
constexpr int NWAVES = 8, NTHREADS = 512;

__device__ __forceinline__ int lds_byte(int r, int c) { const int st = (r >> 4) * 2 + (c >> 5), rr = r & 15, cc = c & 31, ob = rr * 64 + cc * 2; return st * 1024 + (ob ^ (((ob >> 9) & 1) << 5)); }
__device__ __forceinline__ void stage_rc(int b, int& R, int& C) { const int st = b / 1024, sb = b % 1024, swz = sb ^ (((sb >> 9) & 1) << 5); R = (st >> 1) * 16 + swz / 64; C = (st & 1) * 32 + (swz % 64) / 2; }
__device__ __forceinline__ int perm32(int rho) { const int n = rho >> 4, i = rho & 15; return 8 * (i >> 2) + 4 * n + (i & 3); }
__device__ __forceinline__ unsigned cvt_pk_bf16(float lo, float hi) { unsigned r; asm volatile("v_cvt_pk_bf16_f32 %0, %1, %2" : "=v"(r) : "v"(lo), "v"(hi)); return r; }
__device__ __forceinline__ unsigned f2bf(float f) { unsigned u = __builtin_bit_cast(unsigned, f); return (u + 0x7fffu + ((u >> 16) & 1u)) >> 16; }
__device__ __forceinline__ unsigned pk2(float lo, float hi) { return f2bf(lo) | (f2bf(hi) << 16); }
__device__ __forceinline__ float bf2f(unsigned short b) { return __builtin_bit_cast(float, (unsigned)b << 16); }
__device__ __forceinline__ unsigned pk2h(float lo, float hi) { const _Float16 a = (_Float16)lo, b = (_Float16)hi; return (unsigned)__builtin_bit_cast(unsigned short, a) | ((unsigned)__builtin_bit_cast(unsigned short, b) << 16); }
__device__ __forceinline__ float silu(float x) { return x / (1.f + __expf(-x)); }
__device__ __forceinline__ float wave_sum(float v) {
#pragma unroll
    for (int o = 1; o < 64; o <<= 1) v += __shfl_xor(v, o);
    return v;
}

struct WsMapT { unsigned long long slots, dvec, lb, q, lffw, lfbw, v, sg, mod, pos, dftc, dl256, fa2, mb, wfnet, who, win, w1[2], w2[2], h, yctx, ysmp, u, big; };
typedef WsMapT WsMap;
struct Unit { size_t offA, offB; int p0, p1, p2, p3; };
struct OpMap { int rm; unsigned s1, s2; };
__device__ __forceinline__ unsigned rowoff(const OpMap& m, int R) { return (unsigned)(R % m.rm) * m.s1 + (unsigned)(R / m.rm) * m.s2; }

template <class P, bool ALIGN_EPI, bool SP2>
__device__ __forceinline__ void gemm_phase(LAS unsigned char* lds, const P& pb) {
    const int tid = threadIdx.x, wid = __builtin_amdgcn_readfirstlane(tid >> 6), lane = tid & 63, wr = wid >> 2, wc = wid & 3, fr = lane & 15, fq = lane >> 4;
    const int nt = pb.nt;
    unsigned voffA[2], voffB[2];
#pragma unroll
    for (int i = 0; i < 2; ++i) { int R, C; stage_rc(tid * 16 + i * 8192, R, C); const int Rb = P::PERM ? ((R & ~31) + perm32(R & 31)) : R;
        voffA[i] = rowoff(pb.ma, R) + (unsigned)C * 2u; voffB[i] = rowoff(pb.mb, Rb) + (unsigned)C * 2u; }
    const size_t kstepA = pb.kstepA, kstepB = pb.kstepB, hstepA = pb.hstepA, hstepB = pb.hstepB;
    const unsigned ldsw = (unsigned)wid * 1024u;
    const int aoff = lds_byte(wr * 64 + fr, fq * 8), boff = lds_byte(wc * 32 + fr, fq * 8);
#define PG8_SA(b, h) (((b) * 2 + (h)) * HTB)
#define PG8_SB(b, h) ((4 + (b) * 2 + (h)) * HTB)
#define PG8_STAGE(bufoff, gbase, voff) do { _Pragma("unroll") for (int _i = 0; _i < 2; ++_i) \
        __builtin_amdgcn_global_load_lds((const unsigned*)((const char*)(gbase) + (voff)[_i]), (LAS unsigned*)(lds + (bufoff) + ldsw + _i * 8192), 16, 0, 0); } while (0)
#define PG8_LDA(dst, b, h) do { _Pragma("unroll") for (int m = 0; m < 4; ++m) _Pragma("unroll") for (int k = 0; k < 2; ++k) dst[m][k] = *(const LAS bf16x8*)(lds + PG8_SA(b, h) + aoff + m * 2048 + k * 1024); } while (0)
#define PG8_LDB(dst, b, h) do { _Pragma("unroll") for (int n = 0; n < 2; ++n) _Pragma("unroll") for (int k = 0; k < 2; ++k) dst[n][k] = *(const LAS bf16x8*)(lds + PG8_SB(b, h) + boff + n * 2048 + k * 1024); } while (0)
#define PG8_MMA(ai, bj, At, Bt) do { __builtin_amdgcn_s_setprio(1); _Pragma("unroll") for (int m = 0; m < 4; ++m) _Pragma("unroll") for (int n = 0; n < 2; ++n) _Pragma("unroll") for (int k = 0; k < 2; ++k) \
        acc[ai][bj][m][n] = __builtin_amdgcn_mfma_f32_16x16x32_bf16(Bt[n][k], At[m][k], acc[ai][bj][m][n], 0, 0, 0); __builtin_amdgcn_s_setprio(0); } while (0)
#define PG8_WAIT_V(n) asm volatile("s_waitcnt vmcnt(" #n ")" ::: "memory")
#define PG8_WAIT_L(n) asm volatile("s_waitcnt lgkmcnt(" #n ")" ::: "memory")
#define PG8_BAR __builtin_amdgcn_s_barrier()
#define PG8_SCHED __builtin_amdgcn_sched_barrier(0)
    Unit cur, nxt; int ui = 0;
    if (!pb.next(0, cur)) return;
    f32x4 acc[2][2][4][2];
#pragma unroll
    for (int a = 0; a < 2; ++a)
#pragma unroll
        for (int b = 0; b < 2; ++b)
#pragma unroll
            for (int m = 0; m < 4; ++m)
#pragma unroll
                for (int n = 0; n < 2; ++n) acc[a][b][m][n] = (f32x4){0.f, 0.f, 0.f, 0.f};
    bf16x8 At[4][2], B0[2][2], B1[2][2];
    const char* cA = pb.A + cur.offA; const char* cB = pb.B + cur.offB;
    if constexpr (SP2) {
        PG8_STAGE(PG8_SB(0, 0), cB, voffB); PG8_STAGE(PG8_SB(0, 1), cB + hstepB, voffB); PG8_STAGE(PG8_SA(0, 0), cA, voffA); PG8_STAGE(PG8_SA(0, 1), cA + hstepA, voffA);
        if (wr == 1) PG8_BAR;
        PG8_WAIT_V(2); PG8_BAR;
        PG8_STAGE(PG8_SB(1, 0), cB + kstepB, voffB); PG8_STAGE(PG8_SA(1, 0), cA + kstepA, voffA); PG8_STAGE(PG8_SB(1, 1), cB + hstepB + kstepB, voffB);
        PG8_WAIT_V(6); PG8_BAR;
    } else {
        PG8_STAGE(PG8_SB(0, 0), cB, voffB); PG8_STAGE(PG8_SA(0, 0), cA, voffA); PG8_STAGE(PG8_SB(0, 1), cB + hstepB, voffB); PG8_STAGE(PG8_SA(0, 1), cA + hstepA, voffA);
        if (wr == 1) PG8_BAR;
        PG8_WAIT_V(4); PG8_BAR;
        PG8_STAGE(PG8_SB(1, 0), cB + kstepB, voffB); PG8_STAGE(PG8_SA(1, 0), cA + kstepA, voffA); PG8_STAGE(PG8_SB(1, 1), cB + hstepB + kstepB, voffB);
        PG8_WAIT_V(6); PG8_BAR;
    }
    for (;;) {
        const bool has_next = pb.next(ui + 1, nxt);
        const char* nA = has_next ? pb.A + nxt.offA : cA; const char* nB = has_next ? pb.B + nxt.offB : cB;
        for (int t = 0; t < nt; t += 2) {
            const bool last = (t == nt - 2);
            const char* a1 = cA + (size_t)(t + 1) * kstepA;
            const char* a2 = last ? nA : cA + (size_t)(t + 2) * kstepA; const char* b2 = last ? nB : cB + (size_t)(t + 2) * kstepB;
            const char* a3 = a2 + kstepA; const char* b3 = b2 + kstepB;
            if constexpr (SP2) {
            PG8_LDB(B0, 0, 0); PG8_LDB(B1, 0, 1); PG8_SCHED; PG8_LDA(At, 0, 0); PG8_STAGE(PG8_SA(1, 1), a1 + hstepA, voffA);
            PG8_WAIT_V(8); PG8_WAIT_L(0); PG8_BAR; PG8_MMA(0, 0, At, B0); PG8_MMA(0, 1, At, B1); PG8_BAR; PG8_SCHED;
            PG8_LDA(At, 0, 1); PG8_STAGE(PG8_SB(0, 0), b2, voffB); PG8_STAGE(PG8_SB(0, 1), b2 + hstepB, voffB); PG8_STAGE(PG8_SA(0, 0), a2, voffA);
            PG8_WAIT_V(8); PG8_WAIT_L(0); PG8_BAR; PG8_MMA(1, 0, At, B0); PG8_MMA(1, 1, At, B1); PG8_BAR; PG8_SCHED;
            PG8_LDB(B0, 1, 0); PG8_LDB(B1, 1, 1); PG8_SCHED; PG8_LDA(At, 1, 0); PG8_STAGE(PG8_SA(0, 1), a2 + hstepA, voffA);
            PG8_WAIT_V(8); PG8_WAIT_L(0); PG8_BAR; PG8_MMA(0, 0, At, B0); PG8_MMA(0, 1, At, B1); PG8_BAR; PG8_SCHED;
            PG8_LDA(At, 1, 1); PG8_STAGE(PG8_SB(1, 0), b3, voffB); PG8_STAGE(PG8_SB(1, 1), b3 + hstepB, voffB); PG8_STAGE(PG8_SA(1, 0), a3, voffA);
            PG8_WAIT_V(8); PG8_WAIT_L(0); PG8_BAR; PG8_MMA(1, 0, At, B0); PG8_MMA(1, 1, At, B1); PG8_BAR; PG8_SCHED;
            } else {
            PG8_LDB(B0, 0, 0); PG8_SCHED; PG8_LDA(At, 0, 0); PG8_STAGE(PG8_SA(1, 1), a1 + hstepA, voffA);
            PG8_WAIT_L(8); PG8_BAR; PG8_WAIT_L(0); PG8_MMA(0, 0, At, B0); PG8_BAR; PG8_SCHED;
            PG8_LDB(B1, 0, 1); PG8_STAGE(PG8_SB(0, 0), b2, voffB);
            PG8_BAR; PG8_WAIT_L(0); PG8_MMA(0, 1, At, B1); PG8_BAR;
            PG8_LDA(At, 0, 1); PG8_STAGE(PG8_SA(0, 0), a2, voffA);
            PG8_BAR; PG8_WAIT_L(0); PG8_MMA(1, 0, At, B0); PG8_BAR; PG8_SCHED;
            PG8_STAGE(PG8_SB(0, 1), b2 + hstepB, voffB);
            PG8_WAIT_V(6); PG8_BAR; PG8_MMA(1, 1, At, B1); PG8_BAR;
            PG8_LDB(B0, 1, 0); PG8_SCHED; PG8_LDA(At, 1, 0); PG8_STAGE(PG8_SA(0, 1), a2 + hstepA, voffA);
            PG8_WAIT_L(8); PG8_BAR; PG8_WAIT_L(0); PG8_MMA(0, 0, At, B0); PG8_BAR; PG8_SCHED;
            PG8_LDB(B1, 1, 1); PG8_STAGE(PG8_SB(1, 0), b3, voffB);
            PG8_BAR; PG8_WAIT_L(0); PG8_MMA(0, 1, At, B1); PG8_BAR;
            PG8_LDA(At, 1, 1); PG8_STAGE(PG8_SA(1, 0), a3, voffA);
            PG8_BAR; PG8_WAIT_L(0); PG8_MMA(1, 0, At, B0); PG8_BAR; PG8_SCHED;
            PG8_STAGE(PG8_SB(1, 1), b3 + hstepB, voffB);
            PG8_WAIT_V(6); PG8_BAR; PG8_MMA(1, 1, At, B1); PG8_BAR;
            }
        }
        if constexpr (ALIGN_EPI) { if (wr == 0) PG8_BAR; }
        pb.epi(acc, cur, wr, wc, fr, fq);
        if (!has_next) break;
#pragma unroll
        for (int a = 0; a < 2; ++a)
#pragma unroll
            for (int b = 0; b < 2; ++b)
#pragma unroll
                for (int m = 0; m < 4; ++m)
#pragma unroll
                    for (int n = 0; n < 2; ++n) acc[a][b][m][n] = (f32x4){0.f, 0.f, 0.f, 0.f};
        cur = nxt; cA = nA; cB = nB; ++ui;
        if constexpr (ALIGN_EPI) { if (wr == 1) PG8_BAR; }
    }
    PG8_WAIT_V(0);
    if constexpr (!ALIGN_EPI) { if (wr == 0) PG8_BAR; }
    PG8_BAR;
#undef PG8_SA
#undef PG8_SB
#undef PG8_STAGE
#undef PG8_LDA
#undef PG8_LDB
#undef PG8_MMA
#undef PG8_WAIT_V
#undef PG8_WAIT_L
#undef PG8_BAR
#undef PG8_SCHED
}

struct StaticOrder {
    int nM, nN, nwg, G, c;
    __device__ void init(int nM_, int nN_, int G_, int c_) { nM = nM_; nN = nN_; nwg = nM * nN; G = G_; c = c_; }
    __device__ bool next(int i, int& pm, int& pn) const {
        const long L = (long)i * G + c; if (L >= nwg) return false;
        int wgid = (int)L; { const int q = nwg / NXCD, r = nwg % NXCD, xcd = wgid % NXCD, off = wgid / NXCD; wgid = (xcd < r ? xcd * (q + 1) : r * (q + 1) + (xcd - r) * q) + off; }
        const int nig = WGM * nN, gid = wgid / nig, fm = gid * WGM, gsz = (nM - fm) < WGM ? (nM - fm) : WGM;
        pm = fm + ((wgid % nig) % gsz); pn = (wgid % nig) / gsz; return true;
    }
};

struct ProbBase {
    const char* A; const char* B; OpMap ma, mb; size_t hstepA, hstepB, kstepA, kstepB; int nt;
    __device__ void std_operands(const void* A_, int lda, const void* B_, int ldb, int K) {
        A = (const char*)A_; B = (const char*)B_; ma = OpMap{128, (unsigned)lda * 2u, 0u}; mb = OpMap{128, (unsigned)ldb * 2u, 0u};
        hstepA = (size_t)HALF * lda * 2; hstepB = (size_t)HALF * ldb * 2; kstepA = kstepB = BK * 2; nt = K / BK;
    }
};

template <class F> __device__ __forceinline__ void epi_rows_perm(const f32x4 (&acc)[2][2][4][2], int wr, int wc, int fr, int fq, F f) {
#pragma unroll
    for (int ai = 0; ai < 2; ++ai)
#pragma unroll
        for (int m = 0; m < 4; ++m)
#pragma unroll
            for (int bj = 0; bj < 2; ++bj) f(ai * HALF + wr * 64 + m * 16 + fr, bj * HALF + wc * 32 + 8 * fq, acc[ai][bj][m][0], acc[ai][bj][m][1]);
}
template <class F> __device__ __forceinline__ void epi_rows_f32(const f32x4 (&acc)[2][2][4][2], int wr, int wc, int fr, int fq, F f) {
#pragma unroll
    for (int ai = 0; ai < 2; ++ai)
#pragma unroll
        for (int m = 0; m < 4; ++m)
#pragma unroll
            for (int bj = 0; bj < 2; ++bj)
#pragma unroll
                for (int n = 0; n < 2; ++n) f(ai * HALF + wr * 64 + m * 16 + fr, bj * HALF + wc * 32 + 16 * n + 4 * fq, acc[ai][bj][m][n]);
}
__device__ __forceinline__ u32x4 pack8(const f32x4& v0, const f32x4& v1) { u32x4 w; w.x = cvt_pk_bf16(v0[0], v0[1]); w.y = cvt_pk_bf16(v0[2], v0[3]); w.z = cvt_pk_bf16(v1[0], v1[1]); w.w = cvt_pk_bf16(v1[2], v1[3]); return w; }

struct TokOrder : ProbBase {
    StaticOrder so; int row0, lda, ldb;
    __device__ void init_tok(const void* Act, int lda_, const void* Wt, int K, int row0_, int nM, int nN, int G, int c) { std_operands(Act, lda_, Wt, K, K); row0 = row0_; lda = lda_; ldb = K; so.init(nM, nN, G, c); }
    __device__ bool next(int i, Unit& u) const { int pm, pn; if (!so.next(i, pm, pn)) return false; u.p0 = pm; u.p1 = pn; u.offA = (size_t)(row0 + pm * BM) * lda * 2; u.offB = (size_t)pn * BM * ldb * 2; return true; }
};
struct ProbMlp1 : TokOrder {
    static constexpr bool PERM = true;
    bf16_t* O; int ldc;
    __device__ __forceinline__ void epi(const f32x4 (&acc)[2][2][4][2], const Unit& u, int wr, int wc, int fr, int fq) const {
        bf16_t* base = O + (size_t)(row0 + u.p0 * BM) * ldc + u.p1 * BM;
        epi_rows_perm(acc, wr, wc, fr, fq, [&](int r, int c, f32x4 v0, f32x4 v1) {
#pragma unroll
            for (int j = 0; j < 4; ++j) { const float a = fmaxf(v0[j], 0.f), b = fmaxf(v1[j], 0.f); v0[j] = a * a; v1[j] = b * b; }
            *(u32x4*)(base + (size_t)r * ldc + c) = pack8(v0, v1); });
    }
};
struct ProbResid : TokOrder {
    static constexpr bool PERM = false;
    float* X; const float* mod; int layer, gidx;
    __device__ __forceinline__ void epi(const f32x4 (&acc)[2][2][4][2], const Unit& u, int wr, int wc, int fr, int fq) const {
        const int rowt = row0 + u.p0 * BM, cond = rowt >> 12;
        const float* gate = mod + ((size_t)(cond * 2 + layer) * 6 + gidx) * 1024 + u.p1 * BM;
        float* base = X + (size_t)rowt * 1024 + u.p1 * BM;
        epi_rows_f32(acc, wr, wc, fr, fq, [&](int r, int c, f32x4 v) {
            const f32x4 g = *(const f32x4*)(gate + c); f32x4* p = (f32x4*)(base + (size_t)r * 1024 + c); *p = *p + g * v; });
    }
};


struct ProbWin : TokOrder {
    static constexpr bool PERM = true;
    bf16_t* Oq; bf16_t* Offw; bf16_t* Ofbw; bf16_t* Ov; bf16_t* Osg; const float* lb;
    __device__ __forceinline__ void epi(const f32x4 (&acc)[2][2][4][2], const Unit& u, int wr, int wc, int fr, int fq) const {
        const int t = u.p1 >> 2, col0 = (u.p1 & 3) * BM;
        bf16_t* O = t == 0 ? Oq : t == 1 ? Offw : t == 2 ? Ofbw : t == 3 ? Ov : Osg;
        bf16_t* base = O + (size_t)(row0 + u.p0 * BM) * 1024 + col0;
        if (t == 1 || t == 2) {
            const float* lbp = lb + (t - 1) * 1024 + col0;
            epi_rows_perm(acc, wr, wc, fr, fq, [&](int r, int c, f32x4 v0, f32x4 v1) {
                const f32x4 l0 = *(const f32x4*)(lbp + c), l1 = *(const f32x4*)(lbp + c + 4);
#pragma unroll
                for (int j = 0; j < 4; ++j) { v0[j] = __logf(l0[j] + (1.f - l0[j]) / (1.f + __expf(-v0[j]))); v1[j] = __logf(l1[j] + (1.f - l1[j]) / (1.f + __expf(-v1[j]))); }
                u32x4 w; w.x = pk2h(v0[0], v0[1]); w.y = pk2h(v0[2], v0[3]); w.z = pk2h(v1[0], v1[1]); w.w = pk2h(v1[2], v1[3]);
                *(u32x4*)(base + (size_t)r * 1024 + c) = w; });
        } else if (t == 3) {
            epi_rows_perm(acc, wr, wc, fr, fq, [&](int r, int c, f32x4 v0, f32x4 v1) { *(u32x4*)(base + (size_t)r * 1024 + c) = pack8(v0, v1); });
        } else {
            epi_rows_perm(acc, wr, wc, fr, fq, [&](int r, int c, f32x4 v0, f32x4 v1) {
#pragma unroll
                for (int j = 0; j < 4; ++j) { v0[j] = silu(v0[j]); v1[j] = silu(v1[j]); }
                *(u32x4*)(base + (size_t)r * 1024 + c) = pack8(v0, v1); });
        }
    }
};

struct ProbChan : ProbBase {
    static constexpr bool PERM = true;
    int mode, G, c, nunits; bf16_t* Y;
    __device__ void init(int mode_, const void* dftc, const bf16_t* h0, bf16_t* Y_, int G_, int c_) {
        mode = mode_; G = G_; c = c_; Y = Y_; A = (const char*)dftc; B = (const char*)h0; ma = OpMap{128, 512u, 0u}; hstepA = (size_t)HALF * 512; kstepA = kstepB = BK * 2; nt = 4;
        if (mode == 0) { mb = OpMap{128, 2048u, 0u}; hstepB = (size_t)HALF * 2048; nunits = 16 * 4 * 2; }
        else { mb = OpMap{64, 64u * 2048u, 2048u}; hstepB = 2 * 2048; nunits = 4 * 4 * 16 * 2; }
    }
    __device__ bool next(int i, Unit& u) const {
        const int L = i * G + c; if (L >= nunits) return false;
        const int mt = L & 1; u.p0 = mt; u.offA = (size_t)mt * 256 * 512;
        if (mode == 0) { const int g = (L >> 1) & 3, b = L >> 3; u.p1 = b * 2048 + g * 512; u.p2 = 0; u.offB = ((size_t)(b * 256) * 1024 + g * 256) * 2; }
        else { const int j = (L >> 1) & 15, g = (L >> 5) & 3, b = L >> 7; u.p1 = b * 2048 + g * 512; u.p2 = j * 256; u.offB = ((size_t)(4096 + b * 4096 + 4 * j) * 1024 + g * 256) * 2; }
        return true;
    }
    __device__ __forceinline__ void epi(const f32x4 (&acc)[2][2][4][2], const Unit& u, int wr, int wc, int fr, int fq) const {
        const int ldc = mode == 0 ? 256 : 4096;
        bf16_t* base = Y + (size_t)(u.p1 + u.p0 * 256) * ldc + u.p2;
        epi_rows_perm(acc, wr, wc, fr, fq, [&](int r, int cc, f32x4 v0, f32x4 v1) { *(u32x4*)(base + (size_t)r * ldc + cc) = pack8(v0, v1); });
    }
};
struct ProbPosCtx : ProbBase {
    static constexpr bool PERM = true;
    int G, c; bf16_t* Z;
    __device__ void init(const void* dl, const bf16_t* yctx, bf16_t* Z_, int G_, int c_) { std_operands(dl, 512, yctx, 512, 512); G = G_; c = c_; Z = Z_; }
    __device__ bool next(int i, Unit& u) const {
        const int L = i * G + c; if (L >= 64) return false;
        const int pn = L & 3, b = L >> 2; u.p0 = b; u.p1 = pn; u.offA = 0; u.offB = ((size_t)b * 2048 * 256 + (size_t)pn * 256 * 512) * 2; return true;
    }
    __device__ __forceinline__ void epi(const f32x4 (&acc)[2][2][4][2], const Unit& u, int wr, int wc, int fr, int fq) const {
        bf16_t* base = Z + (size_t)(u.p0 * 256) * 1024 + u.p1 * 256;
        epi_rows_perm(acc, wr, wc, fr, fq, [&](int r, int cc, f32x4 v0, f32x4 v1) { *(u32x4*)(base + (size_t)r * 1024 + cc) = pack8(v0, v1); });
    }
};
struct ProbSmpA : ProbBase {
    static constexpr bool PERM = true;
    int G, c; bf16_t* U;
    __device__ void init(const void* fa2, const bf16_t* yt, bf16_t* U_, int G_, int c_) {
        A = (const char*)fa2; B = (const char*)yt; ma = OpMap{128, 512u, 0u}; hstepA = (size_t)HALF * 512; kstepA = BK * 2;
        mb = OpMap{32, 128u, 16384u}; hstepB = 4 * 16384; kstepB = 4096; nt = 4; G = G_; c = c_; U = U_;
    }
    __device__ bool next(int i, Unit& u) const {
        const int L = i * G + c; if (L >= 512) return false;
        const int tau = L & 127, b = L >> 7; u.p0 = b; u.p1 = tau; u.offA = 0; u.offB = ((size_t)(b * 2048 + 16 * tau) * 4096) * 2; return true;
    }
    __device__ __forceinline__ void epi(const f32x4 (&acc)[2][2][4][2], const Unit& u, int wr, int wc, int fr, int fq) const {
        bf16_t* base = U + (size_t)(u.p0 * 1024 + 8 * u.p1) * 8192;
        epi_rows_perm(acc, wr, wc, fr, fq, [&](int r, int cc, f32x4 v0, f32x4 v1) {
            *(u32x4*)(base + (size_t)(cc >> 5) * 8192 + (r & 127) * 64 + (r >> 7) * 32 + (cc & 31)) = pack8(v0, v1); });
    }
};
struct ProbSmpB : ProbBase {
    static constexpr bool PERM = true;
    int G, c; bf16_t* Z;
    __device__ void init(const void* mbm, const bf16_t* Uin, bf16_t* Z_, int G_, int c_) { std_operands(mbm, 512, Uin, 8192, 512); G = G_; c = c_; Z = Z_; }
    __device__ bool next(int i, Unit& u) const {
        const int L = i * G + c; if (L >= 256) return false;
        const int pn = L & 3, q = (L >> 2) & 15, b = L >> 6; u.p0 = b; u.p1 = q; u.p2 = pn;
        u.offA = (size_t)q * 256 * 512 * 2; u.offB = ((size_t)(b * 1024 + pn * 256) * 8192 + q * 512) * 2; return true;
    }
    __device__ __forceinline__ void epi(const f32x4 (&acc)[2][2][4][2], const Unit& u, int wr, int wc, int fr, int fq) const {
        bf16_t* base = Z + (size_t)(4096 + u.p0 * 4096 + 4 * u.p1) * 1024 + u.p2 * 256;
        epi_rows_perm(acc, wr, wc, fr, fq, [&](int r, int cc, f32x4 v0, f32x4 v1) {
            const int l = (r >> 6) + 64 * (r & 63); *(u32x4*)(base + (size_t)l * 1024 + cc) = pack8(v0, v1); });
    }
};

__device__ __forceinline__ void norm_rows(const float* X, int row0, int nrows, const float* g, const float* mod, int layer, int ish, bf16_t* H, int gw, int ngw, int lane) {
    f32x4 gv[4];
#pragma unroll
    for (int j = 0; j < 4; ++j) gv[j] = *(const f32x4*)(g + 4 * lane + 256 * j);
    for (int r = row0 + gw; r < row0 + nrows; r += ngw) {
        const f32x4* xr = (const f32x4*)(X + (size_t)r * 1024) + lane;
        const float* mrow = mod + ((size_t)((r >> 12) * 2 + layer) * 6) * 1024;
        f32x4 v[4]; float s = 0.f;
#pragma unroll
        for (int j = 0; j < 4; ++j) { v[j] = xr[64 * j]; s += (v[j].x * v[j].x + v[j].y * v[j].y) + (v[j].z * v[j].z + v[j].w * v[j].w); }
        const float rstd = rsqrtf(wave_sum(s) * (1.f / 1024.f) + 1e-6f);
        unsigned long long* o8 = (unsigned long long*)(H + (size_t)r * 1024) + lane;
#pragma unroll
        for (int j = 0; j < 4; ++j) {
            const f32x4 sh = *(const f32x4*)(mrow + (size_t)ish * 1024 + 4 * lane + 256 * j), sc = *(const f32x4*)(mrow + (size_t)(ish + 1) * 1024 + 4 * lane + 256 * j);
            const f32x4 o = v[j] * rstd * gv[j] * (sc + 1.f) + sh;
            o8[64 * j] = (unsigned long long)pk2(o.x, o.y) | ((unsigned long long)pk2(o.z, o.w) << 32);
        }
    }
}


__device__ __forceinline__ void embed_rows(const float* xp, const float* xs, const float* er, const float* ec, float* X, const float* g, const float* mod, bf16_t* H, int gw, int ngw, int lane) {
    f32x4 gv[4];
#pragma unroll
    for (int j = 0; j < 4; ++j) gv[j] = *(const f32x4*)(g + 4 * lane + 256 * j);
    for (int r = gw; r < 20480; r += ngw) {
        const f32x4* xr = (const f32x4*)(r < 4096 ? xp + (size_t)r * 1024 : xs + (size_t)(r - 4096) * 1024) + lane;
        const float* mrow = mod + ((size_t)((r >> 12) * 2 + 0) * 6) * 1024;
        f32x4 v[4]; float s = 0.f;
#pragma unroll
        for (int j = 0; j < 4; ++j) v[j] = xr[64 * j];
        if (r >= 4096) { const int t = r & 4095, row = t >> 6, col = t & 63;
            v[0] = v[0] + *(const f32x4*)(er + row * 512 + 4 * lane); v[1] = v[1] + *(const f32x4*)(er + row * 512 + 256 + 4 * lane);
            v[2] = v[2] + *(const f32x4*)(ec + col * 512 + 4 * lane); v[3] = v[3] + *(const f32x4*)(ec + col * 512 + 256 + 4 * lane); }
        f32x4* xo = (f32x4*)(X + (size_t)r * 1024) + lane;
#pragma unroll
        for (int j = 0; j < 4; ++j) { xo[64 * j] = v[j]; s += (v[j].x * v[j].x + v[j].y * v[j].y) + (v[j].z * v[j].z + v[j].w * v[j].w); }
        const float rstd = rsqrtf(wave_sum(s) * (1.f / 1024.f) + 1e-6f);
        unsigned long long* o8 = (unsigned long long*)(H + (size_t)r * 1024) + lane;
#pragma unroll
        for (int j = 0; j < 4; ++j) {
            const f32x4 sh = *(const f32x4*)(mrow + 4 * lane + 256 * j), sc = *(const f32x4*)(mrow + 1024 + 4 * lane + 256 * j);
            const f32x4 o = v[j] * rstd * gv[j] * (sc + 1.f) + sh;
            o8[64 * j] = (unsigned long long)pk2(o.x, o.y) | ((unsigned long long)pk2(o.z, o.w) << 32);
        }
    }
}
__device__ __forceinline__ void gen_tables(unsigned char* ws, const WsMapT& m, long e0, long estride) {
    bf16_t* dftc = (bf16_t*)(ws + m.dftc); bf16_t* dl = (bf16_t*)(ws + m.dl256); bf16_t* fa2 = (bf16_t*)(ws + m.fa2); bf16_t* mbm = (bf16_t*)(ws + m.mb);
    float* er = (float*)(ws + m.pos); float* ec = er + 64 * 512;
    constexpr long N0 = 512 * 256, N1 = 256 * 512, N2 = 256 * 256, N3 = 16L * 256 * 512, N4 = 2 * 64 * 512;
    for (long e = e0; e < N0 + N1 + N2 + N3 + N4; e += estride) {
        long r = e;
        if (r < N0) { const int mrow = (int)(r >> 8), cp = (int)(r & 255), cc = mrow >> 1, ri = mrow & 1; const float x = 2.f * (float)((cc * cp) & 255) / 256.f;
            dftc[r] = (bf16_t)f2bf(ri == 0 ? cospif(x) : -sinpif(x)); continue; } r -= N0;
        if (r < N1) { const int l = (int)(r >> 9), k = (int)(r & 511), ri = k >> 8, lp = k & 255; const float x = 2.f * (float)((l * lp) & 255) / 256.f;
            dl[r] = (bf16_t)f2bf((ri == 0 ? cospif(x) : sinpif(x)) * (1.f / 256.f)); continue; } r -= N1;
        if (r < N2) { const int mrow = (int)(r >> 8), k = (int)(r & 255), sA = mrow >> 7, k1 = (mrow >> 1) & 63, ro = mrow & 1, ri = k >> 7, sB = (k >> 6) & 1, l1 = k & 63;
            const float x = 2.f * (float)((k1 * l1) & 63) / 64.f; float v = 0.f;
            if (sA == sB) v = (ro == ri) ? cospif(x) : (ro == 0 ? sinpif(x) : -sinpif(x));
            fa2[r] = (bf16_t)f2bf(v); continue; } r -= N2;
        if (r < N3) { const int q = (int)(r >> 17), mrow = (int)(r >> 9) & 255, k = (int)(r & 511), ko = mrow >> 6, k2 = mrow & 63, kop = k >> 7, ro = (k >> 6) & 1, l2 = k & 63;
            const int l = 4 * q + ko + 64 * k2; const float x = 2.f * (float)((l * l2) & 4095) / 4096.f; float v = 0.f;
            if (ko == kop) v = (ro == 0 ? cospif(x) : sinpif(x)) * (1.f / 1024.f);
            mbm[r] = (bf16_t)f2bf(v); continue; } r -= N3;
        { const int which = (int)(r >> 15), p = (int)(r >> 9) & 63, j = (int)(r & 511), i = j & 255;
            const float omega = 1.0f / powf(10000.0f, (float)i / 256.0f); const float ang = (float)p * omega;
            (which == 0 ? er : ec)[p * 512 + j] = (j < 256) ? sinf(ang) : cosf(ang); }
    }
}


__device__ __forceinline__ void final_rows(float* X, int row0, int nrows, const float* g, int gw, int ngw, int lane) {
    f32x4 gv[4];
#pragma unroll
    for (int j = 0; j < 4; ++j) gv[j] = *(const f32x4*)(g + 4 * lane + 256 * j);
    for (int r = row0 + gw; r < row0 + nrows; r += ngw) {
        f32x4* xr = (f32x4*)(X + (size_t)r * 1024) + lane;
        f32x4 v[4]; float s = 0.f;
#pragma unroll
        for (int j = 0; j < 4; ++j) { v[j] = xr[64 * j]; s += (v[j].x * v[j].x + v[j].y * v[j].y) + (v[j].z * v[j].z + v[j].w * v[j].w); }
        const float rstd = rsqrtf(wave_sum(s) * (1.f / 1024.f) + 1e-6f);
#pragma unroll
        for (int j = 0; j < 4; ++j) xr[64 * j] = v[j] * rstd * gv[j];
    }
}
__device__ __forceinline__ void mod_unit(LAS unsigned char* lds, int unit, const float* c, const float* c_ctx, const float* ada_w, const float* ada_b, float* mod, int tid, int wave, int lane) {
    LAS float* sc = (LAS float*)lds;
    LAS float* red = (LAS float*)(lds + 20480);
    const int layer = unit / 48, n0 = (unit % 48) * 128;
    for (int i = tid; i < 5 * 1024; i += NTHREADS) { const int cond = i >> 10, k = i & 1023; const float x = cond == 0 ? c_ctx[k] : c[(cond - 1) * 1024 + k]; sc[i] = silu(x); }
    __syncthreads();
    const float* w = ada_w + ((size_t)layer * 1024 + wave * 128) * 6144 + n0 + 2 * lane;
    f32x2 acc[5];
#pragma unroll
    for (int q = 0; q < 5; ++q) acc[q] = (f32x2){0.f, 0.f};
#pragma unroll 8
    for (int k = 0; k < 128; ++k) {
        const f32x2 wv = *(const f32x2*)(w + (size_t)k * 6144);
#pragma unroll
        for (int q = 0; q < 5; ++q) acc[q] += wv * sc[q * 1024 + wave * 128 + k];
    }
#pragma unroll
    for (int q = 0; q < 5; ++q) { red[(wave * 5 + q) * 128 + 2 * lane] = acc[q].x; red[(wave * 5 + q) * 128 + 2 * lane + 1] = acc[q].y; }
    __syncthreads();
    for (int i = tid; i < 5 * 128; i += NTHREADS) { const int q = i >> 7, n = i & 127; float s = 0.f;
#pragma unroll
        for (int ww = 0; ww < 8; ++ww) s += red[(ww * 5 + q) * 128 + n];
        mod[((size_t)q * 2 + layer) * 6144 + n0 + n] = s + ada_b[(size_t)layer * 6144 + n0 + n]; }
    __syncthreads();
}

__device__ __forceinline__ void transpose_item(const float* W, int K, int N, bf16_t* WT, LAS float* scr, int item, int lane) {
    const int nblk = N / 32, kb = item / nblk, nb = item % nblk, k0 = 64 * kb, n0 = 32 * nb;
#pragma unroll 8
    for (int i = 0; i < 32; ++i) { const int kk = 2 * i + (lane >> 5); scr[kk * 33 + (lane & 31)] = W[(size_t)(k0 + kk) * N + n0 + (lane & 31)]; }
    asm volatile("s_waitcnt lgkmcnt(0)" ::: "memory");
    const int c = lane & 7;
#pragma unroll
    for (int j = 0; j < 4; ++j) { const int n = (lane >> 3) + 8 * j; const LAS float* s = scr + (8 * c) * 33 + n;
        u32x4 o; o.x = pk2(s[0 * 33], s[1 * 33]); o.y = pk2(s[2 * 33], s[3 * 33]); o.z = pk2(s[4 * 33], s[5 * 33]); o.w = pk2(s[6 * 33], s[7 * 33]);
        *(u32x4*)(WT + (size_t)(n0 + n) * K + k0 + 8 * c) = o; }
    asm volatile("s_waitcnt lgkmcnt(0)" ::: "memory");
}

typedef float f32x16 __attribute__((ext_vector_type(16)));
typedef short v4i16_t __attribute__((ext_vector_type(4)));
constexpr int QA_RS = 272, QP_RS = 264, KB_RS = 272, KPP_RS = 320, V_RS = 320;
constexpr int T_QA = 0, T_QP = T_QA + 32 * QA_RS, T_KB = T_QP + 32 * QP_RS, T_KPP = T_KB + 32 * KB_RS, T_V = T_KPP + 32 * KPP_RS, T_EL = T_V + 32 * V_RS, DIR_BYTES = T_EL + 512;
constexpr int OBUF_OFF = 2 * DIR_BYTES, OBUF_BYTES = 256 * 256;
static_assert(OBUF_OFF + OBUF_BYTES <= 160 * 1024 - 512 && (DIR_BYTES % 16) == 0 && (T_QP % 16) == 0 && (T_KB % 16) == 0 && (T_KPP % 16) == 0 && (T_V % 16) == 0 && (T_EL % 16) == 0, "scan LDS map");
constexpr int SLOT_ELEMS = 128 * 128;

struct ScanT { const bf16_t* q; const bf16_t* lffw; const bf16_t* lfbw; const bf16_t* v; bf16_t* sg; bf16_t* slots; float* dvec; const float* gnorm; const float* state_in; float* new_state; };

__device__ __forceinline__ bf16x8 tr_pair(const LAS unsigned char* p0, const LAS unsigned char* p1) {
    const v4i16_t lo = __builtin_amdgcn_ds_read_tr16_b64_v4i16((LAS v4i16_t*)p0), hi = __builtin_amdgcn_ds_read_tr16_b64_v4i16((LAS v4i16_t*)p1);
    return (bf16x8){lo[0], lo[1], lo[2], lo[3], hi[0], hi[1], hi[2], hi[3]};
}
__device__ __forceinline__ bf16x8 pack_acc8(const f32x16& x, int s8) {
    u32x4 w; w.x = cvt_pk_bf16(x[8 * s8 + 0], x[8 * s8 + 1]); w.y = cvt_pk_bf16(x[8 * s8 + 2], x[8 * s8 + 3]); w.z = cvt_pk_bf16(x[8 * s8 + 4], x[8 * s8 + 5]); w.w = cvt_pk_bf16(x[8 * s8 + 6], x[8 * s8 + 7]);
    return __builtin_bit_cast(bf16x8, w);
}
__device__ __forceinline__ float h2f(unsigned short b) { return (float)__builtin_bit_cast(_Float16, b); }

template <bool FULL>
__device__ __forceinline__ void scan_item(LAS unsigned char* lds, const ScanT& T, int tok0, int h, bool act0, bool act1, const bf16_t* init0, const bf16_t* init1,
                                          float* fin0, float* fin1, bf16_t* outs0, bf16_t* outs1, float* outd0, float* outd1) {
    const int tid = threadIdx.x, wave = __builtin_amdgcn_readfirstlane(tid >> 6), dir = wave >> 2, wg = wave & 3;
    const bool act = dir ? act1 : act0;
    const bf16_t* init = dir ? init1 : init0;
    LAS unsigned char* D = lds + dir * DIR_BYTES;
    LAS unsigned char* OB = lds + OBUF_OFF;
    const bf16_t* lfp = dir ? T.lfbw : T.lffw;
#define SCAN_LANE(x) int x; asm volatile("v_mbcnt_lo_u32_b32 %0, -1, 0\n\tv_mbcnt_hi_u32_b32 %0, -1, %0" : "=v"(x))
#define SCAN_PREP_ROLE SCAN_LANE(ln_); const int pp = 16 * wg + (ln_ & 15), uu = ln_ >> 4, gt_ = wg * 64 + ln_, vt = gt_ >> 3, vc2 = gt_ & 7
#define SCAN_MFMA_ROLE SCAN_LANE(ln_); const int l31 = ln_ & 31, hh = ln_ >> 5, gq = (ln_ & 15) >> 2, gp = ln_ & 3, vcol = 16 * ((ln_ >> 4) & 1)
    f32x16 S[4];
#pragma unroll
    for (int t4 = 0; t4 < 4; ++t4) {
        if (init && act) { SCAN_LANE(lane); const u32x4* sp = (const u32x4*)(init + ((size_t)(wg * 4 + t4) * 64 + lane) * 16); const u32x4 a = sp[0], b = sp[1];
            const unsigned w8[8] = {a.x, a.y, a.z, a.w, b.x, b.y, b.z, b.w};
#pragma unroll
            for (int j = 0; j < 8; ++j) { S[t4][2 * j] = __builtin_bit_cast(float, w8[j] << 16); S[t4][2 * j + 1] = __builtin_bit_cast(float, w8[j] & 0xffff0000u); } }
        else {
#pragma unroll
            for (int j = 0; j < 16; ++j) S[t4][j] = 0.f; }
    }
    float dsum0 = 0.f, dsum1 = 0.f;
    unsigned qreg[8], lfreg[8]; u32x4 vreg[2];
#define SCAN_LOAD(i) do { const int jsc_ = dir ? 7 - (i) : (i); \
        _Pragma("unroll") for (int e = 0; e < 8; ++e) { const int tl = 8 * uu + e; const size_t tk = (size_t)(tok0 + 32 * jsc_ + (dir ? 31 - tl : tl)) * 1024 + h * 128 + 2 * pp; \
            if (FULL) qreg[e] = *(const unsigned*)(T.q + tk); lfreg[e] = *(const unsigned*)(lfp + tk); } \
        { const size_t tk = (size_t)(tok0 + 32 * jsc_ + (dir ? 31 - vt : vt)) * 1024 + h * 128 + 16 * vc2; vreg[0] = *(const u32x4*)(T.v + tk); vreg[1] = *(const u32x4*)(T.v + tk + 8); } } while (0)
    if (act) { SCAN_PREP_ROLE; SCAN_LOAD(0); }
    for (int s = 0; s <= 16; ++s) {
        const int ph = s - dir;
        if (act && ph >= 0 && ph < 16) {
            const int i = ph >> 1;
            if ((ph & 1) == 0) {
                SCAN_PREP_ROLE; const int lane = ln_;
                *(LAS u32x4*)(D + T_V + vt * V_RS + vc2 * 32) = vreg[0]; *(LAS u32x4*)(D + T_V + vt * V_RS + vc2 * 32 + 16) = vreg[1];
                float c0[8], c1[8]; float a0 = 0.f, a1 = 0.f;
#pragma unroll
                for (int e = 0; e < 8; ++e) { a0 += h2f((unsigned short)(lfreg[e] & 0xffffu)); a1 += h2f((unsigned short)(lfreg[e] >> 16)); c0[e] = a0; c1[e] = a1; }
                float t0[4], t1[4];
#pragma unroll
                for (int u2 = 0; u2 < 4; ++u2) { t0[u2] = __shfl(a0, (lane & 15) + 16 * u2); t1[u2] = __shfl(a1, (lane & 15) + 16 * u2); }
                const float pre0 = (uu > 0 ? t0[0] : 0.f) + (uu > 1 ? t0[1] : 0.f) + (uu > 2 ? t0[2] : 0.f), pre1 = (uu > 0 ? t1[0] : 0.f) + (uu > 1 ? t1[1] : 0.f) + (uu > 2 ? t1[2] : 0.f);
                const float r0 = t0[0] + t0[1], r1 = t1[0] + t1[1], bl0 = r0 + t0[2] + t0[3], bl1 = r1 + t1[2] + t1[3];
                if (FULL) {
                    const float er0 = __expf(r0), er1 = __expf(r1), elr0 = __expf(bl0 - r0), elr1 = __expf(bl1 - r1);
#pragma unroll
                    for (int e = 0; e < 8; ++e) {
                        const int tl = 8 * uu + e;
                        const float d0 = pre0 + c0[e] - r0, d1 = pre1 + c1[e] - r1;
                        const float ea0 = __expf(d0), ea1 = __expf(d1), eb0 = __expf(-d0), eb1 = __expf(-d1);
                        const float k0 = 1.f - __expf(h2f((unsigned short)(lfreg[e] & 0xffffu))), k1 = 1.f - __expf(h2f((unsigned short)(lfreg[e] >> 16)));
                        const float q0 = __builtin_bit_cast(float, qreg[e] << 16), q1 = __builtin_bit_cast(float, qreg[e] & 0xffff0000u);
                        const float qa0 = q0 * ea0, qa1 = q1 * ea1, kb0 = k0 * eb0, kb1 = k1 * eb1;
                        *(LAS unsigned*)(D + T_QA + tl * QA_RS + 4 * pp) = cvt_pk_bf16(qa0, qa1);
                        *(LAS unsigned*)(D + T_QP + tl * QP_RS + 4 * pp) = cvt_pk_bf16(qa0 * er0, qa1 * er1);
                        *(LAS unsigned*)(D + T_KB + tl * KB_RS + 4 * pp) = cvt_pk_bf16(kb0, kb1);
                        *(LAS unsigned*)(D + T_KPP + tl * KPP_RS + 4 * pp) = cvt_pk_bf16(kb0 * elr0, kb1 * elr1);
                        if (e & 1) __builtin_amdgcn_sched_barrier(0);
                    }
                } else {
#pragma unroll
                    for (int e = 0; e < 8; ++e) {
                        const int tl = 8 * uu + e;
                        const float d0 = bl0 - (pre0 + c0[e]), d1 = bl1 - (pre1 + c1[e]);
                        const float k0 = 1.f - __expf(h2f((unsigned short)(lfreg[e] & 0xffffu))), k1 = 1.f - __expf(h2f((unsigned short)(lfreg[e] >> 16)));
                        *(LAS unsigned*)(D + T_KPP + tl * KPP_RS + 4 * pp) = cvt_pk_bf16(k0 * __expf(d0), k1 * __expf(d1));
                    }
                    dsum0 += bl0; dsum1 += bl1;
                }
                if (uu == 0) { *(LAS f32x2*)(D + T_EL + 8 * pp) = (f32x2){__expf(bl0), __expf(bl1)}; }
            } else {
                SCAN_MFMA_ROLE;
                if (FULL) {
                    f32x16 P;
#pragma unroll
                    for (int j = 0; j < 16; ++j) P[j] = 0.f;
#pragma unroll
                    for (int ks = 0; ks < 8; ++ks) {
                        const bf16x8 ka = *(const LAS bf16x8*)(D + T_KB + l31 * KB_RS + (16 * ks + 8 * hh) * 2);
                        const bf16x8 qb = *(const LAS bf16x8*)(D + T_QA + l31 * QA_RS + (16 * ks + 8 * hh) * 2);
                        P = __builtin_amdgcn_mfma_f32_32x32x16_bf16(ka, qb, P, 0, 0, 0);
                    }
#pragma unroll
                    for (int j = 0; j < 16; ++j) { const int srow = (j & 3) + 8 * (j >> 2) + 4 * hh; P[j] = (srow <= l31) ? P[j] : 0.f; }
                    f32x16 o;
#pragma unroll
                    for (int j = 0; j < 16; ++j) o[j] = 0.f;
#pragma unroll
                    for (int s8 = 0; s8 < 2; ++s8) {
                        const LAS unsigned char* vb = D + T_V + (16 * s8 + 4 * hh + gq) * V_RS + (32 * wg + vcol + 4 * gp) * 2;
                        const bf16x8 vf = tr_pair(vb, vb + 8 * V_RS);
                        o = __builtin_amdgcn_mfma_f32_32x32x16_bf16(pack_acc8(P, s8), vf, o, 0, 0, 0);
                    }
#pragma unroll
                    for (int t4 = 0; t4 < 4; ++t4)
#pragma unroll
                        for (int s8 = 0; s8 < 2; ++s8) {
                            const LAS unsigned char* qp = D + T_QP + l31 * QP_RS + (32 * t4 + 16 * s8 + 4 * hh) * 2;
                            const u32x2 lo = *(const LAS u32x2*)qp, hi = *(const LAS u32x2*)(qp + 16);
                            const u32x4 aw = {lo.x, lo.y, hi.x, hi.y};
                            o = __builtin_amdgcn_mfma_f32_32x32x16_bf16(__builtin_bit_cast(bf16x8, aw), pack_acc8(S[t4], s8), o, 0, 0, 0);
                            __builtin_amdgcn_sched_barrier(0);
                        }
                    const int jsc = dir ? 7 - i : i;
#pragma unroll
                    for (int j = 0; j < 16; ++j) {
                        const int tl = (j & 3) + 8 * (j >> 2) + 4 * hh;
                        LAS unsigned short* op = (LAS unsigned short*)(OB + (32 * jsc + (dir ? 31 - tl : tl)) * 256 + (32 * wg + l31) * 2);
                        float val = o[j];
                        if (i >= 4) val += bf2f(*op);
                        *op = (unsigned short)f2bf(val);
                    }
                }
                if (i < 7) { SCAN_PREP_ROLE; SCAN_LOAD(i + 1); }
                __builtin_amdgcn_sched_barrier(0);
#pragma unroll
                for (int t4 = 0; t4 < 4; ++t4) {
#pragma unroll
                    for (int g = 0; g < 4; ++g) { const f32x4 f = *(const LAS f32x4*)(D + T_EL + (32 * t4 + 8 * g + 4 * hh) * 4);
                        S[t4][4 * g + 0] *= f[0]; S[t4][4 * g + 1] *= f[1]; S[t4][4 * g + 2] *= f[2]; S[t4][4 * g + 3] *= f[3]; }
#pragma unroll
                    for (int s8 = 0; s8 < 2; ++s8) {
                        const LAS unsigned char* kb = D + T_KPP + (16 * s8 + 8 * hh + gq) * KPP_RS + (32 * t4 + vcol + 4 * gp) * 2;
                        const LAS unsigned char* vb = D + T_V + (16 * s8 + 8 * hh + gq) * V_RS + (32 * wg + vcol + 4 * gp) * 2;
                        const bf16x8 ka = tr_pair(kb, kb + 4 * KPP_RS), vf = tr_pair(vb, vb + 4 * V_RS);
                        S[t4] = __builtin_amdgcn_mfma_f32_32x32x16_bf16(ka, vf, S[t4], 0, 0, 0);
                    }
                    __builtin_amdgcn_sched_barrier(0);
                }
            }
        }
        __syncthreads();
    }
#undef SCAN_LOAD
    SCAN_MFMA_ROLE; SCAN_LANE(lane);
    if (FULL) {
        const int cv = tid & 15;
        f32x4 gn0 = *(const f32x4*)(T.gnorm + 8 * cv), gn1 = *(const f32x4*)(T.gnorm + 8 * cv + 4);
#pragma unroll 2
        for (int pass = 0; pass < 8; ++pass) {
            const int row = 32 * pass + (tid >> 4);
            const u32x4 ow = *(const LAS u32x4*)(OB + row * 256 + cv * 16);
            bf16_t* gp_ = T.sg + (size_t)(tok0 + row) * 1024 + h * 128 + 8 * cv;
            const u32x4 gw = *(const u32x4*)gp_;
            float ov[8], gv[8];
            const unsigned o4[4] = {ow.x, ow.y, ow.z, ow.w}, g4[4] = {gw.x, gw.y, gw.z, gw.w};
            float ss = 0.f;
#pragma unroll
            for (int j = 0; j < 4; ++j) { ov[2 * j] = __builtin_bit_cast(float, o4[j] << 16); ov[2 * j + 1] = __builtin_bit_cast(float, o4[j] & 0xffff0000u);
                gv[2 * j] = __builtin_bit_cast(float, g4[j] << 16); gv[2 * j + 1] = __builtin_bit_cast(float, g4[j] & 0xffff0000u);
                ss += ov[2 * j] * ov[2 * j] + ov[2 * j + 1] * ov[2 * j + 1]; }
            ss += __shfl_xor(ss, 1); ss += __shfl_xor(ss, 2); ss += __shfl_xor(ss, 4); ss += __shfl_xor(ss, 8);
            const float rstd = rsqrtf(ss * (1.f / 128.f) + 1e-6f);
            u32x4 w;
            w.x = cvt_pk_bf16(ov[0] * rstd * gn0[0] * gv[0], ov[1] * rstd * gn0[1] * gv[1]); w.y = cvt_pk_bf16(ov[2] * rstd * gn0[2] * gv[2], ov[3] * rstd * gn0[3] * gv[3]);
            w.z = cvt_pk_bf16(ov[4] * rstd * gn1[0] * gv[4], ov[5] * rstd * gn1[1] * gv[5]); w.w = cvt_pk_bf16(ov[6] * rstd * gn1[2] * gv[6], ov[7] * rstd * gn1[3] * gv[7]);
            *(u32x4*)gp_ = w;
        }
        float* fin = dir ? fin1 : fin0;
        if (fin && act) {
#pragma unroll
            for (int t4 = 0; t4 < 4; ++t4)
#pragma unroll
                for (int j = 0; j < 16; ++j) fin[(size_t)(32 * t4 + (j & 3) + 8 * (j >> 2) + 4 * hh) * 128 + 32 * wg + l31] = S[t4][j];
        }
        __syncthreads();
    } else {
        bf16_t* outs = dir ? outs1 : outs0; float* outd = dir ? outd1 : outd0;
        if (act) {
#pragma unroll
            for (int t4 = 0; t4 < 4; ++t4) {
                u32x4 a, b;
                a.x = cvt_pk_bf16(S[t4][0], S[t4][1]); a.y = cvt_pk_bf16(S[t4][2], S[t4][3]); a.z = cvt_pk_bf16(S[t4][4], S[t4][5]); a.w = cvt_pk_bf16(S[t4][6], S[t4][7]);
                b.x = cvt_pk_bf16(S[t4][8], S[t4][9]); b.y = cvt_pk_bf16(S[t4][10], S[t4][11]); b.z = cvt_pk_bf16(S[t4][12], S[t4][13]); b.w = cvt_pk_bf16(S[t4][14], S[t4][15]);
                u32x4* sp = (u32x4*)(outs + ((size_t)(wg * 4 + t4) * 64 + lane) * 16); sp[0] = a; sp[1] = b;
            }
            const int pp = 16 * wg + (lane & 15); if ((lane >> 4) == 0) { outd[2 * pp] = __expf(dsum0); outd[2 * pp + 1] = __expf(dsum1); }
        }
    }
}
__device__ __forceinline__ size_t slot_of(int dir, int b, int h, int sc) { return (size_t)((dir * 4 + b) * 8 + h) * 16 + sc; }

__device__ __forceinline__ void scan_phase_a(LAS unsigned char* lds, const ScanT& T, int G, int bx) {
    for (int it = bx; it < 512; it += G) {
        const int sc = it & 15, h = (it >> 4) & 7, b = it >> 7;
        const size_t sf = slot_of(0, b, h, sc < 15 ? sc + 1 : 0), sb = slot_of(1, b, h, sc > 0 ? sc - 1 : 0);
        scan_item<false>(lds, T, 4096 + b * 4096 + sc * 256, h, sc < 15, sc > 0, nullptr, nullptr, nullptr, nullptr, T.slots + sf * SLOT_ELEMS, T.slots + sb * SLOT_ELEMS, T.dvec + sf * 128, T.dvec + sb * 128);
    }
}
__device__ __forceinline__ void scan_phase_b(const ScanT& T, int G, int bx, int tid) {
    for (int gid = bx * NTHREADS + tid; gid < 64 * 2048; gid += G * NTHREADS) {
        const int combo = gid >> 11, e = (gid & 2047) * 8, dir = combo >> 5, b = (combo >> 3) & 3, h = combo & 7;
        const int reg0 = e & 15, ln = (e >> 4) & 63, t4 = (e >> 10) & 3, w = (e >> 12) & 3;
        const int v = 32 * w + (ln & 31);
        float s[8]; int kk[8];
#pragma unroll
        for (int j = 0; j < 8; ++j) { const int rg = reg0 + j; kk[j] = 32 * t4 + (rg & 3) + 8 * (rg >> 2) + 4 * (ln >> 5); s[j] = T.state_in[((size_t)((b * 2 + dir) * 8 + h) * 128 + kk[j]) * 128 + v]; }
        for (int st = 0; st < 16; ++st) {
            const int sc = dir ? 15 - st : st;
            const size_t sl = slot_of(dir, b, h, sc);
            u32x4* sp = (u32x4*)(T.slots + sl * SLOT_ELEMS + e);
            if (st > 0) {
                const u32x4 lw = *sp; const unsigned l4[4] = {lw.x, lw.y, lw.z, lw.w};
#pragma unroll
                for (int j = 0; j < 4; ++j) { s[2 * j] = T.dvec[sl * 128 + kk[2 * j]] * s[2 * j] + __builtin_bit_cast(float, l4[j] << 16);
                    s[2 * j + 1] = T.dvec[sl * 128 + kk[2 * j + 1]] * s[2 * j + 1] + __builtin_bit_cast(float, l4[j] & 0xffff0000u); }
            }
            u32x4 o; o.x = cvt_pk_bf16(s[0], s[1]); o.y = cvt_pk_bf16(s[2], s[3]); o.z = cvt_pk_bf16(s[4], s[5]); o.w = cvt_pk_bf16(s[6], s[7]);
            *sp = o;
        }
    }
}
__device__ __forceinline__ void scan_phase_c(LAS unsigned char* lds, const ScanT& T, int G, int bx) {
    for (int it = bx; it < 640; it += G) {
        if (it < 512) {
            const int sc = it & 15, h = (it >> 4) & 7, b = it >> 7;
            scan_item<true>(lds, T, 4096 + b * 4096 + sc * 256, h, true, true, T.slots + slot_of(0, b, h, sc) * SLOT_ELEMS, T.slots + slot_of(1, b, h, sc) * SLOT_ELEMS,
                            nullptr, nullptr, nullptr, nullptr, nullptr, nullptr);
        } else {
            const int h = (it - 512) & 7, b = (it - 512) >> 3;
            float* ns = T.new_state + (size_t)(b * 2) * 8 * 16384 + (size_t)h * 16384;
            scan_item<true>(lds, T, b * 256, h, true, true, nullptr, nullptr, ns, ns + (size_t)8 * 16384, nullptr, nullptr, nullptr, nullptr);
        }
    }
}

struct Args { const float* in[17]; float* out; unsigned char* ws; WsMap m; int ph_lo, ph_hi, row0, nrows; };
enum { PH_PREP = 0, PH_EMBED = 1, PH_FN_CHAN = 2, PH_FN_POS1 = 3, PH_FN_POS2 = 4, PH_FN_WO = 5, PH_NORM_MLP0 = 6, PH_MLP1_0 = 7, PH_MLP2_0 = 8, PH_NORM_MIX1 = 9, PH_WIN = 10,
       PH_SCAN_A = 11, PH_SCAN_B = 12, PH_SCAN_C = 13, PH_HG_WO = 14, PH_NORM_MLP1 = 15, PH_MLP1_1 = 16, PH_MLP2_1 = 17, PH_FINAL = 18, PH_END = 19 };
constexpr int LDS_BYTES = 160 * 1024;

__global__ void __launch_bounds__(NTHREADS, 2) fwd(Args a) {
    extern __shared__ __attribute__((aligned(16))) unsigned char lds_raw[];
    LAS unsigned char* lds = (LAS unsigned char*)lds_raw;
    const int tid = threadIdx.x, lane = tid & 63, wave = __builtin_amdgcn_readfirstlane(tid >> 6);
    const int G = gridDim.x, bx = blockIdx.x;
    const int gw = bx * NWAVES + wave, ngw = G * NWAVES;
    unsigned char* ws = a.ws;
    const float* mod = (const float*)(ws + a.m.mod);
    bf16_t* Hb = (bf16_t*)(ws + a.m.h);
    bf16_t* Big = (bf16_t*)(ws + a.m.big);
    const float* norm_mlp = a.in[8];
    const float* w1 = a.in[14]; const float* w2 = a.in[15];
    const float* norm_mix = a.in[7]; const float* fnet_wo = a.in[9];
    float* modw = (float*)(ws + a.m.mod);
#define IN(k) (a.ph_lo <= (k) && (k) < a.ph_hi)
    if (IN(PH_PREP)) {
        LAS float* scr = (LAS float*)(lds + wave * 16384);
        constexpr int I_1 = (1024 / 64) * (4096 / 32), I_2 = (4096 / 64) * (1024 / 32);
        constexpr int I_F = (1024 / 64) * (1024 / 32), I_W = (1024 / 64) * (5120 / 32);
        constexpr int NITEMS = I_1 + I_2 + I_F + I_F + I_W;
        for (int un = bx; un < 96; un += G) mod_unit(lds, un, a.in[3], a.in[4], a.in[5], a.in[6], modw, tid, wave, lane);
        if (bx == G - 1) for (int i = tid; i < 2048; i += NTHREADS) { const int dir = i >> 10, ch = i & 1023; const float l0 = a.in[11][(dir * 2 + 0) * 1024 + ch], l1 = a.in[11][(dir * 2 + 1) * 1024 + ch];
            const float mx = fmaxf(l0, l1), e0 = __expf(l0 - mx), e1 = __expf(l1 - mx); ((float*)(ws + a.m.lb))[i] = e1 / (e0 + e1); }
        gen_tables(ws, a.m, (long)bx * NTHREADS + tid, (long)G * NTHREADS);
        for (int it = gw; it < NITEMS; it += ngw) {
            int r = it;
            if (r < I_F) { transpose_item(fnet_wo, 1024, 1024, (bf16_t*)(ws + a.m.wfnet), scr, r, lane); continue; } r -= I_F;
            if (r < I_F) { transpose_item(a.in[13], 1024, 1024, (bf16_t*)(ws + a.m.who), scr, r, lane); continue; } r -= I_F;
            if (r < I_W) { transpose_item(a.in[10], 1024, 5120, (bf16_t*)(ws + a.m.win), scr, r, lane); continue; } r -= I_W;
            if (r < I_1) { transpose_item(w1, 1024, 4096, (bf16_t*)(ws + a.m.w1[0]), scr, r, lane); continue; } r -= I_1;
            transpose_item(w2, 4096, 1024, (bf16_t*)(ws + a.m.w2[0]), scr, r, lane);
        }
    }
    if (IN(PH_EMBED)) embed_rows(a.in[0], a.in[1], (const float*)(ws + a.m.pos), (const float*)(ws + a.m.pos) + 64 * 512, a.out, norm_mix, mod, Hb, gw, ngw, lane);
    if (IN(PH_FN_CHAN)) {
        { ProbChan p; p.init(0, ws + a.m.dftc, Hb, (bf16_t*)(ws + a.m.yctx), G, bx); gemm_phase<ProbChan, true, true>(lds, p); }
        { ProbChan p; p.init(1, ws + a.m.dftc, Hb, (bf16_t*)(ws + a.m.ysmp), G, bx); gemm_phase<ProbChan, true, true>(lds, p); }
    }
    if (IN(PH_FN_POS1)) {
        { ProbPosCtx p; p.init(ws + a.m.dl256, (const bf16_t*)(ws + a.m.yctx), Hb, G, bx); gemm_phase<ProbPosCtx, true, true>(lds, p); }
        { ProbSmpA p; p.init(ws + a.m.fa2, (const bf16_t*)(ws + a.m.ysmp), (bf16_t*)(ws + a.m.u), G, bx); gemm_phase<ProbSmpA, true, true>(lds, p); }
    }
    if (IN(PH_FN_POS2)) { ProbSmpB p; p.init(ws + a.m.mb, (const bf16_t*)(ws + a.m.u), Hb, G, bx); gemm_phase<ProbSmpB, true, true>(lds, p); }
    if (IN(PH_FN_WO)) { ProbResid p; p.init_tok(Hb, 1024, ws + a.m.wfnet, 1024, 0, 80, 4, G, bx); p.X = a.out; p.mod = mod; p.layer = 0; p.gidx = 2; gemm_phase<ProbResid, true, true>(lds, p); }
    if (IN(PH_NORM_MLP0)) norm_rows(a.out, a.row0, a.nrows, norm_mlp, mod, 0, 3, Hb, gw, ngw, lane);
    if (IN(PH_MLP1_0)) { ProbMlp1 p; p.init_tok(Hb, 1024, ws + a.m.w1[0], 1024, a.row0, a.nrows / BM, 4096 / BM, G, bx); p.O = Big; p.ldc = 4096; gemm_phase<ProbMlp1, true, true>(lds, p); }
    if (IN(PH_MLP2_0)) { ProbResid p; p.init_tok(Big, 4096, ws + a.m.w2[0], 4096, a.row0, a.nrows / BM, 1024 / BM, G, bx); p.X = a.out; p.mod = mod; p.layer = 0; p.gidx = 5; gemm_phase<ProbResid, true, true>(lds, p); }
    if (IN(PH_NORM_MIX1)) norm_rows(a.out, a.row0, a.nrows, norm_mix + 1024, mod, 1, 0, Hb, gw, ngw, lane);
    if (IN(PH_WIN)) { ProbWin p; p.init_tok(Hb, 1024, ws + a.m.win, 1024, 0, 80, 20, G, bx); p.Oq = (bf16_t*)(ws + a.m.q); p.Offw = (bf16_t*)(ws + a.m.lffw); p.Ofbw = (bf16_t*)(ws + a.m.lfbw);
        p.Ov = (bf16_t*)(ws + a.m.v); p.Osg = (bf16_t*)(ws + a.m.sg); p.lb = (const float*)(ws + a.m.lb); gemm_phase<ProbWin, true, true>(lds, p); }
    if (IN(PH_SCAN_A) || IN(PH_SCAN_B) || IN(PH_SCAN_C)) {
        ScanT st; st.q = (const bf16_t*)(ws + a.m.q); st.lffw = (const bf16_t*)(ws + a.m.lffw); st.lfbw = (const bf16_t*)(ws + a.m.lfbw); st.v = (const bf16_t*)(ws + a.m.v); st.sg = (bf16_t*)(ws + a.m.sg);
        st.slots = (bf16_t*)(ws + a.m.slots); st.dvec = (float*)(ws + a.m.dvec); st.gnorm = a.in[12]; st.state_in = a.in[2]; st.new_state = a.out + (size_t)20480 * 1024;
        if (IN(PH_SCAN_A)) scan_phase_a(lds, st, G, bx);
        if (IN(PH_SCAN_B)) scan_phase_b(st, G, bx, tid);
        if (IN(PH_SCAN_C)) scan_phase_c(lds, st, G, bx);
    }
    if (IN(PH_HG_WO)) {
        { LAS float* scr = (LAS float*)(lds + wave * 16384);
          constexpr int I_1 = (1024 / 64) * (4096 / 32), I_2 = (4096 / 64) * (1024 / 32);
          for (int it = gw; it < I_1 + I_2; it += ngw) {
              if (it < I_1) transpose_item(w1 + (size_t)1024 * 4096, 1024, 4096, (bf16_t*)(ws + a.m.w1[1]), scr, it, lane);
              else transpose_item(w2 + (size_t)4096 * 1024, 4096, 1024, (bf16_t*)(ws + a.m.w2[1]), scr, it - I_1, lane);
          }
          __syncthreads(); }
        ProbResid p; p.init_tok((bf16_t*)(ws + a.m.sg), 1024, ws + a.m.who, 1024, 0, 80, 4, G, bx); p.X = a.out; p.mod = mod; p.layer = 1; p.gidx = 2; gemm_phase<ProbResid, true, true>(lds, p); }
    if (IN(PH_NORM_MLP1)) norm_rows(a.out, a.row0, a.nrows, norm_mlp + 1024, mod, 1, 3, Hb, gw, ngw, lane);
    if (IN(PH_MLP1_1)) { ProbMlp1 p; p.init_tok(Hb, 1024, ws + a.m.w1[1], 1024, a.row0, a.nrows / BM, 4096 / BM, G, bx); p.O = Big; p.ldc = 4096; gemm_phase<ProbMlp1, true, true>(lds, p); }
    if (IN(PH_MLP2_1)) { ProbResid p; p.init_tok(Big, 4096, ws + a.m.w2[1], 4096, a.row0, a.nrows / BM, 1024 / BM, G, bx); p.X = a.out; p.mod = mod; p.layer = 1; p.gidx = 5; gemm_phase<ProbResid, true, true>(lds, p); }
    if (IN(PH_FINAL)) final_rows(a.out, a.row0, a.nrows, a.in[16], gw, ngw, lane);
#undef IN
}
}
extern "C" void kernel_launch(void* const* d_in, const int* in_sizes, int n_in, void* d_out, int out_size, void* d_ws, size_t ws_size, hipStream_t stream) {
    float* out = (float*)d_out;
    const size_t MiB = 1u << 20, KiB = 1024;
    fk::Args a{};
    for (int i = 0; i < 17; ++i) a.in[i] = (const float*)d_in[i];
    a.out = out; a.ws = (unsigned char*)d_ws;
    a.m.mod = 64 * KiB; a.m.lb = 320 * KiB; a.m.pos = 512 * KiB;
    a.m.who = 1 * MiB; a.m.win = 3 * MiB; a.m.h = 13 * MiB;
    a.m.dftc = 53 * MiB; a.m.dl256 = a.m.dftc + 256 * KiB; a.m.fa2 = a.m.dl256 + 256 * KiB; a.m.mb = 54 * MiB;
    a.m.wfnet = 59 * MiB; a.m.w1[0] = 61 * MiB; a.m.w2[0] = 69 * MiB; a.m.yctx = 77 * MiB; a.m.ysmp = 93 * MiB; a.m.u = 157 * MiB; a.m.big = 77 * MiB;
    a.m.q = 53 * MiB; a.m.lffw = 93 * MiB; a.m.lfbw = 133 * MiB; a.m.v = 173 * MiB; a.m.sg = 213 * MiB;
    a.m.w1[1] = 53 * MiB; a.m.w2[1] = 61 * MiB; a.m.slots = 13 * MiB; a.m.dvec = 45 * MiB;
    static int inited = 0;
    if (!inited) { hipFuncSetAttribute((const void*)fk::fwd, hipFuncAttributeMaxDynamicSharedMemorySize, fk::LDS_BYTES); inited = 1; }
    auto run_all = [&](int ph, size_t big) { fk::Args b = a; b.m.big = big; b.ph_lo = ph; b.ph_hi = ph + 1; b.row0 = 0; b.nrows = NTOK; hipLaunchKernelGGL(fk::fwd, dim3(256), dim3(512), fk::LDS_BYTES, stream, b); };
    for (int ph = fk::PH_PREP; ph <= fk::PH_WIN; ++ph) run_all(ph, 77 * MiB);
    for (int ph = fk::PH_SCAN_A; ph <= fk::PH_SCAN_C; ++ph) run_all(ph, 69 * MiB);
    for (int ph = fk::PH_HG_WO; ph <= fk::PH_FINAL; ++ph) run_all(ph, 69 * MiB);
}
```

```cpp
#include <hip/hip_runtime.h>
#include <cstdint>
#include <cstdio>
namespace fk {
#define LAS __attribute__((address_space(3)))
#define GAS __attribute__((address_space(1)))
typedef unsigned short bf16_t;
typedef short bf16x8 __attribute__((ext_vector_type(8)));
typedef float f32x4 __attribute__((ext_vector_type(4)));
typedef float f32x2 __attribute__((ext_vector_type(2)));
typedef unsigned u32x4 __attribute__((ext_vector_type(4)));
typedef unsigned u32x2 __attribute__((ext_vector_type(2)));
constexpr int BM = 256, BK = 64, HALF = 128, HTB = HALF * BK * 2, STAGE_BYTES = 8 * HTB, NXCD = 8, WGM = 8;
constexpr int NWAVES = 8, NTHREADS = 512;

__device__ __forceinline__ int lds_byte(int r, int c) { const int st = (r >> 4) * 2 + (c >> 5), rr = r & 15, cc = c & 31, ob = rr * 64 + cc * 2; return st * 1024 + (ob ^ (((ob >> 9) & 1) << 5)); }
__device__ __forceinline__ void stage_rc(int b, int& R, int& C) { const int st = b / 1024, sb = b % 1024, swz = sb ^ (((sb >> 9) & 1) << 5); R = (st >> 1) * 16 + swz / 64; C = (st & 1) * 32 + (swz % 64) / 2; }
__device__ __forceinline__ int perm32(int rho) { const int n = rho >> 4, i = rho & 15; return 8 * (i >> 2) + 4 * n + (i & 3); }
__device__ __forceinline__ unsigned cvt_pk_bf16(float lo, float hi) { unsigned r; asm volatile("v_cvt_pk_bf16_f32 %0, %1, %2" : "=v"(r) : "v"(lo), "v"(hi)); return r; }
__device__ __forceinline__ unsigned f2bf(float f) { unsigned u = __builtin_bit_cast(unsigned, f); return (u + 0x7fffu + ((u >> 16) & 1u)) >> 16; }
__device__ __forceinline__ unsigned pk2(float lo, float hi) { return f2bf(lo) | (f2bf(hi) << 16); }
__device__ __forceinline__ float bf2f(unsigned short b) { return __builtin_bit_cast(float, (unsigned)b << 16); }
__device__ __forceinline__ unsigned pk2h(float lo, float hi) { const _Float16 a = (_Float16)lo, b = (_Float16)hi; return (unsigned)__builtin_bit_cast(unsigned short, a) | ((unsigned)__builtin_bit_cast(unsigned short, b) << 16); }
__device__ __forceinline__ float silu(float x) { return x / (1.f + __expf(-x)); }
__device__ __forceinline__ float wave_sum(float v) {
#pragma unroll
    for (int o = 1; o < 64; o <<= 1) v += __shfl_xor(v, o);
    return v;
}

constexpr unsigned long long KiB = 1024ull, MiB = 1ull << 20;
struct WsMapT { unsigned long long slots, dvec, lb, q, lffw, lfbw, v, sg, mod, pos, dftc, dl256, fa2, mb, wfnet, who, win, w1[2], w2[2], h, yctx, ysmp, u, big[2]; };
constexpr WsMapT WM = {   13 * MiB,   45 * MiB,   320 * KiB,   53 * MiB,   93 * MiB,   133 * MiB,   173 * MiB,   213 * MiB,   64 * KiB,   512 * KiB,
      53 * MiB,   53 * MiB + 256 * KiB,   53 * MiB + 512 * KiB,   54 * MiB,   59 * MiB,   1 * MiB,   3 * MiB,   {61 * MiB, 53 * MiB},   {69 * MiB, 61 * MiB},
      13 * MiB,   77 * MiB,   93 * MiB,   157 * MiB,   {77 * MiB, 69 * MiB} };
constexpr unsigned long long CTL_BYTES = 16 * KiB;
struct Unit { size_t offA, offB; int p0, p1, p2, p3; };
struct OpMap { int rm; unsigned s1, s2; };
__device__ __forceinline__ unsigned rowoff(const OpMap& m, int R) { return (unsigned)(R % m.rm) * m.s1 + (unsigned)(R / m.rm) * m.s2; }

template <class P, bool ALIGN_EPI, bool SP2>
__device__ __forceinline__ void gemm_phase(LAS unsigned char* lds, const P& pb) {
    const int tid = threadIdx.x, wid = __builtin_amdgcn_readfirstlane(tid >> 6), lane = tid & 63, wr = wid >> 2, wc = wid & 3, fr = lane & 15, fq = lane >> 4;
    const int nt = pb.nt;
    unsigned voffA[2], voffB[2];
#pragma unroll
    for (int i = 0; i < 2; ++i) { int R, C; stage_rc(tid * 16 + i * 8192, R, C); const int Rb = P::PERM ? ((R & ~31) + perm32(R & 31)) : R;
        voffA[i] = rowoff(pb.ma, R) + (unsigned)C * 2u; voffB[i] = rowoff(pb.mb, Rb) + (unsigned)C * 2u; }
    const size_t kstepA = pb.kstepA, kstepB = pb.kstepB, hstepA = pb.hstepA, hstepB = pb.hstepB;
    const unsigned ldsw = (unsigned)wid * 1024u;
    const int aoff = lds_byte(wr * 64 + fr, fq * 8), boff = lds_byte(wc * 32 + fr, fq * 8);
#define PG8_SA(b, h) (((b) * 2 + (h)) * HTB)
#define PG8_SB(b, h) ((4 + (b) * 2 + (h)) * HTB)
#define PG8_STAGE(bufoff, gbase, voff) do { _Pragma("unroll") for (int _i = 0; _i < 2; ++_i) \
        __builtin_amdgcn_global_load_lds((const unsigned*)((const char*)(gbase) + (voff)[_i]), (LAS unsigned*)(lds + (bufoff) + ldsw + _i * 8192), 16, 0, 0); } while (0)
#define PG8_LDA(dst, b, h) do { _Pragma("unroll") for (int m = 0; m < 4; ++m) _Pragma("unroll") for (int k = 0; k < 2; ++k) dst[m][k] = *(const LAS bf16x8*)(lds + PG8_SA(b, h) + aoff + m * 2048 + k * 1024); } while (0)
#define PG8_LDB(dst, b, h) do { _Pragma("unroll") for (int n = 0; n < 2; ++n) _Pragma("unroll") for (int k = 0; k < 2; ++k) dst[n][k] = *(const LAS bf16x8*)(lds + PG8_SB(b, h) + boff + n * 2048 + k * 1024); } while (0)
#define PG8_MMA(ai, bj, At, Bt) do { __builtin_amdgcn_s_setprio(1); _Pragma("unroll") for (int m = 0; m < 4; ++m) _Pragma("unroll") for (int n = 0; n < 2; ++n) _Pragma("unroll") for (int k = 0; k < 2; ++k) \
        acc[ai][bj][m][n] = __builtin_amdgcn_mfma_f32_16x16x32_bf16(Bt[n][k], At[m][k], acc[ai][bj][m][n], 0, 0, 0); __builtin_amdgcn_s_setprio(0); } while (0)
#define PG8_WAIT_V(n) asm volatile("s_waitcnt vmcnt(" #n ")" ::: "memory")
#define PG8_WAIT_L(n) asm volatile("s_waitcnt lgkmcnt(" #n ")" ::: "memory")
#define PG8_BAR __builtin_amdgcn_s_barrier()
#define PG8_SCHED __builtin_amdgcn_sched_barrier(0)
    Unit cur, nxt; int ui = 0;
    if (!pb.next(0, cur)) return;
    f32x4 acc[2][2][4][2];
#pragma unroll
    for (int a = 0; a < 2; ++a)
#pragma unroll
        for (int b = 0; b < 2; ++b)
#pragma unroll
            for (int m = 0; m < 4; ++m)
#pragma unroll
                for (int n = 0; n < 2; ++n) acc[a][b][m][n] = (f32x4){0.f, 0.f, 0.f, 0.f};
    bf16x8 At[4][2], B0[2][2], B1[2][2];
    const char* cA = pb.A + cur.offA; const char* cB = pb.B + cur.offB;
    if constexpr (SP2) {
        PG8_STAGE(PG8_SB(0, 0), cB, voffB); PG8_STAGE(PG8_SB(0, 1), cB + hstepB, voffB); PG8_STAGE(PG8_SA(0, 0), cA, voffA); PG8_STAGE(PG8_SA(0, 1), cA + hstepA, voffA);
        if (wr == 1) PG8_BAR;
        PG8_WAIT_V(2); PG8_BAR;
        PG8_STAGE(PG8_SB(1, 0), cB + kstepB, voffB); PG8_STAGE(PG8_SA(1, 0), cA + kstepA, voffA); PG8_STAGE(PG8_SB(1, 1), cB + hstepB + kstepB, voffB);
        PG8_WAIT_V(6); PG8_BAR;
    } else {
        PG8_STAGE(PG8_SB(0, 0), cB, voffB); PG8_STAGE(PG8_SA(0, 0), cA, voffA); PG8_STAGE(PG8_SB(0, 1), cB + hstepB, voffB); PG8_STAGE(PG8_SA(0, 1), cA + hstepA, voffA);
        if (wr == 1) PG8_BAR;
        PG8_WAIT_V(4); PG8_BAR;
        PG8_STAGE(PG8_SB(1, 0), cB + kstepB, voffB); PG8_STAGE(PG8_SA(1, 0), cA + kstepA, voffA); PG8_STAGE(PG8_SB(1, 1), cB + hstepB + kstepB, voffB);
        PG8_WAIT_V(6); PG8_BAR;
    }
    for (;;) {
        const bool has_next = pb.next(ui + 1, nxt);
        const char* nA = has_next ? pb.A + nxt.offA : cA; const char* nB = has_next ? pb.B + nxt.offB : cB;
        for (int t = 0; t < nt; t += 2) {
            const bool last = (t == nt - 2);
            const char* a1 = cA + (size_t)(t + 1) * kstepA;
            const char* a2 = last ? nA : cA + (size_t)(t + 2) * kstepA; const char* b2 = last ? nB : cB + (size_t)(t + 2) * kstepB;
            const char* a3 = a2 + kstepA; const char* b3 = b2 + kstepB;
            if constexpr (SP2) {
            PG8_LDB(B0, 0, 0); PG8_LDB(B1, 0, 1); PG8_SCHED; PG8_LDA(At, 0, 0); PG8_STAGE(PG8_SA(1, 1), a1 + hstepA, voffA);
            PG8_WAIT_V(8); PG8_WAIT_L(0); PG8_BAR; PG8_MMA(0, 0, At, B0); PG8_MMA(0, 1, At, B1); PG8_BAR; PG8_SCHED;
            PG8_LDA(At, 0, 1); PG8_STAGE(PG8_SB(0, 0), b2, voffB); PG8_STAGE(PG8_SB(0, 1), b2 + hstepB, voffB); PG8_STAGE(PG8_SA(0, 0), a2, voffA);
            PG8_WAIT_V(8); PG8_WAIT_L(0); PG8_BAR; PG8_MMA(1, 0, At, B0); PG8_MMA(1, 1, At, B1); PG8_BAR; PG8_SCHED;
            PG8_LDB(B0, 1, 0); PG8_LDB(B1, 1, 1); PG8_SCHED; PG8_LDA(At, 1, 0); PG8_STAGE(PG8_SA(0, 1), a2 + hstepA, voffA);
            PG8_WAIT_V(8); PG8_WAIT_L(0); PG8_BAR; PG8_MMA(0, 0, At, B0); PG8_MMA(0, 1, At, B1); PG8_BAR; PG8_SCHED;
            PG8_LDA(At, 1, 1); PG8_STAGE(PG8_SB(1, 0), b3, voffB); PG8_STAGE(PG8_SB(1, 1), b3 + hstepB, voffB); PG8_STAGE(PG8_SA(1, 0), a3, voffA);
            PG8_WAIT_V(8); PG8_WAIT_L(0); PG8_BAR; PG8_MMA(1, 0, At, B0); PG8_MMA(1, 1, At, B1); PG8_BAR; PG8_SCHED;
            } else {
            PG8_LDB(B0, 0, 0); PG8_SCHED; PG8_LDA(At, 0, 0); PG8_STAGE(PG8_SA(1, 1), a1 + hstepA, voffA);
            PG8_WAIT_L(8); PG8_BAR; PG8_WAIT_L(0); PG8_MMA(0, 0, At, B0); PG8_BAR; PG8_SCHED;
            PG8_LDB(B1, 0, 1); PG8_STAGE(PG8_SB(0, 0), b2, voffB);
            PG8_BAR; PG8_WAIT_L(0); PG8_MMA(0, 1, At, B1); PG8_BAR;
            PG8_LDA(At, 0, 1); PG8_STAGE(PG8_SA(0, 0), a2, voffA);
            PG8_BAR; PG8_WAIT_L(0); PG8_MMA(1, 0, At, B0); PG8_BAR; PG8_SCHED;
            PG8_STAGE(PG8_SB(0, 1), b2 + hstepB, voffB);
            PG8_WAIT_V(6); PG8_BAR; PG8_MMA(1, 1, At, B1); PG8_BAR;
            PG8_LDB(B0, 1, 0); PG8_SCHED; PG8_LDA(At, 1, 0); PG8_STAGE(PG8_SA(0, 1), a2 + hstepA, voffA);
            PG8_WAIT_L(8); PG8_BAR; PG8_WAIT_L(0); PG8_MMA(0, 0, At, B0); PG8_BAR; PG8_SCHED;
            PG8_LDB(B1, 1, 1); PG8_STAGE(PG8_SB(1, 0), b3, voffB);
            PG8_BAR; PG8_WAIT_L(0); PG8_MMA(0, 1, At, B1); PG8_BAR;
            PG8_LDA(At, 1, 1); PG8_STAGE(PG8_SA(1, 0), a3, voffA);
            PG8_BAR; PG8_WAIT_L(0); PG8_MMA(1, 0, At, B0); PG8_BAR; PG8_SCHED;
            PG8_STAGE(PG8_SB(1, 1), b3 + hstepB, voffB);
            PG8_WAIT_V(6); PG8_BAR; PG8_MMA(1, 1, At, B1); PG8_BAR;
            }
        }
        if constexpr (ALIGN_EPI) { if (wr == 0) PG8_BAR; }
        pb.epi(acc, cur, wr, wc, fr, fq);
        if (!has_next) break;
#pragma unroll
        for (int a = 0; a < 2; ++a)
#pragma unroll
            for (int b = 0; b < 2; ++b)
#pragma unroll
                for (int m = 0; m < 4; ++m)
#pragma unroll
                    for (int n = 0; n < 2; ++n) acc[a][b][m][n] = (f32x4){0.f, 0.f, 0.f, 0.f};
        cur = nxt; cA = nA; cB = nB; ++ui;
        if constexpr (ALIGN_EPI) { if (wr == 1) PG8_BAR; }
    }
    PG8_WAIT_V(0);
    if constexpr (!ALIGN_EPI) { if (wr == 0) PG8_BAR; }
    PG8_BAR;
#undef PG8_SA
#undef PG8_SB
#undef PG8_STAGE
#undef PG8_LDA
#undef PG8_LDB
#undef PG8_MMA
#undef PG8_WAIT_V
#undef PG8_WAIT_L
#undef PG8_BAR
#undef PG8_SCHED
}

struct StaticOrder {
    int nM, nN, nwg, G, c;
    __device__ void init(int nM_, int nN_, int G_, int c_) { nM = nM_; nN = nN_; nwg = nM * nN; G = G_; c = c_; }
    __device__ bool next(int i, int& pm, int& pn) const {
        const long L = (long)i * G + c; if (L >= nwg) return false;
        int wgid = (int)L; { const int q = nwg / NXCD, r = nwg % NXCD, xcd = wgid % NXCD, off = wgid / NXCD; wgid = (xcd < r ? xcd * (q + 1) : r * (q + 1) + (xcd - r) * q) + off; }
        const int nig = WGM * nN, gid = wgid / nig, fm = gid * WGM, gsz = (nM - fm) < WGM ? (nM - fm) : WGM;
        pm = fm + ((wgid % nig) % gsz); pn = (wgid % nig) / gsz; return true;
    }
};

struct ProbBase {
    const char* A; const char* B; OpMap ma, mb; size_t hstepA, hstepB, kstepA, kstepB; int nt;
    __device__ void std_operands(const void* A_, int lda, const void* B_, int ldb, int K) {
        A = (const char*)A_; B = (const char*)B_; ma = OpMap{128, (unsigned)lda * 2u, 0u}; mb = OpMap{128, (unsigned)ldb * 2u, 0u};
        hstepA = (size_t)HALF * lda * 2; hstepB = (size_t)HALF * ldb * 2; kstepA = kstepB = BK * 2; nt = K / BK;
    }
};

template <class F> __device__ __forceinline__ void epi_rows_perm(const f32x4 (&acc)[2][2][4][2], int wr, int wc, int fr, int fq, F f) {
#pragma unroll
    for (int ai = 0; ai < 2; ++ai)
#pragma unroll
        for (int m = 0; m < 4; ++m)
#pragma unroll
            for (int bj = 0; bj < 2; ++bj) f(ai * HALF + wr * 64 + m * 16 + fr, bj * HALF + wc * 32 + 8 * fq, acc[ai][bj][m][0], acc[ai][bj][m][1]);
}
template <class F> __device__ __forceinline__ void epi_rows_f32(const f32x4 (&acc)[2][2][4][2], int wr, int wc, int fr, int fq, F f) {
#pragma unroll
    for (int ai = 0; ai < 2; ++ai)
#pragma unroll
        for (int m = 0; m < 4; ++m)
#pragma unroll
            for (int bj = 0; bj < 2; ++bj)
#pragma unroll
                for (int n = 0; n < 2; ++n) f(ai * HALF + wr * 64 + m * 16 + fr, bj * HALF + wc * 32 + 16 * n + 4 * fq, acc[ai][bj][m][n]);
}
__device__ __forceinline__ u32x4 pack8(const f32x4& v0, const f32x4& v1) { u32x4 w; w.x = cvt_pk_bf16(v0[0], v0[1]); w.y = cvt_pk_bf16(v0[2], v0[3]); w.z = cvt_pk_bf16(v1[0], v1[1]); w.w = cvt_pk_bf16(v1[2], v1[3]); return w; }

struct TokOrder : ProbBase {
    StaticOrder so; int row0, lda, ldb;
    __device__ void init_tok(const void* Act, int lda_, const void* Wt, int K, int row0_, int nM, int nN, int G, int c) { std_operands(Act, lda_, Wt, K, K); row0 = row0_; lda = lda_; ldb = K; so.init(nM, nN, G, c); }
    __device__ bool next(int i, Unit& u) const { int pm, pn; if (!so.next(i, pm, pn)) return false; u.p0 = pm; u.p1 = pn; u.offA = (size_t)(row0 + pm * BM) * lda * 2; u.offB = (size_t)pn * BM * ldb * 2; return true; }
};
struct ProbMlp1 : TokOrder {
    static constexpr bool PERM = true;
    bf16_t* O; int ldc;
    __device__ __forceinline__ void epi(const f32x4 (&acc)[2][2][4][2], const Unit& u, int wr, int wc, int fr, int fq) const {
        bf16_t* base = O + (size_t)(row0 + u.p0 * BM) * ldc + u.p1 * BM;
        epi_rows_perm(acc, wr, wc, fr, fq, [&](int r, int c, f32x4 v0, f32x4 v1) {
#pragma unroll
            for (int j = 0; j < 4; ++j) { const float a = fmaxf(v0[j], 0.f), b = fmaxf(v1[j], 0.f); v0[j] = a * a; v1[j] = b * b; }
            *(u32x4*)(base + (size_t)r * ldc + c) = pack8(v0, v1); });
    }
};
struct ProbResid : TokOrder {
    static constexpr bool PERM = false;
    float* X; const float* mod; int layer, gidx;
    __device__ __forceinline__ void epi(const f32x4 (&acc)[2][2][4][2], const Unit& u, int wr, int wc, int fr, int fq) const {
        const int rowt = row0 + u.p0 * BM, cond = rowt >> 12;
        const float* gate = mod + ((size_t)(cond * 2 + layer) * 6 + gidx) * 1024 + u.p1 * BM;
        float* base = X + (size_t)rowt * 1024 + u.p1 * BM;
        epi_rows_f32(acc, wr, wc, fr, fq, [&](int r, int c, f32x4 v) {
            const f32x4 g = *(const f32x4*)(gate + c); f32x4* p = (f32x4*)(base + (size_t)r * 1024 + c); *p = *p + g * v; });
    }
};


struct ProbWin : TokOrder {
    static constexpr bool PERM = true;
    bf16_t* Oq; bf16_t* Offw; bf16_t* Ofbw; bf16_t* Ov; bf16_t* Osg; const float* lb;
    __device__ __forceinline__ void epi(const f32x4 (&acc)[2][2][4][2], const Unit& u, int wr, int wc, int fr, int fq) const {
        const int t = u.p1 >> 2, col0 = (u.p1 & 3) * BM;
        bf16_t* O = t == 0 ? Oq : t == 1 ? Offw : t == 2 ? Ofbw : t == 3 ? Ov : Osg;
        bf16_t* base = O + (size_t)(row0 + u.p0 * BM) * 1024 + col0;
        if (t == 1 || t == 2) {
            const float* lbp = lb + (t - 1) * 1024 + col0;
            epi_rows_perm(acc, wr, wc, fr, fq, [&](int r, int c, f32x4 v0, f32x4 v1) {
                const f32x4 l0 = *(const f32x4*)(lbp + c), l1 = *(const f32x4*)(lbp + c + 4);
#pragma unroll
                for (int j = 0; j < 4; ++j) { v0[j] = __logf(l0[j] + (1.f - l0[j]) / (1.f + __expf(-v0[j]))); v1[j] = __logf(l1[j] + (1.f - l1[j]) / (1.f + __expf(-v1[j]))); }
                u32x4 w; w.x = pk2h(v0[0], v0[1]); w.y = pk2h(v0[2], v0[3]); w.z = pk2h(v1[0], v1[1]); w.w = pk2h(v1[2], v1[3]);
                *(u32x4*)(base + (size_t)r * 1024 + c) = w; });
        } else if (t == 3) {
            epi_rows_perm(acc, wr, wc, fr, fq, [&](int r, int c, f32x4 v0, f32x4 v1) { *(u32x4*)(base + (size_t)r * 1024 + c) = pack8(v0, v1); });
        } else {
            epi_rows_perm(acc, wr, wc, fr, fq, [&](int r, int c, f32x4 v0, f32x4 v1) {
#pragma unroll
                for (int j = 0; j < 4; ++j) { v0[j] = silu(v0[j]); v1[j] = silu(v1[j]); }
                *(u32x4*)(base + (size_t)r * 1024 + c) = pack8(v0, v1); });
        }
    }
};

struct ProbChan : ProbBase {
    static constexpr bool PERM = true;
    int mode, G, c, nunits; bf16_t* Y;
    __device__ void init(int mode_, const void* dftc, const bf16_t* h0, bf16_t* Y_, int G_, int c_) {
        mode = mode_; G = G_; c = c_; Y = Y_; A = (const char*)dftc; B = (const char*)h0; ma = OpMap{128, 512u, 0u}; hstepA = (size_t)HALF * 512; kstepA = kstepB = BK * 2; nt = 4;
        if (mode == 0) { mb = OpMap{128, 2048u, 0u}; hstepB = (size_t)HALF * 2048; nunits = 16 * 4 * 2; }
        else { mb = OpMap{64, 64u * 2048u, 2048u}; hstepB = 2 * 2048; nunits = 4 * 4 * 16 * 2; }
    }
    __device__ bool next(int i, Unit& u) const {
        const int L = i * G + c; if (L >= nunits) return false;
        const int mt = L & 1; u.p0 = mt; u.offA = (size_t)mt * 256 * 512;
        if (mode == 0) { const int g = (L >> 1) & 3, b = L >> 3; u.p1 = b * 2048 + g * 512; u.p2 = 0; u.offB = ((size_t)(b * 256) * 1024 + g * 256) * 2; }
        else { const int j = (L >> 1) & 15, g = (L >> 5) & 3, b = L >> 7; u.p1 = b * 2048 + g * 512; u.p2 = j * 256; u.offB = ((size_t)(4096 + b * 4096 + 4 * j) * 1024 + g * 256) * 2; }
        return true;
    }
    __device__ __forceinline__ void epi(const f32x4 (&acc)[2][2][4][2], const Unit& u, int wr, int wc, int fr, int fq) const {
        const int ldc = mode == 0 ? 256 : 4096;
        bf16_t* base = Y + (size_t)(u.p1 + u.p0 * 256) * ldc + u.p2;
        epi_rows_perm(acc, wr, wc, fr, fq, [&](int r, int cc, f32x4 v0, f32x4 v1) { *(u32x4*)(base + (size_t)r * ldc + cc) = pack8(v0, v1); });
    }
};
struct ProbPosCtx : ProbBase {
    static constexpr bool PERM = true;
    int G, c; bf16_t* Z;
    __device__ void init(const void* dl, const bf16_t* yctx, bf16_t* Z_, int G_, int c_) { std_operands(dl, 512, yctx, 512, 512); G = G_; c = c_; Z = Z_; }
    __device__ bool next(int i, Unit& u) const {
        const int L = i * G + c; if (L >= 64) return false;
        const int pn = L & 3, b = L >> 2; u.p0 = b; u.p1 = pn; u.offA = 0; u.offB = ((size_t)b * 2048 * 256 + (size_t)pn * 256 * 512) * 2; return true;
    }
    __device__ __forceinline__ void epi(const f32x4 (&acc)[2][2][4][2], const Unit& u, int wr, int wc, int fr, int fq) const {
        bf16_t* base = Z + (size_t)(u.p0 * 256) * 1024 + u.p1 * 256;
        epi_rows_perm(acc, wr, wc, fr, fq, [&](int r, int cc, f32x4 v0, f32x4 v1) { *(u32x4*)(base + (size_t)r * 1024 + cc) = pack8(v0, v1); });
    }
};
struct ProbSmpA : ProbBase {
    static constexpr bool PERM = true;
    int G, c; bf16_t* U;
    __device__ void init(const void* fa2, const bf16_t* yt, bf16_t* U_, int G_, int c_) {
        A = (const char*)fa2; B = (const char*)yt; ma = OpMap{128, 512u, 0u}; hstepA = (size_t)HALF * 512; kstepA = BK * 2;
        mb = OpMap{32, 128u, 16384u}; hstepB = 4 * 16384; kstepB = 4096; nt = 4; G = G_; c = c_; U = U_;
    }
    __device__ bool next(int i, Unit& u) const {
        const int L = i * G + c; if (L >= 512) return false;
        const int tau = L & 127, b = L >> 7; u.p0 = b; u.p1 = tau; u.offA = 0; u.offB = ((size_t)(b * 2048 + 16 * tau) * 4096) * 2; return true;
    }
    __device__ __forceinline__ void epi(const f32x4 (&acc)[2][2][4][2], const Unit& u, int wr, int wc, int fr, int fq) const {
        bf16_t* base = U + (size_t)(u.p0 * 1024 + 8 * u.p1) * 8192;
        epi_rows_perm(acc, wr, wc, fr, fq, [&](int r, int cc, f32x4 v0, f32x4 v1) {
            *(u32x4*)(base + (size_t)(cc >> 5) * 8192 + (r & 127) * 64 + (r >> 7) * 32 + (cc & 31)) = pack8(v0, v1); });
    }
};
struct ProbSmpB : ProbBase {
    static constexpr bool PERM = true;
    int G, c; bf16_t* Z;
    __device__ void init(const void* mbm, const bf16_t* Uin, bf16_t* Z_, int G_, int c_) { std_operands(mbm, 512, Uin, 8192, 512); G = G_; c = c_; Z = Z_; }
    __device__ bool next(int i, Unit& u) const {
        const int L = i * G + c; if (L >= 256) return false;
        const int pn = L & 3, q = (L >> 2) & 15, b = L >> 6; u.p0 = b; u.p1 = q; u.p2 = pn;
        u.offA = (size_t)q * 256 * 512 * 2; u.offB = ((size_t)(b * 1024 + pn * 256) * 8192 + q * 512) * 2; return true;
    }
    __device__ __forceinline__ void epi(const f32x4 (&acc)[2][2][4][2], const Unit& u, int wr, int wc, int fr, int fq) const {
        bf16_t* base = Z + (size_t)(4096 + u.p0 * 4096 + 4 * u.p1) * 1024 + u.p2 * 256;
        epi_rows_perm(acc, wr, wc, fr, fq, [&](int r, int cc, f32x4 v0, f32x4 v1) {
            const int l = (r >> 6) + 64 * (r & 63); *(u32x4*)(base + (size_t)l * 1024 + cc) = pack8(v0, v1); });
    }
};

__device__ __forceinline__ void norm_rows(const float* X, int row0, int nrows, const float* g, const float* mod, int layer, int ish, bf16_t* H, int gw, int ngw, int lane) {
    f32x4 gv[4];
#pragma unroll
    for (int j = 0; j < 4; ++j) gv[j] = *(const f32x4*)(g + 4 * lane + 256 * j);
    for (int r = row0 + gw; r < row0 + nrows; r += ngw) {
        const f32x4* xr = (const f32x4*)(X + (size_t)r * 1024) + lane;
        const float* mrow = mod + ((size_t)((r >> 12) * 2 + layer) * 6) * 1024;
        f32x4 v[4]; float s = 0.f;
#pragma unroll
        for (int j = 0; j < 4; ++j) { v[j] = xr[64 * j]; s += (v[j].x * v[j].x + v[j].y * v[j].y) + (v[j].z * v[j].z + v[j].w * v[j].w); }
        const float rstd = rsqrtf(wave_sum(s) * (1.f / 1024.f) + 1e-6f);
        unsigned long long* o8 = (unsigned long long*)(H + (size_t)r * 1024) + lane;
#pragma unroll
        for (int j = 0; j < 4; ++j) {
            const f32x4 sh = *(const f32x4*)(mrow + (size_t)ish * 1024 + 4 * lane + 256 * j), sc = *(const f32x4*)(mrow + (size_t)(ish + 1) * 1024 + 4 * lane + 256 * j);
            const f32x4 o = v[j] * rstd * gv[j] * (sc + 1.f) + sh;
            o8[64 * j] = (unsigned long long)pk2(o.x, o.y) | ((unsigned long long)pk2(o.z, o.w) << 32);
        }
    }
}


__device__ __forceinline__ void embed_rows(const float* xp, const float* xs, const float* er, const float* ec, float* X, const float* g, const float* mod, bf16_t* H, int gw, int ngw, int lane) {
    f32x4 gv[4];
#pragma unroll
    for (int j = 0; j < 4; ++j) gv[j] = *(const f32x4*)(g + 4 * lane + 256 * j);
    for (int r = gw; r < 20480; r += ngw) {
        const f32x4* xr = (const f32x4*)(r < 4096 ? xp + (size_t)r * 1024 : xs + (size_t)(r - 4096) * 1024) + lane;
        const float* mrow = mod + ((size_t)((r >> 12) * 2 + 0) * 6) * 1024;
        f32x4 v[4]; float s = 0.f;
#pragma unroll
        for (int j = 0; j < 4; ++j) v[j] = xr[64 * j];
        if (r >= 4096) { const int t = r & 4095, row = t >> 6, col = t & 63;
            v[0] = v[0] + *(const f32x4*)(er + row * 512 + 4 * lane); v[1] = v[1] + *(const f32x4*)(er + row * 512 + 256 + 4 * lane);
            v[2] = v[2] + *(const f32x4*)(ec + col * 512 + 4 * lane); v[3] = v[3] + *(const f32x4*)(ec + col * 512 + 256 + 4 * lane); }
        f32x4* xo = (f32x4*)(X + (size_t)r * 1024) + lane;
#pragma unroll
        for (int j = 0; j < 4; ++j) { xo[64 * j] = v[j]; s += (v[j].x * v[j].x + v[j].y * v[j].y) + (v[j].z * v[j].z + v[j].w * v[j].w); }
        const float rstd = rsqrtf(wave_sum(s) * (1.f / 1024.f) + 1e-6f);
        unsigned long long* o8 = (unsigned long long*)(H + (size_t)r * 1024) + lane;
#pragma unroll
        for (int j = 0; j < 4; ++j) {
            const f32x4 sh = *(const f32x4*)(mrow + 4 * lane + 256 * j), sc = *(const f32x4*)(mrow + 1024 + 4 * lane + 256 * j);
            const f32x4 o = v[j] * rstd * gv[j] * (sc + 1.f) + sh;
            o8[64 * j] = (unsigned long long)pk2(o.x, o.y) | ((unsigned long long)pk2(o.z, o.w) << 32);
        }
    }
}
__device__ __forceinline__ void gen_tables(unsigned char* ws, long e0, long estride) {
    bf16_t* dftc = (bf16_t*)(ws + WM.dftc); bf16_t* dl = (bf16_t*)(ws + WM.dl256); bf16_t* fa2 = (bf16_t*)(ws + WM.fa2); bf16_t* mbm = (bf16_t*)(ws + WM.mb);
    float* er = (float*)(ws + WM.pos); float* ec = er + 64 * 512;
    constexpr long N0 = 512 * 256, N1 = 256 * 512, N2 = 256 * 256, N3 = 16L * 256 * 512, N4 = 2 * 64 * 512;
    for (long e = e0; e < N0 + N1 + N2 + N3 + N4; e += estride) {
        long r = e;
        if (r < N0) { const int mrow = (int)(r >> 8), cp = (int)(r & 255), cc = mrow >> 1, ri = mrow & 1; const float x = 2.f * (float)((cc * cp) & 255) / 256.f;
            dftc[r] = (bf16_t)f2bf(ri == 0 ? cospif(x) : -sinpif(x)); continue; } r -= N0;
        if (r < N1) { const int l = (int)(r >> 9), k = (int)(r & 511), ri = k >> 8, lp = k & 255; const float x = 2.f * (float)((l * lp) & 255) / 256.f;
            dl[r] = (bf16_t)f2bf((ri == 0 ? cospif(x) : sinpif(x)) * (1.f / 256.f)); continue; } r -= N1;
        if (r < N2) { const int mrow = (int)(r >> 8), k = (int)(r & 255), sA = mrow >> 7, k1 = (mrow >> 1) & 63, ro = mrow & 1, ri = k >> 7, sB = (k >> 6) & 1, l1 = k & 63;
            const float x = 2.f * (float)((k1 * l1) & 63) / 64.f; float v = 0.f;
            if (sA == sB) v = (ro == ri) ? cospif(x) : (ro == 0 ? sinpif(x) : -sinpif(x));
            fa2[r] = (bf16_t)f2bf(v); continue; } r -= N2;
        if (r < N3) { const int q = (int)(r >> 17), mrow = (int)(r >> 9) & 255, k = (int)(r & 511), ko = mrow >> 6, k2 = mrow & 63, kop = k >> 7, ro = (k >> 6) & 1, l2 = k & 63;
            const int l = 4 * q + ko + 64 * k2; const float x = 2.f * (float)((l * l2) & 4095) / 4096.f; float v = 0.f;
            if (ko == kop) v = (ro == 0 ? cospif(x) : sinpif(x)) * (1.f / 1024.f);
            mbm[r] = (bf16_t)f2bf(v); continue; } r -= N3;
        { const int which = (int)(r >> 15), p = (int)(r >> 9) & 63, j = (int)(r & 511), i = j & 255;
            const float omega = 1.0f / powf(10000.0f, (float)i / 256.0f); const float ang = (float)p * omega;
            (which == 0 ? er : ec)[p * 512 + j] = (j < 256) ? sinf(ang) : cosf(ang); }
    }
}


__device__ __forceinline__ void final_rows(float* X, int row0, int nrows, const float* g, int gw, int ngw, int lane) {
    f32x4 gv[4];
#pragma unroll
    for (int j = 0; j < 4; ++j) gv[j] = *(const f32x4*)(g + 4 * lane + 256 * j);
    for (int r = row0 + gw; r < row0 + nrows; r += ngw) {
        f32x4* xr = (f32x4*)(X + (size_t)r * 1024) + lane;
        f32x4 v[4]; float s = 0.f;
#pragma unroll
        for (int j = 0; j < 4; ++j) { v[j] = xr[64 * j]; s += (v[j].x * v[j].x + v[j].y * v[j].y) + (v[j].z * v[j].z + v[j].w * v[j].w); }
        const float rstd = rsqrtf(wave_sum(s) * (1.f / 1024.f) + 1e-6f);
#pragma unroll
        for (int j = 0; j < 4; ++j) xr[64 * j] = v[j] * rstd * gv[j];
    }
}
__device__ __forceinline__ void mod_unit(LAS unsigned char* lds, int unit, const float* c, const float* c_ctx, const float* ada_w, const float* ada_b, float* mod, int tid, int wave, int lane) {
    LAS float* sc = (LAS float*)lds;
    LAS float* red = (LAS float*)(lds + 20480);
    const int layer = unit / 48, n0 = (unit % 48) * 128;
    for (int i = tid; i < 5 * 1024; i += NTHREADS) { const int cond = i >> 10, k = i & 1023; const float x = cond == 0 ? c_ctx[k] : c[(cond - 1) * 1024 + k]; sc[i] = silu(x); }
    __syncthreads();
    const float* w = ada_w + ((size_t)layer * 1024 + wave * 128) * 6144 + n0 + 2 * lane;
    f32x2 acc[5];
#pragma unroll
    for (int q = 0; q < 5; ++q) acc[q] = (f32x2){0.f, 0.f};
#pragma unroll 8
    for (int k = 0; k < 128; ++k) {
        const f32x2 wv = *(const f32x2*)(w + (size_t)k * 6144);
#pragma unroll
        for (int q = 0; q < 5; ++q) acc[q] += wv * sc[q * 1024 + wave * 128 + k];
    }
#pragma unroll
    for (int q = 0; q < 5; ++q) { red[(wave * 5 + q) * 128 + 2 * lane] = acc[q].x; red[(wave * 5 + q) * 128 + 2 * lane + 1] = acc[q].y; }
    __syncthreads();
    for (int i = tid; i < 5 * 128; i += NTHREADS) { const int q = i >> 7, n = i & 127; float s = 0.f;
#pragma unroll
        for (int ww = 0; ww < 8; ++ww) s += red[(ww * 5 + q) * 128 + n];
        mod[((size_t)q * 2 + layer) * 6144 + n0 + n] = s + ada_b[(size_t)layer * 6144 + n0 + n]; }
    __syncthreads();
}

__device__ __forceinline__ void transpose_item(const float* W, int K, int N, bf16_t* WT, LAS float* scr, int item, int lane) {
    const int nblk = N / 32, kb = item / nblk, nb = item % nblk, k0 = 64 * kb, n0 = 32 * nb;
#pragma unroll 8
    for (int i = 0; i < 32; ++i) { const int kk = 2 * i + (lane >> 5); scr[kk * 33 + (lane & 31)] = W[(size_t)(k0 + kk) * N + n0 + (lane & 31)]; }
    asm volatile("s_waitcnt lgkmcnt(0)" ::: "memory");
    const int c = lane & 7;
#pragma unroll
    for (int j = 0; j < 4; ++j) { const int n = (lane >> 3) + 8 * j; const LAS float* s = scr + (8 * c) * 33 + n;
        u32x4 o; o.x = pk2(s[0 * 33], s[1 * 33]); o.y = pk2(s[2 * 33], s[3 * 33]); o.z = pk2(s[4 * 33], s[5 * 33]); o.w = pk2(s[6 * 33], s[7 * 33]);
        *(u32x4*)(WT + (size_t)(n0 + n) * K + k0 + 8 * c) = o; }
    asm volatile("s_waitcnt lgkmcnt(0)" ::: "memory");
}

typedef float f32x16 __attribute__((ext_vector_type(16)));
typedef short v4i16_t __attribute__((ext_vector_type(4)));
constexpr int QA_RS = 272, QP_RS = 264, KB_RS = 272, KPP_RS = 320, V_RS = 320;
constexpr int T_QA = 0, T_QP = T_QA + 32 * QA_RS, T_KB = T_QP + 32 * QP_RS, T_KPP = T_KB + 32 * KB_RS, T_V = T_KPP + 32 * KPP_RS, T_EL = T_V + 32 * V_RS, DIR_BYTES = T_EL + 512;
constexpr int OBUF_OFF = 2 * DIR_BYTES, OBUF_BYTES = 256 * 256;
static_assert(OBUF_OFF + OBUF_BYTES <= 160 * 1024 - 512 && (DIR_BYTES % 16) == 0 && (T_QP % 16) == 0 && (T_KB % 16) == 0 && (T_KPP % 16) == 0 && (T_V % 16) == 0 && (T_EL % 16) == 0, "scan LDS map");
constexpr int SLOT_ELEMS = 128 * 128;

struct ScanT { const bf16_t* q; const bf16_t* lffw; const bf16_t* lfbw; const bf16_t* v; bf16_t* sg; bf16_t* slots; float* dvec; const float* gnorm; const float* state_in; float* new_state; };

__device__ __forceinline__ bf16x8 tr_pair(const LAS unsigned char* p0, const LAS unsigned char* p1) {
    const v4i16_t lo = __builtin_amdgcn_ds_read_tr16_b64_v4i16((LAS v4i16_t*)p0), hi = __builtin_amdgcn_ds_read_tr16_b64_v4i16((LAS v4i16_t*)p1);
    return (bf16x8){lo[0], lo[1], lo[2], lo[3], hi[0], hi[1], hi[2], hi[3]};
}
__device__ __forceinline__ bf16x8 pack_acc8(const f32x16& x, int s8) {
    u32x4 w; w.x = cvt_pk_bf16(x[8 * s8 + 0], x[8 * s8 + 1]); w.y = cvt_pk_bf16(x[8 * s8 + 2], x[8 * s8 + 3]); w.z = cvt_pk_bf16(x[8 * s8 + 4], x[8 * s8 + 5]); w.w = cvt_pk_bf16(x[8 * s8 + 6], x[8 * s8 + 7]);
    return __builtin_bit_cast(bf16x8, w);
}
__device__ __forceinline__ float h2f(unsigned short b) { return (float)__builtin_bit_cast(_Float16, b); }

template <bool FULL>
__device__ __forceinline__ void scan_item(LAS unsigned char* lds, const ScanT& T, int tok0, int h, bool act0, bool act1, const bf16_t* init0, const bf16_t* init1,
                                          float* fin0, float* fin1, bf16_t* outs0, bf16_t* outs1, float* outd0, float* outd1) {
    const int tid = threadIdx.x, wave = __builtin_amdgcn_readfirstlane(tid >> 6), dir = wave >> 2, wg = wave & 3;
    const bool act = dir ? act1 : act0;
    const bf16_t* init = dir ? init1 : init0;
    LAS unsigned char* D = lds + dir * DIR_BYTES;
    LAS unsigned char* OB = lds + OBUF_OFF;
    const bf16_t* lfp = dir ? T.lfbw : T.lffw;
#define SCAN_LANE(x) int x; asm volatile("v_mbcnt_lo_u32_b32 %0, -1, 0\n\tv_mbcnt_hi_u32_b32 %0, -1, %0" : "=v"(x))
#define SCAN_PREP_ROLE SCAN_LANE(ln_); const int pp = 16 * wg + (ln_ & 15), uu = ln_ >> 4, gt_ = wg * 64 + ln_, vt = gt_ >> 3, vc2 = gt_ & 7
#define SCAN_MFMA_ROLE SCAN_LANE(ln_); const int l31 = ln_ & 31, hh = ln_ >> 5, gq = (ln_ & 15) >> 2, gp = ln_ & 3, vcol = 16 * ((ln_ >> 4) & 1)
    f32x16 S[4];
#pragma unroll
    for (int t4 = 0; t4 < 4; ++t4) {
        if (init && act) { SCAN_LANE(lane); const u32x4* sp = (const u32x4*)(init + ((size_t)(wg * 4 + t4) * 64 + lane) * 16); const u32x4 a = sp[0], b = sp[1];
            const unsigned w8[8] = {a.x, a.y, a.z, a.w, b.x, b.y, b.z, b.w};
#pragma unroll
            for (int j = 0; j < 8; ++j) { S[t4][2 * j] = __builtin_bit_cast(float, w8[j] << 16); S[t4][2 * j + 1] = __builtin_bit_cast(float, w8[j] & 0xffff0000u); } }
        else {
#pragma unroll
            for (int j = 0; j < 16; ++j) S[t4][j] = 0.f; }
    }
    float dsum0 = 0.f, dsum1 = 0.f;
    unsigned qreg[8], lfreg[8]; u32x4 vreg[2];
#define SCAN_LOAD(i) do { const int jsc_ = dir ? 7 - (i) : (i); \
        _Pragma("unroll") for (int e = 0; e < 8; ++e) { const int tl = 8 * uu + e; const size_t tk = (size_t)(tok0 + 32 * jsc_ + (dir ? 31 - tl : tl)) * 1024 + h * 128 + 2 * pp; \
            if (FULL) qreg[e] = *(const unsigned*)(T.q + tk); lfreg[e] = *(const unsigned*)(lfp + tk); } \
        { const size_t tk = (size_t)(tok0 + 32 * jsc_ + (dir ? 31 - vt : vt)) * 1024 + h * 128 + 16 * vc2; vreg[0] = *(const u32x4*)(T.v + tk); vreg[1] = *(const u32x4*)(T.v + tk + 8); } } while (0)
    if (act) { SCAN_PREP_ROLE; SCAN_LOAD(0); }
    for (int s = 0; s <= 16; ++s) {
        const int ph = s - dir;
        if (act && ph >= 0 && ph < 16) {
            const int i = ph >> 1;
            if ((ph & 1) == 0) {
                SCAN_PREP_ROLE; const int lane = ln_;
                *(LAS u32x4*)(D + T_V + vt * V_RS + vc2 * 32) = vreg[0]; *(LAS u32x4*)(D + T_V + vt * V_RS + vc2 * 32 + 16) = vreg[1];
                float c0[8], c1[8]; float a0 = 0.f, a1 = 0.f;
#pragma unroll
                for (int e = 0; e < 8; ++e) { a0 += h2f((unsigned short)(lfreg[e] & 0xffffu)); a1 += h2f((unsigned short)(lfreg[e] >> 16)); c0[e] = a0; c1[e] = a1; }
                float t0[4], t1[4];
#pragma unroll
                for (int u2 = 0; u2 < 4; ++u2) { t0[u2] = __shfl(a0, (lane & 15) + 16 * u2); t1[u2] = __shfl(a1, (lane & 15) + 16 * u2); }
                const float pre0 = (uu > 0 ? t0[0] : 0.f) + (uu > 1 ? t0[1] : 0.f) + (uu > 2 ? t0[2] : 0.f), pre1 = (uu > 0 ? t1[0] : 0.f) + (uu > 1 ? t1[1] : 0.f) + (uu > 2 ? t1[2] : 0.f);
                const float r0 = t0[0] + t0[1], r1 = t1[0] + t1[1], bl0 = r0 + t0[2] + t0[3], bl1 = r1 + t1[2] + t1[3];
                if (FULL) {
                    const float er0 = __expf(r0), er1 = __expf(r1), elr0 = __expf(bl0 - r0), elr1 = __expf(bl1 - r1);
#pragma unroll
                    for (int e = 0; e < 8; ++e) {
                        const int tl = 8 * uu + e;
                        const float d0 = pre0 + c0[e] - r0, d1 = pre1 + c1[e] - r1;
                        const float ea0 = __expf(d0), ea1 = __expf(d1), eb0 = __expf(-d0), eb1 = __expf(-d1);
                        const float k0 = 1.f - __expf(h2f((unsigned short)(lfreg[e] & 0xffffu))), k1 = 1.f - __expf(h2f((unsigned short)(lfreg[e] >> 16)));
                        const float q0 = __builtin_bit_cast(float, qreg[e] << 16), q1 = __builtin_bit_cast(float, qreg[e] & 0xffff0000u);
                        const float qa0 = q0 * ea0, qa1 = q1 * ea1, kb0 = k0 * eb0, kb1 = k1 * eb1;
                        *(LAS unsigned*)(D + T_QA + tl * QA_RS + 4 * pp) = cvt_pk_bf16(qa0, qa1);
                        *(LAS unsigned*)(D + T_QP + tl * QP_RS + 4 * pp) = cvt_pk_bf16(qa0 * er0, qa1 * er1);
                        *(LAS unsigned*)(D + T_KB + tl * KB_RS + 4 * pp) = cvt_pk_bf16(kb0, kb1);
                        *(LAS unsigned*)(D + T_KPP + tl * KPP_RS + 4 * pp) = cvt_pk_bf16(kb0 * elr0, kb1 * elr1);
                        if (e & 1) __builtin_amdgcn_sched_barrier(0);
                    }
                } else {
#pragma unroll
                    for (int e = 0; e < 8; ++e) {
                        const int tl = 8 * uu + e;
                        const float d0 = bl0 - (pre0 + c0[e]), d1 = bl1 - (pre1 + c1[e]);
                        const float k0 = 1.f - __expf(h2f((unsigned short)(lfreg[e] & 0xffffu))), k1 = 1.f - __expf(h2f((unsigned short)(lfreg[e] >> 16)));
                        *(LAS unsigned*)(D + T_KPP + tl * KPP_RS + 4 * pp) = cvt_pk_bf16(k0 * __expf(d0), k1 * __expf(d1));
                    }
                    dsum0 += bl0; dsum1 += bl1;
                }
                if (uu == 0) { *(LAS f32x2*)(D + T_EL + 8 * pp) = (f32x2){__expf(bl0), __expf(bl1)}; }
            } else {
                SCAN_MFMA_ROLE;
                if (FULL) {
                    f32x16 P;
#pragma unroll
                    for (int j = 0; j < 16; ++j) P[j] = 0.f;
#pragma unroll
                    for (int ks = 0; ks < 8; ++ks) {
                        const bf16x8 ka = *(const LAS bf16x8*)(D + T_KB + l31 * KB_RS + (16 * ks + 8 * hh) * 2);
                        const bf16x8 qb = *(const LAS bf16x8*)(D + T_QA + l31 * QA_RS + (16 * ks + 8 * hh) * 2);
                        P = __builtin_amdgcn_mfma_f32_32x32x16_bf16(ka, qb, P, 0, 0, 0);
                    }
#pragma unroll
                    for (int j = 0; j < 16; ++j) { const int srow = (j & 3) + 8 * (j >> 2) + 4 * hh; P[j] = (srow <= l31) ? P[j] : 0.f; }
                    f32x16 o;
#pragma unroll
                    for (int j = 0; j < 16; ++j) o[j] = 0.f;
#pragma unroll
                    for (int s8 = 0; s8 < 2; ++s8) {
                        const LAS unsigned char* vb = D + T_V + (16 * s8 + 4 * hh + gq) * V_RS + (32 * wg + vcol + 4 * gp) * 2;
                        const bf16x8 vf = tr_pair(vb, vb + 8 * V_RS);
                        o = __builtin_amdgcn_mfma_f32_32x32x16_bf16(pack_acc8(P, s8), vf, o, 0, 0, 0);
                    }
#pragma unroll
                    for (int t4 = 0; t4 < 4; ++t4)
#pragma unroll
                        for (int s8 = 0; s8 < 2; ++s8) {
                            const LAS unsigned char* qp = D + T_QP + l31 * QP_RS + (32 * t4 + 16 * s8 + 4 * hh) * 2;
                            const u32x2 lo = *(const LAS u32x2*)qp, hi = *(const LAS u32x2*)(qp + 16);
                            const u32x4 aw = {lo.x, lo.y, hi.x, hi.y};
                            o = __builtin_amdgcn_mfma_f32_32x32x16_bf16(__builtin_bit_cast(bf16x8, aw), pack_acc8(S[t4], s8), o, 0, 0, 0);
                            __builtin_amdgcn_sched_barrier(0);
                        }
                    const int jsc = dir ? 7 - i : i;
#pragma unroll
                    for (int j = 0; j < 16; ++j) {
                        const int tl = (j & 3) + 8 * (j >> 2) + 4 * hh;
                        LAS unsigned short* op = (LAS unsigned short*)(OB + (32 * jsc + (dir ? 31 - tl : tl)) * 256 + (32 * wg + l31) * 2);
                        float val = o[j];
                        if (i >= 4) val += bf2f(*op);
                        *op = (unsigned short)f2bf(val);
                    }
                }
                if (i < 7) { SCAN_PREP_ROLE; SCAN_LOAD(i + 1); }
                __builtin_amdgcn_sched_barrier(0);
#pragma unroll
                for (int t4 = 0; t4 < 4; ++t4) {
#pragma unroll
                    for (int g = 0; g < 4; ++g) { const f32x4 f = *(const LAS f32x4*)(D + T_EL + (32 * t4 + 8 * g + 4 * hh) * 4);
                        S[t4][4 * g + 0] *= f[0]; S[t4][4 * g + 1] *= f[1]; S[t4][4 * g + 2] *= f[2]; S[t4][4 * g + 3] *= f[3]; }
#pragma unroll
                    for (int s8 = 0; s8 < 2; ++s8) {
                        const LAS unsigned char* kb = D + T_KPP + (16 * s8 + 8 * hh + gq) * KPP_RS + (32 * t4 + vcol + 4 * gp) * 2;
                        const LAS unsigned char* vb = D + T_V + (16 * s8 + 8 * hh + gq) * V_RS + (32 * wg + vcol + 4 * gp) * 2;
                        const bf16x8 ka = tr_pair(kb, kb + 4 * KPP_RS), vf = tr_pair(vb, vb + 4 * V_RS);
                        S[t4] = __builtin_amdgcn_mfma_f32_32x32x16_bf16(ka, vf, S[t4], 0, 0, 0);
                    }
                    __builtin_amdgcn_sched_barrier(0);
                }
            }
        }
        __syncthreads();
    }
#undef SCAN_LOAD
    SCAN_MFMA_ROLE; SCAN_LANE(lane);
    if (FULL) {
        const int cv = tid & 15;
        f32x4 gn0 = *(const f32x4*)(T.gnorm + 8 * cv), gn1 = *(const f32x4*)(T.gnorm + 8 * cv + 4);
#pragma unroll 2
        for (int pass = 0; pass < 8; ++pass) {
            const int row = 32 * pass + (tid >> 4);
            const u32x4 ow = *(const LAS u32x4*)(OB + row * 256 + cv * 16);
            bf16_t* gp_ = T.sg + (size_t)(tok0 + row) * 1024 + h * 128 + 8 * cv;
            const u32x4 gw = *(const u32x4*)gp_;
            float ov[8], gv[8];
            const unsigned o4[4] = {ow.x, ow.y, ow.z, ow.w}, g4[4] = {gw.x, gw.y, gw.z, gw.w};
            float ss = 0.f;
#pragma unroll
            for (int j = 0; j < 4; ++j) { ov[2 * j] = __builtin_bit_cast(float, o4[j] << 16); ov[2 * j + 1] = __builtin_bit_cast(float, o4[j] & 0xffff0000u);
                gv[2 * j] = __builtin_bit_cast(float, g4[j] << 16); gv[2 * j + 1] = __builtin_bit_cast(float, g4[j] & 0xffff0000u);
                ss += ov[2 * j] * ov[2 * j] + ov[2 * j + 1] * ov[2 * j + 1]; }
            ss += __shfl_xor(ss, 1); ss += __shfl_xor(ss, 2); ss += __shfl_xor(ss, 4); ss += __shfl_xor(ss, 8);
            const float rstd = rsqrtf(ss * (1.f / 128.f) + 1e-6f);
            u32x4 w;
            w.x = cvt_pk_bf16(ov[0] * rstd * gn0[0] * gv[0], ov[1] * rstd * gn0[1] * gv[1]); w.y = cvt_pk_bf16(ov[2] * rstd * gn0[2] * gv[2], ov[3] * rstd * gn0[3] * gv[3]);
            w.z = cvt_pk_bf16(ov[4] * rstd * gn1[0] * gv[4], ov[5] * rstd * gn1[1] * gv[5]); w.w = cvt_pk_bf16(ov[6] * rstd * gn1[2] * gv[6], ov[7] * rstd * gn1[3] * gv[7]);
            *(u32x4*)gp_ = w;
        }
        float* fin = dir ? fin1 : fin0;
        if (fin && act) {
#pragma unroll
            for (int t4 = 0; t4 < 4; ++t4)
#pragma unroll
                for (int j = 0; j < 16; ++j) fin[(size_t)(32 * t4 + (j & 3) + 8 * (j >> 2) + 4 * hh) * 128 + 32 * wg + l31] = S[t4][j];
        }
        __syncthreads();
    } else {
        bf16_t* outs = dir ? outs1 : outs0; float* outd = dir ? outd1 : outd0;
        if (act) {
#pragma unroll
            for (int t4 = 0; t4 < 4; ++t4) {
                u32x4 a, b;
                a.x = cvt_pk_bf16(S[t4][0], S[t4][1]); a.y = cvt_pk_bf16(S[t4][2], S[t4][3]); a.z = cvt_pk_bf16(S[t4][4], S[t4][5]); a.w = cvt_pk_bf16(S[t4][6], S[t4][7]);
                b.x = cvt_pk_bf16(S[t4][8], S[t4][9]); b.y = cvt_pk_bf16(S[t4][10], S[t4][11]); b.z = cvt_pk_bf16(S[t4][12], S[t4][13]); b.w = cvt_pk_bf16(S[t4][14], S[t4][15]);
                u32x4* sp = (u32x4*)(outs + ((size_t)(wg * 4 + t4) * 64 + lane) * 16); sp[0] = a; sp[1] = b;
            }
            const int pp = 16 * wg + (lane & 15); if ((lane >> 4) == 0) { outd[2 * pp] = __expf(dsum0); outd[2 * pp + 1] = __expf(dsum1); }
        }
    }
}
__device__ __forceinline__ size_t slot_of(int dir, int b, int h, int sc) { return (size_t)((dir * 4 + b) * 8 + h) * 16 + sc; }

__device__ __forceinline__ void scan_phase_a(LAS unsigned char* lds, const ScanT& T, int G, int bx) {
    for (int it = bx; it < 512; it += G) {
        const int sc = it & 15, h = (it >> 4) & 7, b = it >> 7;
        const size_t sf = slot_of(0, b, h, sc < 15 ? sc + 1 : 0), sb = slot_of(1, b, h, sc > 0 ? sc - 1 : 0);
        scan_item<false>(lds, T, 4096 + b * 4096 + sc * 256, h, sc < 15, sc > 0, nullptr, nullptr, nullptr, nullptr, T.slots + sf * SLOT_ELEMS, T.slots + sb * SLOT_ELEMS, T.dvec + sf * 128, T.dvec + sb * 128);
    }
}
__device__ __forceinline__ void scan_phase_b(const ScanT& T, int G, int bx, int tid) {
    for (int gid = bx * NTHREADS + tid; gid < 64 * 2048; gid += G * NTHREADS) {
        const int combo = gid >> 11, e = (gid & 2047) * 8, dir = combo >> 5, b = (combo >> 3) & 3, h = combo & 7;
        const int reg0 = e & 15, ln = (e >> 4) & 63, t4 = (e >> 10) & 3, w = (e >> 12) & 3;
        const int v = 32 * w + (ln & 31);
        float s[8]; int kk[8];
#pragma unroll
        for (int j = 0; j < 8; ++j) { const int rg = reg0 + j; kk[j] = 32 * t4 + (rg & 3) + 8 * (rg >> 2) + 4 * (ln >> 5); s[j] = T.state_in[((size_t)((b * 2 + dir) * 8 + h) * 128 + kk[j]) * 128 + v]; }
        for (int st = 0; st < 16; ++st) {
            const int sc = dir ? 15 - st : st;
            const size_t sl = slot_of(dir, b, h, sc);
            u32x4* sp = (u32x4*)(T.slots + sl * SLOT_ELEMS + e);
            if (st > 0) {
                const u32x4 lw = *sp; const unsigned l4[4] = {lw.x, lw.y, lw.z, lw.w};
#pragma unroll
                for (int j = 0; j < 4; ++j) { s[2 * j] = T.dvec[sl * 128 + kk[2 * j]] * s[2 * j] + __builtin_bit_cast(float, l4[j] << 16);
                    s[2 * j + 1] = T.dvec[sl * 128 + kk[2 * j + 1]] * s[2 * j + 1] + __builtin_bit_cast(float, l4[j] & 0xffff0000u); }
            }
            u32x4 o; o.x = cvt_pk_bf16(s[0], s[1]); o.y = cvt_pk_bf16(s[2], s[3]); o.z = cvt_pk_bf16(s[4], s[5]); o.w = cvt_pk_bf16(s[6], s[7]);
            *sp = o;
        }
    }
}
__device__ __forceinline__ void scan_phase_c(LAS unsigned char* lds, const ScanT& T, int G, int bx) {
    for (int it = bx; it < 640; it += G) {
        if (it < 512) {
            const int sc = it & 15, h = (it >> 4) & 7, b = it >> 7;
            scan_item<true>(lds, T, 4096 + b * 4096 + sc * 256, h, true, true, T.slots + slot_of(0, b, h, sc) * SLOT_ELEMS, T.slots + slot_of(1, b, h, sc) * SLOT_ELEMS,
                            nullptr, nullptr, nullptr, nullptr, nullptr, nullptr);
        } else {
            const int h = (it - 512) & 7, b = (it - 512) >> 3;
            float* ns = T.new_state + (size_t)(b * 2) * 8 * 16384 + (size_t)h * 16384;
            scan_item<true>(lds, T, b * 256, h, true, true, nullptr, nullptr, ns, ns + (size_t)8 * 16384, nullptr, nullptr, nullptr, nullptr);
        }
    }
}


#define XB_TMO      128
#define XB_XCNT(j)  (256  + 64 * (j))
#define XB_XSUB(j)  (1280 + 64 * (j))
#define XB_XGEN(j)  (2304 + 64 * (j))
#define XB_TOP      3328
#define XB_TOPGEN   3392
#define XCD_BAR_WORDS 3456
#define XB_SPIN_CAP (1u << 18)
__device__ __forceinline__ unsigned xb_ld(unsigned* p)              { return __hip_atomic_load(p, __ATOMIC_RELAXED, __HIP_MEMORY_SCOPE_AGENT); }
__device__ __forceinline__ unsigned xb_add(unsigned* p, unsigned v) { return __hip_atomic_fetch_add(p, v, __ATOMIC_RELAXED, __HIP_MEMORY_SCOPE_AGENT); }
__device__ __forceinline__ unsigned xb_xcc_id() { return (unsigned)__builtin_amdgcn_s_getreg((3 << 11) | 20) & 0xFu; }
#define XB_SPIN(cond, bar) do { unsigned _sp = 0; while (cond) { __builtin_amdgcn_s_sleep(1); \
    if ((++_sp & 255u) == 0u) { if (xb_ld(&(bar)[XB_TMO])) break; if (_sp > XB_SPIN_CAP) { atomicAdd(&(bar)[XB_TMO], 1u); break; } } } } while (0)
struct XcdBarrier { unsigned* bar; unsigned x; volatile LAS unsigned* st; };
__device__ __forceinline__ XcdBarrier xcd_barrier_post(unsigned* bar, volatile LAS unsigned* st) {
    XcdBarrier b; b.bar = bar; b.x = xb_xcc_id(); b.st = st;
    if (threadIdx.x == 0) (void)xb_add(&bar[XB_XCNT(b.x)], 1u);
    return b;
}
__device__ __forceinline__ void xcd_barrier_complete(unsigned* bar, unsigned x, unsigned& nloc, unsigned& nx) {
    const unsigned G = gridDim.x * gridDim.y * gridDim.z;
    unsigned sum, cnt, mine, sp = 0u;
    for (;;) {
        sum = 0u; cnt = 0u; mine = 0u;
#pragma unroll
        for (unsigned j = 0; j < 16; ++j) { const unsigned c = xb_ld(&bar[XB_XCNT(j)]); sum += c; cnt += (c > 0u) ? 1u : 0u; mine = (j == x) ? c : mine; }
        if (sum == G) break;
        __builtin_amdgcn_s_sleep(1);
        if ((++sp & 255u) == 0u) { if (xb_ld(&bar[XB_TMO])) break; if (sp > XB_SPIN_CAP) { atomicAdd(&bar[XB_TMO], 1u); break; } }
    }
    nloc = mine > 0u ? mine : 1u; nx = cnt > 0u ? cnt : 1u;
}
__device__ __forceinline__ void xcd_barrier(const XcdBarrier& b) {
    asm volatile("s_waitcnt vmcnt(0)" ::: "memory");
    __syncthreads();
    if (threadIdx.x == 0) {
        unsigned* bar = b.bar;
        __builtin_amdgcn_s_waitcnt(0);
        unsigned nloc = b.st[0], nx = b.st[1];
        if (nloc == 0u) { xcd_barrier_complete(bar, b.x, nloc, nx); b.st[0] = nloc; b.st[1] = nx; }
        const unsigned old = xb_add(&bar[XB_XSUB(b.x)], 1u);
        const unsigned gen = old / nloc;
        if (old + 1u == (gen + 1u) * nloc) {
            __builtin_amdgcn_fence(__ATOMIC_RELEASE, "agent");
            asm volatile("s_waitcnt vmcnt(0)" ::: "memory");
            const unsigned og = xb_add(&bar[XB_TOP], 1u);
            const unsigned tg = og / nx;
            if (og + 1u == (tg + 1u) * nx) xb_add(&bar[XB_TOPGEN], 1u);
            else XB_SPIN(xb_ld(&bar[XB_TOPGEN]) == tg, bar);
            __builtin_amdgcn_fence(__ATOMIC_ACQUIRE, "agent");
            xb_add(&bar[XB_XGEN(b.x)], 1u);
            asm volatile("s_waitcnt vmcnt(0)" ::: "memory");
        } else {
            XB_SPIN(xb_ld(&bar[XB_XGEN(b.x)]) == gen, bar);
            __builtin_amdgcn_fence(__ATOMIC_ACQUIRE, "agent");
            asm volatile("s_waitcnt vmcnt(0)" ::: "memory");
        }
    }
    __syncthreads();
}

struct Args { const float* in[17]; float* out; unsigned char* ws; int ph_lo, ph_hi; };
enum { PH_PREP = 0, PH_EMBED = 1, PH_FN_CHAN = 2, PH_FN_POS1 = 3, PH_FN_POS2 = 4, PH_FN_WO = 5, PH_NORM_MLP0 = 6, PH_MLP1_0 = 7, PH_MLP2_0 = 8, PH_NORM_MIX1 = 9, PH_WIN = 10,
       PH_SCAN_A = 11, PH_SCAN_B = 12, PH_SCAN_C = 13, PH_HG_WO = 14, PH_NORM_MLP1 = 15, PH_MLP1_1 = 16, PH_MLP2_1 = 17, PH_FINAL = 18, PH_END = 19 };
constexpr int LDS_BYTES = 160 * 1024, MISC_OFF = LDS_BYTES - 256;

__global__ void __launch_bounds__(NTHREADS, 2) fwd(Args a) {
    extern __shared__ __attribute__((aligned(16))) unsigned char lds_raw[];
    LAS unsigned char* lds = (LAS unsigned char*)lds_raw;
    const int tid = threadIdx.x, lane = tid & 63, wave = __builtin_amdgcn_readfirstlane(tid >> 6);
    const int G = gridDim.x, bx = blockIdx.x;
    const int gw = bx * NWAVES + wave, ngw = G * NWAVES;
    unsigned char* ws = a.ws;
    const float* mod = (const float*)(ws + WM.mod);
    bf16_t* Hb = (bf16_t*)(ws + WM.h);
    bf16_t* Big = (bf16_t*)(ws + WM.big[0]); bf16_t* Big1 = (bf16_t*)(ws + WM.big[1]);
    const float* norm_mlp = a.in[8];
    const float* w1 = a.in[14]; const float* w2 = a.in[15];
    const float* norm_mix = a.in[7]; const float* fnet_wo = a.in[9];
    float* modw = (float*)(ws + WM.mod);
#define IN(k) (a.ph_lo <= (k) && (k) < a.ph_hi)
    if (tid < 64) ((LAS unsigned*)(lds + MISC_OFF))[tid] = 0u;
    __syncthreads();
    XcdBarrier bar = xcd_barrier_post((unsigned*)ws, (volatile LAS unsigned*)(lds + MISC_OFF));
#define SEAM(k) do { if (IN(k) && IN((k) + 1)) xcd_barrier(bar); } while (0)
    if (IN(PH_PREP)) {
        LAS float* scr = (LAS float*)(lds + wave * 16384);
        constexpr int I_1 = (1024 / 64) * (4096 / 32), I_2 = (4096 / 64) * (1024 / 32);
        constexpr int I_F = (1024 / 64) * (1024 / 32), I_W = (1024 / 64) * (5120 / 32);
        constexpr int NITEMS = I_1 + I_2 + I_F + I_F + I_W;
        for (int un = bx; un < 96; un += G) mod_unit(lds, un, a.in[3], a.in[4], a.in[5], a.in[6], modw, tid, wave, lane);
        if (bx == G - 1) for (int i = tid; i < 2048; i += NTHREADS) { const int dir = i >> 10, ch = i & 1023; const float l0 = a.in[11][(dir * 2 + 0) * 1024 + ch], l1 = a.in[11][(dir * 2 + 1) * 1024 + ch];
            const float mx = fmaxf(l0, l1), e0 = __expf(l0 - mx), e1 = __expf(l1 - mx); ((float*)(ws + WM.lb))[i] = e1 / (e0 + e1); }
        gen_tables(ws, (long)bx * NTHREADS + tid, (long)G * NTHREADS);
        for (int it = gw; it < NITEMS; it += ngw) {
            int r = it;
            if (r < I_F) { transpose_item(fnet_wo, 1024, 1024, (bf16_t*)(ws + WM.wfnet), scr, r, lane); continue; } r -= I_F;
            if (r < I_F) { transpose_item(a.in[13], 1024, 1024, (bf16_t*)(ws + WM.who), scr, r, lane); continue; } r -= I_F;
            if (r < I_W) { transpose_item(a.in[10], 1024, 5120, (bf16_t*)(ws + WM.win), scr, r, lane); continue; } r -= I_W;
            if (r < I_1) { transpose_item(w1, 1024, 4096, (bf16_t*)(ws + WM.w1[0]), scr, r, lane); continue; } r -= I_1;
            transpose_item(w2, 4096, 1024, (bf16_t*)(ws + WM.w2[0]), scr, r, lane);
        }
    }
    SEAM(PH_PREP);
    if (IN(PH_EMBED)) embed_rows(a.in[0], a.in[1], (const float*)(ws + WM.pos), (const float*)(ws + WM.pos) + 64 * 512, a.out, norm_mix, mod, Hb, gw, ngw, lane);
    SEAM(PH_EMBED);
    if (IN(PH_FN_CHAN)) {
        { ProbChan p; p.init(0, ws + WM.dftc, Hb, (bf16_t*)(ws + WM.yctx), G, bx); gemm_phase<ProbChan, true, true>(lds, p); }
        { ProbChan p; p.init(1, ws + WM.dftc, Hb, (bf16_t*)(ws + WM.ysmp), G, bx); gemm_phase<ProbChan, true, true>(lds, p); }
    }
    SEAM(PH_FN_CHAN);
    if (IN(PH_FN_POS1)) {
        { ProbPosCtx p; p.init(ws + WM.dl256, (const bf16_t*)(ws + WM.yctx), Hb, G, bx); gemm_phase<ProbPosCtx, true, true>(lds, p); }
        { ProbSmpA p; p.init(ws + WM.fa2, (const bf16_t*)(ws + WM.ysmp), (bf16_t*)(ws + WM.u), G, bx); gemm_phase<ProbSmpA, true, true>(lds, p); }
    }
    SEAM(PH_FN_POS1);
    if (IN(PH_FN_POS2)) { ProbSmpB p; p.init(ws + WM.mb, (const bf16_t*)(ws + WM.u), Hb, G, bx); gemm_phase<ProbSmpB, true, true>(lds, p); }
    SEAM(PH_FN_POS2);
    if (IN(PH_FN_WO)) { ProbResid p; p.init_tok(Hb, 1024, ws + WM.wfnet, 1024, 0, 80, 4, G, bx); p.X = a.out; p.mod = mod; p.layer = 0; p.gidx = 2; gemm_phase<ProbResid, true, true>(lds, p); }
    SEAM(PH_FN_WO);
    if (IN(PH_NORM_MLP0)) norm_rows(a.out, 0, 20480, norm_mlp, mod, 0, 3, Hb, gw, ngw, lane);
    SEAM(PH_NORM_MLP0);
    if (IN(PH_MLP1_0)) { ProbMlp1 p; p.init_tok(Hb, 1024, ws + WM.w1[0], 1024, 0, 80, 4096 / BM, G, bx); p.O = Big; p.ldc = 4096; gemm_phase<ProbMlp1, true, true>(lds, p); }
    SEAM(PH_MLP1_0);
    if (IN(PH_MLP2_0)) { ProbResid p; p.init_tok(Big, 4096, ws + WM.w2[0], 4096, 0, 80, 1024 / BM, G, bx); p.X = a.out; p.mod = mod; p.layer = 0; p.gidx = 5; gemm_phase<ProbResid, true, true>(lds, p); }
    SEAM(PH_MLP2_0);
    if (IN(PH_NORM_MIX1)) norm_rows(a.out, 0, 20480, norm_mix + 1024, mod, 1, 0, Hb, gw, ngw, lane);
    SEAM(PH_NORM_MIX1);
    if (IN(PH_WIN)) { ProbWin p; p.init_tok(Hb, 1024, ws + WM.win, 1024, 0, 80, 20, G, bx); p.Oq = (bf16_t*)(ws + WM.q); p.Offw = (bf16_t*)(ws + WM.lffw); p.Ofbw = (bf16_t*)(ws + WM.lfbw);
        p.Ov = (bf16_t*)(ws + WM.v); p.Osg = (bf16_t*)(ws + WM.sg); p.lb = (const float*)(ws + WM.lb); gemm_phase<ProbWin, true, true>(lds, p); }
    SEAM(PH_WIN);
    if (IN(PH_SCAN_A) || IN(PH_SCAN_B) || IN(PH_SCAN_C)) {
        ScanT st; st.q = (const bf16_t*)(ws + WM.q); st.lffw = (const bf16_t*)(ws + WM.lffw); st.lfbw = (const bf16_t*)(ws + WM.lfbw); st.v = (const bf16_t*)(ws + WM.v); st.sg = (bf16_t*)(ws + WM.sg);
        st.slots = (bf16_t*)(ws + WM.slots); st.dvec = (float*)(ws + WM.dvec); st.gnorm = a.in[12]; st.state_in = a.in[2]; st.new_state = a.out + (size_t)20480 * 1024;
        if (IN(PH_SCAN_A)) scan_phase_a(lds, st, G, bx);
        SEAM(PH_SCAN_A);
        if (IN(PH_SCAN_B)) scan_phase_b(st, G, bx, tid);
        SEAM(PH_SCAN_B);
        if (IN(PH_SCAN_C)) scan_phase_c(lds, st, G, bx);
    }
    SEAM(PH_SCAN_C);
    if (IN(PH_HG_WO)) {
        { LAS float* scr = (LAS float*)(lds + wave * 16384);
          constexpr int I_1 = (1024 / 64) * (4096 / 32), I_2 = (4096 / 64) * (1024 / 32);
          for (int it = gw; it < I_1 + I_2; it += ngw) {
              if (it < I_1) transpose_item(w1 + (size_t)1024 * 4096, 1024, 4096, (bf16_t*)(ws + WM.w1[1]), scr, it, lane);
              else transpose_item(w2 + (size_t)4096 * 1024, 4096, 1024, (bf16_t*)(ws + WM.w2[1]), scr, it - I_1, lane);
          }
          __syncthreads(); }
        ProbResid p; p.init_tok((bf16_t*)(ws + WM.sg), 1024, ws + WM.who, 1024, 0, 80, 4, G, bx); p.X = a.out; p.mod = mod; p.layer = 1; p.gidx = 2; gemm_phase<ProbResid, true, true>(lds, p); }
    SEAM(PH_HG_WO);
    if (IN(PH_NORM_MLP1)) norm_rows(a.out, 0, 20480, norm_mlp + 1024, mod, 1, 3, Hb, gw, ngw, lane);
    SEAM(PH_NORM_MLP1);
    if (IN(PH_MLP1_1)) { ProbMlp1 p; p.init_tok(Hb, 1024, ws + WM.w1[1], 1024, 0, 80, 4096 / BM, G, bx); p.O = Big1; p.ldc = 4096; gemm_phase<ProbMlp1, true, true>(lds, p); }
    SEAM(PH_MLP1_1);
    if (IN(PH_MLP2_1)) { ProbResid p; p.init_tok(Big1, 4096, ws + WM.w2[1], 4096, 0, 80, 1024 / BM, G, bx); p.X = a.out; p.mod = mod; p.layer = 1; p.gidx = 5; gemm_phase<ProbResid, true, true>(lds, p); }
    SEAM(PH_MLP2_1);
    if (IN(PH_FINAL)) final_rows(a.out, 0, 20480, a.in[16], gw, ngw, lane);
#undef IN
}
}
#ifndef MK_N_LAUNCHES
#define MK_N_LAUNCHES 1
#endif
extern "C" void kernel_launch(void* const* d_in, const int* in_sizes, int n_in, void* d_out, int out_size, void* d_ws, size_t ws_size, hipStream_t stream) {
    static int grid = 0;
    if (grid == 0) {
        int dev = 0, cus = 0;
        if (hipGetDevice(&dev) != hipSuccess || hipDeviceGetAttribute(&cus, hipDeviceAttributeMultiprocessorCount, dev) != hipSuccess || cus <= 0) cus = 256;
        hipFuncSetAttribute((const void*)fk::fwd, hipFuncAttributeMaxDynamicSharedMemorySize, fk::LDS_BYTES);
        int per_cu = 0;
        if (hipOccupancyMaxActiveBlocksPerMultiprocessor(&per_cu, (const void*)fk::fwd, fk::NTHREADS, fk::LDS_BYTES) != hipSuccess || per_cu < 1)
            fprintf(stderr, "kernel_launch: occupancy query reports %d workgroups per CU\n", per_cu);
        (void)hipGetLastError();
        grid = cus;
    }
    hipMemsetAsync(d_ws, 0, fk::CTL_BYTES, stream);
    fk::Args a{};
    for (int i = 0; i < 17; ++i) a.in[i] = (const float*)d_in[i];
    a.out = (float*)d_out; a.ws = (unsigned char*)d_ws;
#if MK_N_LAUNCHES == 1
    a.ph_lo = 0; a.ph_hi = fk::PH_END;
    hipLaunchKernelGGL(fk::fwd, dim3(grid), dim3(fk::NTHREADS), fk::LDS_BYTES, stream, a);
#else
    for (int ph = 0; ph < fk::PH_END; ++ph) { a.ph_lo = ph; a.ph_hi = ph + 1; hipLaunchKernelGGL(fk::fwd, dim3(grid), dim3(fk::NTHREADS), fk::LDS_BYTES, stream, a); }
#endif
}
```

```cpp
#include <hip/hip_runtime.h>
#include <cstdint>
#include <cstdio>
namespace fk {
#define LAS __attribute__((address_space(3)))
#define GAS __attribute__((address_space(1)))
typedef unsigned short bf16_t;
typedef short bf16x8 __attribute__((ext_vector_type(8)));
typedef float f32x4 __attribute__((ext_vector_type(4)));
typedef float f32x2 __attribute__((ext_vector_type(2)));
typedef unsigned u32x4 __attribute__((ext_vector_type(4)));
typedef unsigned u32x2 __attribute__((ext_vector_type(2)));
constexpr int BM = 256, BK = 64, HALF = 128, HTB = HALF * BK * 2, STAGE_BYTES = 8 * HTB, NXCD = 8, WGM = 8;
constexpr int NWAVES = 8, NTHREADS = 512;

__device__ __forceinline__ int lds_byte(int r, int c) { const int st = (r >> 4) * 2 + (c >> 5), rr = r & 15, cc = c & 31, ob = rr * 64 + cc * 2; return st * 1024 + (ob ^ (((ob >> 9) & 1) << 5)); }
__device__ __forceinline__ void stage_rc(int b, int& R, int& C) { const int st = b / 1024, sb = b % 1024, swz = sb ^ (((sb >> 9) & 1) << 5); R = (st >> 1) * 16 + swz / 64; C = (st & 1) * 32 + (swz % 64) / 2; }
__device__ __forceinline__ int perm32(int rho) { const int n = rho >> 4, i = rho & 15; return 8 * (i >> 2) + 4 * n + (i & 3); }
__device__ __forceinline__ unsigned cvt_pk_bf16(float lo, float hi) { unsigned r; asm volatile("v_cvt_pk_bf16_f32 %0, %1, %2" : "=v"(r) : "v"(lo), "v"(hi)); return r; }
__device__ __forceinline__ unsigned f2bf(float f) { unsigned u = __builtin_bit_cast(unsigned, f); return (u + 0x7fffu + ((u >> 16) & 1u)) >> 16; }
__device__ __forceinline__ unsigned pk2(float lo, float hi) { return f2bf(lo) | (f2bf(hi) << 16); }
__device__ __forceinline__ float bf2f(unsigned short b) { return __builtin_bit_cast(float, (unsigned)b << 16); }
__device__ __forceinline__ unsigned pk2h(float lo, float hi) { const _Float16 a = (_Float16)lo, b = (_Float16)hi; return (unsigned)__builtin_bit_cast(unsigned short, a) | ((unsigned)__builtin_bit_cast(unsigned short, b) << 16); }
__device__ __forceinline__ float h2f_(unsigned short b) { return (float)__builtin_bit_cast(_Float16, b); }
__device__ __forceinline__ float silu(float x) { return x / (1.f + __expf(-x)); }
__device__ __forceinline__ float wave_sum(float v) {
#pragma unroll
    for (int o = 1; o < 64; o <<= 1) v += __shfl_xor(v, o);
    return v;
}

constexpr unsigned long long KiB = 1024ull, MiB = 1ull << 20;
struct WsMapT { unsigned long long slots, dvec, lb, q, lffw, lfbw, v, sg, mod, pos, dftc, dl256, fa2, mb, wfnet, who, win, w1[2], w2[2], h, yctx, ysmp, u, big[2]; };
constexpr WsMapT WM = {   13 * MiB,   45 * MiB,   320 * KiB,   53 * MiB,   93 * MiB,   133 * MiB,   173 * MiB,   213 * MiB,   64 * KiB,   512 * KiB,
      53 * MiB,   53 * MiB + 256 * KiB,   53 * MiB + 512 * KiB,   54 * MiB,   59 * MiB,   1 * MiB,   3 * MiB,   {61 * MiB, 53 * MiB},   {237 * MiB, 61 * MiB},
      13 * MiB,   77 * MiB,   93 * MiB,   157 * MiB,   {77 * MiB, 69 * MiB} };
constexpr unsigned long long SLAB_FN = 77 * MiB, SLAB_M0 = 53 * MiB, SLAB_HG = 69 * MiB, SLAB_M1 = 13 * MiB;
constexpr unsigned long long CTL_BYTES = 16 * KiB;
struct Unit { size_t offA, offB; int p0, p1, p2, p3, nt; };
struct OpMap { int rm; unsigned s1, s2; };
__device__ __forceinline__ unsigned rowoff(const OpMap& m, int R) { return (unsigned)(R % m.rm) * m.s1 + (unsigned)(R / m.rm) * m.s2; }

template <class P, bool ALIGN_EPI, bool SP2>
__device__ __forceinline__ void gemm_phase(LAS unsigned char* lds, const P& pb) {
    const int tid = threadIdx.x, wid = __builtin_amdgcn_readfirstlane(tid >> 6), lane = tid & 63, wr = wid >> 2, wc = wid & 3, fr = lane & 15, fq = lane >> 4;
    unsigned voffA[2], voffB[2];
#pragma unroll
    for (int i = 0; i < 2; ++i) { int R, C; stage_rc(tid * 16 + i * 8192, R, C); const int Rb = P::PERM ? ((R & ~31) + perm32(R & 31)) : R;
        voffA[i] = rowoff(pb.ma, R) + (unsigned)C * 2u; voffB[i] = rowoff(pb.mb, Rb) + (unsigned)C * 2u; }
    const size_t kstepA = pb.kstepA, kstepB = pb.kstepB, hstepA = pb.hstepA, hstepB = pb.hstepB;
    const unsigned ldsw = (unsigned)wid * 1024u;
    const int aoff = lds_byte(wr * 64 + fr, fq * 8), boff = lds_byte(wc * 32 + fr, fq * 8);
#define PG8_SA(b, h) (((b) * 2 + (h)) * HTB)
#define PG8_SB(b, h) ((4 + (b) * 2 + (h)) * HTB)
#define PG8_STAGE(bufoff, gbase, voff) do { _Pragma("unroll") for (int _i = 0; _i < 2; ++_i) \
        __builtin_amdgcn_global_load_lds((const unsigned*)((const char*)(gbase) + (voff)[_i]), (LAS unsigned*)(lds + (bufoff) + ldsw + _i * 8192), 16, 0, 0); } while (0)
#define PG8_LDA(dst, b, h) do { _Pragma("unroll") for (int m = 0; m < 4; ++m) _Pragma("unroll") for (int k = 0; k < 2; ++k) dst[m][k] = *(const LAS bf16x8*)(lds + PG8_SA(b, h) + aoff + m * 2048 + k * 1024); } while (0)
#define PG8_LDB(dst, b, h) do { _Pragma("unroll") for (int n = 0; n < 2; ++n) _Pragma("unroll") for (int k = 0; k < 2; ++k) dst[n][k] = *(const LAS bf16x8*)(lds + PG8_SB(b, h) + boff + n * 2048 + k * 1024); } while (0)
#define PG8_MMA(ai, bj, At, Bt) do { __builtin_amdgcn_s_setprio(1); _Pragma("unroll") for (int m = 0; m < 4; ++m) _Pragma("unroll") for (int n = 0; n < 2; ++n) _Pragma("unroll") for (int k = 0; k < 2; ++k) \
        acc[ai][bj][m][n] = __builtin_amdgcn_mfma_f32_16x16x32_bf16(Bt[n][k], At[m][k], acc[ai][bj][m][n], 0, 0, 0); __builtin_amdgcn_s_setprio(0); } while (0)
#define PG8_WAIT_V(n) asm volatile("s_waitcnt vmcnt(" #n ")" ::: "memory")
#define PG8_WAIT_L(n) asm volatile("s_waitcnt lgkmcnt(" #n ")" ::: "memory")
#define PG8_BAR __builtin_amdgcn_s_barrier()
#define PG8_SCHED __builtin_amdgcn_sched_barrier(0)
    Unit cur, nxt; int ui = 0;
    if (!pb.next(0, cur)) return;
    f32x4 acc[2][2][4][2];
#pragma unroll
    for (int a = 0; a < 2; ++a)
#pragma unroll
        for (int b = 0; b < 2; ++b)
#pragma unroll
            for (int m = 0; m < 4; ++m)
#pragma unroll
                for (int n = 0; n < 2; ++n) acc[a][b][m][n] = (f32x4){0.f, 0.f, 0.f, 0.f};
    bf16x8 At[4][2], B0[2][2], B1[2][2];
    const char* cA = pb.A + cur.offA; const char* cB = pb.B + cur.offB;
    if constexpr (SP2) {
        PG8_STAGE(PG8_SB(0, 0), cB, voffB); PG8_STAGE(PG8_SB(0, 1), cB + hstepB, voffB); PG8_STAGE(PG8_SA(0, 0), cA, voffA); PG8_STAGE(PG8_SA(0, 1), cA + hstepA, voffA);
        if (wr == 1) PG8_BAR;
        PG8_WAIT_V(2); PG8_BAR;
        PG8_STAGE(PG8_SB(1, 0), cB + kstepB, voffB); PG8_STAGE(PG8_SA(1, 0), cA + kstepA, voffA); PG8_STAGE(PG8_SB(1, 1), cB + hstepB + kstepB, voffB);
        PG8_WAIT_V(6); PG8_BAR;
    } else {
        PG8_STAGE(PG8_SB(0, 0), cB, voffB); PG8_STAGE(PG8_SA(0, 0), cA, voffA); PG8_STAGE(PG8_SB(0, 1), cB + hstepB, voffB); PG8_STAGE(PG8_SA(0, 1), cA + hstepA, voffA);
        if (wr == 1) PG8_BAR;
        PG8_WAIT_V(4); PG8_BAR;
        PG8_STAGE(PG8_SB(1, 0), cB + kstepB, voffB); PG8_STAGE(PG8_SA(1, 0), cA + kstepA, voffA); PG8_STAGE(PG8_SB(1, 1), cB + hstepB + kstepB, voffB);
        PG8_WAIT_V(6); PG8_BAR;
    }
    for (;;) {
        const bool has_next = pb.next(ui + 1, nxt);
        const char* nA = has_next ? pb.A + nxt.offA : cA; const char* nB = has_next ? pb.B + nxt.offB : cB;
        const int nt = cur.nt;
        for (int t = 0; t < nt; t += 2) {
            const bool last = (t == nt - 2);
            const char* a1 = cA + (size_t)(t + 1) * kstepA;
            const char* a2 = last ? nA : cA + (size_t)(t + 2) * kstepA; const char* b2 = last ? nB : cB + (size_t)(t + 2) * kstepB;
            const char* a3 = a2 + kstepA; const char* b3 = b2 + kstepB;
            if constexpr (SP2) {
            PG8_LDB(B0, 0, 0); PG8_LDB(B1, 0, 1); PG8_SCHED; PG8_LDA(At, 0, 0); PG8_STAGE(PG8_SA(1, 1), a1 + hstepA, voffA);
            PG8_WAIT_V(8); PG8_WAIT_L(0); PG8_BAR; PG8_MMA(0, 0, At, B0); PG8_MMA(0, 1, At, B1); PG8_BAR; PG8_SCHED;
            PG8_LDA(At, 0, 1); PG8_STAGE(PG8_SB(0, 0), b2, voffB); PG8_STAGE(PG8_SB(0, 1), b2 + hstepB, voffB); PG8_STAGE(PG8_SA(0, 0), a2, voffA);
            PG8_WAIT_V(8); PG8_WAIT_L(0); PG8_BAR; PG8_MMA(1, 0, At, B0); PG8_MMA(1, 1, At, B1); PG8_BAR; PG8_SCHED;
            PG8_LDB(B0, 1, 0); PG8_LDB(B1, 1, 1); PG8_SCHED; PG8_LDA(At, 1, 0); PG8_STAGE(PG8_SA(0, 1), a2 + hstepA, voffA);
            PG8_WAIT_V(8); PG8_WAIT_L(0); PG8_BAR; PG8_MMA(0, 0, At, B0); PG8_MMA(0, 1, At, B1); PG8_BAR; PG8_SCHED;
            PG8_LDA(At, 1, 1); PG8_STAGE(PG8_SB(1, 0), b3, voffB); PG8_STAGE(PG8_SB(1, 1), b3 + hstepB, voffB); PG8_STAGE(PG8_SA(1, 0), a3, voffA);
            PG8_WAIT_V(8); PG8_WAIT_L(0); PG8_BAR; PG8_MMA(1, 0, At, B0); PG8_MMA(1, 1, At, B1); PG8_BAR; PG8_SCHED;
            } else {
            PG8_LDB(B0, 0, 0); PG8_SCHED; PG8_LDA(At, 0, 0); PG8_STAGE(PG8_SA(1, 1), a1 + hstepA, voffA);
            PG8_WAIT_L(8); PG8_BAR; PG8_WAIT_L(0); PG8_MMA(0, 0, At, B0); PG8_BAR; PG8_SCHED;
            PG8_LDB(B1, 0, 1); PG8_STAGE(PG8_SB(0, 0), b2, voffB);
            PG8_BAR; PG8_WAIT_L(0); PG8_MMA(0, 1, At, B1); PG8_BAR;
            PG8_LDA(At, 0, 1); PG8_STAGE(PG8_SA(0, 0), a2, voffA);
            PG8_BAR; PG8_WAIT_L(0); PG8_MMA(1, 0, At, B0); PG8_BAR; PG8_SCHED;
            PG8_STAGE(PG8_SB(0, 1), b2 + hstepB, voffB);
            PG8_WAIT_V(6); PG8_BAR; PG8_MMA(1, 1, At, B1); PG8_BAR;
            PG8_LDB(B0, 1, 0); PG8_SCHED; PG8_LDA(At, 1, 0); PG8_STAGE(PG8_SA(0, 1), a2 + hstepA, voffA);
            PG8_WAIT_L(8); PG8_BAR; PG8_WAIT_L(0); PG8_MMA(0, 0, At, B0); PG8_BAR; PG8_SCHED;
            PG8_LDB(B1, 1, 1); PG8_STAGE(PG8_SB(1, 0), b3, voffB);
            PG8_BAR; PG8_WAIT_L(0); PG8_MMA(0, 1, At, B1); PG8_BAR;
            PG8_LDA(At, 1, 1); PG8_STAGE(PG8_SA(1, 0), a3, voffA);
            PG8_BAR; PG8_WAIT_L(0); PG8_MMA(1, 0, At, B0); PG8_BAR; PG8_SCHED;
            PG8_STAGE(PG8_SB(1, 1), b3 + hstepB, voffB);
            PG8_WAIT_V(6); PG8_BAR; PG8_MMA(1, 1, At, B1); PG8_BAR;
            }
        }
        if constexpr (ALIGN_EPI) { if (wr == 0) PG8_BAR; }
        pb.epi(acc, cur, wr, wc, fr, fq);
        if (!has_next) break;
#pragma unroll
        for (int a = 0; a < 2; ++a)
#pragma unroll
            for (int b = 0; b < 2; ++b)
#pragma unroll
                for (int m = 0; m < 4; ++m)
#pragma unroll
                    for (int n = 0; n < 2; ++n) acc[a][b][m][n] = (f32x4){0.f, 0.f, 0.f, 0.f};
        cur = nxt; cA = nA; cB = nB; ++ui;
        if constexpr (ALIGN_EPI) { if (wr == 1) PG8_BAR; }
    }
    PG8_WAIT_V(0);
    if constexpr (!ALIGN_EPI) { if (wr == 0) PG8_BAR; }
    PG8_BAR;
#undef PG8_SA
#undef PG8_SB
#undef PG8_STAGE
#undef PG8_LDA
#undef PG8_LDB
#undef PG8_MMA
#undef PG8_WAIT_V
#undef PG8_WAIT_L
#undef PG8_BAR
#undef PG8_SCHED
}

struct StaticOrder {
    int nM, nN, nwg, G, c;
    __device__ void init(int nM_, int nN_, int G_, int c_) { nM = nM_; nN = nN_; nwg = nM * nN; G = G_; c = c_; }
    __device__ bool next(int i, int& pm, int& pn) const { const long L = (long)i * G + c; if (L >= nwg) return false; map((int)L, pm, pn); return true; }
    __device__ void map(int L, int& pm, int& pn) const {
        int wgid = L; { const int q = nwg / NXCD, r = nwg % NXCD, xcd = wgid % NXCD, off = wgid / NXCD; wgid = (xcd < r ? xcd * (q + 1) : r * (q + 1) + (xcd - r) * q) + off; }
        const int nig = WGM * nN, gid = wgid / nig, fm = gid * WGM, gsz = (nM - fm) < WGM ? (nM - fm) : WGM;
        pm = fm + ((wgid % nig) % gsz); pn = (wgid % nig) / gsz;
    }
};

struct ProbBase {
    const char* A; const char* B; OpMap ma, mb; size_t hstepA, hstepB, kstepA, kstepB; int nt;
    __device__ void std_operands(const void* A_, int lda, const void* B_, int ldb, int K) {
        A = (const char*)A_; B = (const char*)B_; ma = OpMap{128, (unsigned)lda * 2u, 0u}; mb = OpMap{128, (unsigned)ldb * 2u, 0u};
        hstepA = (size_t)HALF * lda * 2; hstepB = (size_t)HALF * ldb * 2; kstepA = kstepB = BK * 2; nt = K / BK;
    }
};

template <class F> __device__ __forceinline__ void epi_rows_perm(const f32x4 (&acc)[2][2][4][2], int wr, int wc, int fr, int fq, F f) {
    asm volatile("" : "+v"(fr), "+v"(fq));
#pragma unroll
    for (int ai = 0; ai < 2; ++ai)
#pragma unroll
        for (int m = 0; m < 4; ++m)
#pragma unroll
            for (int bj = 0; bj < 2; ++bj) f(ai * HALF + wr * 64 + m * 16 + fr, bj * HALF + wc * 32 + 8 * fq, acc[ai][bj][m][0], acc[ai][bj][m][1]);
}
template <class F> __device__ __forceinline__ void epi_rows_f32(const f32x4 (&acc)[2][2][4][2], int wr, int wc, int fr, int fq, F f) {
    asm volatile("" : "+v"(fr), "+v"(fq));
#pragma unroll
    for (int ai = 0; ai < 2; ++ai)
#pragma unroll
        for (int m = 0; m < 4; ++m)
#pragma unroll
            for (int bj = 0; bj < 2; ++bj)
#pragma unroll
                for (int n = 0; n < 2; ++n) f(ai * HALF + wr * 64 + m * 16 + fr, bj * HALF + wc * 32 + 16 * n + 4 * fq, acc[ai][bj][m][n]);
}
__device__ __forceinline__ u32x4 pack8(const f32x4& v0, const f32x4& v1) { u32x4 w; w.x = cvt_pk_bf16(v0[0], v0[1]); w.y = cvt_pk_bf16(v0[2], v0[3]); w.z = cvt_pk_bf16(v1[0], v1[1]); w.w = cvt_pk_bf16(v1[2], v1[3]); return w; }

struct TokOrder : ProbBase {
    StaticOrder so; int row0, lda, ldb;
    __device__ void init_tok(const void* Act, int lda_, const void* Wt, int K, int row0_, int nM, int nN, int G, int c) { std_operands(Act, lda_, Wt, K, K); row0 = row0_; lda = lda_; ldb = K; so.init(nM, nN, G, c); }
    __device__ bool next(int i, Unit& u) const { int pm, pn; if (!so.next(i, pm, pn)) return false; u.p0 = pm; u.p1 = pn; u.p2 = -1; u.nt = nt; u.offA = (size_t)(row0 + pm * BM) * lda * 2; u.offB = (size_t)pn * BM * ldb * 2; return true; }
};
struct ProbMlp1 : TokOrder {
    static constexpr bool PERM = true;
    bf16_t* O; int ldc;
    __device__ __forceinline__ void epi(const f32x4 (&acc)[2][2][4][2], const Unit& u, int wr, int wc, int fr, int fq) const {
        bf16_t* base = O + (size_t)(row0 + u.p0 * BM) * ldc + u.p1 * BM;
        epi_rows_perm(acc, wr, wc, fr, fq, [&](int r, int c, f32x4 v0, f32x4 v1) {
#pragma unroll
            for (int j = 0; j < 4; ++j) { const float a = fmaxf(v0[j], 0.f), b = fmaxf(v1[j], 0.f); v0[j] = a * a; v1[j] = b * b; }
            *(u32x4*)(base + (size_t)r * ldc + c) = pack8(v0, v1); });
    }
};
template <bool FIRST> struct ProbResidT : TokOrder {
    static constexpr bool PERM = false;
    float* X; const float* mod; int layer, gidx; unsigned short* slab; int G2, c2;
    const float* xp; const float* xs; const float* er; const float* ec;
    __device__ void init_split(int G_, int c_, unsigned short* slab_) { G2 = G_; c2 = c_; slab = slab_; xp = nullptr; xs = nullptr; er = nullptr; ec = nullptr; }
    __device__ bool next(int i, Unit& u) const {
        if (G2 != 256) return TokOrder::next(i, u);
        int pm, pn;
        if (i > 1) return false;
        const int which = (c2 & 1) ? 1 - i : i;
        if (which == 0) { so.map(c2, pm, pn); u.p2 = -1; u.p3 = 0; u.nt = nt; u.offA = (size_t)(row0 + pm * BM) * lda * 2; u.offB = (size_t)pn * BM * ldb * 2; }
        else { const int L = 256 + (c2 >> 2), kq = c2 & 3, ntq = nt >> 2; so.map(L, pm, pn); u.p2 = kq; u.p3 = L - 256; u.nt = ntq;
            u.offA = (size_t)(row0 + pm * BM) * lda * 2 + (size_t)kq * ntq * BK * 2; u.offB = (size_t)pn * BM * ldb * 2 + (size_t)kq * ntq * BK * 2; }
        u.p0 = pm; u.p1 = pn; return true;
    }
    __device__ __forceinline__ void epi(const f32x4 (&acc)[2][2][4][2], const Unit& u, int wr, int wc, int fr, int fq) const {
        const int rowt = row0 + u.p0 * BM, cond = rowt >> 12;
        const float* gate = mod + ((size_t)(cond * 2 + layer) * 6 + gidx) * 1024 + u.p1 * BM;
        if (u.p2 <= 0) {
            float* base = X + (size_t)rowt * 1024 + u.p1 * BM;
            if constexpr (FIRST) {
                const int colt = u.p1 * BM; const bool smp = rowt >= 4096, use_er = colt < 512; const int t0 = rowt & 4095;
                const float* xsrc = smp ? xs + (size_t)(rowt - 4096) * 1024 + colt : xp + (size_t)rowt * 1024 + colt;
                const float* pbase = use_er ? er + colt : ec + colt - 512;
                epi_rows_f32(acc, wr, wc, fr, fq, [&](int r, int c, f32x4 v) {
                    const f32x4 g = *(const f32x4*)(gate + c); f32x4 x0 = *(const f32x4*)(xsrc + (size_t)r * 1024 + c);
                    if (smp) { const int t = t0 + r; x0 = x0 + *(const f32x4*)(pbase + (use_er ? (t >> 6) : (t & 63)) * 512 + c); }
                    *(f32x4*)(base + (size_t)r * 1024 + c) = x0 + g * v; });
            } else {
                epi_rows_f32(acc, wr, wc, fr, fq, [&](int r, int c, f32x4 v) {
                    const f32x4 g = *(const f32x4*)(gate + c); f32x4* p = (f32x4*)(base + (size_t)r * 1024 + c); *p = *p + g * v; });
            }
        } else {
            unsigned short* base = slab + (size_t)(u.p3 * 3 + u.p2 - 1) * 65536;
            epi_rows_f32(acc, wr, wc, fr, fq, [&](int r, int c, f32x4 v) {
                const f32x4 g = *(const f32x4*)(gate + c); const f32x4 w = g * v; u32x2 o; o.x = pk2h(w[0], w[1]); o.y = pk2h(w[2], w[3]); *(u32x2*)(base + (size_t)r * 256 + c) = o; });
        }
    }
};
typedef ProbResidT<false> ProbResid; typedef ProbResidT<true> ProbResidFirst;
__device__ __forceinline__ void build_split_table(LAS unsigned char* tab, int G, int tid) {
    for (int i = tid; i < 320; i += NTHREADS) tab[i] = 255;
    __syncthreads();
    if (G == 256) { StaticOrder so; so.init(80, 4, G, 0); for (int L = 256 + tid; L < 320; L += NTHREADS) { int pm, pn; so.map(L, pm, pn); tab[pm * 4 + pn] = (unsigned char)(L - 256); } }
    __syncthreads();
}
__device__ __forceinline__ f32x4 slab_sum(const unsigned short* slab, int idx, int r255, int col) {
    f32x4 s = (f32x4){0.f, 0.f, 0.f, 0.f};
#pragma unroll
    for (int q = 0; q < 3; ++q) { const u32x2 w = *(const u32x2*)(slab + (size_t)(idx * 3 + q) * 65536 + (size_t)r255 * 256 + col);
        s[0] += h2f_((unsigned short)(w.x & 0xffffu)); s[1] += h2f_((unsigned short)(w.x >> 16)); s[2] += h2f_((unsigned short)(w.y & 0xffffu)); s[3] += h2f_((unsigned short)(w.y >> 16)); }
    return s;
}

struct ProbWin : TokOrder {
    static constexpr bool PERM = true;
    bf16_t* Oq; bf16_t* Offw; bf16_t* Ofbw; bf16_t* Ov; bf16_t* Osg; const float* lb;
    __device__ __forceinline__ void epi(const f32x4 (&acc)[2][2][4][2], const Unit& u, int wr, int wc, int fr, int fq) const {
        const int t = u.p1 >> 2, col0 = (u.p1 & 3) * BM;
        bf16_t* O = t == 0 ? Oq : t == 1 ? Offw : t == 2 ? Ofbw : t == 3 ? Ov : Osg;
        bf16_t* base = O + (size_t)(row0 + u.p0 * BM) * 1024 + col0;
        if (t == 1 || t == 2) {
            const float* lbp = lb + (t - 1) * 1024 + col0;
            epi_rows_perm(acc, wr, wc, fr, fq, [&](int r, int c, f32x4 v0, f32x4 v1) {
                const f32x4 l0 = *(const f32x4*)(lbp + c), l1 = *(const f32x4*)(lbp + c + 4);
#pragma unroll
                for (int j = 0; j < 4; ++j) { v0[j] = __builtin_amdgcn_logf(l0[j] + (1.f - l0[j]) * __builtin_amdgcn_rcpf(1.f + __builtin_amdgcn_exp2f(-1.44269504f * v0[j]))); v1[j] = __builtin_amdgcn_logf(l1[j] + (1.f - l1[j]) * __builtin_amdgcn_rcpf(1.f + __builtin_amdgcn_exp2f(-1.44269504f * v1[j]))); }
                u32x4 w; w.x = pk2h(v0[0], v0[1]); w.y = pk2h(v0[2], v0[3]); w.z = pk2h(v1[0], v1[1]); w.w = pk2h(v1[2], v1[3]);
                *(u32x4*)(base + (size_t)r * 1024 + c) = w; });
        } else if (t == 3) {
            epi_rows_perm(acc, wr, wc, fr, fq, [&](int r, int c, f32x4 v0, f32x4 v1) { *(u32x4*)(base + (size_t)r * 1024 + c) = pack8(v0, v1); });
        } else {
            epi_rows_perm(acc, wr, wc, fr, fq, [&](int r, int c, f32x4 v0, f32x4 v1) {
#pragma unroll
                for (int j = 0; j < 4; ++j) { v0[j] = silu(v0[j]); v1[j] = silu(v1[j]); }
                *(u32x4*)(base + (size_t)r * 1024 + c) = pack8(v0, v1); });
        }
    }
};

struct ProbChan : ProbBase {
    static constexpr bool PERM = true;
    int mode, G, c, nunits; bf16_t* Y;
    __device__ void init(int mode_, const void* dftc, const bf16_t* h0, bf16_t* Y_, int G_, int c_) {
        mode = mode_; G = G_; c = c_; Y = Y_; A = (const char*)dftc; B = (const char*)h0; ma = OpMap{128, 512u, 0u}; hstepA = (size_t)HALF * 512; kstepA = kstepB = BK * 2; nt = 4;
        if (mode == 0) { mb = OpMap{128, 2048u, 0u}; hstepB = (size_t)HALF * 2048; nunits = 16 * 4 * 2; }
        else { mb = OpMap{64, 64u * 2048u, 2048u}; hstepB = 2 * 2048; nunits = 4 * 4 * 16 * 2; }
    }
    __device__ bool next(int i, Unit& u) const {
        const int L = i * G + c; if (L >= nunits) return false;
        const int mt = L & 1; u.p0 = mt; u.nt = nt; u.offA = (size_t)mt * 256 * 512;
        if (mode == 0) { const int g = (L >> 1) & 3, b = L >> 3; u.p1 = b * 2048 + g * 512; u.p2 = 0; u.offB = ((size_t)(b * 256) * 1024 + g * 256) * 2; }
        else { const int j = (L >> 1) & 15, g = (L >> 5) & 3, b = L >> 7; u.p1 = b * 2048 + g * 512; u.p2 = j * 256; u.offB = ((size_t)(4096 + b * 4096 + 4 * j) * 1024 + g * 256) * 2; }
        return true;
    }
    __device__ __forceinline__ void epi(const f32x4 (&acc)[2][2][4][2], const Unit& u, int wr, int wc, int fr, int fq) const {
        const int ldc = mode == 0 ? 256 : 4096;
        bf16_t* base = Y + (size_t)(u.p1 + u.p0 * 256) * ldc + u.p2;
        epi_rows_perm(acc, wr, wc, fr, fq, [&](int r, int cc, f32x4 v0, f32x4 v1) { *(u32x4*)(base + (size_t)r * ldc + cc) = pack8(v0, v1); });
    }
};
struct ProbPosCtx : ProbBase {
    static constexpr bool PERM = true;
    int G, c; bf16_t* Z;
    __device__ void init(const void* dl, const bf16_t* yctx, bf16_t* Z_, int G_, int c_) { std_operands(dl, 512, yctx, 512, 512); G = G_; c = c_; Z = Z_; }
    __device__ bool next(int i, Unit& u) const {
        const int L = i * G + c; if (L >= 64) return false;
        const int pn = L & 3, b = L >> 2; u.p0 = b; u.p1 = pn; u.nt = nt; u.offA = 0; u.offB = ((size_t)b * 2048 * 256 + (size_t)pn * 256 * 512) * 2; return true;
    }
    __device__ __forceinline__ void epi(const f32x4 (&acc)[2][2][4][2], const Unit& u, int wr, int wc, int fr, int fq) const {
        bf16_t* base = Z + (size_t)(u.p0 * 256) * 1024 + u.p1 * 256;
        epi_rows_perm(acc, wr, wc, fr, fq, [&](int r, int cc, f32x4 v0, f32x4 v1) { *(u32x4*)(base + (size_t)r * 1024 + cc) = pack8(v0, v1); });
    }
};
struct ProbSmpA : ProbBase {
    static constexpr bool PERM = true;
    int G, c; bf16_t* U;
    __device__ void init(const void* fa2, const bf16_t* yt, bf16_t* U_, int G_, int c_) {
        A = (const char*)fa2; B = (const char*)yt; ma = OpMap{128, 512u, 0u}; hstepA = (size_t)HALF * 512; kstepA = BK * 2;
        mb = OpMap{32, 128u, 16384u}; hstepB = 4 * 16384; kstepB = 4096; nt = 4; G = G_; c = c_; U = U_;
    }
    __device__ bool next(int i, Unit& u) const {
        const int L = i * G + c; if (L >= 512) return false;
        const int tau = L & 127, b = L >> 7; u.p0 = b; u.p1 = tau; u.nt = nt; u.offA = 0; u.offB = ((size_t)(b * 2048 + 16 * tau) * 4096) * 2; return true;
    }
    __device__ __forceinline__ void epi(const f32x4 (&acc)[2][2][4][2], const Unit& u, int wr, int wc, int fr, int fq) const {
        bf16_t* base = U + (size_t)(u.p0 * 1024 + 8 * u.p1) * 8192;
        epi_rows_perm(acc, wr, wc, fr, fq, [&](int r, int cc, f32x4 v0, f32x4 v1) {
            *(u32x4*)(base + (size_t)(cc >> 5) * 8192 + (r & 127) * 64 + (r >> 7) * 32 + (cc & 31)) = pack8(v0, v1); });
    }
};
struct ProbSmpB : ProbBase {
    static constexpr bool PERM = true;
    int G, c; bf16_t* Z;
    __device__ void init(const void* mbm, const bf16_t* Uin, bf16_t* Z_, int G_, int c_) { std_operands(mbm, 512, Uin, 8192, 512); G = G_; c = c_; Z = Z_; }
    __device__ bool next(int i, Unit& u) const {
        const int L = i * G + c; if (L >= 256) return false;
        const int pn = L & 3, q = (L >> 2) & 15, b = L >> 6; u.p0 = b; u.p1 = q; u.p2 = pn; u.nt = nt;
        u.offA = (size_t)q * 256 * 512 * 2; u.offB = ((size_t)(b * 1024 + pn * 256) * 8192 + q * 512) * 2; return true;
    }
    __device__ __forceinline__ void epi(const f32x4 (&acc)[2][2][4][2], const Unit& u, int wr, int wc, int fr, int fq) const {
        bf16_t* base = Z + (size_t)(4096 + u.p0 * 4096 + 4 * u.p1) * 1024 + u.p2 * 256;
        epi_rows_perm(acc, wr, wc, fr, fq, [&](int r, int cc, f32x4 v0, f32x4 v1) {
            const int l = (r >> 6) + 64 * (r & 63); *(u32x4*)(base + (size_t)l * 1024 + cc) = pack8(v0, v1); });
    }
};

__device__ __forceinline__ void norm_rows(float* X, int row0, int nrows, const float* g, const float* mod, int layer, int ish, bf16_t* H, int gw, int ngw, int lane, const LAS unsigned char* stab, const unsigned short* slab) {
    f32x4 gv[4];
#pragma unroll
    for (int j = 0; j < 4; ++j) gv[j] = *(const f32x4*)(g + 4 * lane + 256 * j);
    f32x4 nx[4];
    { const int r = row0 + gw; if (r < row0 + nrows) { const f32x4* p = (const f32x4*)(X + (size_t)r * 1024) + lane;
#pragma unroll
        for (int j = 0; j < 4; ++j) nx[j] = p[64 * j]; } }
    for (int r = row0 + gw; r < row0 + nrows; r += ngw) {
        f32x4* xr = (f32x4*)(X + (size_t)r * 1024) + lane;
        const float* mrow = mod + ((size_t)((r >> 12) * 2 + layer) * 6) * 1024;
        f32x4 v[4]; float s = 0.f;
#pragma unroll
        for (int j = 0; j < 4; ++j) v[j] = nx[j];
        if (r + ngw < row0 + nrows) { const f32x4* p = (const f32x4*)(X + (size_t)(r + ngw) * 1024) + lane;
#pragma unroll
            for (int j = 0; j < 4; ++j) nx[j] = p[64 * j]; }
#pragma unroll
        for (int j = 0; j < 4; ++j) { const int si = stab[(r >> 8) * 4 + j]; if (si != 255) { v[j] = v[j] + slab_sum(slab, si, r & 255, 4 * lane); xr[64 * j] = v[j]; } s += (v[j].x * v[j].x + v[j].y * v[j].y) + (v[j].z * v[j].z + v[j].w * v[j].w); }
        const float rstd = rsqrtf(wave_sum(s) * (1.f / 1024.f) + 1e-6f);
        unsigned long long* o8 = (unsigned long long*)(H + (size_t)r * 1024) + lane;
#pragma unroll
        for (int j = 0; j < 4; ++j) {
            const f32x4 sh = *(const f32x4*)(mrow + (size_t)ish * 1024 + 4 * lane + 256 * j), sc = *(const f32x4*)(mrow + (size_t)(ish + 1) * 1024 + 4 * lane + 256 * j);
            const f32x4 o = v[j] * rstd * gv[j] * (sc + 1.f) + sh;
            o8[64 * j] = (unsigned long long)pk2(o.x, o.y) | ((unsigned long long)pk2(o.z, o.w) << 32);
        }
    }
}


__device__ __forceinline__ void embed_rows(const float* xp, const float* xs, const float* er, const float* ec, const float* g, const float* mod, bf16_t* H, int gw, int ngw, int lane) {
    f32x4 gv[4];
#pragma unroll
    for (int j = 0; j < 4; ++j) gv[j] = *(const f32x4*)(g + 4 * lane + 256 * j);
    for (int r = gw; r < 20480; r += ngw) {
        const f32x4* xr = (const f32x4*)(r < 4096 ? xp + (size_t)r * 1024 : xs + (size_t)(r - 4096) * 1024) + lane;
        const float* mrow = mod + ((size_t)((r >> 12) * 2 + 0) * 6) * 1024;
        f32x4 v[4]; float s = 0.f;
#pragma unroll
        for (int j = 0; j < 4; ++j) v[j] = xr[64 * j];
        if (r >= 4096) { const int t = r & 4095, row = t >> 6, col = t & 63;
            v[0] = v[0] + *(const f32x4*)(er + row * 512 + 4 * lane); v[1] = v[1] + *(const f32x4*)(er + row * 512 + 256 + 4 * lane);
            v[2] = v[2] + *(const f32x4*)(ec + col * 512 + 4 * lane); v[3] = v[3] + *(const f32x4*)(ec + col * 512 + 256 + 4 * lane); }
#pragma unroll
        for (int j = 0; j < 4; ++j) { s += (v[j].x * v[j].x + v[j].y * v[j].y) + (v[j].z * v[j].z + v[j].w * v[j].w); }
        const float rstd = rsqrtf(wave_sum(s) * (1.f / 1024.f) + 1e-6f);
        unsigned long long* o8 = (unsigned long long*)(H + (size_t)r * 1024) + lane;
#pragma unroll
        for (int j = 0; j < 4; ++j) {
            const f32x4 sh = *(const f32x4*)(mrow + 4 * lane + 256 * j), sc = *(const f32x4*)(mrow + 1024 + 4 * lane + 256 * j);
            const f32x4 o = v[j] * rstd * gv[j] * (sc + 1.f) + sh;
            o8[64 * j] = (unsigned long long)pk2(o.x, o.y) | ((unsigned long long)pk2(o.z, o.w) << 32);
        }
    }
}
__device__ __forceinline__ void gen_tables(unsigned char* ws, long e0, long estride) {
    bf16_t* dftc = (bf16_t*)(ws + WM.dftc); bf16_t* dl = (bf16_t*)(ws + WM.dl256); bf16_t* fa2 = (bf16_t*)(ws + WM.fa2); bf16_t* mbm = (bf16_t*)(ws + WM.mb);
    float* er = (float*)(ws + WM.pos); float* ec = er + 64 * 512;
    constexpr long N0 = 512 * 256, N1 = 256 * 512, N2 = 256 * 256, N3 = 16L * 256 * 512, N4 = 2 * 64 * 512;
    for (long e = e0; e < N0 + N1 + N2 + N3 + N4; e += estride) {
        long r = e;
        if (r < N0) { const int mrow = (int)(r >> 8), cp = (int)(r & 255), cc = mrow >> 1, ri = mrow & 1; const float x = 2.f * (float)((cc * cp) & 255) / 256.f;
            dftc[r] = (bf16_t)f2bf(ri == 0 ? cospif(x) : -sinpif(x)); continue; } r -= N0;
        if (r < N1) { const int l = (int)(r >> 9), k = (int)(r & 511), ri = k >> 8, lp = k & 255; const float x = 2.f * (float)((l * lp) & 255) / 256.f;
            dl[r] = (bf16_t)f2bf((ri == 0 ? cospif(x) : sinpif(x)) * (1.f / 256.f)); continue; } r -= N1;
        if (r < N2) { const int mrow = (int)(r >> 8), k = (int)(r & 255), sA = mrow >> 7, k1 = (mrow >> 1) & 63, ro = mrow & 1, ri = k >> 7, sB = (k >> 6) & 1, l1 = k & 63;
            const float x = 2.f * (float)((k1 * l1) & 63) / 64.f; float v = 0.f;
            if (sA == sB) v = (ro == ri) ? cospif(x) : (ro == 0 ? sinpif(x) : -sinpif(x));
            fa2[r] = (bf16_t)f2bf(v); continue; } r -= N2;
        if (r < N3) { const int q = (int)(r >> 17), mrow = (int)(r >> 9) & 255, k = (int)(r & 511), ko = mrow >> 6, k2 = mrow & 63, kop = k >> 7, ro = (k >> 6) & 1, l2 = k & 63;
            const int l = 4 * q + ko + 64 * k2; const float x = 2.f * (float)((l * l2) & 4095) / 4096.f; float v = 0.f;
            if (ko == kop) v = (ro == 0 ? cospif(x) : sinpif(x)) * (1.f / 1024.f);
            mbm[r] = (bf16_t)f2bf(v); continue; } r -= N3;
        { const int which = (int)(r >> 15), p = (int)(r >> 9) & 63, j = (int)(r & 511), i = j & 255;
            const float omega = 1.0f / powf(10000.0f, (float)i / 256.0f); const float ang = (float)p * omega;
            (which == 0 ? er : ec)[p * 512 + j] = (j < 256) ? sinf(ang) : cosf(ang); }
    }
}


__device__ __forceinline__ void final_rows(float* X, int row0, int nrows, const float* g, int gw, int ngw, int lane, const LAS unsigned char* stab, const unsigned short* slab) {
    f32x4 gv[4];
#pragma unroll
    for (int j = 0; j < 4; ++j) gv[j] = *(const f32x4*)(g + 4 * lane + 256 * j);
    f32x4 nx[4];
    { const int r = row0 + gw; if (r < row0 + nrows) { const f32x4* p = (const f32x4*)(X + (size_t)r * 1024) + lane;
#pragma unroll
        for (int j = 0; j < 4; ++j) nx[j] = p[64 * j]; } }
    for (int r = row0 + gw; r < row0 + nrows; r += ngw) {
        f32x4* xr = (f32x4*)(X + (size_t)r * 1024) + lane;
        f32x4 v[4]; float s = 0.f;
#pragma unroll
        for (int j = 0; j < 4; ++j) v[j] = nx[j];
        if (r + ngw < row0 + nrows) { const f32x4* p = (const f32x4*)(X + (size_t)(r + ngw) * 1024) + lane;
#pragma unroll
            for (int j = 0; j < 4; ++j) nx[j] = p[64 * j]; }
#pragma unroll
        for (int j = 0; j < 4; ++j) { const int si = stab[(r >> 8) * 4 + j]; if (si != 255) v[j] = v[j] + slab_sum(slab, si, r & 255, 4 * lane); s += (v[j].x * v[j].x + v[j].y * v[j].y) + (v[j].z * v[j].z + v[j].w * v[j].w); }
        const float rstd = rsqrtf(wave_sum(s) * (1.f / 1024.f) + 1e-6f);
#pragma unroll
        for (int j = 0; j < 4; ++j) xr[64 * j] = v[j] * rstd * gv[j];
    }
}
__device__ __forceinline__ void mod_unit(LAS unsigned char* lds, int unit, const float* c, const float* c_ctx, const float* ada_w, const float* ada_b, float* mod, int tid, int wave, int lane) {
    LAS float* sc = (LAS float*)lds;
    LAS float* red = (LAS float*)(lds + 20480);
    const int layer = unit / 192, n0 = (unit % 192) * 32, col = lane & 31, kh = lane >> 5;
    for (int i = tid; i < 5 * 1024; i += NTHREADS) { const int cond = i >> 10, k = i & 1023; const float x = cond == 0 ? c_ctx[k] : c[(cond - 1) * 1024 + k]; sc[i] = silu(x); }
    __syncthreads();
    const float* w = ada_w + ((size_t)layer * 1024 + wave * 128 + kh) * 6144 + n0 + col;
    float acc[5];
#pragma unroll
    for (int q = 0; q < 5; ++q) acc[q] = 0.f;
#pragma unroll 8
    for (int k = 0; k < 64; ++k) {
        const float wv = w[(size_t)(2 * k) * 6144];
#pragma unroll
        for (int q = 0; q < 5; ++q) acc[q] += wv * sc[q * 1024 + wave * 128 + 2 * k + kh];
    }
#pragma unroll
    for (int q = 0; q < 5; ++q) { acc[q] += __shfl_xor(acc[q], 32); if (kh == 0) red[(wave * 5 + q) * 32 + col] = acc[q]; }
    __syncthreads();
    for (int i = tid; i < 5 * 32; i += NTHREADS) { const int q = i >> 5, n = i & 31; float s = 0.f;
#pragma unroll
        for (int ww = 0; ww < 8; ++ww) s += red[(ww * 5 + q) * 32 + n];
        mod[((size_t)q * 2 + layer) * 6144 + n0 + n] = s + ada_b[(size_t)layer * 6144 + n0 + n]; }
    __syncthreads();
}

__device__ __forceinline__ void transpose_item(const float* W, int K, int N, bf16_t* WT, LAS float* scr, int item, int lane) {
    const int nblk = N / 32, kb = item / nblk, nb = item % nblk, k0 = 64 * kb, n0 = 32 * nb;
    f32x4 ld[8];
#pragma unroll
    for (int i = 0; i < 8; ++i) ld[i] = *(const f32x4*)(W + (size_t)(k0 + 8 * i + (lane >> 3)) * N + n0 + 4 * (lane & 7));
#pragma unroll
    for (int i = 0; i < 8; ++i) { LAS float* d = scr + (8 * i + (lane >> 3)) * 33 + 4 * (lane & 7); d[0] = ld[i][0]; d[1] = ld[i][1]; d[2] = ld[i][2]; d[3] = ld[i][3]; }
    asm volatile("s_waitcnt lgkmcnt(0)" ::: "memory");
    const int c = lane & 7;
#pragma unroll
    for (int j = 0; j < 4; ++j) { const int n = (lane >> 3) + 8 * j; const LAS float* s = scr + (8 * c) * 33 + n;
        u32x4 o; o.x = pk2(s[0 * 33], s[1 * 33]); o.y = pk2(s[2 * 33], s[3 * 33]); o.z = pk2(s[4 * 33], s[5 * 33]); o.w = pk2(s[6 * 33], s[7 * 33]);
        *(u32x4*)(WT + (size_t)(n0 + n) * K + k0 + 8 * c) = o; }
    asm volatile("s_waitcnt lgkmcnt(0)" ::: "memory");
}


#if defined(PROF_ID)
#define PROF_DECL unsigned long long prof_t0_ = 0ull; const bool prof_on_ = (blockIdx.x == 0) && (__builtin_amdgcn_readfirstlane(threadIdx.x >> 6) == 0)
#define PROF_BEGIN() do { if (prof_on_) prof_t0_ = __builtin_amdgcn_s_memrealtime(); } while (0)
#define PROF_END(id) do { if (prof_on_ && (id) == PROF_ID) { const unsigned long long d_ = __builtin_amdgcn_s_memrealtime() - prof_t0_; if (threadIdx.x == 0) *(LAS unsigned long long*)(prof_lds_ + 160 * 1024 - 512 + 256) += d_; } } while (0)
#else
#define PROF_DECL
#define PROF_BEGIN() do { } while (0)
#define PROF_END(id) do { } while (0)
#endif
typedef float f32x16 __attribute__((ext_vector_type(16)));
typedef short v4i16_t __attribute__((ext_vector_type(4)));
constexpr int QA_RS = 272, QP_RS = 264, KB_RS = 272, KPP_RS = 320, V_RS = 320;
constexpr int T_QA = 0, T_QP = T_QA + 32 * QA_RS, T_KB = T_QP + 32 * QP_RS, T_KPP = T_KB + 32 * KB_RS, T_V = T_KPP + 32 * KPP_RS, T_EL = T_V + 32 * V_RS, DIR_BYTES = T_EL + 512;
constexpr int OBUF_OFF = 2 * DIR_BYTES, OBUF_BYTES = 256 * 256;
static_assert(OBUF_OFF + OBUF_BYTES <= 160 * 1024 - 512 && (DIR_BYTES % 16) == 0 && (T_QP % 16) == 0 && (T_KB % 16) == 0 && (T_KPP % 16) == 0 && (T_V % 16) == 0 && (T_EL % 16) == 0, "scan LDS map");
constexpr int SLOT_ELEMS = 128 * 128;
#ifndef SCAN_STAGGER
#define SCAN_STAGGER 0
#endif

struct ScanT { const bf16_t* q; const bf16_t* lffw; const bf16_t* lfbw; const bf16_t* v; bf16_t* sg; bf16_t* slots; float* dvec; const float* gnorm; const float* state_in; float* new_state; };

__device__ __forceinline__ bf16x8 tr_pair(const LAS unsigned char* p0, const LAS unsigned char* p1) {
    const v4i16_t lo = __builtin_amdgcn_ds_read_tr16_b64_v4i16((LAS v4i16_t*)p0), hi = __builtin_amdgcn_ds_read_tr16_b64_v4i16((LAS v4i16_t*)p1);
    return (bf16x8){lo[0], lo[1], lo[2], lo[3], hi[0], hi[1], hi[2], hi[3]};
}
__device__ __forceinline__ bf16x8 pack_acc8(const f32x16& x, int s8) {
    u32x4 w; w.x = cvt_pk_bf16(x[8 * s8 + 0], x[8 * s8 + 1]); w.y = cvt_pk_bf16(x[8 * s8 + 2], x[8 * s8 + 3]); w.z = cvt_pk_bf16(x[8 * s8 + 4], x[8 * s8 + 5]); w.w = cvt_pk_bf16(x[8 * s8 + 6], x[8 * s8 + 7]);
    return __builtin_bit_cast(bf16x8, w);
}
__device__ __forceinline__ float h2f(unsigned short b) { return (float)__builtin_bit_cast(_Float16, b); }

template <bool FULL>
__device__ __forceinline__ void scan_item(LAS unsigned char* lds, const ScanT& T, int tok0, int h, bool act0, bool act1, const bf16_t* init0, const bf16_t* init1,
                                          float* fin0, float* fin1, bf16_t* outs0, bf16_t* outs1, float* outd0, float* outd1) {
    const int tid = threadIdx.x, wave = __builtin_amdgcn_readfirstlane(tid >> 6), dir = wave >> 2, wg = wave & 3;
    LAS unsigned char* prof_lds_ = lds; (void)prof_lds_; PROF_DECL; PROF_BEGIN();
    const bool act = dir ? act1 : act0;
    const bf16_t* init = dir ? init1 : init0;
    LAS unsigned char* D = lds + dir * DIR_BYTES;
    LAS unsigned char* OB = lds + OBUF_OFF;
    const bf16_t* lfp = dir ? T.lfbw : T.lffw;
#define SCAN_LANE(x) int x; asm volatile("v_mbcnt_lo_u32_b32 %0, -1, 0\n\tv_mbcnt_hi_u32_b32 %0, -1, %0" : "=v"(x))
#define SCAN_PREP_ROLE SCAN_LANE(ln_); const int pp = 16 * wg + (ln_ & 15), uu = ln_ >> 4, gt_ = wg * 64 + ln_, vt = gt_ >> 3, vc2 = gt_ & 7
#define SCAN_MFMA_ROLE SCAN_LANE(ln_); const int l31 = ln_ & 31, hh = ln_ >> 5, gq = (ln_ & 15) >> 2, gp = ln_ & 3, vcol = 16 * ((ln_ >> 4) & 1)
    f32x16 S[4];
#pragma unroll
    for (int t4 = 0; t4 < 4; ++t4) {
        if (init && act) { SCAN_LANE(lane); const u32x4* sp = (const u32x4*)(init + ((size_t)(wg * 4 + t4) * 64 + lane) * 16); const u32x4 a = sp[0], b = sp[1];
            const unsigned w8[8] = {a.x, a.y, a.z, a.w, b.x, b.y, b.z, b.w};
#pragma unroll
            for (int j = 0; j < 8; ++j) { S[t4][2 * j] = __builtin_bit_cast(float, w8[j] << 16); S[t4][2 * j + 1] = __builtin_bit_cast(float, w8[j] & 0xffff0000u); } }
        else {
#pragma unroll
            for (int j = 0; j < 16; ++j) S[t4][j] = 0.f; }
    }
    float dsum0 = 0.f, dsum1 = 0.f;
    unsigned qreg[8], lfreg[8]; u32x4 vreg[2];
#define SCAN_LOAD(i) do { const int jsc_ = dir ? 7 - (i) : (i); \
        _Pragma("unroll") for (int e = 0; e < 8; ++e) { const int tl = 8 * uu + e; const size_t tk = (size_t)(tok0 + 32 * jsc_ + (dir ? 31 - tl : tl)) * 1024 + h * 128 + 2 * pp; \
            if (FULL) qreg[e] = *(const unsigned*)(T.q + tk); lfreg[e] = *(const unsigned*)(lfp + tk); } \
        { const size_t tk = (size_t)(tok0 + 32 * jsc_ + (dir ? 31 - vt : vt)) * 1024 + h * 128 + 16 * vc2; vreg[0] = *(const u32x4*)(T.v + tk); vreg[1] = *(const u32x4*)(T.v + tk + 8); } } while (0)
    if (act) { SCAN_PREP_ROLE; SCAN_LOAD(0); }
    PROF_END(6);
    for (int s = 0; s < 16 + SCAN_STAGGER; ++s) {
        const int ph = s - (SCAN_STAGGER ? dir : 0);
        if (act && ph >= 0 && ph < 16) {
            const int i = ph >> 1;
            if ((ph & 1) == 0) {
                SCAN_PREP_ROLE; const int lane = ln_;
#if defined(PROF_ID)
                PROF_BEGIN(); asm volatile("s_waitcnt vmcnt(0)" ::: "memory"); PROF_END(1); PROF_BEGIN();
#endif
                *(LAS u32x4*)(D + T_V + vt * V_RS + vc2 * 32) = vreg[0]; *(LAS u32x4*)(D + T_V + vt * V_RS + vc2 * 32 + 16) = vreg[1];
                f32x2 cc[8]; f32x2 aa = (f32x2){0.f, 0.f};
#pragma unroll
                for (int e = 0; e < 8; ++e) { aa += (f32x2){h2f((unsigned short)(lfreg[e] & 0xffffu)), h2f((unsigned short)(lfreg[e] >> 16))}; cc[e] = aa; }
                f32x2 tq[4];
#pragma unroll
                for (int u2 = 0; u2 < 4; ++u2) { tq[u2].x = __shfl(aa.x, (lane & 15) + 16 * u2); tq[u2].y = __shfl(aa.y, (lane & 15) + 16 * u2); }
                const f32x2 zz = (f32x2){0.f, 0.f};
                const f32x2 pre = (uu > 0 ? tq[0] : zz) + (uu > 1 ? tq[1] : zz) + (uu > 2 ? tq[2] : zz);
                const f32x2 rr = tq[0] + tq[1], bl = rr + tq[2] + tq[3];
#define EX2V(v) ((f32x2){__builtin_amdgcn_exp2f((v).x), __builtin_amdgcn_exp2f((v).y)})
                if (FULL) {
                    const f32x2 er = EX2V(rr), elr = EX2V(bl - rr), base = pre - rr;
#pragma unroll
                    for (int e = 0; e < 8; ++e) {
                        const int tl = 8 * uu + e;
                        const f32x2 d = base + cc[e];
                        const f32x2 ea = EX2V(d), eb = EX2V(-d);
                        const f32x2 lfv = (f32x2){h2f((unsigned short)(lfreg[e] & 0xffffu)), h2f((unsigned short)(lfreg[e] >> 16))};
                        const f32x2 kk = 1.f - EX2V(lfv);
                        const f32x2 qq = (f32x2){__builtin_bit_cast(float, qreg[e] << 16), __builtin_bit_cast(float, qreg[e] & 0xffff0000u)};
                        const f32x2 qa = qq * ea, kb = kk * eb, qp = qa * er, kpp = kb * elr;
                        *(LAS unsigned*)(D + T_QA + tl * QA_RS + 4 * pp) = cvt_pk_bf16(qa.x, qa.y);
                        *(LAS unsigned*)(D + T_QP + tl * QP_RS + 4 * pp) = cvt_pk_bf16(qp.x, qp.y);
                        *(LAS unsigned*)(D + T_KB + tl * KB_RS + 4 * pp) = cvt_pk_bf16(kb.x, kb.y);
                        *(LAS unsigned*)(D + T_KPP + tl * KPP_RS + 4 * pp) = cvt_pk_bf16(kpp.x, kpp.y);
                        if (e & 1) __builtin_amdgcn_sched_barrier(0);
                    }
                } else {
                    const f32x2 base = bl - pre;
#pragma unroll
                    for (int e = 0; e < 8; ++e) {
                        const int tl = 8 * uu + e;
                        const f32x2 d = base - cc[e];
                        const f32x2 lfv = (f32x2){h2f((unsigned short)(lfreg[e] & 0xffffu)), h2f((unsigned short)(lfreg[e] >> 16))};
                        const f32x2 kpp = (1.f - EX2V(lfv)) * EX2V(d);
                        *(LAS unsigned*)(D + T_KPP + tl * KPP_RS + 4 * pp) = cvt_pk_bf16(kpp.x, kpp.y);
                    }
                    dsum0 += bl.x; dsum1 += bl.y;
                }
                if (uu == 0) { *(LAS f32x2*)(D + T_EL + 8 * pp) = EX2V(bl); }
                __builtin_amdgcn_sched_barrier(0);
#if defined(PROF_ID)
                asm volatile("s_waitcnt lgkmcnt(0)" ::: "memory"); PROF_END(2);
#endif
                if (i < 7) SCAN_LOAD(i + 1);
            } else {
                SCAN_MFMA_ROLE; PROF_BEGIN();
                if (FULL) {
                    f32x16 P;
#pragma unroll
                    for (int j = 0; j < 16; ++j) P[j] = 0.f;
#pragma unroll
                    for (int ks = 0; ks < 8; ++ks) {
                        const bf16x8 ka = *(const LAS bf16x8*)(D + T_KB + l31 * KB_RS + (16 * ks + 8 * hh) * 2);
                        const bf16x8 qb = *(const LAS bf16x8*)(D + T_QA + l31 * QA_RS + (16 * ks + 8 * hh) * 2);
                        P = __builtin_amdgcn_mfma_f32_32x32x16_bf16(ka, qb, P, 0, 0, 0);
                    }
#pragma unroll
                    for (int j = 0; j < 16; ++j) { const int srow = (j & 3) + 8 * (j >> 2) + 4 * hh; P[j] = (srow <= l31) ? P[j] : 0.f; }
                    f32x16 o;
#pragma unroll
                    for (int j = 0; j < 16; ++j) o[j] = 0.f;
#pragma unroll
                    for (int s8 = 0; s8 < 2; ++s8) {
                        const LAS unsigned char* vb = D + T_V + (16 * s8 + 4 * hh + gq) * V_RS + (32 * wg + vcol + 4 * gp) * 2;
                        const bf16x8 vf = tr_pair(vb, vb + 8 * V_RS);
                        o = __builtin_amdgcn_mfma_f32_32x32x16_bf16(pack_acc8(P, s8), vf, o, 0, 0, 0);
                    }
#pragma unroll
                    for (int t4 = 0; t4 < 4; ++t4)
#pragma unroll
                        for (int s8 = 0; s8 < 2; ++s8) {
                            const LAS unsigned char* qp = D + T_QP + l31 * QP_RS + (32 * t4 + 16 * s8 + 4 * hh) * 2;
                            const u32x2 lo = *(const LAS u32x2*)qp, hi = *(const LAS u32x2*)(qp + 16);
                            const u32x4 aw = {lo.x, lo.y, hi.x, hi.y};
                            o = __builtin_amdgcn_mfma_f32_32x32x16_bf16(__builtin_bit_cast(bf16x8, aw), pack_acc8(S[t4], s8), o, 0, 0, 0);
                        }
                    const int jsc = dir ? 7 - i : i;
                    LAS unsigned short* ob = (LAS unsigned short*)(OB + (32 * jsc + (dir ? 31 - 4 * hh : 4 * hh)) * 256 + (32 * wg + l31) * 2);
                    const int rs = dir ? -128 : 128;
                    if (i >= 4) {
                        unsigned short pv[16];
#pragma unroll
                        for (int j = 0; j < 16; ++j) pv[j] = ob[((j & 3) + 8 * (j >> 2)) * rs];
#pragma unroll
                        for (int j = 0; j < 16; ++j) o[j] += bf2f(pv[j]);
                    }
#pragma unroll
                    for (int j = 0; j < 16; ++j) ob[((j & 3) + 8 * (j >> 2)) * rs] = (unsigned short)cvt_pk_bf16(o[j], o[j]);
                }
                __builtin_amdgcn_sched_barrier(0);
#pragma unroll
                for (int t4 = 0; t4 < 4; ++t4) {
#pragma unroll
                    for (int g = 0; g < 4; ++g) { const f32x4 f = *(const LAS f32x4*)(D + T_EL + (32 * t4 + 8 * g + 4 * hh) * 4);
                        S[t4][4 * g + 0] *= f[0]; S[t4][4 * g + 1] *= f[1]; S[t4][4 * g + 2] *= f[2]; S[t4][4 * g + 3] *= f[3]; }
#pragma unroll
                    for (int s8 = 0; s8 < 2; ++s8) {
                        const LAS unsigned char* kb = D + T_KPP + (16 * s8 + 8 * hh + gq) * KPP_RS + (32 * t4 + vcol + 4 * gp) * 2;
                        const LAS unsigned char* vb = D + T_V + (16 * s8 + 8 * hh + gq) * V_RS + (32 * wg + vcol + 4 * gp) * 2;
                        const bf16x8 ka = tr_pair(kb, kb + 4 * KPP_RS), vf = tr_pair(vb, vb + 4 * V_RS);
                        S[t4] = __builtin_amdgcn_mfma_f32_32x32x16_bf16(ka, vf, S[t4], 0, 0, 0);
                    }
                    if (t4 == 1) __builtin_amdgcn_sched_barrier(0);
                }
                PROF_END(3);
            }
        }
        PROF_BEGIN();
        __syncthreads();
        PROF_END(4);
    }
#undef SCAN_LOAD
    SCAN_MFMA_ROLE; SCAN_LANE(lane); PROF_BEGIN();
    if (FULL) {
        float* fin = dir ? fin1 : fin0;
        if (fin && act) {
#pragma unroll
            for (int t4 = 0; t4 < 4; ++t4)
#pragma unroll
                for (int j = 0; j < 16; ++j) fin[(size_t)(32 * t4 + (j & 3) + 8 * (j >> 2) + 4 * hh) * 128 + 32 * wg + l31] = S[t4][j];
        }
        const int cv = tid & 15;
        f32x4 gn0 = *(const f32x4*)(T.gnorm + 8 * cv), gn1 = *(const f32x4*)(T.gnorm + 8 * cv + 4);
        u32x4 gwv[8];
#pragma unroll
        for (int pass = 0; pass < 8; ++pass) gwv[pass] = *(const u32x4*)(T.sg + (size_t)(tok0 + 32 * pass + (tid >> 4)) * 1024 + h * 128 + 8 * cv);
#pragma unroll
        for (int pass = 0; pass < 8; ++pass) {
            const int row = 32 * pass + (tid >> 4);
            const u32x4 ow = *(const LAS u32x4*)(OB + row * 256 + cv * 16);
            bf16_t* gp_ = T.sg + (size_t)(tok0 + row) * 1024 + h * 128 + 8 * cv;
            const u32x4 gw = gwv[pass];
            float ov[8], gv[8];
            const unsigned o4[4] = {ow.x, ow.y, ow.z, ow.w}, g4[4] = {gw.x, gw.y, gw.z, gw.w};
            float ss = 0.f;
#pragma unroll
            for (int j = 0; j < 4; ++j) { ov[2 * j] = __builtin_bit_cast(float, o4[j] << 16); ov[2 * j + 1] = __builtin_bit_cast(float, o4[j] & 0xffff0000u);
                gv[2 * j] = __builtin_bit_cast(float, g4[j] << 16); gv[2 * j + 1] = __builtin_bit_cast(float, g4[j] & 0xffff0000u);
                ss += ov[2 * j] * ov[2 * j] + ov[2 * j + 1] * ov[2 * j + 1]; }
            ss += __shfl_xor(ss, 1); ss += __shfl_xor(ss, 2); ss += __shfl_xor(ss, 4); ss += __shfl_xor(ss, 8);
            const float rstd = rsqrtf(ss * (1.f / 128.f) + 1e-6f);
            u32x4 w;
            w.x = cvt_pk_bf16(ov[0] * rstd * gn0[0] * gv[0], ov[1] * rstd * gn0[1] * gv[1]); w.y = cvt_pk_bf16(ov[2] * rstd * gn0[2] * gv[2], ov[3] * rstd * gn0[3] * gv[3]);
            w.z = cvt_pk_bf16(ov[4] * rstd * gn1[0] * gv[4], ov[5] * rstd * gn1[1] * gv[5]); w.w = cvt_pk_bf16(ov[6] * rstd * gn1[2] * gv[6], ov[7] * rstd * gn1[3] * gv[7]);
            *(u32x4*)gp_ = w;
        }
#if defined(PROF_ID)
        asm volatile("s_waitcnt vmcnt(0)" ::: "memory");
#endif
        __syncthreads(); PROF_END(5);
    } else {
        bf16_t* outs = dir ? outs1 : outs0; float* outd = dir ? outd1 : outd0;
        if (act) {
#pragma unroll
            for (int t4 = 0; t4 < 4; ++t4) {
                u32x4 a, b;
                a.x = cvt_pk_bf16(S[t4][0], S[t4][1]); a.y = cvt_pk_bf16(S[t4][2], S[t4][3]); a.z = cvt_pk_bf16(S[t4][4], S[t4][5]); a.w = cvt_pk_bf16(S[t4][6], S[t4][7]);
                b.x = cvt_pk_bf16(S[t4][8], S[t4][9]); b.y = cvt_pk_bf16(S[t4][10], S[t4][11]); b.z = cvt_pk_bf16(S[t4][12], S[t4][13]); b.w = cvt_pk_bf16(S[t4][14], S[t4][15]);
                u32x4* sp = (u32x4*)(outs + ((size_t)(wg * 4 + t4) * 64 + lane) * 16); sp[0] = a; sp[1] = b;
            }
            const int pp = 16 * wg + (lane & 15); if ((lane >> 4) == 0) { outd[2 * pp] = __builtin_amdgcn_exp2f(dsum0); outd[2 * pp + 1] = __builtin_amdgcn_exp2f(dsum1); }
        }
    }
}
__device__ __forceinline__ size_t slot_of(int dir, int b, int h, int sc) { return (size_t)((dir * 4 + b) * 8 + h) * 16 + sc; }

__device__ __forceinline__ void scan_phase_a(LAS unsigned char* lds, const ScanT& T, int G, int bx) {
    for (int it = bx; it < 512; it += G) {
        const int sc = it & 15, h = (it >> 4) & 7, b = it >> 7;
        const size_t sf = slot_of(0, b, h, sc < 15 ? sc + 1 : 0), sb = slot_of(1, b, h, sc > 0 ? sc - 1 : 0);
        scan_item<false>(lds, T, 4096 + b * 4096 + sc * 256, h, sc < 15, sc > 0, nullptr, nullptr, nullptr, nullptr, T.slots + sf * SLOT_ELEMS, T.slots + sb * SLOT_ELEMS, T.dvec + sf * 128, T.dvec + sb * 128);
    }
}
__device__ __forceinline__ void scan_phase_b(const ScanT& T, int G, int bx, int tid) {
    for (int gid = bx * NTHREADS + tid; gid < 64 * 2048; gid += G * NTHREADS) {
        const int combo = gid >> 11, e = (gid & 2047) * 8, dir = combo >> 5, b = (combo >> 3) & 3, h = combo & 7;
        const int reg0 = e & 15, ln = (e >> 4) & 63, t4 = (e >> 10) & 3, w = (e >> 12) & 3;
        const int v = 32 * w + (ln & 31);
        float s[8]; int kk[8];
#pragma unroll
        for (int j = 0; j < 8; ++j) { const int rg = reg0 + j; kk[j] = 32 * t4 + (rg & 3) + 8 * (rg >> 2) + 4 * (ln >> 5); s[j] = T.state_in[((size_t)((b * 2 + dir) * 8 + h) * 128 + kk[j]) * 128 + v]; }
        for (int st = 0; st < 16; ++st) {
            const int sc = dir ? 15 - st : st;
            const size_t sl = slot_of(dir, b, h, sc);
            u32x4* sp = (u32x4*)(T.slots + sl * SLOT_ELEMS + e);
            if (st > 0) {
                const u32x4 lw = *sp; const unsigned l4[4] = {lw.x, lw.y, lw.z, lw.w};
#pragma unroll
                for (int j = 0; j < 4; ++j) { s[2 * j] = T.dvec[sl * 128 + kk[2 * j]] * s[2 * j] + __builtin_bit_cast(float, l4[j] << 16);
                    s[2 * j + 1] = T.dvec[sl * 128 + kk[2 * j + 1]] * s[2 * j + 1] + __builtin_bit_cast(float, l4[j] & 0xffff0000u); }
            }
            u32x4 o; o.x = cvt_pk_bf16(s[0], s[1]); o.y = cvt_pk_bf16(s[2], s[3]); o.z = cvt_pk_bf16(s[4], s[5]); o.w = cvt_pk_bf16(s[6], s[7]);
            *sp = o;
        }
    }
}
__device__ __forceinline__ void scan_phase_c(LAS unsigned char* lds, const ScanT& T, int G, int bx) {
    for (int it = bx; it < 640; it += G) {
        if (it < 512) {
            const int sc = it & 15, h = (it >> 4) & 7, b = it >> 7;
            scan_item<true>(lds, T, 4096 + b * 4096 + sc * 256, h, true, true, T.slots + slot_of(0, b, h, sc) * SLOT_ELEMS, T.slots + slot_of(1, b, h, sc) * SLOT_ELEMS,
                            nullptr, nullptr, nullptr, nullptr, nullptr, nullptr);
        } else {
            const int h = (it - 512) & 7, b = (it - 512) >> 3;
            float* ns = T.new_state + (size_t)(b * 2) * 8 * 16384 + (size_t)h * 16384;
            scan_item<true>(lds, T, b * 256, h, true, true, nullptr, nullptr, ns, ns + (size_t)8 * 16384, nullptr, nullptr, nullptr, nullptr);
        }
    }
}


#define XB_TMO      128
#define XB_XCNT(j)  (256  + 64 * (j))
#define XB_XSUB(j)  (1280 + 64 * (j))
#define XB_XGEN(j)  (2304 + 64 * (j))
#define XB_TOP      3328
#define XB_TOPGEN   3392
#define XCD_BAR_WORDS 3456
#define XB_SPIN_CAP (1u << 18)
__device__ __forceinline__ unsigned xb_ld(unsigned* p)              { return __hip_atomic_load(p, __ATOMIC_RELAXED, __HIP_MEMORY_SCOPE_AGENT); }
__device__ __forceinline__ unsigned xb_add(unsigned* p, unsigned v) { return __hip_atomic_fetch_add(p, v, __ATOMIC_RELAXED, __HIP_MEMORY_SCOPE_AGENT); }
__device__ __forceinline__ unsigned xb_xcc_id() { return (unsigned)__builtin_amdgcn_s_getreg((3 << 11) | 20) & 0xFu; }
#define XB_SPIN(cond, bar) do { unsigned _sp = 0; while (cond) { __builtin_amdgcn_s_sleep(1); \
    if ((++_sp & 255u) == 0u) { if (xb_ld(&(bar)[XB_TMO])) break; if (_sp > XB_SPIN_CAP) { atomicAdd(&(bar)[XB_TMO], 1u); break; } } } } while (0)
struct XcdBarrier { unsigned* bar; unsigned x; volatile LAS unsigned* st; };
__device__ __forceinline__ XcdBarrier xcd_barrier_post(unsigned* bar, volatile LAS unsigned* st) {
    XcdBarrier b; b.bar = bar; b.x = xb_xcc_id(); b.st = st;
    if (threadIdx.x == 0) (void)xb_add(&bar[XB_XCNT(b.x)], 1u);
    return b;
}
__device__ __forceinline__ void xcd_barrier_complete(unsigned* bar, unsigned x, unsigned& nloc, unsigned& nx) {
    const unsigned G = gridDim.x * gridDim.y * gridDim.z;
    unsigned sum, cnt, mine, sp = 0u;
    for (;;) {
        sum = 0u; cnt = 0u; mine = 0u;
#pragma unroll
        for (unsigned j = 0; j < 16; ++j) { const unsigned c = xb_ld(&bar[XB_XCNT(j)]); sum += c; cnt += (c > 0u) ? 1u : 0u; mine = (j == x) ? c : mine; }
        if (sum == G) break;
        __builtin_amdgcn_s_sleep(1);
        if ((++sp & 255u) == 0u) { if (xb_ld(&bar[XB_TMO])) break; if (sp > XB_SPIN_CAP) { atomicAdd(&bar[XB_TMO], 1u); break; } }
    }
    nloc = mine > 0u ? mine : 1u; nx = cnt > 0u ? cnt : 1u;
}
__device__ __forceinline__ void xcd_barrier(const XcdBarrier& b) {
    asm volatile("s_waitcnt vmcnt(0)" ::: "memory");
    __syncthreads();
    if (threadIdx.x == 0) {
        unsigned* bar = b.bar;
        __builtin_amdgcn_s_waitcnt(0);
        unsigned nloc = b.st[0], nx = b.st[1];
        if (nloc == 0u) { xcd_barrier_complete(bar, b.x, nloc, nx); b.st[0] = nloc; b.st[1] = nx; }
        const unsigned old = xb_add(&bar[XB_XSUB(b.x)], 1u);
        const unsigned gen = old / nloc;
        if (old + 1u == (gen + 1u) * nloc) {
            __builtin_amdgcn_fence(__ATOMIC_RELEASE, "agent");
            asm volatile("s_waitcnt vmcnt(0)" ::: "memory");
            const unsigned og = xb_add(&bar[XB_TOP], 1u);
            const unsigned tg = og / nx;
            if (og + 1u == (tg + 1u) * nx) xb_add(&bar[XB_TOPGEN], 1u);
            else XB_SPIN(xb_ld(&bar[XB_TOPGEN]) == tg, bar);
            __builtin_amdgcn_fence(__ATOMIC_ACQUIRE, "agent");
            xb_add(&bar[XB_XGEN(b.x)], 1u);
            asm volatile("s_waitcnt vmcnt(0)" ::: "memory");
        } else {
            XB_SPIN(xb_ld(&bar[XB_XGEN(b.x)]) == gen, bar);
            __builtin_amdgcn_fence(__ATOMIC_ACQUIRE, "agent");
            asm volatile("s_waitcnt vmcnt(0)" ::: "memory");
        }
    }
    __syncthreads();
}

struct Args { const float* in[17]; float* out; unsigned char* ws; int ph_lo, ph_hi; };
enum { PH_PREP = 0, PH_EMBED = 1, PH_FN_CHAN = 2, PH_FN_POS1 = 3, PH_FN_POS2 = 4, PH_FN_WO = 5, PH_NORM_MLP0 = 6, PH_MLP1_0 = 7, PH_MLP2_0 = 8, PH_NORM_MIX1 = 9, PH_WIN = 10,
       PH_SCAN_A = 11, PH_SCAN_B = 12, PH_SCAN_C = 13, PH_HG_WO = 14, PH_NORM_MLP1 = 15, PH_MLP1_1 = 16, PH_MLP2_1 = 17, PH_FINAL = 18, PH_END = 19 };
constexpr int LDS_BYTES = 160 * 1024, MISC_OFF = LDS_BYTES - 512;

__global__ void __launch_bounds__(NTHREADS, 2) fwd(Args a) {
    extern __shared__ __attribute__((aligned(16))) unsigned char lds_raw[];
    LAS unsigned char* lds = (LAS unsigned char*)lds_raw;
    const int tid = threadIdx.x, lane = tid & 63, wave = __builtin_amdgcn_readfirstlane(tid >> 6);
    const int G = gridDim.x, bx = blockIdx.x;
    const int gw = bx * NWAVES + wave, ngw = G * NWAVES;
    unsigned char* ws = a.ws;
    const float* mod = (const float*)(ws + WM.mod);
    bf16_t* Hb = (bf16_t*)(ws + WM.h);
    bf16_t* Big = (bf16_t*)(ws + WM.big[0]); bf16_t* Big1 = (bf16_t*)(ws + WM.big[1]);
    const float* norm_mlp = a.in[8];
    const float* w1 = a.in[14]; const float* w2 = a.in[15];
    const float* norm_mix = a.in[7]; const float* fnet_wo = a.in[9];
    float* modw = (float*)(ws + WM.mod);
#define IN(k) (a.ph_lo <= (k) && (k) < a.ph_hi)
    if (tid < 128) ((LAS unsigned*)(lds + MISC_OFF))[tid] = 0u;
    __syncthreads();
    XcdBarrier bar = xcd_barrier_post((unsigned*)ws, (volatile LAS unsigned*)(lds + MISC_OFF));
#if defined(PROBE_A)
#define STAMP(k) do { if (bx == 0 && tid == 0) ((LAS unsigned long long*)(lds + MISC_OFF + 64))[(k)] = __builtin_amdgcn_s_memrealtime(); } while (0)
#else
#define STAMP(k) do { } while (0)
#endif
    STAMP(0);
#define SEAM(k) do { if (IN(k) && IN((k) + 1)) xcd_barrier(bar); STAMP((k) + 1); } while (0)
    if (IN(PH_PREP)) {
        LAS float* scr = (LAS float*)(lds + wave * 16384);
        constexpr int I_1 = (1024 / 64) * (4096 / 32), I_2 = (4096 / 64) * (1024 / 32);
        constexpr int I_F = (1024 / 64) * (1024 / 32), I_W = (1024 / 64) * (5120 / 32);
        constexpr int NITEMS = I_1 + I_2 + I_F + I_F + I_W;
        for (int un = bx; un < 384; un += G) mod_unit(lds, un, a.in[3], a.in[4], a.in[5], a.in[6], modw, tid, wave, lane);
        if (bx == G - 1) for (int i = tid; i < 2048; i += NTHREADS) { const int dir = i >> 10, ch = i & 1023; const float l0 = a.in[11][(dir * 2 + 0) * 1024 + ch], l1 = a.in[11][(dir * 2 + 1) * 1024 + ch];
            const float mx = fmaxf(l0, l1), e0 = __expf(l0 - mx), e1 = __expf(l1 - mx); ((float*)(ws + WM.lb))[i] = e1 / (e0 + e1); }
        gen_tables(ws, (long)bx * NTHREADS + tid, (long)G * NTHREADS);
        for (int it = gw; it < NITEMS; it += ngw) {
            int r = it;
            if (r < I_F) { transpose_item(fnet_wo, 1024, 1024, (bf16_t*)(ws + WM.wfnet), scr, r, lane); continue; } r -= I_F;
            if (r < I_F) { transpose_item(a.in[13], 1024, 1024, (bf16_t*)(ws + WM.who), scr, r, lane); continue; } r -= I_F;
            if (r < I_W) { transpose_item(a.in[10], 1024, 5120, (bf16_t*)(ws + WM.win), scr, r, lane); continue; } r -= I_W;
            if (r < I_1) { transpose_item(w1, 1024, 4096, (bf16_t*)(ws + WM.w1[0]), scr, r, lane); continue; } r -= I_1;
            transpose_item(w2, 4096, 1024, (bf16_t*)(ws + WM.w2[0]), scr, r, lane);
        }
    }
    SEAM(PH_PREP);
    if (IN(PH_EMBED)) embed_rows(a.in[0], a.in[1], (const float*)(ws + WM.pos), (const float*)(ws + WM.pos) + 64 * 512, norm_mix, mod, Hb, gw, ngw, lane);
    SEAM(PH_EMBED);
    if (IN(PH_FN_CHAN)) {
        { ProbChan p; p.init(0, ws + WM.dftc, Hb, (bf16_t*)(ws + WM.yctx), G, bx); gemm_phase<ProbChan, true, true>(lds, p); }
        { ProbChan p; p.init(1, ws + WM.dftc, Hb, (bf16_t*)(ws + WM.ysmp), G, bx); gemm_phase<ProbChan, true, true>(lds, p); }
    }
    SEAM(PH_FN_CHAN);
    if (IN(PH_FN_POS1)) {
        { ProbPosCtx p; p.init(ws + WM.dl256, (const bf16_t*)(ws + WM.yctx), Hb, G, bx); gemm_phase<ProbPosCtx, true, true>(lds, p); }
        { ProbSmpA p; p.init(ws + WM.fa2, (const bf16_t*)(ws + WM.ysmp), (bf16_t*)(ws + WM.u), G, bx); gemm_phase<ProbSmpA, true, true>(lds, p); }
    }
    SEAM(PH_FN_POS1);
    if (IN(PH_FN_POS2)) { ProbSmpB p; p.init(ws + WM.mb, (const bf16_t*)(ws + WM.u), Hb, G, bx); gemm_phase<ProbSmpB, true, true>(lds, p); }
    SEAM(PH_FN_POS2);
    if (IN(PH_FN_WO)) { ProbResidFirst p; p.init_tok(Hb, 1024, ws + WM.wfnet, 1024, 0, 80, 4, G, bx); p.X = a.out; p.mod = mod; p.layer = 0; p.gidx = 2; p.init_split(G, bx, (unsigned short*)(ws + SLAB_FN)); p.xp = a.in[0]; p.xs = a.in[1]; p.er = (const float*)(ws + WM.pos); p.ec = p.er + 64 * 512; gemm_phase<ProbResidFirst, true, true>(lds, p); }
    SEAM(PH_FN_WO);
    if (IN(PH_NORM_MLP0)) { build_split_table(lds, G, tid); norm_rows(a.out, 0, 20480, norm_mlp, mod, 0, 3, Hb, gw, ngw, lane, lds, (const unsigned short*)(ws + SLAB_FN)); }
    SEAM(PH_NORM_MLP0);
    if (IN(PH_MLP1_0)) { ProbMlp1 p; p.init_tok(Hb, 1024, ws + WM.w1[0], 1024, 0, 80, 4096 / BM, G, bx); p.O = Big; p.ldc = 4096; gemm_phase<ProbMlp1, true, true>(lds, p); }
    SEAM(PH_MLP1_0);
    if (IN(PH_MLP2_0)) { ProbResid p; p.init_tok(Big, 4096, ws + WM.w2[0], 4096, 0, 80, 1024 / BM, G, bx); p.X = a.out; p.mod = mod; p.layer = 0; p.gidx = 5; p.init_split(G, bx, (unsigned short*)(ws + SLAB_M0)); gemm_phase<ProbResid, true, true>(lds, p); }
    SEAM(PH_MLP2_0);
    if (IN(PH_NORM_MIX1)) { build_split_table(lds, G, tid); norm_rows(a.out, 0, 20480, norm_mix + 1024, mod, 1, 0, Hb, gw, ngw, lane, lds, (const unsigned short*)(ws + SLAB_M0)); }
    SEAM(PH_NORM_MIX1);
    if (IN(PH_WIN)) { ProbWin p; p.init_tok(Hb, 1024, ws + WM.win, 1024, 0, 80, 20, G, bx); p.Oq = (bf16_t*)(ws + WM.q); p.Offw = (bf16_t*)(ws + WM.lffw); p.Ofbw = (bf16_t*)(ws + WM.lfbw);
        p.Ov = (bf16_t*)(ws + WM.v); p.Osg = (bf16_t*)(ws + WM.sg); p.lb = (const float*)(ws + WM.lb); gemm_phase<ProbWin, true, true>(lds, p); }
    SEAM(PH_WIN);
    if (IN(PH_SCAN_A) || IN(PH_SCAN_B) || IN(PH_SCAN_C)) {
        ScanT st; st.q = (const bf16_t*)(ws + WM.q); st.lffw = (const bf16_t*)(ws + WM.lffw); st.lfbw = (const bf16_t*)(ws + WM.lfbw); st.v = (const bf16_t*)(ws + WM.v); st.sg = (bf16_t*)(ws + WM.sg);
        st.slots = (bf16_t*)(ws + WM.slots); st.dvec = (float*)(ws + WM.dvec); st.gnorm = a.in[12]; st.state_in = a.in[2]; st.new_state = a.out + (size_t)20480 * 1024;
        if (IN(PH_SCAN_A)) scan_phase_a(lds, st, G, bx);
        SEAM(PH_SCAN_A);
        if (IN(PH_SCAN_B)) scan_phase_b(st, G, bx, tid);
        SEAM(PH_SCAN_B);
        if (IN(PH_SCAN_C)) scan_phase_c(lds, st, G, bx);
    }
    SEAM(PH_SCAN_C);
    if (IN(PH_HG_WO)) {
        { LAS float* scr = (LAS float*)(lds + wave * 16384);
          constexpr int I_1 = (1024 / 64) * (4096 / 32), I_2 = (4096 / 64) * (1024 / 32);
          for (int it = gw; it < I_1 + I_2; it += ngw) {
              if (it < I_1) transpose_item(w1 + (size_t)1024 * 4096, 1024, 4096, (bf16_t*)(ws + WM.w1[1]), scr, it, lane);
              else transpose_item(w2 + (size_t)4096 * 1024, 4096, 1024, (bf16_t*)(ws + WM.w2[1]), scr, it - I_1, lane);
          }
          __syncthreads(); }
        ProbResid p; p.init_tok((bf16_t*)(ws + WM.sg), 1024, ws + WM.who, 1024, 0, 80, 4, G, bx); p.X = a.out; p.mod = mod; p.layer = 1; p.gidx = 2; p.init_split(G, bx, (unsigned short*)(ws + SLAB_HG)); gemm_phase<ProbResid, true, true>(lds, p); }
    SEAM(PH_HG_WO);
    if (IN(PH_NORM_MLP1)) { build_split_table(lds, G, tid); norm_rows(a.out, 0, 20480, norm_mlp + 1024, mod, 1, 3, Hb, gw, ngw, lane, lds, (const unsigned short*)(ws + SLAB_HG)); }
    SEAM(PH_NORM_MLP1);
    if (IN(PH_MLP1_1)) { ProbMlp1 p; p.init_tok(Hb, 1024, ws + WM.w1[1], 1024, 0, 80, 4096 / BM, G, bx); p.O = Big1; p.ldc = 4096; gemm_phase<ProbMlp1, true, true>(lds, p); }
    SEAM(PH_MLP1_1);
    if (IN(PH_MLP2_1)) { ProbResid p; p.init_tok(Big1, 4096, ws + WM.w2[1], 4096, 0, 80, 1024 / BM, G, bx); p.X = a.out; p.mod = mod; p.layer = 1; p.gidx = 5; p.init_split(G, bx, (unsigned short*)(ws + SLAB_M1)); gemm_phase<ProbResid, true, true>(lds, p); }
    SEAM(PH_MLP2_1);
    if (IN(PH_FINAL)) { build_split_table(lds, G, tid); final_rows(a.out, 0, 20480, a.in[16], gw, ngw, lane, lds, (const unsigned short*)(ws + SLAB_M1)); }
#if defined(PROF_ID)
    if (bx == 0 && tid == 0) { const unsigned long long d = *(LAS unsigned long long*)(lds + LDS_BYTES - 512 + 256); const unsigned long long t0 = __builtin_amdgcn_s_memrealtime(); while (__builtin_amdgcn_s_memrealtime() - t0 < 16ull * d) __builtin_amdgcn_s_sleep(8); }
#endif
#if defined(PROBE_A)
    if (bx == 0 && tid == 0) { asm volatile("s_waitcnt vmcnt(0)" ::: "memory"); STAMP(PH_END); const unsigned long long d = ((LAS unsigned long long*)(lds + MISC_OFF + 64))[PROBE_B] - ((LAS unsigned long long*)(lds + MISC_OFF + 64))[PROBE_A];
        const unsigned long long t0 = __builtin_amdgcn_s_memrealtime(); while (__builtin_amdgcn_s_memrealtime() - t0 < 4ull * d) __builtin_amdgcn_s_sleep(8); }
#endif
#undef IN
}
}
#ifndef MK_N_LAUNCHES
#define MK_N_LAUNCHES 1
#endif
extern "C" void kernel_launch(void* const* d_in, const int* in_sizes, int n_in, void* d_out, int out_size, void* d_ws, size_t ws_size, hipStream_t stream) {
    static int grid = 0;
    if (grid == 0) {
        int dev = 0, cus = 0;
        if (hipGetDevice(&dev) != hipSuccess || hipDeviceGetAttribute(&cus, hipDeviceAttributeMultiprocessorCount, dev) != hipSuccess || cus <= 0) cus = 256;
        hipFuncSetAttribute((const void*)fk::fwd, hipFuncAttributeMaxDynamicSharedMemorySize, fk::LDS_BYTES);
        int per_cu = 0;
        if (hipOccupancyMaxActiveBlocksPerMultiprocessor(&per_cu, (const void*)fk::fwd, fk::NTHREADS, fk::LDS_BYTES) != hipSuccess || per_cu < 1)
            fprintf(stderr, "kernel_launch: occupancy query reports %d workgroups per CU\n", per_cu);
        (void)hipGetLastError();
        grid = cus;
    }
    hipMemsetAsync(d_ws, 0, fk::CTL_BYTES, stream);
    fk::Args a{};
    for (int i = 0; i < 17; ++i) a.in[i] = (const float*)d_in[i];
    a.out = (float*)d_out; a.ws = (unsigned char*)d_ws;
#if MK_N_LAUNCHES == 1
    a.ph_lo = 0; a.ph_hi = fk::PH_END;
    hipLaunchKernelGGL(fk::fwd, dim3(grid), dim3(fk::NTHREADS), fk::LDS_BYTES, stream, a);
#else
    for (int ph = 0; ph < fk::PH_END; ++ph) { a.ph_lo = ph; a.ph_hi = ph + 1; hipLaunchKernelGGL(fk::fwd, dim3(grid), dim3(fk::NTHREADS), fk::LDS_BYTES, stream, a); }
#endif
}
```

```cpp
#include <hip/hip_runtime.h>
#include <cstdint>
#include <cstdio>
namespace fk {
#define LAS __attribute__((address_space(3)))
#define GAS __attribute__((address_space(1)))
typedef unsigned short bf16_t;
typedef short bf16x8 __attribute__((ext_vector_type(8)));
typedef float f32x4 __attribute__((ext_vector_type(4)));
typedef float f32x2 __attribute__((ext_vector_type(2)));
typedef unsigned u32x4 __attribute__((ext_vector_type(4)));
typedef unsigned u32x2 __attribute__((ext_vector_type(2)));
constexpr int BM = 256, BK = 64, HALF = 128, HTB = HALF * BK * 2, STAGE_BYTES = 8 * HTB, NXCD = 8, WGM = 8;
constexpr int NWAVES = 8, NTHREADS = 512;

__device__ __forceinline__ int lds_byte(int r, int c) { const int st = (r >> 4) * 2 + (c >> 5), rr = r & 15, cc = c & 31, ob = rr * 64 + cc * 2; return st * 1024 + (ob ^ (((ob >> 9) & 1) << 5)); }
__device__ __forceinline__ void stage_rc(int b, int& R, int& C) { const int st = b / 1024, sb = b % 1024, swz = sb ^ (((sb >> 9) & 1) << 5); R = (st >> 1) * 16 + swz / 64; C = (st & 1) * 32 + (swz % 64) / 2; }
__device__ __forceinline__ int perm32(int rho) { const int n = rho >> 4, i = rho & 15; return 8 * (i >> 2) + 4 * n + (i & 3); }
__device__ __forceinline__ unsigned cvt_pk_bf16(float lo, float hi) { unsigned r; asm volatile("v_cvt_pk_bf16_f32 %0, %1, %2" : "=v"(r) : "v"(lo), "v"(hi)); return r; }
__device__ __forceinline__ unsigned f2bf(float f) { unsigned u = __builtin_bit_cast(unsigned, f); return (u + 0x7fffu + ((u >> 16) & 1u)) >> 16; }
__device__ __forceinline__ unsigned pk2(float lo, float hi) { return f2bf(lo) | (f2bf(hi) << 16); }
__device__ __forceinline__ float bf2f(unsigned short b) { return __builtin_bit_cast(float, (unsigned)b << 16); }
__device__ __forceinline__ unsigned pk2h(float lo, float hi) { const _Float16 a = (_Float16)lo, b = (_Float16)hi; return (unsigned)__builtin_bit_cast(unsigned short, a) | ((unsigned)__builtin_bit_cast(unsigned short, b) << 16); }
__device__ __forceinline__ float h2f_(unsigned short b) { return (float)__builtin_bit_cast(_Float16, b); }
__device__ __forceinline__ f32x4 ld_bf4(const void* p) { const u32x2 w = *(const u32x2*)p; return (f32x4){__builtin_bit_cast(float, w.x << 16), __builtin_bit_cast(float, w.x & 0xffff0000u), __builtin_bit_cast(float, w.y << 16), __builtin_bit_cast(float, w.y & 0xffff0000u)}; }
__device__ __forceinline__ void st_bf4(void* p, const f32x4& v) { u32x2 w; w.x = cvt_pk_bf16(v[0], v[1]); w.y = cvt_pk_bf16(v[2], v[3]); *(u32x2*)p = w; }
__device__ __forceinline__ float silu(float x) { return x / (1.f + __expf(-x)); }
__device__ __forceinline__ float wave_sum(float v) {
#pragma unroll
    for (int o = 1; o < 64; o <<= 1) v += __shfl_xor(v, o);
    return v;
}

constexpr unsigned long long KiB = 1024ull, MiB = 1ull << 20;
struct WsMapT { unsigned long long slots, dvec, lb, q, lffw, lfbw, v, sg, mod, pos, dftc, dl256, fa2, mb, wfnet, who, win, w1[2], w2[2], h, yctx, ysmp, u, big[2]; };
constexpr WsMapT WM = {   13 * MiB,   45 * MiB,   320 * KiB,   53 * MiB,   93 * MiB,   133 * MiB,   173 * MiB,   213 * MiB,   64 * KiB,   512 * KiB,
      53 * MiB,   53 * MiB + 256 * KiB,   53 * MiB + 512 * KiB,   54 * MiB,   59 * MiB,   1 * MiB,   3 * MiB,   {61 * MiB, 53 * MiB},   {237 * MiB, 61 * MiB},
      13 * MiB,   77 * MiB,   93 * MiB,   157 * MiB,   {77 * MiB, 69 * MiB} };
constexpr unsigned long long SLAB_FN = 77 * MiB, SLAB_M0 = 53 * MiB, SLAB_HG = 69 * MiB, SLAB_M1 = 13 * MiB;
constexpr unsigned long long CTL_BYTES = 16 * KiB;
struct Unit { size_t offA, offB; int p0, p1, p2, p3, nt; };
struct OpMap { int rm; unsigned s1, s2; };
__device__ __forceinline__ unsigned rowoff(const OpMap& m, int R) { return (unsigned)(R % m.rm) * m.s1 + (unsigned)(R / m.rm) * m.s2; }

template <class P, bool ALIGN_EPI, bool SP2>
__device__ __forceinline__ void gemm_phase(LAS unsigned char* lds, const P& pb) {
    const int tid = threadIdx.x, wid = __builtin_amdgcn_readfirstlane(tid >> 6), lane = tid & 63, wr = wid >> 2, wc = wid & 3, fr = lane & 15, fq = lane >> 4;
    unsigned voffA[2], voffB[2];
#pragma unroll
    for (int i = 0; i < 2; ++i) { int R, C; stage_rc(tid * 16 + i * 8192, R, C); const int Rb = P::PERM ? ((R & ~31) + perm32(R & 31)) : R;
        voffA[i] = rowoff(pb.ma, R) + (unsigned)C * 2u; voffB[i] = rowoff(pb.mb, Rb) + (unsigned)C * 2u; }
    const size_t kstepA = pb.kstepA, kstepB = pb.kstepB, hstepA = pb.hstepA, hstepB = pb.hstepB;
    const unsigned ldsw = (unsigned)wid * 1024u;
    const int aoff = lds_byte(wr * 64 + fr, fq * 8), boff = lds_byte(wc * 32 + fr, fq * 8);
#define PG8_SA(b, h) (((b) * 2 + (h)) * HTB)
#define PG8_SB(b, h) ((4 + (b) * 2 + (h)) * HTB)
#define PG8_STAGE(bufoff, gbase, voff) do { _Pragma("unroll") for (int _i = 0; _i < 2; ++_i) \
        __builtin_amdgcn_global_load_lds((const unsigned*)((const char*)(gbase) + (voff)[_i]), (LAS unsigned*)(lds + (bufoff) + ldsw + _i * 8192), 16, 0, 0); } while (0)
#define PG8_LDA(dst, b, h) do { _Pragma("unroll") for (int m = 0; m < 4; ++m) _Pragma("unroll") for (int k = 0; k < 2; ++k) dst[m][k] = *(const LAS bf16x8*)(lds + PG8_SA(b, h) + aoff + m * 2048 + k * 1024); } while (0)
#define PG8_LDB(dst, b, h) do { _Pragma("unroll") for (int n = 0; n < 2; ++n) _Pragma("unroll") for (int k = 0; k < 2; ++k) dst[n][k] = *(const LAS bf16x8*)(lds + PG8_SB(b, h) + boff + n * 2048 + k * 1024); } while (0)
#define PG8_MMA(ai, bj, At, Bt) do { __builtin_amdgcn_s_setprio(1); _Pragma("unroll") for (int m = 0; m < 4; ++m) _Pragma("unroll") for (int n = 0; n < 2; ++n) _Pragma("unroll") for (int k = 0; k < 2; ++k) \
        acc[ai][bj][m][n] = __builtin_amdgcn_mfma_f32_16x16x32_bf16(Bt[n][k], At[m][k], acc[ai][bj][m][n], 0, 0, 0); __builtin_amdgcn_s_setprio(0); } while (0)
#define PG8_WAIT_V(n) asm volatile("s_waitcnt vmcnt(" #n ")" ::: "memory")
#define PG8_WAIT_L(n) asm volatile("s_waitcnt lgkmcnt(" #n ")" ::: "memory")
#define PG8_BAR __builtin_amdgcn_s_barrier()
#define PG8_SCHED __builtin_amdgcn_sched_barrier(0)
    Unit cur, nxt; int ui = 0;
    if (!pb.next(0, cur)) return;
    f32x4 acc[2][2][4][2];
#pragma unroll
    for (int a = 0; a < 2; ++a)
#pragma unroll
        for (int b = 0; b < 2; ++b)
#pragma unroll
            for (int m = 0; m < 4; ++m)
#pragma unroll
                for (int n = 0; n < 2; ++n) acc[a][b][m][n] = (f32x4){0.f, 0.f, 0.f, 0.f};
    bf16x8 At[4][2], B0[2][2], B1[2][2];
    const char* cA = pb.A + cur.offA; const char* cB = pb.B + cur.offB;
    if constexpr (SP2) {
        PG8_STAGE(PG8_SB(0, 0), cB, voffB); PG8_STAGE(PG8_SB(0, 1), cB + hstepB, voffB); PG8_STAGE(PG8_SA(0, 0), cA, voffA); PG8_STAGE(PG8_SA(0, 1), cA + hstepA, voffA);
        if (wr == 1) PG8_BAR;
        PG8_WAIT_V(2); PG8_BAR;
        PG8_STAGE(PG8_SB(1, 0), cB + kstepB, voffB); PG8_STAGE(PG8_SA(1, 0), cA + kstepA, voffA); PG8_STAGE(PG8_SB(1, 1), cB + hstepB + kstepB, voffB);
        PG8_WAIT_V(6); PG8_BAR;
    } else {
        PG8_STAGE(PG8_SB(0, 0), cB, voffB); PG8_STAGE(PG8_SA(0, 0), cA, voffA); PG8_STAGE(PG8_SB(0, 1), cB + hstepB, voffB); PG8_STAGE(PG8_SA(0, 1), cA + hstepA, voffA);
        if (wr == 1) PG8_BAR;
        PG8_WAIT_V(4); PG8_BAR;
        PG8_STAGE(PG8_SB(1, 0), cB + kstepB, voffB); PG8_STAGE(PG8_SA(1, 0), cA + kstepA, voffA); PG8_STAGE(PG8_SB(1, 1), cB + hstepB + kstepB, voffB);
        PG8_WAIT_V(6); PG8_BAR;
    }
    for (;;) {
        const bool has_next = pb.next(ui + 1, nxt);
        const char* nA = has_next ? pb.A + nxt.offA : cA; const char* nB = has_next ? pb.B + nxt.offB : cB;
        const int nt = cur.nt;
        for (int t = 0; t < nt; t += 2) {
            const bool last = (t == nt - 2);
            const char* a1 = cA + (size_t)(t + 1) * kstepA;
            const char* a2 = last ? nA : cA + (size_t)(t + 2) * kstepA; const char* b2 = last ? nB : cB + (size_t)(t + 2) * kstepB;
            const char* a3 = a2 + kstepA; const char* b3 = b2 + kstepB;
            if constexpr (SP2) {
            PG8_LDB(B0, 0, 0); PG8_LDB(B1, 0, 1); PG8_SCHED; PG8_LDA(At, 0, 0); PG8_STAGE(PG8_SA(1, 1), a1 + hstepA, voffA);
            PG8_WAIT_V(8); PG8_WAIT_L(0); PG8_BAR; PG8_MMA(0, 0, At, B0); PG8_MMA(0, 1, At, B1); PG8_BAR; PG8_SCHED;
            PG8_LDA(At, 0, 1); PG8_STAGE(PG8_SB(0, 0), b2, voffB); PG8_STAGE(PG8_SB(0, 1), b2 + hstepB, voffB); PG8_STAGE(PG8_SA(0, 0), a2, voffA);
            PG8_WAIT_V(8); PG8_WAIT_L(0); PG8_BAR; PG8_MMA(1, 0, At, B0); PG8_MMA(1, 1, At, B1); PG8_BAR; PG8_SCHED;
            PG8_LDB(B0, 1, 0); PG8_LDB(B1, 1, 1); PG8_SCHED; PG8_LDA(At, 1, 0); PG8_STAGE(PG8_SA(0, 1), a2 + hstepA, voffA);
            PG8_WAIT_V(8); PG8_WAIT_L(0); PG8_BAR; PG8_MMA(0, 0, At, B0); PG8_MMA(0, 1, At, B1); PG8_BAR; PG8_SCHED;
            PG8_LDA(At, 1, 1); PG8_STAGE(PG8_SB(1, 0), b3, voffB); PG8_STAGE(PG8_SB(1, 1), b3 + hstepB, voffB); PG8_STAGE(PG8_SA(1, 0), a3, voffA);
            PG8_WAIT_V(8); PG8_WAIT_L(0); PG8_BAR; PG8_MMA(1, 0, At, B0); PG8_MMA(1, 1, At, B1); PG8_BAR; PG8_SCHED;
            } else {
            PG8_LDB(B0, 0, 0); PG8_SCHED; PG8_LDA(At, 0, 0); PG8_STAGE(PG8_SA(1, 1), a1 + hstepA, voffA);
            PG8_WAIT_L(8); PG8_BAR; PG8_WAIT_L(0); PG8_MMA(0, 0, At, B0); PG8_BAR; PG8_SCHED;
            PG8_LDB(B1, 0, 1); PG8_STAGE(PG8_SB(0, 0), b2, voffB);
            PG8_BAR; PG8_WAIT_L(0); PG8_MMA(0, 1, At, B1); PG8_BAR;
            PG8_LDA(At, 0, 1); PG8_STAGE(PG8_SA(0, 0), a2, voffA);
            PG8_BAR; PG8_WAIT_L(0); PG8_MMA(1, 0, At, B0); PG8_BAR; PG8_SCHED;
            PG8_STAGE(PG8_SB(0, 1), b2 + hstepB, voffB);
            PG8_WAIT_V(6); PG8_BAR; PG8_MMA(1, 1, At, B1); PG8_BAR;
            PG8_LDB(B0, 1, 0); PG8_SCHED; PG8_LDA(At, 1, 0); PG8_STAGE(PG8_SA(0, 1), a2 + hstepA, voffA);
            PG8_WAIT_L(8); PG8_BAR; PG8_WAIT_L(0); PG8_MMA(0, 0, At, B0); PG8_BAR; PG8_SCHED;
            PG8_LDB(B1, 1, 1); PG8_STAGE(PG8_SB(1, 0), b3, voffB);
            PG8_BAR; PG8_WAIT_L(0); PG8_MMA(0, 1, At, B1); PG8_BAR;
            PG8_LDA(At, 1, 1); PG8_STAGE(PG8_SA(1, 0), a3, voffA);
            PG8_BAR; PG8_WAIT_L(0); PG8_MMA(1, 0, At, B0); PG8_BAR; PG8_SCHED;
            PG8_STAGE(PG8_SB(1, 1), b3 + hstepB, voffB);
            PG8_WAIT_V(6); PG8_BAR; PG8_MMA(1, 1, At, B1); PG8_BAR;
            }
        }
        if constexpr (ALIGN_EPI) { if (wr == 0) PG8_BAR; }
        pb.epi(acc, cur, wr, wc, fr, fq);
        if (!has_next) break;
#pragma unroll
        for (int a = 0; a < 2; ++a)
#pragma unroll
            for (int b = 0; b < 2; ++b)
#pragma unroll
                for (int m = 0; m < 4; ++m)
#pragma unroll
                    for (int n = 0; n < 2; ++n) acc[a][b][m][n] = (f32x4){0.f, 0.f, 0.f, 0.f};
        cur = nxt; cA = nA; cB = nB; ++ui;
        if constexpr (ALIGN_EPI) { if (wr == 1) PG8_BAR; }
    }
    PG8_WAIT_V(0);
    if constexpr (!ALIGN_EPI) { if (wr == 0) PG8_BAR; }
    PG8_BAR;
#undef PG8_SA
#undef PG8_SB
#undef PG8_STAGE
#undef PG8_LDA
#undef PG8_LDB
#undef PG8_MMA
#undef PG8_WAIT_V
#undef PG8_WAIT_L
#undef PG8_BAR
#undef PG8_SCHED
}

struct StaticOrder {
    int nM, nN, nwg, G, c;
    __device__ void init(int nM_, int nN_, int G_, int c_) { nM = nM_; nN = nN_; nwg = nM * nN; G = G_; c = c_; }
    __device__ bool next(int i, int& pm, int& pn) const { const long L = (long)i * G + c; if (L >= nwg) return false; map((int)L, pm, pn); return true; }
    __device__ void map(int L, int& pm, int& pn) const {
        int wgid = L; { const int q = nwg / NXCD, r = nwg % NXCD, xcd = wgid % NXCD, off = wgid / NXCD; wgid = (xcd < r ? xcd * (q + 1) : r * (q + 1) + (xcd - r) * q) + off; }
        const int nig = WGM * nN, gid = wgid / nig, fm = gid * WGM, gsz = (nM - fm) < WGM ? (nM - fm) : WGM;
        pm = fm + ((wgid % nig) % gsz); pn = (wgid % nig) / gsz;
    }
};

struct ProbBase {
    const char* A; const char* B; OpMap ma, mb; size_t hstepA, hstepB, kstepA, kstepB; int nt;
    __device__ void std_operands(const void* A_, int lda, const void* B_, int ldb, int K) {
        A = (const char*)A_; B = (const char*)B_; ma = OpMap{128, (unsigned)lda * 2u, 0u}; mb = OpMap{128, (unsigned)ldb * 2u, 0u};
        hstepA = (size_t)HALF * lda * 2; hstepB = (size_t)HALF * ldb * 2; kstepA = kstepB = BK * 2; nt = K / BK;
    }
};

template <class F> __device__ __forceinline__ void epi_rows_perm(const f32x4 (&acc)[2][2][4][2], int wr, int wc, int fr, int fq, F f) {
    asm volatile("" : "+v"(fr), "+v"(fq));
#pragma unroll
    for (int ai = 0; ai < 2; ++ai)
#pragma unroll
        for (int m = 0; m < 4; ++m)
#pragma unroll
            for (int bj = 0; bj < 2; ++bj) f(ai * HALF + wr * 64 + m * 16 + fr, bj * HALF + wc * 32 + 8 * fq, acc[ai][bj][m][0], acc[ai][bj][m][1]);
}
template <class F> __device__ __forceinline__ void epi_rows_f32(const f32x4 (&acc)[2][2][4][2], int wr, int wc, int fr, int fq, F f) {
    asm volatile("" : "+v"(fr), "+v"(fq));
#pragma unroll
    for (int ai = 0; ai < 2; ++ai)
#pragma unroll
        for (int m = 0; m < 4; ++m)
#pragma unroll
            for (int bj = 0; bj < 2; ++bj)
#pragma unroll
                for (int n = 0; n < 2; ++n) f(ai * HALF + wr * 64 + m * 16 + fr, bj * HALF + wc * 32 + 16 * n + 4 * fq, acc[ai][bj][m][n]);
}
__device__ __forceinline__ u32x4 pack8(const f32x4& v0, const f32x4& v1) { u32x4 w; w.x = cvt_pk_bf16(v0[0], v0[1]); w.y = cvt_pk_bf16(v0[2], v0[3]); w.z = cvt_pk_bf16(v1[0], v1[1]); w.w = cvt_pk_bf16(v1[2], v1[3]); return w; }

struct TokOrder : ProbBase {
    StaticOrder so; int row0, lda, ldb;
    __device__ void init_tok(const void* Act, int lda_, const void* Wt, int K, int row0_, int nM, int nN, int G, int c) { std_operands(Act, lda_, Wt, K, K); row0 = row0_; lda = lda_; ldb = K; so.init(nM, nN, G, c); }
    __device__ bool next(int i, Unit& u) const { int pm, pn; if (!so.next(i, pm, pn)) return false; u.p0 = pm; u.p1 = pn; u.p2 = -1; u.nt = nt; u.offA = (size_t)(row0 + pm * BM) * lda * 2; u.offB = (size_t)pn * BM * ldb * 2; return true; }
};
struct ProbMlp1 : TokOrder {
    static constexpr bool PERM = true;
    bf16_t* O; int ldc;
    __device__ __forceinline__ void epi(const f32x4 (&acc)[2][2][4][2], const Unit& u, int wr, int wc, int fr, int fq) const {
        bf16_t* base = O + (size_t)(row0 + u.p0 * BM) * ldc + u.p1 * BM;
        epi_rows_perm(acc, wr, wc, fr, fq, [&](int r, int c, f32x4 v0, f32x4 v1) {
#pragma unroll
            for (int j = 0; j < 4; ++j) { const float a = fmaxf(v0[j], 0.f), b = fmaxf(v1[j], 0.f); v0[j] = a * a; v1[j] = b * b; }
            *(u32x4*)(base + (size_t)r * ldc + c) = pack8(v0, v1); });
    }
};
template <bool FIRST> struct ProbResidT : TokOrder {
    static constexpr bool PERM = false;
    bf16_t* X; const float* mod; int layer, gidx; unsigned short* slab; int G2, c2;
    const float* xp; const float* xs; const float* er; const float* ec;
    __device__ void init_split(int G_, int c_, unsigned short* slab_) { G2 = G_; c2 = c_; slab = slab_; xp = nullptr; xs = nullptr; er = nullptr; ec = nullptr; }
    __device__ bool next(int i, Unit& u) const {
        if (G2 != 256) return TokOrder::next(i, u);
        int pm, pn;
        if (i > 1) return false;
        const int which = (c2 & 1) ? 1 - i : i;
        if (which == 0) { so.map(c2, pm, pn); u.p2 = -1; u.p3 = 0; u.nt = nt; u.offA = (size_t)(row0 + pm * BM) * lda * 2; u.offB = (size_t)pn * BM * ldb * 2; }
        else { const int L = 256 + (c2 >> 2), kq = c2 & 3, ntq = nt >> 2; so.map(L, pm, pn); u.p2 = kq; u.p3 = L - 256; u.nt = ntq;
            u.offA = (size_t)(row0 + pm * BM) * lda * 2 + (size_t)kq * ntq * BK * 2; u.offB = (size_t)pn * BM * ldb * 2 + (size_t)kq * ntq * BK * 2; }
        u.p0 = pm; u.p1 = pn; return true;
    }
    __device__ __forceinline__ void epi(const f32x4 (&acc)[2][2][4][2], const Unit& u, int wr, int wc, int fr, int fq) const {
        const int rowt = row0 + u.p0 * BM, cond = rowt >> 12;
        const float* gate = mod + ((size_t)(cond * 2 + layer) * 6 + gidx) * 1024 + u.p1 * BM;
        if (u.p2 <= 0) {
            bf16_t* base = X + (size_t)rowt * 2048 + u.p1 * BM;
            if constexpr (FIRST) {
                const int colt = u.p1 * BM; const bool smp = rowt >= 4096, use_er = colt < 512; const int t0 = rowt & 4095;
                const float* xsrc = smp ? xs + (size_t)(rowt - 4096) * 1024 + colt : xp + (size_t)rowt * 1024 + colt;
                const float* pbase = use_er ? er + colt : ec + colt - 512;
                epi_rows_f32(acc, wr, wc, fr, fq, [&](int r, int c, f32x4 v) {
                    const f32x4 g = *(const f32x4*)(gate + c); f32x4 x0 = *(const f32x4*)(xsrc + (size_t)r * 1024 + c);
                    if (smp) { const int t = t0 + r; x0 = x0 + *(const f32x4*)(pbase + (use_er ? (t >> 6) : (t & 63)) * 512 + c); }
                    st_bf4(base + (size_t)r * 2048 + c, x0 + g * v); });
            } else {
                epi_rows_f32(acc, wr, wc, fr, fq, [&](int r, int c, f32x4 v) {
                    const f32x4 g = *(const f32x4*)(gate + c); bf16_t* p = base + (size_t)r * 2048 + c; st_bf4(p, ld_bf4(p) + g * v); });
            }
        } else {
            unsigned short* base = slab + (size_t)(u.p3 * 3 + u.p2 - 1) * 65536;
            epi_rows_f32(acc, wr, wc, fr, fq, [&](int r, int c, f32x4 v) {
                const f32x4 g = *(const f32x4*)(gate + c); const f32x4 w = g * v; u32x2 o; o.x = pk2h(w[0], w[1]); o.y = pk2h(w[2], w[3]); *(u32x2*)(base + (size_t)r * 256 + c) = o; });
        }
    }
};
typedef ProbResidT<false> ProbResid; typedef ProbResidT<true> ProbResidFirst;
__device__ __forceinline__ void build_split_table(LAS unsigned char* tab, int G, int tid) {
    for (int i = tid; i < 320; i += NTHREADS) tab[i] = 255;
    __syncthreads();
    if (G == 256) { StaticOrder so; so.init(80, 4, G, 0); for (int L = 256 + tid; L < 320; L += NTHREADS) { int pm, pn; so.map(L, pm, pn); tab[pm * 4 + pn] = (unsigned char)(L - 256); } }
    __syncthreads();
}
__device__ __forceinline__ f32x4 slab_sum(const unsigned short* slab, int idx, int r255, int col) {
    f32x4 s = (f32x4){0.f, 0.f, 0.f, 0.f};
#pragma unroll
    for (int q = 0; q < 3; ++q) { const u32x2 w = *(const u32x2*)(slab + (size_t)(idx * 3 + q) * 65536 + (size_t)r255 * 256 + col);
        s[0] += h2f_((unsigned short)(w.x & 0xffffu)); s[1] += h2f_((unsigned short)(w.x >> 16)); s[2] += h2f_((unsigned short)(w.y & 0xffffu)); s[3] += h2f_((unsigned short)(w.y >> 16)); }
    return s;
}

struct ProbWin : TokOrder {
    static constexpr bool PERM = true;
    bf16_t* Oq; bf16_t* Offw; bf16_t* Ofbw; bf16_t* Ov; bf16_t* Osg; const float* lb;
    __device__ __forceinline__ void epi(const f32x4 (&acc)[2][2][4][2], const Unit& u, int wr, int wc, int fr, int fq) const {
        const int t = u.p1 >> 2, col0 = (u.p1 & 3) * BM;
        bf16_t* O = t == 0 ? Oq : t == 1 ? Offw : t == 2 ? Ofbw : t == 3 ? Ov : Osg;
        bf16_t* base = O + (size_t)(row0 + u.p0 * BM) * 1024 + col0;
        if (t == 1 || t == 2) {
            const float* lbp = lb + (t - 1) * 1024 + col0;
            epi_rows_perm(acc, wr, wc, fr, fq, [&](int r, int c, f32x4 v0, f32x4 v1) {
                const f32x4 l0 = *(const f32x4*)(lbp + c), l1 = *(const f32x4*)(lbp + c + 4);
#pragma unroll
                for (int j = 0; j < 4; ++j) { v0[j] = __builtin_amdgcn_logf(l0[j] + (1.f - l0[j]) * __builtin_amdgcn_rcpf(1.f + __builtin_amdgcn_exp2f(-1.44269504f * v0[j]))); v1[j] = __builtin_amdgcn_logf(l1[j] + (1.f - l1[j]) * __builtin_amdgcn_rcpf(1.f + __builtin_amdgcn_exp2f(-1.44269504f * v1[j]))); }
                u32x4 w; w.x = pk2h(v0[0], v0[1]); w.y = pk2h(v0[2], v0[3]); w.z = pk2h(v1[0], v1[1]); w.w = pk2h(v1[2], v1[3]);
                *(u32x4*)(base + (size_t)r * 1024 + c) = w; });
        } else if (t == 3) {
            epi_rows_perm(acc, wr, wc, fr, fq, [&](int r, int c, f32x4 v0, f32x4 v1) { *(u32x4*)(base + (size_t)r * 1024 + c) = pack8(v0, v1); });
        } else {
            epi_rows_perm(acc, wr, wc, fr, fq, [&](int r, int c, f32x4 v0, f32x4 v1) {
#pragma unroll
                for (int j = 0; j < 4; ++j) { v0[j] = silu(v0[j]); v1[j] = silu(v1[j]); }
                *(u32x4*)(base + (size_t)r * 1024 + c) = pack8(v0, v1); });
        }
    }
};

struct ProbChan : ProbBase {
    static constexpr bool PERM = true;
    int mode, G, c, nunits; bf16_t* Y;
    __device__ void init(int mode_, const void* dftc, const bf16_t* h0, bf16_t* Y_, int G_, int c_) {
        mode = mode_; G = G_; c = c_; Y = Y_; A = (const char*)dftc; B = (const char*)h0; ma = OpMap{128, 512u, 0u}; hstepA = (size_t)HALF * 512; kstepA = kstepB = BK * 2; nt = 4;
        if (mode == 0) { mb = OpMap{128, 2048u, 0u}; hstepB = (size_t)HALF * 2048; nunits = 16 * 4 * 2; }
        else { mb = OpMap{64, 64u * 2048u, 2048u}; hstepB = 2 * 2048; nunits = 4 * 4 * 16 * 2; }
    }
    __device__ bool next(int i, Unit& u) const {
        const int L = i * G + c; if (L >= nunits) return false;
        const int mt = L & 1; u.p0 = mt; u.nt = nt; u.offA = (size_t)mt * 256 * 512;
        if (mode == 0) { const int g = (L >> 1) & 3, b = L >> 3; u.p1 = b * 2048 + g * 512; u.p2 = 0; u.offB = ((size_t)(b * 256) * 1024 + g * 256) * 2; }
        else { const int j = (L >> 1) & 15, g = (L >> 5) & 3, b = L >> 7; u.p1 = b * 2048 + g * 512; u.p2 = j * 256; u.offB = ((size_t)(4096 + b * 4096 + 4 * j) * 1024 + g * 256) * 2; }
        return true;
    }
    __device__ __forceinline__ void epi(const f32x4 (&acc)[2][2][4][2], const Unit& u, int wr, int wc, int fr, int fq) const {
        const int ldc = mode == 0 ? 256 : 4096;
        bf16_t* base = Y + (size_t)(u.p1 + u.p0 * 256) * ldc + u.p2;
        epi_rows_perm(acc, wr, wc, fr, fq, [&](int r, int cc, f32x4 v0, f32x4 v1) { *(u32x4*)(base + (size_t)r * ldc + cc) = pack8(v0, v1); });
    }
};
struct ProbPosCtx : ProbBase {
    static constexpr bool PERM = true;
    int G, c; bf16_t* Z;
    __device__ void init(const void* dl, const bf16_t* yctx, bf16_t* Z_, int G_, int c_) { std_operands(dl, 512, yctx, 512, 512); G = G_; c = c_; Z = Z_; }
    __device__ bool next(int i, Unit& u) const {
        const int L = i * G + c; if (L >= 64) return false;
        const int pn = L & 3, b = L >> 2; u.p0 = b; u.p1 = pn; u.nt = nt; u.offA = 0; u.offB = ((size_t)b * 2048 * 256 + (size_t)pn * 256 * 512) * 2; return true;
    }
    __device__ __forceinline__ void epi(const f32x4 (&acc)[2][2][4][2], const Unit& u, int wr, int wc, int fr, int fq) const {
        bf16_t* base = Z + (size_t)(u.p0 * 256) * 1024 + u.p1 * 256;
        epi_rows_perm(acc, wr, wc, fr, fq, [&](int r, int cc, f32x4 v0, f32x4 v1) { *(u32x4*)(base + (size_t)r * 1024 + cc) = pack8(v0, v1); });
    }
};
struct ProbSmpA : ProbBase {
    static constexpr bool PERM = true;
    int G, c; bf16_t* U;
    __device__ void init(const void* fa2, const bf16_t* yt, bf16_t* U_, int G_, int c_) {
        A = (const char*)fa2; B = (const char*)yt; ma = OpMap{128, 512u, 0u}; hstepA = (size_t)HALF * 512; kstepA = BK * 2;
        mb = OpMap{32, 128u, 16384u}; hstepB = 4 * 16384; kstepB = 4096; nt = 4; G = G_; c = c_; U = U_;
    }
    __device__ bool next(int i, Unit& u) const {
        const int L = i * G + c; if (L >= 512) return false;
        const int tau = L & 127, b = L >> 7; u.p0 = b; u.p1 = tau; u.nt = nt; u.offA = 0; u.offB = ((size_t)(b * 2048 + 16 * tau) * 4096) * 2; return true;
    }
    __device__ __forceinline__ void epi(const f32x4 (&acc)[2][2][4][2], const Unit& u, int wr, int wc, int fr, int fq) const {
        bf16_t* base = U + (size_t)(u.p0 * 1024 + 8 * u.p1) * 8192;
        epi_rows_perm(acc, wr, wc, fr, fq, [&](int r, int cc, f32x4 v0, f32x4 v1) {
            *(u32x4*)(base + (size_t)(cc >> 5) * 8192 + (r & 127) * 64 + (r >> 7) * 32 + (cc & 31)) = pack8(v0, v1); });
    }
};
struct ProbSmpB : ProbBase {
    static constexpr bool PERM = true;
    int G, c; bf16_t* Z;
    __device__ void init(const void* mbm, const bf16_t* Uin, bf16_t* Z_, int G_, int c_) { std_operands(mbm, 512, Uin, 8192, 512); G = G_; c = c_; Z = Z_; }
    __device__ bool next(int i, Unit& u) const {
        const int L = i * G + c; if (L >= 256) return false;
        const int pn = L & 3, q = (L >> 2) & 15, b = L >> 6; u.p0 = b; u.p1 = q; u.p2 = pn; u.nt = nt;
        u.offA = (size_t)q * 256 * 512 * 2; u.offB = ((size_t)(b * 1024 + pn * 256) * 8192 + q * 512) * 2; return true;
    }
    __device__ __forceinline__ void epi(const f32x4 (&acc)[2][2][4][2], const Unit& u, int wr, int wc, int fr, int fq) const {
        bf16_t* base = Z + (size_t)(4096 + u.p0 * 4096 + 4 * u.p1) * 1024 + u.p2 * 256;
        epi_rows_perm(acc, wr, wc, fr, fq, [&](int r, int cc, f32x4 v0, f32x4 v1) {
            const int l = (r >> 6) + 64 * (r & 63); *(u32x4*)(base + (size_t)l * 1024 + cc) = pack8(v0, v1); });
    }
};

__device__ __forceinline__ void norm_rows(bf16_t* X, int row0, int nrows, const float* g, const float* mod, int layer, int ish, bf16_t* H, int gw, int ngw, int lane, const LAS unsigned char* stab, const unsigned short* slab) {
    f32x4 gv[4];
#pragma unroll
    for (int j = 0; j < 4; ++j) gv[j] = *(const f32x4*)(g + 4 * lane + 256 * j);
    u32x2 nx[4];
    { const int r = row0 + gw; if (r < row0 + nrows) { const u32x2* p = (const u32x2*)(X + (size_t)r * 2048) + lane;
#pragma unroll
        for (int j = 0; j < 4; ++j) nx[j] = p[64 * j]; } }
    for (int r = row0 + gw; r < row0 + nrows; r += ngw) {
        u32x2* xr = (u32x2*)(X + (size_t)r * 2048) + lane;
        const float* mrow = mod + ((size_t)((r >> 12) * 2 + layer) * 6) * 1024;
        f32x4 v[4]; float s = 0.f;
#pragma unroll
        for (int j = 0; j < 4; ++j) v[j] = (f32x4){__builtin_bit_cast(float, nx[j].x << 16), __builtin_bit_cast(float, nx[j].x & 0xffff0000u), __builtin_bit_cast(float, nx[j].y << 16), __builtin_bit_cast(float, nx[j].y & 0xffff0000u)};
        if (r + ngw < row0 + nrows) { const u32x2* p = (const u32x2*)(X + (size_t)(r + ngw) * 2048) + lane;
#pragma unroll
            for (int j = 0; j < 4; ++j) nx[j] = p[64 * j]; }
#pragma unroll
        for (int j = 0; j < 4; ++j) { const int si = stab[(r >> 8) * 4 + j]; if (si != 255) { v[j] = v[j] + slab_sum(slab, si, r & 255, 4 * lane); st_bf4(xr + 64 * j, v[j]); } s += (v[j].x * v[j].x + v[j].y * v[j].y) + (v[j].z * v[j].z + v[j].w * v[j].w); }
        const float rstd = rsqrtf(wave_sum(s) * (1.f / 1024.f) + 1e-6f);
        unsigned long long* o8 = (unsigned long long*)(H + (size_t)r * 1024) + lane;
#pragma unroll
        for (int j = 0; j < 4; ++j) {
            const f32x4 sh = *(const f32x4*)(mrow + (size_t)ish * 1024 + 4 * lane + 256 * j), sc = *(const f32x4*)(mrow + (size_t)(ish + 1) * 1024 + 4 * lane + 256 * j);
            const f32x4 o = v[j] * rstd * gv[j] * (sc + 1.f) + sh;
            o8[64 * j] = (unsigned long long)pk2(o.x, o.y) | ((unsigned long long)pk2(o.z, o.w) << 32);
        }
    }
}


__device__ __forceinline__ void embed_rows(const float* xp, const float* xs, const float* er, const float* ec, const float* g, const float* mod, bf16_t* H, int gw, int ngw, int lane) {
    f32x4 gv[4];
#pragma unroll
    for (int j = 0; j < 4; ++j) gv[j] = *(const f32x4*)(g + 4 * lane + 256 * j);
    for (int r = gw; r < 20480; r += ngw) {
        const f32x4* xr = (const f32x4*)(r < 4096 ? xp + (size_t)r * 1024 : xs + (size_t)(r - 4096) * 1024) + lane;
        const float* mrow = mod + ((size_t)((r >> 12) * 2 + 0) * 6) * 1024;
        f32x4 v[4]; float s = 0.f;
#pragma unroll
        for (int j = 0; j < 4; ++j) v[j] = xr[64 * j];
        if (r >= 4096) { const int t = r & 4095, row = t >> 6, col = t & 63;
            v[0] = v[0] + *(const f32x4*)(er + row * 512 + 4 * lane); v[1] = v[1] + *(const f32x4*)(er + row * 512 + 256 + 4 * lane);
            v[2] = v[2] + *(const f32x4*)(ec + col * 512 + 4 * lane); v[3] = v[3] + *(const f32x4*)(ec + col * 512 + 256 + 4 * lane); }
#pragma unroll
        for (int j = 0; j < 4; ++j) { s += (v[j].x * v[j].x + v[j].y * v[j].y) + (v[j].z * v[j].z + v[j].w * v[j].w); }
        const float rstd = rsqrtf(wave_sum(s) * (1.f / 1024.f) + 1e-6f);
        unsigned long long* o8 = (unsigned long long*)(H + (size_t)r * 1024) + lane;
#pragma unroll
        for (int j = 0; j < 4; ++j) {
            const f32x4 sh = *(const f32x4*)(mrow + 4 * lane + 256 * j), sc = *(const f32x4*)(mrow + 1024 + 4 * lane + 256 * j);
            const f32x4 o = v[j] * rstd * gv[j] * (sc + 1.f) + sh;
            o8[64 * j] = (unsigned long long)pk2(o.x, o.y) | ((unsigned long long)pk2(o.z, o.w) << 32);
        }
    }
}
__device__ __forceinline__ void gen_tables(unsigned char* ws, long e0, long estride) {
    bf16_t* dftc = (bf16_t*)(ws + WM.dftc); bf16_t* dl = (bf16_t*)(ws + WM.dl256); bf16_t* fa2 = (bf16_t*)(ws + WM.fa2); bf16_t* mbm = (bf16_t*)(ws + WM.mb);
    float* er = (float*)(ws + WM.pos); float* ec = er + 64 * 512;
    constexpr long N0 = 512 * 256, N1 = 256 * 512, N2 = 256 * 256, N3 = 16L * 256 * 512, N4 = 2 * 64 * 512;
    for (long e = e0; e < N0 + N1 + N2 + N3 + N4; e += estride) {
        long r = e;
        if (r < N0) { const int mrow = (int)(r >> 8), cp = (int)(r & 255), cc = mrow >> 1, ri = mrow & 1; const float x = 2.f * (float)((cc * cp) & 255) / 256.f;
            dftc[r] = (bf16_t)f2bf(ri == 0 ? cospif(x) : -sinpif(x)); continue; } r -= N0;
        if (r < N1) { const int l = (int)(r >> 9), k = (int)(r & 511), ri = k >> 8, lp = k & 255; const float x = 2.f * (float)((l * lp) & 255) / 256.f;
            dl[r] = (bf16_t)f2bf((ri == 0 ? cospif(x) : sinpif(x)) * (1.f / 256.f)); continue; } r -= N1;
        if (r < N2) { const int mrow = (int)(r >> 8), k = (int)(r & 255), sA = mrow >> 7, k1 = (mrow >> 1) & 63, ro = mrow & 1, ri = k >> 7, sB = (k >> 6) & 1, l1 = k & 63;
            const float x = 2.f * (float)((k1 * l1) & 63) / 64.f; float v = 0.f;
            if (sA == sB) v = (ro == ri) ? cospif(x) : (ro == 0 ? sinpif(x) : -sinpif(x));
            fa2[r] = (bf16_t)f2bf(v); continue; } r -= N2;
        if (r < N3) { const int q = (int)(r >> 17), mrow = (int)(r >> 9) & 255, k = (int)(r & 511), ko = mrow >> 6, k2 = mrow & 63, kop = k >> 7, ro = (k >> 6) & 1, l2 = k & 63;
            const int l = 4 * q + ko + 64 * k2; const float x = 2.f * (float)((l * l2) & 4095) / 4096.f; float v = 0.f;
            if (ko == kop) v = (ro == 0 ? cospif(x) : sinpif(x)) * (1.f / 1024.f);
            mbm[r] = (bf16_t)f2bf(v); continue; } r -= N3;
        { const int which = (int)(r >> 15), p = (int)(r >> 9) & 63, j = (int)(r & 511), i = j & 255;
            const float omega = 1.0f / powf(10000.0f, (float)i / 256.0f); const float ang = (float)p * omega;
            (which == 0 ? er : ec)[p * 512 + j] = (j < 256) ? sinf(ang) : cosf(ang); }
    }
}


__device__ __forceinline__ void final_rows(float* X, int row0, int nrows, const float* g, int gw, int ngw, int lane, const LAS unsigned char* stab, const unsigned short* slab) {
    f32x4 gv[4];
#pragma unroll
    for (int j = 0; j < 4; ++j) gv[j] = *(const f32x4*)(g + 4 * lane + 256 * j);
    u32x2 nx[4];
    { const int r = row0 + gw; if (r < row0 + nrows) { const u32x2* p = (const u32x2*)(X + (size_t)r * 1024) + lane;
#pragma unroll
        for (int j = 0; j < 4; ++j) nx[j] = p[64 * j]; } }
    for (int r = row0 + gw; r < row0 + nrows; r += ngw) {
        f32x4* xr = (f32x4*)(X + (size_t)r * 1024) + lane;
        f32x4 v[4]; float s = 0.f;
#pragma unroll
        for (int j = 0; j < 4; ++j) v[j] = (f32x4){__builtin_bit_cast(float, nx[j].x << 16), __builtin_bit_cast(float, nx[j].x & 0xffff0000u), __builtin_bit_cast(float, nx[j].y << 16), __builtin_bit_cast(float, nx[j].y & 0xffff0000u)};
        if (r + ngw < row0 + nrows) { const u32x2* p = (const u32x2*)(X + (size_t)(r + ngw) * 1024) + lane;
#pragma unroll
            for (int j = 0; j < 4; ++j) nx[j] = p[64 * j]; }
#pragma unroll
        for (int j = 0; j < 4; ++j) { const int si = stab[(r >> 8) * 4 + j]; if (si != 255) v[j] = v[j] + slab_sum(slab, si, r & 255, 4 * lane); s += (v[j].x * v[j].x + v[j].y * v[j].y) + (v[j].z * v[j].z + v[j].w * v[j].w); }
        const float rstd = rsqrtf(wave_sum(s) * (1.f / 1024.f) + 1e-6f);
#pragma unroll
        for (int j = 0; j < 4; ++j) xr[64 * j] = v[j] * rstd * gv[j];
    }
}
__device__ __forceinline__ void mod_unit(LAS unsigned char* lds, int unit, const float* c, const float* c_ctx, const float* ada_w, const float* ada_b, float* mod, int tid, int wave, int lane) {
    LAS float* sc = (LAS float*)lds;
    LAS float* red = (LAS float*)(lds + 20480);
    const int layer = unit / 192, n0 = (unit % 192) * 32, col = lane & 31, kh = lane >> 5;
    for (int i = tid; i < 5 * 1024; i += NTHREADS) { const int cond = i >> 10, k = i & 1023; const float x = cond == 0 ? c_ctx[k] : c[(cond - 1) * 1024 + k]; sc[i] = silu(x); }
    __syncthreads();
    const float* w = ada_w + ((size_t)layer * 1024 + wave * 128 + kh) * 6144 + n0 + col;
    float acc[5];
#pragma unroll
    for (int q = 0; q < 5; ++q) acc[q] = 0.f;
#pragma unroll 8
    for (int k = 0; k < 64; ++k) {
        const float wv = w[(size_t)(2 * k) * 6144];
#pragma unroll
        for (int q = 0; q < 5; ++q) acc[q] += wv * sc[q * 1024 + wave * 128 + 2 * k + kh];
    }
#pragma unroll
    for (int q = 0; q < 5; ++q) { acc[q] += __shfl_xor(acc[q], 32); if (kh == 0) red[(wave * 5 + q) * 32 + col] = acc[q]; }
    __syncthreads();
    for (int i = tid; i < 5 * 32; i += NTHREADS) { const int q = i >> 5, n = i & 31; float s = 0.f;
#pragma unroll
        for (int ww = 0; ww < 8; ++ww) s += red[(ww * 5 + q) * 32 + n];
        mod[((size_t)q * 2 + layer) * 6144 + n0 + n] = s + ada_b[(size_t)layer * 6144 + n0 + n]; }
    __syncthreads();
}

__device__ __forceinline__ void transpose_item(const float* W, int K, int N, bf16_t* WT, LAS float* scr, int item, int lane) {
    const int nblk = N / 32, kb = item / nblk, nb = item % nblk, k0 = 64 * kb, n0 = 32 * nb;
    f32x4 ld[8];
#pragma unroll
    for (int i = 0; i < 8; ++i) ld[i] = *(const f32x4*)(W + (size_t)(k0 + 8 * i + (lane >> 3)) * N + n0 + 4 * (lane & 7));
#pragma unroll
    for (int i = 0; i < 8; ++i) { LAS float* d = scr + (8 * i + (lane >> 3)) * 33 + 4 * (lane & 7); d[0] = ld[i][0]; d[1] = ld[i][1]; d[2] = ld[i][2]; d[3] = ld[i][3]; }
    asm volatile("s_waitcnt lgkmcnt(0)" ::: "memory");
    const int c = lane & 7;
#pragma unroll
    for (int j = 0; j < 4; ++j) { const int n = (lane >> 3) + 8 * j; const LAS float* s = scr + (8 * c) * 33 + n;
        u32x4 o; o.x = pk2(s[0 * 33], s[1 * 33]); o.y = pk2(s[2 * 33], s[3 * 33]); o.z = pk2(s[4 * 33], s[5 * 33]); o.w = pk2(s[6 * 33], s[7 * 33]);
        *(u32x4*)(WT + (size_t)(n0 + n) * K + k0 + 8 * c) = o; }
    asm volatile("s_waitcnt lgkmcnt(0)" ::: "memory");
}


#if defined(PROF_ID)
#define PROF_DECL unsigned long long prof_t0_ = 0ull; const bool prof_on_ = (blockIdx.x == 0) && (__builtin_amdgcn_readfirstlane(threadIdx.x >> 6) == 0)
#define PROF_BEGIN() do { if (prof_on_) prof_t0_ = __builtin_amdgcn_s_memrealtime(); } while (0)
#define PROF_END(id) do { if (prof_on_ && (id) == PROF_ID) { const unsigned long long d_ = __builtin_amdgcn_s_memrealtime() - prof_t0_; if (threadIdx.x == 0) *(LAS unsigned long long*)(prof_lds_ + 160 * 1024 - 512 + 256) += d_; } } while (0)
#else
#define PROF_DECL
#define PROF_BEGIN() do { } while (0)
#define PROF_END(id) do { } while (0)
#endif
typedef float f32x16 __attribute__((ext_vector_type(16)));
typedef short v4i16_t __attribute__((ext_vector_type(4)));
constexpr int QA_RS = 272, QP_RS = 264, KB_RS = 272, KPP_RS = 320, V_RS = 320;
constexpr int T_QA = 0, T_QP = T_QA + 32 * QA_RS, T_KB = T_QP + 32 * QP_RS, T_KPP = T_KB + 32 * KB_RS, T_V = T_KPP + 32 * KPP_RS, T_EL = T_V + 32 * V_RS, DIR_BYTES = T_EL + 512;
constexpr int OBUF_OFF = 2 * DIR_BYTES, OBUF_BYTES = 256 * 256;
static_assert(OBUF_OFF + OBUF_BYTES <= 160 * 1024 - 512 && (DIR_BYTES % 16) == 0 && (T_QP % 16) == 0 && (T_KB % 16) == 0 && (T_KPP % 16) == 0 && (T_V % 16) == 0 && (T_EL % 16) == 0, "scan LDS map");
constexpr int SLOT_ELEMS = 128 * 128;
#ifndef SCAN_STAGGER
#define SCAN_STAGGER 0
#endif

struct ScanT { const bf16_t* q; const bf16_t* lffw; const bf16_t* lfbw; const bf16_t* v; bf16_t* sg; bf16_t* slots; float* dvec; const float* gnorm; const float* state_in; float* new_state; };

__device__ __forceinline__ bf16x8 tr_pair(const LAS unsigned char* p0, const LAS unsigned char* p1) {
    const v4i16_t lo = __builtin_amdgcn_ds_read_tr16_b64_v4i16((LAS v4i16_t*)p0), hi = __builtin_amdgcn_ds_read_tr16_b64_v4i16((LAS v4i16_t*)p1);
    return (bf16x8){lo[0], lo[1], lo[2], lo[3], hi[0], hi[1], hi[2], hi[3]};
}
__device__ __forceinline__ bf16x8 pack_acc8(const f32x16& x, int s8) {
    u32x4 w; w.x = cvt_pk_bf16(x[8 * s8 + 0], x[8 * s8 + 1]); w.y = cvt_pk_bf16(x[8 * s8 + 2], x[8 * s8 + 3]); w.z = cvt_pk_bf16(x[8 * s8 + 4], x[8 * s8 + 5]); w.w = cvt_pk_bf16(x[8 * s8 + 6], x[8 * s8 + 7]);
    return __builtin_bit_cast(bf16x8, w);
}
__device__ __forceinline__ float h2f(unsigned short b) { return (float)__builtin_bit_cast(_Float16, b); }

template <bool FULL>
__device__ __forceinline__ void scan_item(LAS unsigned char* lds, const ScanT& T, int tok0, int h, bool act0, bool act1, const bf16_t* init0, const bf16_t* init1,
                                          float* fin0, float* fin1, bf16_t* outs0, bf16_t* outs1, float* outd0, float* outd1) {
    const int tid = threadIdx.x, wave = __builtin_amdgcn_readfirstlane(tid >> 6), dir = wave >> 2, wg = wave & 3;
    LAS unsigned char* prof_lds_ = lds; (void)prof_lds_; PROF_DECL; PROF_BEGIN();
    const bool act = dir ? act1 : act0;
    const bf16_t* init = dir ? init1 : init0;
    LAS unsigned char* D = lds + dir * DIR_BYTES;
    LAS unsigned char* OB = lds + OBUF_OFF;
    const bf16_t* lfp = dir ? T.lfbw : T.lffw;
#define SCAN_LANE(x) int x; asm volatile("v_mbcnt_lo_u32_b32 %0, -1, 0\n\tv_mbcnt_hi_u32_b32 %0, -1, %0" : "=v"(x))
#define SCAN_PREP_ROLE SCAN_LANE(ln_); const int pp = 16 * wg + (ln_ & 15), uu = ln_ >> 4, gt_ = wg * 64 + ln_, vt = gt_ >> 3, vc2 = gt_ & 7
#define SCAN_MFMA_ROLE SCAN_LANE(ln_); const int l31 = ln_ & 31, hh = ln_ >> 5, gq = (ln_ & 15) >> 2, gp = ln_ & 3, vcol = 16 * ((ln_ >> 4) & 1)
    f32x16 S[4];
#pragma unroll
    for (int t4 = 0; t4 < 4; ++t4) {
        if (init && act) { SCAN_LANE(lane); const u32x4* sp = (const u32x4*)(init + ((size_t)(wg * 4 + t4) * 64 + lane) * 16); const u32x4 a = sp[0], b = sp[1];
            const unsigned w8[8] = {a.x, a.y, a.z, a.w, b.x, b.y, b.z, b.w};
#pragma unroll
            for (int j = 0; j < 8; ++j) { S[t4][2 * j] = __builtin_bit_cast(float, w8[j] << 16); S[t4][2 * j + 1] = __builtin_bit_cast(float, w8[j] & 0xffff0000u); } }
        else {
#pragma unroll
            for (int j = 0; j < 16; ++j) S[t4][j] = 0.f; }
    }
    float dsum0 = 0.f, dsum1 = 0.f;
    unsigned qreg[8], lfreg[8]; u32x4 vreg[2];
#define SCAN_LOAD(i) do { const int jsc_ = dir ? 7 - (i) : (i); \
        _Pragma("unroll") for (int e = 0; e < 8; ++e) { const int tl = 8 * uu + e; const size_t tk = (size_t)(tok0 + 32 * jsc_ + (dir ? 31 - tl : tl)) * 1024 + h * 128 + 2 * pp; \
            if (FULL) qreg[e] = *(const unsigned*)(T.q + tk); lfreg[e] = *(const unsigned*)(lfp + tk); } \
        { const size_t tk = (size_t)(tok0 + 32 * jsc_ + (dir ? 31 - vt : vt)) * 1024 + h * 128 + 16 * vc2; vreg[0] = *(const u32x4*)(T.v + tk); vreg[1] = *(const u32x4*)(T.v + tk + 8); } } while (0)
    if (act) { SCAN_PREP_ROLE; SCAN_LOAD(0); }
    PROF_END(6);
    for (int s = 0; s < 16 + SCAN_STAGGER; ++s) {
        const int ph = s - (SCAN_STAGGER ? dir : 0);
        if (act && ph >= 0 && ph < 16) {
            const int i = ph >> 1;
            if ((ph & 1) == 0) {
                SCAN_PREP_ROLE; const int lane = ln_;
#if defined(PROF_ID)
                PROF_BEGIN(); asm volatile("s_waitcnt vmcnt(0)" ::: "memory"); PROF_END(1); PROF_BEGIN();
#endif
                *(LAS u32x4*)(D + T_V + vt * V_RS + vc2 * 32) = vreg[0]; *(LAS u32x4*)(D + T_V + vt * V_RS + vc2 * 32 + 16) = vreg[1];
                f32x2 cc[8]; f32x2 aa = (f32x2){0.f, 0.f};
#pragma unroll
                for (int e = 0; e < 8; ++e) { aa += (f32x2){h2f((unsigned short)(lfreg[e] & 0xffffu)), h2f((unsigned short)(lfreg[e] >> 16))}; cc[e] = aa; }
                f32x2 tq[4];
#pragma unroll
                for (int u2 = 0; u2 < 4; ++u2) { tq[u2].x = __shfl(aa.x, (lane & 15) + 16 * u2); tq[u2].y = __shfl(aa.y, (lane & 15) + 16 * u2); }
                const f32x2 zz = (f32x2){0.f, 0.f};
                const f32x2 pre = (uu > 0 ? tq[0] : zz) + (uu > 1 ? tq[1] : zz) + (uu > 2 ? tq[2] : zz);
                const f32x2 rr = tq[0] + tq[1], bl = rr + tq[2] + tq[3];
#define EX2V(v) ((f32x2){__builtin_amdgcn_exp2f((v).x), __builtin_amdgcn_exp2f((v).y)})
                if (FULL) {
                    const f32x2 er = EX2V(rr), elr = EX2V(bl - rr), base = pre - rr;
#pragma unroll
                    for (int e = 0; e < 8; ++e) {
                        const int tl = 8 * uu + e;
                        const f32x2 d = base + cc[e];
                        const f32x2 ea = EX2V(d), eb = EX2V(-d);
                        const f32x2 lfv = (f32x2){h2f((unsigned short)(lfreg[e] & 0xffffu)), h2f((unsigned short)(lfreg[e] >> 16))};
                        const f32x2 kk = 1.f - EX2V(lfv);
                        const f32x2 qq = (f32x2){__builtin_bit_cast(float, qreg[e] << 16), __builtin_bit_cast(float, qreg[e] & 0xffff0000u)};
                        const f32x2 qa = qq * ea, kb = kk * eb, qp = qa * er, kpp = kb * elr;
                        *(LAS unsigned*)(D + T_QA + tl * QA_RS + 4 * pp) = cvt_pk_bf16(qa.x, qa.y);
                        *(LAS unsigned*)(D + T_QP + tl * QP_RS + 4 * pp) = cvt_pk_bf16(qp.x, qp.y);
                        *(LAS unsigned*)(D + T_KB + tl * KB_RS + 4 * pp) = cvt_pk_bf16(kb.x, kb.y);
                        *(LAS unsigned*)(D + T_KPP + tl * KPP_RS + 4 * pp) = cvt_pk_bf16(kpp.x, kpp.y);
                        if (e & 1) __builtin_amdgcn_sched_barrier(0);
                    }
                } else {
                    const f32x2 base = bl - pre;
#pragma unroll
                    for (int e = 0; e < 8; ++e) {
                        const int tl = 8 * uu + e;
                        const f32x2 d = base - cc[e];
                        const f32x2 lfv = (f32x2){h2f((unsigned short)(lfreg[e] & 0xffffu)), h2f((unsigned short)(lfreg[e] >> 16))};
                        const f32x2 kpp = (1.f - EX2V(lfv)) * EX2V(d);
                        *(LAS unsigned*)(D + T_KPP + tl * KPP_RS + 4 * pp) = cvt_pk_bf16(kpp.x, kpp.y);
                    }
                    dsum0 += bl.x; dsum1 += bl.y;
                }
                if (uu == 0) { *(LAS f32x2*)(D + T_EL + 8 * pp) = EX2V(bl); }
                __builtin_amdgcn_sched_barrier(0);
#if defined(PROF_ID)
                asm volatile("s_waitcnt lgkmcnt(0)" ::: "memory"); PROF_END(2);
#endif
                if (i < 7) SCAN_LOAD(i + 1);
            } else {
                SCAN_MFMA_ROLE; PROF_BEGIN();
                if (FULL) {
                    f32x16 P;
#pragma unroll
                    for (int j = 0; j < 16; ++j) P[j] = 0.f;
#pragma unroll
                    for (int ks = 0; ks < 8; ++ks) {
                        const bf16x8 ka = *(const LAS bf16x8*)(D + T_KB + l31 * KB_RS + (16 * ks + 8 * hh) * 2);
                        const bf16x8 qb = *(const LAS bf16x8*)(D + T_QA + l31 * QA_RS + (16 * ks + 8 * hh) * 2);
                        P = __builtin_amdgcn_mfma_f32_32x32x16_bf16(ka, qb, P, 0, 0, 0);
                    }
#pragma unroll
                    for (int j = 0; j < 16; ++j) { const int srow = (j & 3) + 8 * (j >> 2) + 4 * hh; P[j] = (srow <= l31) ? P[j] : 0.f; }
                    f32x16 o;
#pragma unroll
                    for (int j = 0; j < 16; ++j) o[j] = 0.f;
#pragma unroll
                    for (int s8 = 0; s8 < 2; ++s8) {
                        const LAS unsigned char* vb = D + T_V + (16 * s8 + 4 * hh + gq) * V_RS + (32 * wg + vcol + 4 * gp) * 2;
                        const bf16x8 vf = tr_pair(vb, vb + 8 * V_RS);
                        o = __builtin_amdgcn_mfma_f32_32x32x16_bf16(pack_acc8(P, s8), vf, o, 0, 0, 0);
                    }
#pragma unroll
                    for (int t4 = 0; t4 < 4; ++t4)
#pragma unroll
                        for (int s8 = 0; s8 < 2; ++s8) {
                            const LAS unsigned char* qp = D + T_QP + l31 * QP_RS + (32 * t4 + 16 * s8 + 4 * hh) * 2;
                            const u32x2 lo = *(const LAS u32x2*)qp, hi = *(const LAS u32x2*)(qp + 16);
                            const u32x4 aw = {lo.x, lo.y, hi.x, hi.y};
                            o = __builtin_amdgcn_mfma_f32_32x32x16_bf16(__builtin_bit_cast(bf16x8, aw), pack_acc8(S[t4], s8), o, 0, 0, 0);
                        }
                    const int jsc = dir ? 7 - i : i;
                    LAS unsigned short* ob = (LAS unsigned short*)(OB + (32 * jsc + (dir ? 31 - 4 * hh : 4 * hh)) * 256 + (32 * wg + l31) * 2);
                    const int rs = dir ? -128 : 128;
                    if (i >= 4) {
                        unsigned short pv[16];
#pragma unroll
                        for (int j = 0; j < 16; ++j) pv[j] = ob[((j & 3) + 8 * (j >> 2)) * rs];
#pragma unroll
                        for (int j = 0; j < 16; ++j) o[j] += bf2f(pv[j]);
                    }
#pragma unroll
                    for (int j = 0; j < 16; ++j) ob[((j & 3) + 8 * (j >> 2)) * rs] = (unsigned short)cvt_pk_bf16(o[j], o[j]);
                }
                __builtin_amdgcn_sched_barrier(0);
#pragma unroll
                for (int t4 = 0; t4 < 4; ++t4) {
#pragma unroll
                    for (int g = 0; g < 4; ++g) { const f32x4 f = *(const LAS f32x4*)(D + T_EL + (32 * t4 + 8 * g + 4 * hh) * 4);
                        S[t4][4 * g + 0] *= f[0]; S[t4][4 * g + 1] *= f[1]; S[t4][4 * g + 2] *= f[2]; S[t4][4 * g + 3] *= f[3]; }
#pragma unroll
                    for (int s8 = 0; s8 < 2; ++s8) {
                        const LAS unsigned char* kb = D + T_KPP + (16 * s8 + 8 * hh + gq) * KPP_RS + (32 * t4 + vcol + 4 * gp) * 2;
                        const LAS unsigned char* vb = D + T_V + (16 * s8 + 8 * hh + gq) * V_RS + (32 * wg + vcol + 4 * gp) * 2;
                        const bf16x8 ka = tr_pair(kb, kb + 4 * KPP_RS), vf = tr_pair(vb, vb + 4 * V_RS);
                        S[t4] = __builtin_amdgcn_mfma_f32_32x32x16_bf16(ka, vf, S[t4], 0, 0, 0);
                    }
                    if (t4 == 1) __builtin_amdgcn_sched_barrier(0);
                }
                PROF_END(3);
            }
        }
        PROF_BEGIN();
        __syncthreads();
        PROF_END(4);
    }
#undef SCAN_LOAD
    SCAN_MFMA_ROLE; SCAN_LANE(lane); PROF_BEGIN();
    if (FULL) {
        float* fin = dir ? fin1 : fin0;
        if (fin && act) {
#pragma unroll
            for (int t4 = 0; t4 < 4; ++t4)
#pragma unroll
                for (int j = 0; j < 16; ++j) fin[(size_t)(32 * t4 + (j & 3) + 8 * (j >> 2) + 4 * hh) * 128 + 32 * wg + l31] = S[t4][j];
        }
        const int cv = tid & 15;
        f32x4 gn0 = *(const f32x4*)(T.gnorm + 8 * cv), gn1 = *(const f32x4*)(T.gnorm + 8 * cv + 4);
        u32x4 gwv[8];
#pragma unroll
        for (int pass = 0; pass < 8; ++pass) gwv[pass] = *(const u32x4*)(T.sg + (size_t)(tok0 + 32 * pass + (tid >> 4)) * 1024 + h * 128 + 8 * cv);
#pragma unroll
        for (int pass = 0; pass < 8; ++pass) {
            const int row = 32 * pass + (tid >> 4);
            const u32x4 ow = *(const LAS u32x4*)(OB + row * 256 + cv * 16);
            bf16_t* gp_ = T.sg + (size_t)(tok0 + row) * 1024 + h * 128 + 8 * cv;
            const u32x4 gw = gwv[pass];
            float ov[8], gv[8];
            const unsigned o4[4] = {ow.x, ow.y, ow.z, ow.w}, g4[4] = {gw.x, gw.y, gw.z, gw.w};
            float ss = 0.f;
#pragma unroll
            for (int j = 0; j < 4; ++j) { ov[2 * j] = __builtin_bit_cast(float, o4[j] << 16); ov[2 * j + 1] = __builtin_bit_cast(float, o4[j] & 0xffff0000u);
                gv[2 * j] = __builtin_bit_cast(float, g4[j] << 16); gv[2 * j + 1] = __builtin_bit_cast(float, g4[j] & 0xffff0000u);
                ss += ov[2 * j] * ov[2 * j] + ov[2 * j + 1] * ov[2 * j + 1]; }
            ss += __shfl_xor(ss, 1); ss += __shfl_xor(ss, 2); ss += __shfl_xor(ss, 4); ss += __shfl_xor(ss, 8);
            const float rstd = rsqrtf(ss * (1.f / 128.f) + 1e-6f);
            u32x4 w;
            w.x = cvt_pk_bf16(ov[0] * rstd * gn0[0] * gv[0], ov[1] * rstd * gn0[1] * gv[1]); w.y = cvt_pk_bf16(ov[2] * rstd * gn0[2] * gv[2], ov[3] * rstd * gn0[3] * gv[3]);
            w.z = cvt_pk_bf16(ov[4] * rstd * gn1[0] * gv[4], ov[5] * rstd * gn1[1] * gv[5]); w.w = cvt_pk_bf16(ov[6] * rstd * gn1[2] * gv[6], ov[7] * rstd * gn1[3] * gv[7]);
            *(u32x4*)gp_ = w;
        }
#if defined(PROF_ID)
        asm volatile("s_waitcnt vmcnt(0)" ::: "memory");
#endif
        __syncthreads(); PROF_END(5);
    } else {
        bf16_t* outs = dir ? outs1 : outs0; float* outd = dir ? outd1 : outd0;
        if (act) {
#pragma unroll
            for (int t4 = 0; t4 < 4; ++t4) {
                u32x4 a, b;
                a.x = cvt_pk_bf16(S[t4][0], S[t4][1]); a.y = cvt_pk_bf16(S[t4][2], S[t4][3]); a.z = cvt_pk_bf16(S[t4][4], S[t4][5]); a.w = cvt_pk_bf16(S[t4][6], S[t4][7]);
                b.x = cvt_pk_bf16(S[t4][8], S[t4][9]); b.y = cvt_pk_bf16(S[t4][10], S[t4][11]); b.z = cvt_pk_bf16(S[t4][12], S[t4][13]); b.w = cvt_pk_bf16(S[t4][14], S[t4][15]);
                u32x4* sp = (u32x4*)(outs + ((size_t)(wg * 4 + t4) * 64 + lane) * 16); sp[0] = a; sp[1] = b;
            }
            const int pp = 16 * wg + (lane & 15); if ((lane >> 4) == 0) { outd[2 * pp] = __builtin_amdgcn_exp2f(dsum0); outd[2 * pp + 1] = __builtin_amdgcn_exp2f(dsum1); }
        }
    }
}
__device__ __forceinline__ size_t slot_of(int dir, int b, int h, int sc) { return (size_t)((dir * 4 + b) * 8 + h) * 16 + sc; }

__device__ __forceinline__ void scan_phase_a(LAS unsigned char* lds, const ScanT& T, int G, int bx) {
    for (int it = bx; it < 512; it += G) {
        const int sc = it & 15, h = (it >> 4) & 7, b = it >> 7;
        const size_t sf = slot_of(0, b, h, sc < 15 ? sc + 1 : 0), sb = slot_of(1, b, h, sc > 0 ? sc - 1 : 0);
        scan_item<false>(lds, T, 4096 + b * 4096 + sc * 256, h, sc < 15, sc > 0, nullptr, nullptr, nullptr, nullptr, T.slots + sf * SLOT_ELEMS, T.slots + sb * SLOT_ELEMS, T.dvec + sf * 128, T.dvec + sb * 128);
    }
}
__device__ __forceinline__ void scan_phase_b(const ScanT& T, int G, int bx, int tid) {
    for (int gid = bx * NTHREADS + tid; gid < 64 * 2048; gid += G * NTHREADS) {
        const int combo = gid >> 11, e = (gid & 2047) * 8, dir = combo >> 5, b = (combo >> 3) & 3, h = combo & 7;
        const int reg0 = e & 15, ln = (e >> 4) & 63, t4 = (e >> 10) & 3, w = (e >> 12) & 3;
        const int v = 32 * w + (ln & 31);
        float s[8]; int kk[8];
#pragma unroll
        for (int j = 0; j < 8; ++j) { const int rg = reg0 + j; kk[j] = 32 * t4 + (rg & 3) + 8 * (rg >> 2) + 4 * (ln >> 5); s[j] = T.state_in[((size_t)((b * 2 + dir) * 8 + h) * 128 + kk[j]) * 128 + v]; }
        for (int st = 0; st < 16; ++st) {
            const int sc = dir ? 15 - st : st;
            const size_t sl = slot_of(dir, b, h, sc);
            u32x4* sp = (u32x4*)(T.slots + sl * SLOT_ELEMS + e);
            if (st > 0) {
                const u32x4 lw = *sp; const unsigned l4[4] = {lw.x, lw.y, lw.z, lw.w};
#pragma unroll
                for (int j = 0; j < 4; ++j) { s[2 * j] = T.dvec[sl * 128 + kk[2 * j]] * s[2 * j] + __builtin_bit_cast(float, l4[j] << 16);
                    s[2 * j + 1] = T.dvec[sl * 128 + kk[2 * j + 1]] * s[2 * j + 1] + __builtin_bit_cast(float, l4[j] & 0xffff0000u); }
            }
            u32x4 o; o.x = cvt_pk_bf16(s[0], s[1]); o.y = cvt_pk_bf16(s[2], s[3]); o.z = cvt_pk_bf16(s[4], s[5]); o.w = cvt_pk_bf16(s[6], s[7]);
            *sp = o;
        }
    }
}
__device__ __forceinline__ void scan_phase_c(LAS unsigned char* lds, const ScanT& T, int G, int bx) {
    for (int it = bx; it < 640; it += G) {
        if (it < 512) {
            const int sc = it & 15, h = (it >> 4) & 7, b = it >> 7;
            scan_item<true>(lds, T, 4096 + b * 4096 + sc * 256, h, true, true, T.slots + slot_of(0, b, h, sc) * SLOT_ELEMS, T.slots + slot_of(1, b, h, sc) * SLOT_ELEMS,
                            nullptr, nullptr, nullptr, nullptr, nullptr, nullptr);
        } else {
            const int h = (it - 512) & 7, b = (it - 512) >> 3;
            float* ns = T.new_state + (size_t)(b * 2) * 8 * 16384 + (size_t)h * 16384;
            scan_item<true>(lds, T, b * 256, h, true, true, nullptr, nullptr, ns, ns + (size_t)8 * 16384, nullptr, nullptr, nullptr, nullptr);
        }
    }
}


#define XB_TMO      128
#define XB_XCNT(j)  (256  + 64 * (j))
#define XB_XSUB(j)  (1280 + 64 * (j))
#define XB_XGEN(j)  (2304 + 64 * (j))
#define XB_TOP      3328
#define XB_TOPGEN   3392
#define XCD_BAR_WORDS 3456
#define XB_SPIN_CAP (1u << 18)
__device__ __forceinline__ unsigned xb_ld(unsigned* p)              { return __hip_atomic_load(p, __ATOMIC_RELAXED, __HIP_MEMORY_SCOPE_AGENT); }
__device__ __forceinline__ unsigned xb_add(unsigned* p, unsigned v) { return __hip_atomic_fetch_add(p, v, __ATOMIC_RELAXED, __HIP_MEMORY_SCOPE_AGENT); }
__device__ __forceinline__ unsigned xb_xcc_id() { return (unsigned)__builtin_amdgcn_s_getreg((3 << 11) | 20) & 0xFu; }
#define XB_SPIN(cond, bar) do { unsigned _sp = 0; while (cond) { __builtin_amdgcn_s_sleep(1); \
    if ((++_sp & 255u) == 0u) { if (xb_ld(&(bar)[XB_TMO])) break; if (_sp > XB_SPIN_CAP) { atomicAdd(&(bar)[XB_TMO], 1u); break; } } } } while (0)
struct XcdBarrier { unsigned* bar; unsigned x; volatile LAS unsigned* st; };
__device__ __forceinline__ XcdBarrier xcd_barrier_post(unsigned* bar, volatile LAS unsigned* st) {
    XcdBarrier b; b.bar = bar; b.x = xb_xcc_id(); b.st = st;
    if (threadIdx.x == 0) (void)xb_add(&bar[XB_XCNT(b.x)], 1u);
    return b;
}
__device__ __forceinline__ void xcd_barrier_complete(unsigned* bar, unsigned x, unsigned& nloc, unsigned& nx) {
    const unsigned G = gridDim.x * gridDim.y * gridDim.z;
    unsigned sum, cnt, mine, sp = 0u;
    for (;;) {
        sum = 0u; cnt = 0u; mine = 0u;
#pragma unroll
        for (unsigned j = 0; j < 16; ++j) { const unsigned c = xb_ld(&bar[XB_XCNT(j)]); sum += c; cnt += (c > 0u) ? 1u : 0u; mine = (j == x) ? c : mine; }
        if (sum == G) break;
        __builtin_amdgcn_s_sleep(1);
        if ((++sp & 255u) == 0u) { if (xb_ld(&bar[XB_TMO])) break; if (sp > XB_SPIN_CAP) { atomicAdd(&bar[XB_TMO], 1u); break; } }
    }
    nloc = mine > 0u ? mine : 1u; nx = cnt > 0u ? cnt : 1u;
}
__device__ __forceinline__ void xcd_barrier(const XcdBarrier& b) {
    asm volatile("s_waitcnt vmcnt(0)" ::: "memory");
    __syncthreads();
    if (threadIdx.x == 0) {
        unsigned* bar = b.bar;
        __builtin_amdgcn_s_waitcnt(0);
        unsigned nloc = b.st[0], nx = b.st[1];
        if (nloc == 0u) { xcd_barrier_complete(bar, b.x, nloc, nx); b.st[0] = nloc; b.st[1] = nx; }
        const unsigned old = xb_add(&bar[XB_XSUB(b.x)], 1u);
        const unsigned gen = old / nloc;
        if (old + 1u == (gen + 1u) * nloc) {
            __builtin_amdgcn_fence(__ATOMIC_RELEASE, "agent");
            asm volatile("s_waitcnt vmcnt(0)" ::: "memory");
            const unsigned og = xb_add(&bar[XB_TOP], 1u);
            const unsigned tg = og / nx;
            if (og + 1u == (tg + 1u) * nx) xb_add(&bar[XB_TOPGEN], 1u);
            else XB_SPIN(xb_ld(&bar[XB_TOPGEN]) == tg, bar);
            __builtin_amdgcn_fence(__ATOMIC_ACQUIRE, "agent");
            xb_add(&bar[XB_XGEN(b.x)], 1u);
            asm volatile("s_waitcnt vmcnt(0)" ::: "memory");
        } else {
            XB_SPIN(xb_ld(&bar[XB_XGEN(b.x)]) == gen, bar);
            __builtin_amdgcn_fence(__ATOMIC_ACQUIRE, "agent");
            asm volatile("s_waitcnt vmcnt(0)" ::: "memory");
        }
    }
    __syncthreads();
}

struct Args { const float* in[17]; float* out; unsigned char* ws; int ph_lo, ph_hi; };
enum { PH_PREP = 0, PH_EMBED = 1, PH_FN_CHAN = 2, PH_FN_POS1 = 3, PH_FN_POS2 = 4, PH_FN_WO = 5, PH_NORM_MLP0 = 6, PH_MLP1_0 = 7, PH_MLP2_0 = 8, PH_NORM_MIX1 = 9, PH_WIN = 10,
       PH_SCAN_A = 11, PH_SCAN_B = 12, PH_SCAN_C = 13, PH_HG_WO = 14, PH_NORM_MLP1 = 15, PH_MLP1_1 = 16, PH_MLP2_1 = 17, PH_FINAL = 18, PH_END = 19 };
constexpr int LDS_BYTES = 160 * 1024, MISC_OFF = LDS_BYTES - 512;

__global__ void __launch_bounds__(NTHREADS, 2) fwd(Args a) {
    extern __shared__ __attribute__((aligned(16))) unsigned char lds_raw[];
    LAS unsigned char* lds = (LAS unsigned char*)lds_raw;
    const int tid = threadIdx.x, lane = tid & 63, wave = __builtin_amdgcn_readfirstlane(tid >> 6);
    const int G = gridDim.x, bx = blockIdx.x;
    const int gw = bx * NWAVES + wave, ngw = G * NWAVES;
    unsigned char* ws = a.ws;
    const float* mod = (const float*)(ws + WM.mod);
    bf16_t* Hb = (bf16_t*)(ws + WM.h);
    bf16_t* Big = (bf16_t*)(ws + WM.big[0]); bf16_t* Big1 = (bf16_t*)(ws + WM.big[1]);
    const float* norm_mlp = a.in[8];
    const float* w1 = a.in[14]; const float* w2 = a.in[15];
    const float* norm_mix = a.in[7]; const float* fnet_wo = a.in[9];
    float* modw = (float*)(ws + WM.mod);
#define IN(k) (a.ph_lo <= (k) && (k) < a.ph_hi)
    if (tid < 128) ((LAS unsigned*)(lds + MISC_OFF))[tid] = 0u;
    __syncthreads();
    XcdBarrier bar = xcd_barrier_post((unsigned*)ws, (volatile LAS unsigned*)(lds + MISC_OFF));
#if defined(PROBE_A)
#define STAMP(k) do { if (bx == 0 && tid == 0) ((LAS unsigned long long*)(lds + MISC_OFF + 64))[(k)] = __builtin_amdgcn_s_memrealtime(); } while (0)
#else
#define STAMP(k) do { } while (0)
#endif
    STAMP(0);
#define SEAM(k) do { if (IN(k) && IN((k) + 1)) xcd_barrier(bar); STAMP((k) + 1); } while (0)
    if (IN(PH_PREP)) {
        LAS float* scr = (LAS float*)(lds + wave * 16384);
        constexpr int I_1 = (1024 / 64) * (4096 / 32), I_2 = (4096 / 64) * (1024 / 32);
        constexpr int I_F = (1024 / 64) * (1024 / 32), I_W = (1024 / 64) * (5120 / 32);
        constexpr int NITEMS = I_1 + I_2 + I_F + I_F + I_W;
        for (int un = bx; un < 384; un += G) mod_unit(lds, un, a.in[3], a.in[4], a.in[5], a.in[6], modw, tid, wave, lane);
        if (bx == G - 1) for (int i = tid; i < 2048; i += NTHREADS) { const int dir = i >> 10, ch = i & 1023; const float l0 = a.in[11][(dir * 2 + 0) * 1024 + ch], l1 = a.in[11][(dir * 2 + 1) * 1024 + ch];
            const float mx = fmaxf(l0, l1), e0 = __expf(l0 - mx), e1 = __expf(l1 - mx); ((float*)(ws + WM.lb))[i] = e1 / (e0 + e1); }
        gen_tables(ws, (long)bx * NTHREADS + tid, (long)G * NTHREADS);
        for (int it = gw; it < NITEMS; it += ngw) {
            int r = it;
            if (r < I_F) { transpose_item(fnet_wo, 1024, 1024, (bf16_t*)(ws + WM.wfnet), scr, r, lane); continue; } r -= I_F;
            if (r < I_F) { transpose_item(a.in[13], 1024, 1024, (bf16_t*)(ws + WM.who), scr, r, lane); continue; } r -= I_F;
            if (r < I_W) { transpose_item(a.in[10], 1024, 5120, (bf16_t*)(ws + WM.win), scr, r, lane); continue; } r -= I_W;
            if (r < I_1) { transpose_item(w1, 1024, 4096, (bf16_t*)(ws + WM.w1[0]), scr, r, lane); continue; } r -= I_1;
            transpose_item(w2, 4096, 1024, (bf16_t*)(ws + WM.w2[0]), scr, r, lane);
        }
    }
    SEAM(PH_PREP);
    if (IN(PH_EMBED)) embed_rows(a.in[0], a.in[1], (const float*)(ws + WM.pos), (const float*)(ws + WM.pos) + 64 * 512, norm_mix, mod, Hb, gw, ngw, lane);
    SEAM(PH_EMBED);
    if (IN(PH_FN_CHAN)) {
        { ProbChan p; p.init(0, ws + WM.dftc, Hb, (bf16_t*)(ws + WM.yctx), G, bx); gemm_phase<ProbChan, true, true>(lds, p); }
        { ProbChan p; p.init(1, ws + WM.dftc, Hb, (bf16_t*)(ws + WM.ysmp), G, bx); gemm_phase<ProbChan, true, true>(lds, p); }
    }
    SEAM(PH_FN_CHAN);
    if (IN(PH_FN_POS1)) {
        { ProbPosCtx p; p.init(ws + WM.dl256, (const bf16_t*)(ws + WM.yctx), Hb, G, bx); gemm_phase<ProbPosCtx, true, true>(lds, p); }
        { ProbSmpA p; p.init(ws + WM.fa2, (const bf16_t*)(ws + WM.ysmp), (bf16_t*)(ws + WM.u), G, bx); gemm_phase<ProbSmpA, true, true>(lds, p); }
    }
    SEAM(PH_FN_POS1);
    if (IN(PH_FN_POS2)) { ProbSmpB p; p.init(ws + WM.mb, (const bf16_t*)(ws + WM.u), Hb, G, bx); gemm_phase<ProbSmpB, true, true>(lds, p); }
    SEAM(PH_FN_POS2);
    if (IN(PH_FN_WO)) { ProbResidFirst p; p.init_tok(Hb, 1024, ws + WM.wfnet, 1024, 0, 80, 4, G, bx); p.X = (bf16_t*)a.out; p.mod = mod; p.layer = 0; p.gidx = 2; p.init_split(G, bx, (unsigned short*)(ws + SLAB_FN)); p.xp = a.in[0]; p.xs = a.in[1]; p.er = (const float*)(ws + WM.pos); p.ec = p.er + 64 * 512; gemm_phase<ProbResidFirst, true, true>(lds, p); }
    SEAM(PH_FN_WO);
    if (IN(PH_NORM_MLP0)) { build_split_table(lds, G, tid); norm_rows((bf16_t*)a.out, 0, 20480, norm_mlp, mod, 0, 3, Hb, gw, ngw, lane, lds, (const unsigned short*)(ws + SLAB_FN)); }
    SEAM(PH_NORM_MLP0);
    if (IN(PH_MLP1_0)) { ProbMlp1 p; p.init_tok(Hb, 1024, ws + WM.w1[0], 1024, 0, 80, 4096 / BM, G, bx); p.O = Big; p.ldc = 4096; gemm_phase<ProbMlp1, true, true>(lds, p); }
    SEAM(PH_MLP1_0);
    if (IN(PH_MLP2_0)) { ProbResid p; p.init_tok(Big, 4096, ws + WM.w2[0], 4096, 0, 80, 1024 / BM, G, bx); p.X = (bf16_t*)a.out; p.mod = mod; p.layer = 0; p.gidx = 5; p.init_split(G, bx, (unsigned short*)(ws + SLAB_M0)); gemm_phase<ProbResid, true, true>(lds, p); }
    SEAM(PH_MLP2_0);
    if (IN(PH_NORM_MIX1)) { build_split_table(lds, G, tid); norm_rows((bf16_t*)a.out, 0, 20480, norm_mix + 1024, mod, 1, 0, Hb, gw, ngw, lane, lds, (const unsigned short*)(ws + SLAB_M0)); }
    SEAM(PH_NORM_MIX1);
    if (IN(PH_WIN)) { ProbWin p; p.init_tok(Hb, 1024, ws + WM.win, 1024, 0, 80, 20, G, bx); p.Oq = (bf16_t*)(ws + WM.q); p.Offw = (bf16_t*)(ws + WM.lffw); p.Ofbw = (bf16_t*)(ws + WM.lfbw);
        p.Ov = (bf16_t*)(ws + WM.v); p.Osg = (bf16_t*)(ws + WM.sg); p.lb = (const float*)(ws + WM.lb); gemm_phase<ProbWin, true, true>(lds, p); }
    SEAM(PH_WIN);
    if (IN(PH_SCAN_A) || IN(PH_SCAN_B) || IN(PH_SCAN_C)) {
        ScanT st; st.q = (const bf16_t*)(ws + WM.q); st.lffw = (const bf16_t*)(ws + WM.lffw); st.lfbw = (const bf16_t*)(ws + WM.lfbw); st.v = (const bf16_t*)(ws + WM.v); st.sg = (bf16_t*)(ws + WM.sg);
        st.slots = (bf16_t*)(ws + WM.slots); st.dvec = (float*)(ws + WM.dvec); st.gnorm = a.in[12]; st.state_in = a.in[2]; st.new_state = a.out + (size_t)20480 * 1024;
        if (IN(PH_SCAN_A)) scan_phase_a(lds, st, G, bx);
        SEAM(PH_SCAN_A);
        if (IN(PH_SCAN_B)) scan_phase_b(st, G, bx, tid);
        SEAM(PH_SCAN_B);
        if (IN(PH_SCAN_C)) scan_phase_c(lds, st, G, bx);
    }
    SEAM(PH_SCAN_C);
    if (IN(PH_HG_WO)) {
        { LAS float* scr = (LAS float*)(lds + wave * 16384);
          constexpr int I_1 = (1024 / 64) * (4096 / 32), I_2 = (4096 / 64) * (1024 / 32);
          for (int it = gw; it < I_1 + I_2; it += ngw) {
              if (it < I_1) transpose_item(w1 + (size_t)1024 * 4096, 1024, 4096, (bf16_t*)(ws + WM.w1[1]), scr, it, lane);
              else transpose_item(w2 + (size_t)4096 * 1024, 4096, 1024, (bf16_t*)(ws + WM.w2[1]), scr, it - I_1, lane);
          }
          __syncthreads(); }
        ProbResid p; p.init_tok((bf16_t*)(ws + WM.sg), 1024, ws + WM.who, 1024, 0, 80, 4, G, bx); p.X = (bf16_t*)a.out; p.mod = mod; p.layer = 1; p.gidx = 2; p.init_split(G, bx, (unsigned short*)(ws + SLAB_HG)); gemm_phase<ProbResid, true, true>(lds, p); }
    SEAM(PH_HG_WO);
    if (IN(PH_NORM_MLP1)) { build_split_table(lds, G, tid); norm_rows((bf16_t*)a.out, 0, 20480, norm_mlp + 1024, mod, 1, 3, Hb, gw, ngw, lane, lds, (const unsigned short*)(ws + SLAB_HG)); }
    SEAM(PH_NORM_MLP1);
    if (IN(PH_MLP1_1)) { ProbMlp1 p; p.init_tok(Hb, 1024, ws + WM.w1[1], 1024, 0, 80, 4096 / BM, G, bx); p.O = Big1; p.ldc = 4096; gemm_phase<ProbMlp1, true, true>(lds, p); }
    SEAM(PH_MLP1_1);
    if (IN(PH_MLP2_1)) { ProbResid p; p.init_tok(Big1, 4096, ws + WM.w2[1], 4096, 0, 80, 1024 / BM, G, bx); p.X = (bf16_t*)a.out; p.mod = mod; p.layer = 1; p.gidx = 5; p.init_split(G, bx, (unsigned short*)(ws + SLAB_M1)); gemm_phase<ProbResid, true, true>(lds, p); }
    SEAM(PH_MLP2_1);
    if (IN(PH_FINAL)) { build_split_table(lds, G, tid); final_rows(a.out, 0, 20480, a.in[16], gw, ngw, lane, lds, (const unsigned short*)(ws + SLAB_M1)); }
#if defined(PROF_ID)
    if (bx == 0 && tid == 0) { const unsigned long long d = *(LAS unsigned long long*)(lds + LDS_BYTES - 512 + 256); const unsigned long long t0 = __builtin_amdgcn_s_memrealtime(); while (__builtin_amdgcn_s_memrealtime() - t0 < 16ull * d) __builtin_amdgcn_s_sleep(8); }
#endif
#if defined(PROBE_A)
    if (bx == 0 && tid == 0) { asm volatile("s_waitcnt vmcnt(0)" ::: "memory"); STAMP(PH_END); const unsigned long long d = ((LAS unsigned long long*)(lds + MISC_OFF + 64))[PROBE_B] - ((LAS unsigned long long*)(lds + MISC_OFF + 64))[PROBE_A];
        const unsigned long long t0 = __builtin_amdgcn_s_memrealtime(); while (__builtin_amdgcn_s_memrealtime() - t0 < 4ull * d) __builtin_amdgcn_s_sleep(8); }
#endif
#undef IN
}
}
#ifndef MK_N_LAUNCHES
#define MK_N_LAUNCHES 1
#endif
extern "C" void kernel_launch(void* const* d_in, const int* in_sizes, int n_in, void* d_out, int out_size, void* d_ws, size_t ws_size, hipStream_t stream) {
    static int grid = 0;
    if (grid == 0) {
        int dev = 0, cus = 0;
        if (hipGetDevice(&dev) != hipSuccess || hipDeviceGetAttribute(&cus, hipDeviceAttributeMultiprocessorCount, dev) != hipSuccess || cus <= 0) cus = 256;
        hipFuncSetAttribute((const void*)fk::fwd, hipFuncAttributeMaxDynamicSharedMemorySize, fk::LDS_BYTES);
        int per_cu = 0;
        if (hipOccupancyMaxActiveBlocksPerMultiprocessor(&per_cu, (const void*)fk::fwd, fk::NTHREADS, fk::LDS_BYTES) != hipSuccess || per_cu < 1)
            fprintf(stderr, "kernel_launch: occupancy query reports %d workgroups per CU\n", per_cu);
        (void)hipGetLastError();
        grid = cus;
    }
    hipMemsetAsync(d_ws, 0, fk::CTL_BYTES, stream);
    fk::Args a{};
    for (int i = 0; i < 17; ++i) a.in[i] = (const float*)d_in[i];
    a.out = (float*)d_out; a.ws = (unsigned char*)d_ws;
#if MK_N_LAUNCHES == 1
    a.ph_lo = 0; a.ph_hi = fk::PH_END;
    hipLaunchKernelGGL(fk::fwd, dim3(grid), dim3(fk::NTHREADS), fk::LDS_BYTES, stream, a);
#else
    for (int ph = 0; ph < fk::PH_END; ++ph) { a.ph_lo = ph; a.ph_hi = ph + 1; hipLaunchKernelGGL(fk::fwd, dim3(grid), dim3(fk::NTHREADS), fk::LDS_BYTES, stream, a); }
#endif
}
```

```cpp
#include <hip/hip_runtime.h>
#include <cstdint>
#include <cstdio>
namespace fk {
#define LAS __attribute__((address_space(3)))
#define GAS __attribute__((address_space(1)))
typedef unsigned short bf16_t;
typedef short bf16x8 __attribute__((ext_vector_type(8)));
typedef float f32x4 __attribute__((ext_vector_type(4)));
typedef float f32x2 __attribute__((ext_vector_type(2)));
typedef unsigned u32x4 __attribute__((ext_vector_type(4)));
typedef unsigned u32x2 __attribute__((ext_vector_type(2)));
constexpr int BM = 256, BK = 64, HALF = 128, HTB = HALF * BK * 2, STAGE_BYTES = 8 * HTB, NXCD = 8, WGM = 8;
constexpr int NWAVES = 8, NTHREADS = 512;

__device__ __forceinline__ int lds_byte(int r, int c) { const int st = (r >> 4) * 2 + (c >> 5), rr = r & 15, cc = c & 31, ob = rr * 64 + cc * 2; return st * 1024 + (ob ^ (((ob >> 9) & 1) << 5)); }
__device__ __forceinline__ void stage_rc(int b, int& R, int& C) { const int st = b / 1024, sb = b % 1024, swz = sb ^ (((sb >> 9) & 1) << 5); R = (st >> 1) * 16 + swz / 64; C = (st & 1) * 32 + (swz % 64) / 2; }
__device__ __forceinline__ int perm32(int rho) { const int n = rho >> 4, i = rho & 15; return 8 * (i >> 2) + 4 * n + (i & 3); }
__device__ __forceinline__ unsigned cvt_pk_bf16(float lo, float hi) { unsigned r; asm volatile("v_cvt_pk_bf16_f32 %0, %1, %2" : "=v"(r) : "v"(lo), "v"(hi)); return r; }
__device__ __forceinline__ unsigned f2bf(float f) { unsigned u = __builtin_bit_cast(unsigned, f); return (u + 0x7fffu + ((u >> 16) & 1u)) >> 16; }
__device__ __forceinline__ unsigned pk2(float lo, float hi) { return f2bf(lo) | (f2bf(hi) << 16); }
__device__ __forceinline__ float bf2f(unsigned short b) { return __builtin_bit_cast(float, (unsigned)b << 16); }
__device__ __forceinline__ unsigned pk2h(float lo, float hi) { const _Float16 a = (_Float16)lo, b = (_Float16)hi; return (unsigned)__builtin_bit_cast(unsigned short, a) | ((unsigned)__builtin_bit_cast(unsigned short, b) << 16); }
__device__ __forceinline__ float h2f_(unsigned short b) { return (float)__builtin_bit_cast(_Float16, b); }
__device__ __forceinline__ f32x4 ld_bf4(const void* p) { const u32x2 w = *(const u32x2*)p; return (f32x4){__builtin_bit_cast(float, w.x << 16), __builtin_bit_cast(float, w.x & 0xffff0000u), __builtin_bit_cast(float, w.y << 16), __builtin_bit_cast(float, w.y & 0xffff0000u)}; }
__device__ __forceinline__ void st_bf4(void* p, const f32x4& v) { u32x2 w; w.x = cvt_pk_bf16(v[0], v[1]); w.y = cvt_pk_bf16(v[2], v[3]); *(u32x2*)p = w; }
__device__ __forceinline__ float silu(float x) { return x / (1.f + __expf(-x)); }
__device__ __forceinline__ float wave_sum(float v) {
#pragma unroll
    for (int o = 1; o < 64; o <<= 1) v += __shfl_xor(v, o);
    return v;
}

constexpr unsigned long long KiB = 1024ull, MiB = 1ull << 20;
struct WsMapT { unsigned long long slots, dvec, lb, q, lffw, lfbw, v, sg, mod, pos, dftc, dl256, fa2, mb, wfnet, who, win, w1[2], w2[2], h, yctx, ysmp, u, big[2]; };
constexpr WsMapT WM = {   13 * MiB,   45 * MiB,   320 * KiB,   53 * MiB,   93 * MiB,   133 * MiB,   173 * MiB,   213 * MiB,   64 * KiB,   512 * KiB,
      53 * MiB,   53 * MiB + 256 * KiB,   53 * MiB + 512 * KiB,   54 * MiB,   59 * MiB,   1 * MiB,   3 * MiB,   {61 * MiB, 53 * MiB},   {237 * MiB, 61 * MiB},
      13 * MiB,   77 * MiB,   93 * MiB,   157 * MiB,   {77 * MiB, 69 * MiB} };
constexpr unsigned long long SLAB_FN = 77 * MiB, SLAB_M0 = 53 * MiB, SLAB_HG = 69 * MiB, SLAB_M1 = 13 * MiB;
constexpr unsigned long long CTL_BYTES = 16 * KiB;
#if defined(PROF_ID)
#define PROF_DECL unsigned long long prof_t0_ = 0ull; const bool prof_on_ = (blockIdx.x == 0) && (__builtin_amdgcn_readfirstlane(threadIdx.x >> 6) == 0)
#define PROF_BEGIN() do { if (prof_on_) prof_t0_ = __builtin_amdgcn_s_memrealtime(); } while (0)
#define PROF_END(id) do { if (prof_on_ && (id) == PROF_ID) { const unsigned long long d_ = __builtin_amdgcn_s_memrealtime() - prof_t0_; if (threadIdx.x == 0) *(LAS unsigned long long*)(prof_lds_ + 160 * 1024 - 512 + 256) += d_; } } while (0)
#else
#define PROF_DECL
#define PROF_BEGIN() do { } while (0)
#define PROF_END(id) do { } while (0)
#endif

struct Unit { size_t offA, offB; int p0, p1, p2, p3, nt; };
struct OpMap { int rm; unsigned s1, s2; };
__device__ __forceinline__ unsigned rowoff(const OpMap& m, int R) { return (unsigned)(R % m.rm) * m.s1 + (unsigned)(R / m.rm) * m.s2; }

template <class P, bool ALIGN_EPI, bool SP2>
__device__ __forceinline__ void gemm_phase(LAS unsigned char* lds, const P& pb) {
    const int tid = threadIdx.x, wid = __builtin_amdgcn_readfirstlane(tid >> 6), lane = tid & 63, wr = wid >> 2, wc = wid & 3, fr = lane & 15, fq = lane >> 4;
    unsigned voffA[2], voffB[2];
#pragma unroll
    for (int i = 0; i < 2; ++i) { int R, C; stage_rc(tid * 16 + i * 8192, R, C); const int Rb = P::PERM ? ((R & ~31) + perm32(R & 31)) : R;
        voffA[i] = rowoff(pb.ma, R) + (unsigned)C * 2u; voffB[i] = rowoff(pb.mb, Rb) + (unsigned)C * 2u; }
    const size_t kstepA = pb.kstepA, kstepB = pb.kstepB, hstepA = pb.hstepA, hstepB = pb.hstepB;
    const unsigned ldsw = (unsigned)wid * 1024u;
    const int aoff = lds_byte(wr * 64 + fr, fq * 8), boff = lds_byte(wc * 32 + fr, fq * 8);
#define PG8_SA(b, h) (((b) * 2 + (h)) * HTB)
#define PG8_SB(b, h) ((4 + (b) * 2 + (h)) * HTB)
#define PG8_STAGE(bufoff, gbase, voff) do { _Pragma("unroll") for (int _i = 0; _i < 2; ++_i) \
        __builtin_amdgcn_global_load_lds((const unsigned*)((const char*)(gbase) + (voff)[_i]), (LAS unsigned*)(lds + (bufoff) + ldsw + _i * 8192), 16, 0, 0); } while (0)
#define PG8_LDA(dst, b, h) do { _Pragma("unroll") for (int m = 0; m < 4; ++m) _Pragma("unroll") for (int k = 0; k < 2; ++k) dst[m][k] = *(const LAS bf16x8*)(lds + PG8_SA(b, h) + aoff + m * 2048 + k * 1024); } while (0)
#define PG8_LDB(dst, b, h) do { _Pragma("unroll") for (int n = 0; n < 2; ++n) _Pragma("unroll") for (int k = 0; k < 2; ++k) dst[n][k] = *(const LAS bf16x8*)(lds + PG8_SB(b, h) + boff + n * 2048 + k * 1024); } while (0)
#define PG8_MMA(ai, bj, At, Bt) do { __builtin_amdgcn_s_setprio(1); _Pragma("unroll") for (int m = 0; m < 4; ++m) _Pragma("unroll") for (int n = 0; n < 2; ++n) _Pragma("unroll") for (int k = 0; k < 2; ++k) \
        acc[ai][bj][m][n] = __builtin_amdgcn_mfma_f32_16x16x32_bf16(Bt[n][k], At[m][k], acc[ai][bj][m][n], 0, 0, 0); __builtin_amdgcn_s_setprio(0); } while (0)
#define PG8_WAIT_V(n) asm volatile("s_waitcnt vmcnt(" #n ")" ::: "memory")
#define PG8_WAIT_L(n) asm volatile("s_waitcnt lgkmcnt(" #n ")" ::: "memory")
#define PG8_BAR __builtin_amdgcn_s_barrier()
#define PG8_SCHED __builtin_amdgcn_sched_barrier(0)
    Unit cur, nxt; int ui = 0;
    if (!pb.next(0, cur)) return;
    f32x4 acc[2][2][4][2];
#pragma unroll
    for (int a = 0; a < 2; ++a)
#pragma unroll
        for (int b = 0; b < 2; ++b)
#pragma unroll
            for (int m = 0; m < 4; ++m)
#pragma unroll
                for (int n = 0; n < 2; ++n) acc[a][b][m][n] = (f32x4){0.f, 0.f, 0.f, 0.f};
    bf16x8 At[4][2], B0[2][2], B1[2][2];
    const char* cA = pb.A + cur.offA; const char* cB = pb.B + cur.offB;
    if constexpr (SP2) {
        PG8_STAGE(PG8_SB(0, 0), cB, voffB); PG8_STAGE(PG8_SB(0, 1), cB + hstepB, voffB); PG8_STAGE(PG8_SA(0, 0), cA, voffA); PG8_STAGE(PG8_SA(0, 1), cA + hstepA, voffA);
        if (wr == 1) PG8_BAR;
        PG8_WAIT_V(2); PG8_BAR;
        PG8_STAGE(PG8_SB(1, 0), cB + kstepB, voffB); PG8_STAGE(PG8_SA(1, 0), cA + kstepA, voffA); PG8_STAGE(PG8_SB(1, 1), cB + hstepB + kstepB, voffB);
        PG8_WAIT_V(6); PG8_BAR;
    } else {
        PG8_STAGE(PG8_SB(0, 0), cB, voffB); PG8_STAGE(PG8_SA(0, 0), cA, voffA); PG8_STAGE(PG8_SB(0, 1), cB + hstepB, voffB); PG8_STAGE(PG8_SA(0, 1), cA + hstepA, voffA);
        if (wr == 1) PG8_BAR;
        PG8_WAIT_V(4); PG8_BAR;
        PG8_STAGE(PG8_SB(1, 0), cB + kstepB, voffB); PG8_STAGE(PG8_SA(1, 0), cA + kstepA, voffA); PG8_STAGE(PG8_SB(1, 1), cB + hstepB + kstepB, voffB);
        PG8_WAIT_V(6); PG8_BAR;
    }
    for (;;) {
        const bool has_next = pb.next(ui + 1, nxt);
        const char* nA = has_next ? pb.A + nxt.offA : cA; const char* nB = has_next ? pb.B + nxt.offB : cB;
        const int nt = cur.nt;
        for (int t = 0; t < nt; t += 2) {
            const bool last = (t == nt - 2);
            const char* a1 = cA + (size_t)(t + 1) * kstepA;
            const char* a2 = last ? nA : cA + (size_t)(t + 2) * kstepA; const char* b2 = last ? nB : cB + (size_t)(t + 2) * kstepB;
            const char* a3 = a2 + kstepA; const char* b3 = b2 + kstepB;
            if constexpr (SP2) {
            PG8_LDB(B0, 0, 0); PG8_LDB(B1, 0, 1); PG8_SCHED; PG8_LDA(At, 0, 0); PG8_STAGE(PG8_SA(1, 1), a1 + hstepA, voffA);
            PG8_WAIT_V(8); PG8_WAIT_L(0); PG8_BAR; PG8_MMA(0, 0, At, B0); PG8_MMA(0, 1, At, B1); PG8_BAR; PG8_SCHED;
            PG8_LDA(At, 0, 1); PG8_STAGE(PG8_SB(0, 0), b2, voffB); PG8_STAGE(PG8_SB(0, 1), b2 + hstepB, voffB); PG8_STAGE(PG8_SA(0, 0), a2, voffA);
            PG8_WAIT_V(8); PG8_WAIT_L(0); PG8_BAR; PG8_MMA(1, 0, At, B0); PG8_MMA(1, 1, At, B1); PG8_BAR; PG8_SCHED;
            PG8_LDB(B0, 1, 0); PG8_LDB(B1, 1, 1); PG8_SCHED; PG8_LDA(At, 1, 0); PG8_STAGE(PG8_SA(0, 1), a2 + hstepA, voffA);
            PG8_WAIT_V(8); PG8_WAIT_L(0); PG8_BAR; PG8_MMA(0, 0, At, B0); PG8_MMA(0, 1, At, B1); PG8_BAR; PG8_SCHED;
            PG8_LDA(At, 1, 1); PG8_STAGE(PG8_SB(1, 0), b3, voffB); PG8_STAGE(PG8_SB(1, 1), b3 + hstepB, voffB); PG8_STAGE(PG8_SA(1, 0), a3, voffA);
            PG8_WAIT_V(8); PG8_WAIT_L(0); PG8_BAR; PG8_MMA(1, 0, At, B0); PG8_MMA(1, 1, At, B1); PG8_BAR; PG8_SCHED;
            } else {
            PG8_LDB(B0, 0, 0); PG8_SCHED; PG8_LDA(At, 0, 0); PG8_STAGE(PG8_SA(1, 1), a1 + hstepA, voffA);
            PG8_WAIT_L(8); PG8_BAR; PG8_WAIT_L(0); PG8_MMA(0, 0, At, B0); PG8_BAR; PG8_SCHED;
            PG8_LDB(B1, 0, 1); PG8_STAGE(PG8_SB(0, 0), b2, voffB);
            PG8_BAR; PG8_WAIT_L(0); PG8_MMA(0, 1, At, B1); PG8_BAR;
            PG8_LDA(At, 0, 1); PG8_STAGE(PG8_SA(0, 0), a2, voffA);
            PG8_BAR; PG8_WAIT_L(0); PG8_MMA(1, 0, At, B0); PG8_BAR; PG8_SCHED;
            PG8_STAGE(PG8_SB(0, 1), b2 + hstepB, voffB);
            PG8_WAIT_V(6); PG8_BAR; PG8_MMA(1, 1, At, B1); PG8_BAR;
            PG8_LDB(B0, 1, 0); PG8_SCHED; PG8_LDA(At, 1, 0); PG8_STAGE(PG8_SA(0, 1), a2 + hstepA, voffA);
            PG8_WAIT_L(8); PG8_BAR; PG8_WAIT_L(0); PG8_MMA(0, 0, At, B0); PG8_BAR; PG8_SCHED;
            PG8_LDB(B1, 1, 1); PG8_STAGE(PG8_SB(1, 0), b3, voffB);
            PG8_BAR; PG8_WAIT_L(0); PG8_MMA(0, 1, At, B1); PG8_BAR;
            PG8_LDA(At, 1, 1); PG8_STAGE(PG8_SA(1, 0), a3, voffA);
            PG8_BAR; PG8_WAIT_L(0); PG8_MMA(1, 0, At, B0); PG8_BAR; PG8_SCHED;
            PG8_STAGE(PG8_SB(1, 1), b3 + hstepB, voffB);
            PG8_WAIT_V(6); PG8_BAR; PG8_MMA(1, 1, At, B1); PG8_BAR;
            }
        }
        if constexpr (ALIGN_EPI) { if (wr == 0) PG8_BAR; }
        pb.epi(acc, cur, wr, wc, fr, fq);
        if (!has_next) break;
#pragma unroll
        for (int a = 0; a < 2; ++a)
#pragma unroll
            for (int b = 0; b < 2; ++b)
#pragma unroll
                for (int m = 0; m < 4; ++m)
#pragma unroll
                    for (int n = 0; n < 2; ++n) acc[a][b][m][n] = (f32x4){0.f, 0.f, 0.f, 0.f};
        cur = nxt; cA = nA; cB = nB; ++ui;
        if constexpr (ALIGN_EPI) { if (wr == 1) PG8_BAR; }
    }
    PG8_WAIT_V(0);
    if constexpr (!ALIGN_EPI) { if (wr == 0) PG8_BAR; }
    PG8_BAR;
#undef PG8_SA
#undef PG8_SB
#undef PG8_STAGE
#undef PG8_LDA
#undef PG8_LDB
#undef PG8_MMA
#undef PG8_WAIT_V
#undef PG8_WAIT_L
#undef PG8_BAR
#undef PG8_SCHED
}

struct StaticOrder {
    int nM, nN, nwg, G, c;
    __device__ void init(int nM_, int nN_, int G_, int c_) { nM = nM_; nN = nN_; nwg = nM * nN; G = G_; c = c_; }
    __device__ bool next(int i, int& pm, int& pn) const { const long L = (long)i * G + c; if (L >= nwg) return false; map((int)L, pm, pn); return true; }
    __device__ void map(int L, int& pm, int& pn) const {
        int wgid = L; { const int q = nwg / NXCD, r = nwg % NXCD, xcd = wgid % NXCD, off = wgid / NXCD; wgid = (xcd < r ? xcd * (q + 1) : r * (q + 1) + (xcd - r) * q) + off; }
        const int nig = WGM * nN, gid = wgid / nig, fm = gid * WGM, gsz = (nM - fm) < WGM ? (nM - fm) : WGM;
        pm = fm + ((wgid % nig) % gsz); pn = (wgid % nig) / gsz;
    }
};

struct ProbBase {
    const char* A; const char* B; OpMap ma, mb; size_t hstepA, hstepB, kstepA, kstepB; int nt;
    __device__ void std_operands(const void* A_, int lda, const void* B_, int ldb, int K) {
        A = (const char*)A_; B = (const char*)B_; ma = OpMap{128, (unsigned)lda * 2u, 0u}; mb = OpMap{128, (unsigned)ldb * 2u, 0u};
        hstepA = (size_t)HALF * lda * 2; hstepB = (size_t)HALF * ldb * 2; kstepA = kstepB = BK * 2; nt = K / BK;
    }
};

template <class F> __device__ __forceinline__ void epi_rows_perm(const f32x4 (&acc)[2][2][4][2], int wr, int wc, int fr, int fq, F f) {
    asm volatile("" : "+v"(fr), "+v"(fq));
#pragma unroll
    for (int ai = 0; ai < 2; ++ai)
#pragma unroll
        for (int m = 0; m < 4; ++m)
#pragma unroll
            for (int bj = 0; bj < 2; ++bj) f(ai * HALF + wr * 64 + m * 16 + fr, bj * HALF + wc * 32 + 8 * fq, acc[ai][bj][m][0], acc[ai][bj][m][1]);
}
template <class F> __device__ __forceinline__ void epi_rows_f32(const f32x4 (&acc)[2][2][4][2], int wr, int wc, int fr, int fq, F f) {
    asm volatile("" : "+v"(fr), "+v"(fq));
#pragma unroll
    for (int ai = 0; ai < 2; ++ai)
#pragma unroll
        for (int m = 0; m < 4; ++m)
#pragma unroll
            for (int bj = 0; bj < 2; ++bj)
#pragma unroll
                for (int n = 0; n < 2; ++n) f(ai * HALF + wr * 64 + m * 16 + fr, bj * HALF + wc * 32 + 16 * n + 4 * fq, acc[ai][bj][m][n]);
}
__device__ __forceinline__ u32x4 pack8(const f32x4& v0, const f32x4& v1) { u32x4 w; w.x = cvt_pk_bf16(v0[0], v0[1]); w.y = cvt_pk_bf16(v0[2], v0[3]); w.z = cvt_pk_bf16(v1[0], v1[1]); w.w = cvt_pk_bf16(v1[2], v1[3]); return w; }

struct TokOrder : ProbBase {
    StaticOrder so; int row0, lda, ldb;
    __device__ void init_tok(const void* Act, int lda_, const void* Wt, int K, int row0_, int nM, int nN, int G, int c) { std_operands(Act, lda_, Wt, K, K); row0 = row0_; lda = lda_; ldb = K; so.init(nM, nN, G, c); }
    __device__ bool next(int i, Unit& u) const { int pm, pn; if (!so.next(i, pm, pn)) return false; u.p0 = pm; u.p1 = pn; u.p2 = -1; u.nt = nt; u.offA = (size_t)(row0 + pm * BM) * lda * 2; u.offB = (size_t)pn * BM * ldb * 2; return true; }
};
struct ProbMlp1 : TokOrder {
    static constexpr bool PERM = true;
    bf16_t* O; int ldc;
    __device__ __forceinline__ void epi(const f32x4 (&acc)[2][2][4][2], const Unit& u, int wr, int wc, int fr, int fq) const {
        bf16_t* base = O + (size_t)(row0 + u.p0 * BM) * ldc + u.p1 * BM;
        epi_rows_perm(acc, wr, wc, fr, fq, [&](int r, int c, f32x4 v0, f32x4 v1) {
#pragma unroll
            for (int j = 0; j < 4; ++j) { const float a = fmaxf(v0[j], 0.f), b = fmaxf(v1[j], 0.f); v0[j] = a * a; v1[j] = b * b; }
            *(u32x4*)(base + (size_t)r * ldc + c) = pack8(v0, v1); });
    }
};
template <bool FIRST> struct ProbResidT : TokOrder {
    static constexpr bool PERM = false;
    bf16_t* X; const float* mod; int layer, gidx; unsigned short* slab; int G2, c2;
    const float* xp; const float* xs; const float* er; const float* ec;
    __device__ void init_split(int G_, int c_, unsigned short* slab_) { G2 = G_; c2 = c_; slab = slab_; xp = nullptr; xs = nullptr; er = nullptr; ec = nullptr; }
    __device__ bool next(int i, Unit& u) const {
        if (G2 != 256) return TokOrder::next(i, u);
        int pm, pn;
        if (i > 1) return false;
        const int which = (c2 & 1) ? 1 - i : i;
        if (which == 0) { so.map(c2, pm, pn); u.p2 = -1; u.p3 = 0; u.nt = nt; u.offA = (size_t)(row0 + pm * BM) * lda * 2; u.offB = (size_t)pn * BM * ldb * 2; }
        else { const int L = 256 + (c2 >> 2), kq = c2 & 3, ntq = nt >> 2; so.map(L, pm, pn); u.p2 = kq; u.p3 = L - 256; u.nt = ntq;
            u.offA = (size_t)(row0 + pm * BM) * lda * 2 + (size_t)kq * ntq * BK * 2; u.offB = (size_t)pn * BM * ldb * 2 + (size_t)kq * ntq * BK * 2; }
        u.p0 = pm; u.p1 = pn; return true;
    }
    __device__ __forceinline__ void epi(const f32x4 (&acc)[2][2][4][2], const Unit& u, int wr, int wc, int fr, int fq) const {
        const int rowt = row0 + u.p0 * BM, cond = rowt >> 12;
        const float* gate = mod + ((size_t)(cond * 2 + layer) * 6 + gidx) * 1024 + u.p1 * BM;
        if (u.p2 <= 0) {
            bf16_t* base = X + (size_t)rowt * 2048 + u.p1 * BM;
            if constexpr (FIRST) {
                const int colt = u.p1 * BM; const bool smp = rowt >= 4096, use_er = colt < 512; const int t0 = rowt & 4095;
                const float* xsrc = smp ? xs + (size_t)(rowt - 4096) * 1024 + colt : xp + (size_t)rowt * 1024 + colt;
                const float* pbase = use_er ? er + colt : ec + colt - 512;
                epi_rows_f32(acc, wr, wc, fr, fq, [&](int r, int c, f32x4 v) {
                    const f32x4 g = *(const f32x4*)(gate + c); f32x4 x0 = *(const f32x4*)(xsrc + (size_t)r * 1024 + c);
                    if (smp) { const int t = t0 + r; x0 = x0 + *(const f32x4*)(pbase + (use_er ? (t >> 6) : (t & 63)) * 512 + c); }
                    st_bf4(base + (size_t)r * 2048 + (r & 1) * 1024 + c, x0 + g * v); });
            } else {
                epi_rows_f32(acc, wr, wc, fr, fq, [&](int r, int c, f32x4 v) {
                    const f32x4 g = *(const f32x4*)(gate + c); bf16_t* p = base + (size_t)r * 2048 + (r & 1) * 1024 + c; st_bf4(p, ld_bf4(p) + g * v); });
            }
        } else {
            unsigned short* base = slab + (size_t)(u.p3 * 3 + u.p2 - 1) * 65536;
            epi_rows_f32(acc, wr, wc, fr, fq, [&](int r, int c, f32x4 v) {
                const f32x4 g = *(const f32x4*)(gate + c); const f32x4 w = g * v; u32x2 o; o.x = pk2h(w[0], w[1]); o.y = pk2h(w[2], w[3]); *(u32x2*)(base + (size_t)r * 256 + c) = o; });
        }
    }
};
typedef ProbResidT<false> ProbResid; typedef ProbResidT<true> ProbResidFirst;
__device__ __forceinline__ void build_split_table(LAS unsigned char* tab, int G, int tid) {
    for (int i = tid; i < 320; i += NTHREADS) tab[i] = 255;
    __syncthreads();
    if (G == 256) { StaticOrder so; so.init(80, 4, G, 0); for (int L = 256 + tid; L < 320; L += NTHREADS) { int pm, pn; so.map(L, pm, pn); tab[pm * 4 + pn] = (unsigned char)(L - 256); } }
    __syncthreads();
}
struct SlabRaw { u32x2 w[3]; };
__device__ __forceinline__ SlabRaw slab_load(const unsigned short* slab, int idx, int r255, int col) { SlabRaw s;
#pragma unroll
    for (int q = 0; q < 3; ++q) s.w[q] = *(const u32x2*)(slab + (size_t)(idx * 3 + q) * 65536 + (size_t)r255 * 256 + col);
    return s; }
__device__ __forceinline__ f32x4 slab_add(const SlabRaw& r) { f32x4 s = (f32x4){0.f, 0.f, 0.f, 0.f};
#pragma unroll
    for (int q = 0; q < 3; ++q) { s[0] += h2f_((unsigned short)(r.w[q].x & 0xffffu)); s[1] += h2f_((unsigned short)(r.w[q].x >> 16)); s[2] += h2f_((unsigned short)(r.w[q].y & 0xffffu)); s[3] += h2f_((unsigned short)(r.w[q].y >> 16)); }
    return s; }
__device__ __forceinline__ f32x4 slab_sum(const unsigned short* slab, int idx, int r255, int col) {
    f32x4 s = (f32x4){0.f, 0.f, 0.f, 0.f};
#pragma unroll
    for (int q = 0; q < 3; ++q) { const u32x2 w = *(const u32x2*)(slab + (size_t)(idx * 3 + q) * 65536 + (size_t)r255 * 256 + col);
        s[0] += h2f_((unsigned short)(w.x & 0xffffu)); s[1] += h2f_((unsigned short)(w.x >> 16)); s[2] += h2f_((unsigned short)(w.y & 0xffffu)); s[3] += h2f_((unsigned short)(w.y >> 16)); }
    return s;
}

struct ProbWin : TokOrder {
    static constexpr bool PERM = true;
    bf16_t* Oq; bf16_t* Offw; bf16_t* Ofbw; bf16_t* Ov; bf16_t* Osg; const float* lb;
    __device__ __forceinline__ void epi(const f32x4 (&acc)[2][2][4][2], const Unit& u, int wr, int wc, int fr, int fq) const {
        const int t = u.p1 >> 2, col0 = (u.p1 & 3) * BM;
        bf16_t* O = t == 0 ? Oq : t == 1 ? Offw : t == 2 ? Ofbw : t == 3 ? Ov : Osg;
        bf16_t* base = O + (size_t)(row0 + u.p0 * BM) * 1024 + col0;
        if (t == 1 || t == 2) {
            const float* lbp = lb + (t - 1) * 1024 + col0;
            epi_rows_perm(acc, wr, wc, fr, fq, [&](int r, int c, f32x4 v0, f32x4 v1) {
                const f32x4 l0 = *(const f32x4*)(lbp + c), l1 = *(const f32x4*)(lbp + c + 4);
#pragma unroll
                for (int j = 0; j < 4; ++j) { v0[j] = __builtin_amdgcn_logf(l0[j] + (1.f - l0[j]) * __builtin_amdgcn_rcpf(1.f + __builtin_amdgcn_exp2f(-1.44269504f * v0[j]))); v1[j] = __builtin_amdgcn_logf(l1[j] + (1.f - l1[j]) * __builtin_amdgcn_rcpf(1.f + __builtin_amdgcn_exp2f(-1.44269504f * v1[j]))); }
                u32x4 w; w.x = pk2h(v0[0], v0[1]); w.y = pk2h(v0[2], v0[3]); w.z = pk2h(v1[0], v1[1]); w.w = pk2h(v1[2], v1[3]);
                *(u32x4*)(base + (size_t)r * 1024 + c) = w; });
        } else if (t == 3) {
            epi_rows_perm(acc, wr, wc, fr, fq, [&](int r, int c, f32x4 v0, f32x4 v1) { *(u32x4*)(base + (size_t)r * 1024 + c) = pack8(v0, v1); });
        } else {
            epi_rows_perm(acc, wr, wc, fr, fq, [&](int r, int c, f32x4 v0, f32x4 v1) {
#pragma unroll
                for (int j = 0; j < 4; ++j) { v0[j] = silu(v0[j]); v1[j] = silu(v1[j]); }
                *(u32x4*)(base + (size_t)r * 1024 + c) = pack8(v0, v1); });
        }
    }
};

struct ProbChan : ProbBase {
    static constexpr bool PERM = true;
    int mode, G, c, nunits; bf16_t* Y;
    __device__ void init(int mode_, const void* dftc, const bf16_t* h0, bf16_t* Y_, int G_, int c_) {
        mode = mode_; G = G_; c = c_; Y = Y_; A = (const char*)dftc; B = (const char*)h0; ma = OpMap{128, 512u, 0u}; hstepA = (size_t)HALF * 512; kstepA = kstepB = BK * 2; nt = 4;
        if (mode == 0) { mb = OpMap{128, 2048u, 0u}; hstepB = (size_t)HALF * 2048; nunits = 16 * 4 * 2; }
        else { mb = OpMap{64, 64u * 2048u, 2048u}; hstepB = 2 * 2048; nunits = 4 * 4 * 16 * 2; }
    }
    __device__ bool next(int i, Unit& u) const {
        const int L = i * G + c; if (L >= nunits) return false;
        const int mt = L & 1; u.p0 = mt; u.nt = nt; u.offA = (size_t)mt * 256 * 512;
        if (mode == 0) { const int g = (L >> 1) & 3, b = L >> 3; u.p1 = b * 2048 + g * 512; u.p2 = 0; u.offB = ((size_t)(b * 256) * 1024 + g * 256) * 2; }
        else { const int j = (L >> 1) & 15, g = (L >> 5) & 3, b = L >> 7; u.p1 = b * 2048 + g * 512; u.p2 = j * 256; u.offB = ((size_t)(4096 + b * 4096 + 4 * j) * 1024 + g * 256) * 2; }
        return true;
    }
    __device__ __forceinline__ void epi(const f32x4 (&acc)[2][2][4][2], const Unit& u, int wr, int wc, int fr, int fq) const {
        const int ldc = mode == 0 ? 256 : 4096;
        bf16_t* base = Y + (size_t)(u.p1 + u.p0 * 256) * ldc + u.p2;
        epi_rows_perm(acc, wr, wc, fr, fq, [&](int r, int cc, f32x4 v0, f32x4 v1) { *(u32x4*)(base + (size_t)r * ldc + cc) = pack8(v0, v1); });
    }
};
struct ProbPosCtx : ProbBase {
    static constexpr bool PERM = true;
    int G, c; bf16_t* Z;
    __device__ void init(const void* dl, const bf16_t* yctx, bf16_t* Z_, int G_, int c_) { std_operands(dl, 512, yctx, 512, 512); G = G_; c = c_; Z = Z_; }
    __device__ bool next(int i, Unit& u) const {
        const int L = i * G + c; if (L >= 64) return false;
        const int pn = L & 3, b = L >> 2; u.p0 = b; u.p1 = pn; u.nt = nt; u.offA = 0; u.offB = ((size_t)b * 2048 * 256 + (size_t)pn * 256 * 512) * 2; return true;
    }
    __device__ __forceinline__ void epi(const f32x4 (&acc)[2][2][4][2], const Unit& u, int wr, int wc, int fr, int fq) const {
        bf16_t* base = Z + (size_t)(u.p0 * 256) * 1024 + u.p1 * 256;
        epi_rows_perm(acc, wr, wc, fr, fq, [&](int r, int cc, f32x4 v0, f32x4 v1) { *(u32x4*)(base + (size_t)r * 1024 + cc) = pack8(v0, v1); });
    }
};
struct ProbSmpA : ProbBase {
    static constexpr bool PERM = true;
    int G, c; bf16_t* U;
    __device__ void init(const void* fa2, const bf16_t* yt, bf16_t* U_, int G_, int c_) {
        A = (const char*)fa2; B = (const char*)yt; ma = OpMap{128, 512u, 0u}; hstepA = (size_t)HALF * 512; kstepA = BK * 2;
        mb = OpMap{32, 128u, 16384u}; hstepB = 4 * 16384; kstepB = 4096; nt = 4; G = G_; c = c_; U = U_;
    }
    __device__ bool next(int i, Unit& u) const {
        const int L = i * G + c; if (L >= 512) return false;
        const int tau = L & 127, b = L >> 7; u.p0 = b; u.p1 = tau; u.nt = nt; u.offA = 0; u.offB = ((size_t)(b * 2048 + 16 * tau) * 4096) * 2; return true;
    }
    __device__ __forceinline__ void epi(const f32x4 (&acc)[2][2][4][2], const Unit& u, int wr, int wc, int fr, int fq) const {
        bf16_t* base = U + (size_t)(u.p0 * 1024 + 8 * u.p1) * 8192;
        epi_rows_perm(acc, wr, wc, fr, fq, [&](int r, int cc, f32x4 v0, f32x4 v1) {
            *(u32x4*)(base + (size_t)(cc >> 5) * 8192 + (r & 127) * 64 + (r >> 7) * 32 + (cc & 31)) = pack8(v0, v1); });
    }
};
struct ProbSmpB : ProbBase {
    static constexpr bool PERM = true;
    int G, c; bf16_t* Z;
    __device__ void init(const void* mbm, const bf16_t* Uin, bf16_t* Z_, int G_, int c_) { std_operands(mbm, 512, Uin, 8192, 512); G = G_; c = c_; Z = Z_; }
    __device__ bool next(int i, Unit& u) const {
        const int L = i * G + c; if (L >= 256) return false;
        const int pn = L & 3, q = (L >> 2) & 15, b = L >> 6; u.p0 = b; u.p1 = q; u.p2 = pn; u.nt = nt;
        u.offA = (size_t)q * 256 * 512 * 2; u.offB = ((size_t)(b * 1024 + pn * 256) * 8192 + q * 512) * 2; return true;
    }
    __device__ __forceinline__ void epi(const f32x4 (&acc)[2][2][4][2], const Unit& u, int wr, int wc, int fr, int fq) const {
        bf16_t* base = Z + (size_t)(4096 + u.p0 * 4096 + 4 * u.p1) * 1024 + u.p2 * 256;
        epi_rows_perm(acc, wr, wc, fr, fq, [&](int r, int cc, f32x4 v0, f32x4 v1) {
            const int l = (r >> 6) + 64 * (r & 63); *(u32x4*)(base + (size_t)l * 1024 + cc) = pack8(v0, v1); });
    }
};

__device__ __forceinline__ void norm_rows(bf16_t* X, int row0, int nrows, const float* g, const float* mod, int layer, int ish, bf16_t* H, int gw, int ngw, int lane, const LAS unsigned char* stab, const unsigned short* slab) {
    constexpr int NB = 5;
    LAS unsigned char* prof_lds_ = (LAS unsigned char*)0; (void)prof_lds_; PROF_DECL; PROF_BEGIN();
    f32x4 gv[4], gm[4], shv[4];
#pragma unroll
    for (int j = 0; j < 4; ++j) gv[j] = *(const f32x4*)(g + 4 * lane + 256 * j);
    const int rpw = (nrows + ngw - 1) / ngw, rbeg = row0 + gw * rpw, rend = (rbeg + rpw < row0 + nrows) ? rbeg + rpw : row0 + nrows;
    int ccur = -1;
    for (int rb = rbeg; rb < rend; rb += NB) {
        u32x2 nx[NB][4];
#pragma unroll
        for (int b = 0; b < NB; ++b) { const int r = rb + b; if (r < rend) { const u32x2* p = (const u32x2*)(X + (size_t)r * 2048 + (r & 1) * 1024) + lane;
#pragma unroll
            for (int j = 0; j < 4; ++j) nx[b][j] = p[64 * j]; } }
#pragma unroll
        for (int b = 0; b < NB; ++b) {
            const int r = rb + b; if (r >= rend) break;
            if ((r >> 12) != ccur) { ccur = r >> 12; const float* mrow = mod + ((size_t)(ccur * 2 + layer) * 6) * 1024;
#pragma unroll
                for (int j = 0; j < 4; ++j) { shv[j] = *(const f32x4*)(mrow + (size_t)ish * 1024 + 4 * lane + 256 * j); gm[j] = gv[j] * (*(const f32x4*)(mrow + (size_t)(ish + 1) * 1024 + 4 * lane + 256 * j) + 1.f); } }
            u32x2* xr = (u32x2*)(X + (size_t)r * 2048 + (r & 1) * 1024) + lane;
            f32x4 v[4]; float s = 0.f;
            int si4[4]; SlabRaw sr[4];
#pragma unroll
            for (int j = 0; j < 4; ++j) { si4[j] = stab[(r >> 8) * 4 + j]; if (si4[j] != 255) sr[j] = slab_load(slab, si4[j], r & 255, 4 * lane); }
#pragma unroll
            for (int j = 0; j < 4; ++j) { v[j] = (f32x4){__builtin_bit_cast(float, nx[b][j].x << 16), __builtin_bit_cast(float, nx[b][j].x & 0xffff0000u), __builtin_bit_cast(float, nx[b][j].y << 16), __builtin_bit_cast(float, nx[b][j].y & 0xffff0000u)}; if (si4[j] != 255) { v[j] = v[j] + slab_add(sr[j]); st_bf4(xr + 64 * j, v[j]); }
                s += (v[j].x * v[j].x + v[j].y * v[j].y) + (v[j].z * v[j].z + v[j].w * v[j].w); }
            const float rstd = rsqrtf(wave_sum(s) * (1.f / 1024.f) + 1e-6f);
            unsigned long long* o8 = (unsigned long long*)(H + (size_t)r * 1024) + lane;
#pragma unroll
            for (int j = 0; j < 4; ++j) { const f32x4 o = v[j] * rstd * gm[j] + shv[j]; o8[64 * j] = (unsigned long long)cvt_pk_bf16(o.x, o.y) | ((unsigned long long)cvt_pk_bf16(o.z, o.w) << 32); }
        }
    }
    PROF_END(11);
}


__device__ __forceinline__ void embed_rows(const float* xp, const float* xs, const float* er, const float* ec, const float* g, const float* mod, bf16_t* H, int gw, int ngw, int lane) {
    constexpr int NB = 4;
    f32x4 gv[4], gm[4], shv[4];
#pragma unroll
    for (int j = 0; j < 4; ++j) gv[j] = *(const f32x4*)(g + 4 * lane + 256 * j);
    const int rpw = (20480 + ngw - 1) / ngw, rbeg = gw * rpw, rend = (rbeg + rpw < 20480) ? rbeg + rpw : 20480;
    int ccur = -1;
    int prow = -1; f32x4 pr0 = (f32x4){0.f, 0.f, 0.f, 0.f}, pr1 = pr0;
    for (int rb = rbeg; rb < rend; rb += NB) {
        f32x4 nx[NB][4], pc[NB][2];
#pragma unroll
        for (int b = 0; b < NB; ++b) { const int r = rb + b; if (r < rend) { const f32x4* xr = (const f32x4*)(r < 4096 ? xp + (size_t)r * 1024 : xs + (size_t)(r - 4096) * 1024) + lane;
#pragma unroll
            for (int j = 0; j < 4; ++j) nx[b][j] = xr[64 * j];
            if (r >= 4096) { const int col = r & 63; pc[b][0] = *(const f32x4*)(ec + col * 512 + 4 * lane); pc[b][1] = *(const f32x4*)(ec + col * 512 + 256 + 4 * lane); } } }
#pragma unroll
        for (int b = 0; b < NB; ++b) {
            const int r = rb + b; if (r >= rend) break;
            if ((r >> 12) != ccur) { ccur = r >> 12; const float* mrow = mod + ((size_t)(ccur * 2 + 0) * 6) * 1024;
#pragma unroll
                for (int j = 0; j < 4; ++j) { shv[j] = *(const f32x4*)(mrow + 4 * lane + 256 * j); gm[j] = gv[j] * (*(const f32x4*)(mrow + 1024 + 4 * lane + 256 * j) + 1.f); } }
            f32x4 v[4]; float s = 0.f;
#pragma unroll
            for (int j = 0; j < 4; ++j) v[j] = nx[b][j];
            if (r >= 4096) { const int row = (r & 4095) >> 6;
                if (row != prow) { prow = row; pr0 = *(const f32x4*)(er + row * 512 + 4 * lane); pr1 = *(const f32x4*)(er + row * 512 + 256 + 4 * lane); }
                v[0] = v[0] + pr0; v[1] = v[1] + pr1; v[2] = v[2] + pc[b][0]; v[3] = v[3] + pc[b][1]; }
#pragma unroll
            for (int j = 0; j < 4; ++j) s += (v[j].x * v[j].x + v[j].y * v[j].y) + (v[j].z * v[j].z + v[j].w * v[j].w);
            const float rstd = rsqrtf(wave_sum(s) * (1.f / 1024.f) + 1e-6f);
            unsigned long long* o8 = (unsigned long long*)(H + (size_t)r * 1024) + lane;
#pragma unroll
            for (int j = 0; j < 4; ++j) { const f32x4 o = v[j] * rstd * gm[j] + shv[j]; o8[64 * j] = (unsigned long long)cvt_pk_bf16(o.x, o.y) | ((unsigned long long)cvt_pk_bf16(o.z, o.w) << 32); }
        }
    }
}
__device__ __forceinline__ void gen_tables(unsigned char* ws, long e0, long estride) {
    bf16_t* dftc = (bf16_t*)(ws + WM.dftc); bf16_t* dl = (bf16_t*)(ws + WM.dl256); bf16_t* fa2 = (bf16_t*)(ws + WM.fa2); bf16_t* mbm = (bf16_t*)(ws + WM.mb);
    float* er = (float*)(ws + WM.pos); float* ec = er + 64 * 512;
    constexpr long N0 = 512 * 256, N1 = 256 * 512, N2 = 256 * 256, N3 = 16L * 256 * 512, N4 = 2 * 64 * 512;
    for (long e = e0; e < N0 + N1 + N2 + N3 + N4; e += estride) {
        long r = e;
        if (r < N0) { const int mrow = (int)(r >> 8), cp = (int)(r & 255), cc = mrow >> 1, ri = mrow & 1; const float x = 2.f * (float)((cc * cp) & 255) / 256.f;
            dftc[r] = (bf16_t)f2bf(ri == 0 ? cospif(x) : -sinpif(x)); continue; } r -= N0;
        if (r < N1) { const int l = (int)(r >> 9), k = (int)(r & 511), ri = k >> 8, lp = k & 255; const float x = 2.f * (float)((l * lp) & 255) / 256.f;
            dl[r] = (bf16_t)f2bf((ri == 0 ? cospif(x) : sinpif(x)) * (1.f / 256.f)); continue; } r -= N1;
        if (r < N2) { const int mrow = (int)(r >> 8), k = (int)(r & 255), sA = mrow >> 7, k1 = (mrow >> 1) & 63, ro = mrow & 1, ri = k >> 7, sB = (k >> 6) & 1, l1 = k & 63;
            const float x = 2.f * (float)((k1 * l1) & 63) / 64.f; float v = 0.f;
            if (sA == sB) v = (ro == ri) ? cospif(x) : (ro == 0 ? sinpif(x) : -sinpif(x));
            fa2[r] = (bf16_t)f2bf(v); continue; } r -= N2;
        if (r < N3) { const int q = (int)(r >> 17), mrow = (int)(r >> 9) & 255, k = (int)(r & 511), ko = mrow >> 6, k2 = mrow & 63, kop = k >> 7, ro = (k >> 6) & 1, l2 = k & 63;
            const int l = 4 * q + ko + 64 * k2; const float x = 2.f * (float)((l * l2) & 4095) / 4096.f; float v = 0.f;
            if (ko == kop) v = (ro == 0 ? cospif(x) : sinpif(x)) * (1.f / 1024.f);
            mbm[r] = (bf16_t)f2bf(v); continue; } r -= N3;
        { const int which = (int)(r >> 15), p = (int)(r >> 9) & 63, j = (int)(r & 511), i = j & 255;
            const float omega = 1.0f / powf(10000.0f, (float)i / 256.0f); const float ang = (float)p * omega;
            (which == 0 ? er : ec)[p * 512 + j] = (j < 256) ? sinf(ang) : cosf(ang); }
    }
}


__device__ __forceinline__ void final_rows(float* X, int row0, int nrows, const float* g, int gw, int ngw, int lane, const LAS unsigned char* stab, const unsigned short* slab) {
    constexpr int NB = 5;
    f32x4 gv[4];
#pragma unroll
    for (int j = 0; j < 4; ++j) gv[j] = *(const f32x4*)(g + 4 * lane + 256 * j);
    for (int rb = row0 + gw; rb < row0 + nrows; rb += NB * ngw) {
        u32x2 nx[NB][4];
#pragma unroll
        for (int b = 0; b < NB; ++b) { const int r = rb + b * ngw; if (r < row0 + nrows) { const u32x2* p = (const u32x2*)(X + (size_t)r * 1024) + (r & 1) * 256 + lane;
#pragma unroll
            for (int j = 0; j < 4; ++j) nx[b][j] = p[64 * j]; } }
#pragma unroll
        for (int b = 0; b < NB; ++b) {
            const int r = rb + b * ngw; if (r >= row0 + nrows) break;
            f32x4* xr = (f32x4*)(X + (size_t)r * 1024) + lane;
            f32x4 v[4]; float s = 0.f;
            int si4[4]; SlabRaw sr[4];
#pragma unroll
            for (int j = 0; j < 4; ++j) { si4[j] = stab[(r >> 8) * 4 + j]; if (si4[j] != 255) sr[j] = slab_load(slab, si4[j], r & 255, 4 * lane); }
#pragma unroll
            for (int j = 0; j < 4; ++j) { v[j] = (f32x4){__builtin_bit_cast(float, nx[b][j].x << 16), __builtin_bit_cast(float, nx[b][j].x & 0xffff0000u), __builtin_bit_cast(float, nx[b][j].y << 16), __builtin_bit_cast(float, nx[b][j].y & 0xffff0000u)}; if (si4[j] != 255) v[j] = v[j] + slab_add(sr[j]);
                s += (v[j].x * v[j].x + v[j].y * v[j].y) + (v[j].z * v[j].z + v[j].w * v[j].w); }
            const float rstd = rsqrtf(wave_sum(s) * (1.f / 1024.f) + 1e-6f);
#pragma unroll
            for (int j = 0; j < 4; ++j) xr[64 * j] = v[j] * rstd * gv[j];
        }
    }
}
__device__ __forceinline__ void mod_unit(LAS unsigned char* lds, int unit, const float* c, const float* c_ctx, const float* ada_w, const float* ada_b, float* mod, int tid, int wave, int lane) {
    LAS float* sc = (LAS float*)lds;
    LAS float* red = (LAS float*)(lds + 20480);
    const int layer = unit / 192, n0 = (unit % 192) * 32, col = lane & 31, kh = lane >> 5;
    for (int i = tid; i < 5 * 1024; i += NTHREADS) { const int cond = i >> 10, k = i & 1023; const float x = cond == 0 ? c_ctx[k] : c[(cond - 1) * 1024 + k]; sc[i] = silu(x); }
    __syncthreads();
    const float* w = ada_w + ((size_t)layer * 1024 + wave * 128 + kh) * 6144 + n0 + col;
    float acc[5];
#pragma unroll
    for (int q = 0; q < 5; ++q) acc[q] = 0.f;
#pragma unroll 16
    for (int k = 0; k < 64; ++k) {
        const float wv = w[(size_t)(2 * k) * 6144];
#pragma unroll
        for (int q = 0; q < 5; ++q) acc[q] += wv * sc[q * 1024 + wave * 128 + 2 * k + kh];
    }
#pragma unroll
    for (int q = 0; q < 5; ++q) { acc[q] += __shfl_xor(acc[q], 32); if (kh == 0) red[(wave * 5 + q) * 32 + col] = acc[q]; }
    __syncthreads();
    for (int i = tid; i < 5 * 32; i += NTHREADS) { const int q = i >> 5, n = i & 31; float s = 0.f;
#pragma unroll
        for (int ww = 0; ww < 8; ++ww) s += red[(ww * 5 + q) * 32 + n];
        mod[((size_t)q * 2 + layer) * 6144 + n0 + n] = s + ada_b[(size_t)layer * 6144 + n0 + n]; }
    __syncthreads();
}

__device__ __forceinline__ void transpose_item(const float* W, int K, int N, bf16_t* WT, LAS float* scr, int item, int lane) {
    const int nblk = N / 32, kb = item / nblk, nb = item % nblk, k0 = 64 * kb, n0 = 32 * nb;
    f32x4 ld[8];
#pragma unroll
    for (int i = 0; i < 8; ++i) ld[i] = *(const f32x4*)(W + (size_t)(k0 + 8 * i + (lane >> 3)) * N + n0 + 4 * (lane & 7));
#pragma unroll
    for (int i = 0; i < 8; ++i) { LAS float* d = scr + (8 * i + (lane >> 3)) * 33 + 4 * (lane & 7); d[0] = ld[i][0]; d[1] = ld[i][1]; d[2] = ld[i][2]; d[3] = ld[i][3]; }
    asm volatile("s_waitcnt lgkmcnt(0)" ::: "memory");
    const int c = lane & 7;
#pragma unroll
    for (int j = 0; j < 4; ++j) { const int n = (lane >> 3) + 8 * j; const LAS float* s = scr + (8 * c) * 33 + n;
        u32x4 o; o.x = pk2(s[0 * 33], s[1 * 33]); o.y = pk2(s[2 * 33], s[3 * 33]); o.z = pk2(s[4 * 33], s[5 * 33]); o.w = pk2(s[6 * 33], s[7 * 33]);
        *(u32x4*)(WT + (size_t)(n0 + n) * K + k0 + 8 * c) = o; }
    asm volatile("s_waitcnt lgkmcnt(0)" ::: "memory");
}


typedef float f32x16 __attribute__((ext_vector_type(16)));
typedef short v4i16_t __attribute__((ext_vector_type(4)));
constexpr int QA_RS = 272, QP_RS = 264, KB_RS = 272, KPP_RS = 320, V_RS = 320;
constexpr int T_QA = 0, T_QP = T_QA + 32 * QA_RS, T_KB = T_QP + 32 * QP_RS, T_KPP = T_KB + 32 * KB_RS, T_V = T_KPP + 32 * KPP_RS, T_EL = T_V + 32 * V_RS, DIR_BYTES = T_EL + 512;
constexpr int OBUF_OFF = 2 * DIR_BYTES, OBUF_BYTES = 256 * 256;
static_assert(OBUF_OFF + OBUF_BYTES <= 160 * 1024 - 512 && (DIR_BYTES % 16) == 0 && (T_QP % 16) == 0 && (T_KB % 16) == 0 && (T_KPP % 16) == 0 && (T_V % 16) == 0 && (T_EL % 16) == 0, "scan LDS map");
constexpr int SLOT_ELEMS = 128 * 128;
#ifndef SCAN_STAGGER
#define SCAN_STAGGER 0
#endif

struct ScanT { const bf16_t* q; const bf16_t* lffw; const bf16_t* lfbw; const bf16_t* v; bf16_t* sg; bf16_t* slots; float* dvec; const float* gnorm; const float* state_in; float* new_state; };

__device__ __forceinline__ bf16x8 tr_pair(const LAS unsigned char* p0, const LAS unsigned char* p1) {
    const v4i16_t lo = __builtin_amdgcn_ds_read_tr16_b64_v4i16((LAS v4i16_t*)p0), hi = __builtin_amdgcn_ds_read_tr16_b64_v4i16((LAS v4i16_t*)p1);
    return (bf16x8){lo[0], lo[1], lo[2], lo[3], hi[0], hi[1], hi[2], hi[3]};
}
__device__ __forceinline__ bf16x8 pack_acc8(const f32x16& x, int s8) {
    u32x4 w; w.x = cvt_pk_bf16(x[8 * s8 + 0], x[8 * s8 + 1]); w.y = cvt_pk_bf16(x[8 * s8 + 2], x[8 * s8 + 3]); w.z = cvt_pk_bf16(x[8 * s8 + 4], x[8 * s8 + 5]); w.w = cvt_pk_bf16(x[8 * s8 + 6], x[8 * s8 + 7]);
    return __builtin_bit_cast(bf16x8, w);
}
__device__ __forceinline__ float h2f(unsigned short b) { return (float)__builtin_bit_cast(_Float16, b); }

template <bool FULL>
__device__ __forceinline__ void scan_item(LAS unsigned char* lds, const ScanT& T, int tok0, int h, bool act0, bool act1, const bf16_t* init0, const bf16_t* init1,
                                          float* fin0, float* fin1, bf16_t* outs0, bf16_t* outs1, float* outd0, float* outd1) {
    const int tid = threadIdx.x, wave = __builtin_amdgcn_readfirstlane(tid >> 6), dir = wave >> 2, wg = wave & 3;
    LAS unsigned char* prof_lds_ = lds; (void)prof_lds_; PROF_DECL; PROF_BEGIN();
    const bool act = dir ? act1 : act0;
    const bf16_t* init = dir ? init1 : init0;
    LAS unsigned char* D = lds + dir * DIR_BYTES;
    LAS unsigned char* OB = lds + OBUF_OFF;
    const bf16_t* lfp = dir ? T.lfbw : T.lffw;
#define SCAN_LANE(x) int x; asm volatile("v_mbcnt_lo_u32_b32 %0, -1, 0\n\tv_mbcnt_hi_u32_b32 %0, -1, %0" : "=v"(x))
#define SCAN_PREP_ROLE SCAN_LANE(ln_); const int pp = 16 * wg + (ln_ & 15), uu = ln_ >> 4, gt_ = wg * 64 + ln_, vt = gt_ >> 3, vc2 = gt_ & 7
#define SCAN_MFMA_ROLE SCAN_LANE(ln_); const int l31 = ln_ & 31, hh = ln_ >> 5, gq = (ln_ & 15) >> 2, gp = ln_ & 3, vcol = 16 * ((ln_ >> 4) & 1)
    f32x16 S[4];
#pragma unroll
    for (int t4 = 0; t4 < 4; ++t4) {
        if (init && act) { SCAN_LANE(lane); const u32x4* sp = (const u32x4*)(init + ((size_t)(wg * 4 + t4) * 64 + lane) * 16); const u32x4 a = sp[0], b = sp[1];
            const unsigned w8[8] = {a.x, a.y, a.z, a.w, b.x, b.y, b.z, b.w};
#pragma unroll
            for (int j = 0; j < 8; ++j) { S[t4][2 * j] = __builtin_bit_cast(float, w8[j] << 16); S[t4][2 * j + 1] = __builtin_bit_cast(float, w8[j] & 0xffff0000u); } }
        else {
#pragma unroll
            for (int j = 0; j < 16; ++j) S[t4][j] = 0.f; }
    }
    float dsum0 = 0.f, dsum1 = 0.f;
    unsigned qreg[8], lfreg[8]; u32x4 vreg[2];
#define SCAN_LOAD(i) do { const int jsc_ = dir ? 7 - (i) : (i); \
        _Pragma("unroll") for (int e = 0; e < 8; ++e) { const int tl = 8 * uu + e; const size_t tk = (size_t)(tok0 + 32 * jsc_ + (dir ? 31 - tl : tl)) * 1024 + h * 128 + 2 * pp; \
            if (FULL) qreg[e] = *(const unsigned*)(T.q + tk); lfreg[e] = *(const unsigned*)(lfp + tk); } \
        { const size_t tk = (size_t)(tok0 + 32 * jsc_ + (dir ? 31 - vt : vt)) * 1024 + h * 128 + 16 * vc2; vreg[0] = *(const u32x4*)(T.v + tk); vreg[1] = *(const u32x4*)(T.v + tk + 8); } } while (0)
    if (act) { SCAN_PREP_ROLE; SCAN_LOAD(0); }
    PROF_END(6);
    for (int s = 0; s < 16 + SCAN_STAGGER; ++s) {
        const int ph = s - (SCAN_STAGGER ? dir : 0);
        if (act && ph >= 0 && ph < 16) {
            const int i = ph >> 1;
            if ((ph & 1) == 0) {
                SCAN_PREP_ROLE; const int lane = ln_;
#if defined(PROF_ID)
                PROF_BEGIN(); asm volatile("s_waitcnt vmcnt(0)" ::: "memory"); PROF_END(1); PROF_BEGIN();
#endif
                *(LAS u32x4*)(D + T_V + vt * V_RS + vc2 * 32) = vreg[0]; *(LAS u32x4*)(D + T_V + vt * V_RS + vc2 * 32 + 16) = vreg[1];
                f32x2 cc[8]; f32x2 aa = (f32x2){0.f, 0.f};
#pragma unroll
                for (int e = 0; e < 8; ++e) { aa += (f32x2){h2f((unsigned short)(lfreg[e] & 0xffffu)), h2f((unsigned short)(lfreg[e] >> 16))}; cc[e] = aa; }
                f32x2 tq[4];
#pragma unroll
                for (int u2 = 0; u2 < 4; ++u2) { tq[u2].x = __shfl(aa.x, (lane & 15) + 16 * u2); tq[u2].y = __shfl(aa.y, (lane & 15) + 16 * u2); }
                const f32x2 zz = (f32x2){0.f, 0.f};
                const f32x2 pre = (uu > 0 ? tq[0] : zz) + (uu > 1 ? tq[1] : zz) + (uu > 2 ? tq[2] : zz);
                const f32x2 rr = tq[0] + tq[1], bl = rr + tq[2] + tq[3];
#define EX2V(v) ((f32x2){__builtin_amdgcn_exp2f((v).x), __builtin_amdgcn_exp2f((v).y)})
                if (FULL) {
                    const f32x2 er = EX2V(rr), elr = EX2V(bl - rr), base = pre - rr;
#pragma unroll
                    for (int e = 0; e < 8; ++e) {
                        const int tl = 8 * uu + e;
                        const f32x2 d = base + cc[e];
                        const f32x2 ea = EX2V(d), eb = EX2V(-d);
                        const f32x2 lfv = (f32x2){h2f((unsigned short)(lfreg[e] & 0xffffu)), h2f((unsigned short)(lfreg[e] >> 16))};
                        const f32x2 kk = 1.f - EX2V(lfv);
                        const f32x2 qq = (f32x2){__builtin_bit_cast(float, qreg[e] << 16), __builtin_bit_cast(float, qreg[e] & 0xffff0000u)};
                        const f32x2 qa = qq * ea, kb = kk * eb, qp = qa * er, kpp = kb * elr;
                        *(LAS unsigned*)(D + T_QA + tl * QA_RS + 4 * pp) = cvt_pk_bf16(qa.x, qa.y);
                        *(LAS unsigned*)(D + T_QP + tl * QP_RS + 4 * pp) = cvt_pk_bf16(qp.x, qp.y);
                        *(LAS unsigned*)(D + T_KB + tl * KB_RS + 4 * pp) = cvt_pk_bf16(kb.x, kb.y);
                        *(LAS unsigned*)(D + T_KPP + tl * KPP_RS + 4 * pp) = cvt_pk_bf16(kpp.x, kpp.y);
                        if (e & 1) __builtin_amdgcn_sched_barrier(0);
                    }
                } else {
                    const f32x2 base = bl - pre;
#pragma unroll
                    for (int e = 0; e < 8; ++e) {
                        const int tl = 8 * uu + e;
                        const f32x2 d = base - cc[e];
                        const f32x2 lfv = (f32x2){h2f((unsigned short)(lfreg[e] & 0xffffu)), h2f((unsigned short)(lfreg[e] >> 16))};
                        const f32x2 kpp = (1.f - EX2V(lfv)) * EX2V(d);
                        *(LAS unsigned*)(D + T_KPP + tl * KPP_RS + 4 * pp) = cvt_pk_bf16(kpp.x, kpp.y);
                    }
                    dsum0 += bl.x; dsum1 += bl.y;
                }
                if (uu == 0) { *(LAS f32x2*)(D + T_EL + 8 * pp) = EX2V(bl); }
                __builtin_amdgcn_sched_barrier(0);
#if defined(PROF_ID)
                asm volatile("s_waitcnt lgkmcnt(0)" ::: "memory"); PROF_END(2);
#endif
                if (i < 7) SCAN_LOAD(i + 1);
            } else {
                SCAN_MFMA_ROLE; PROF_BEGIN();
                if (FULL) {
                    f32x16 P;
#pragma unroll
                    for (int j = 0; j < 16; ++j) P[j] = 0.f;
#pragma unroll
                    for (int ks = 0; ks < 8; ++ks) {
                        const bf16x8 ka = *(const LAS bf16x8*)(D + T_KB + l31 * KB_RS + (16 * ks + 8 * hh) * 2);
                        const bf16x8 qb = *(const LAS bf16x8*)(D + T_QA + l31 * QA_RS + (16 * ks + 8 * hh) * 2);
                        P = __builtin_amdgcn_mfma_f32_32x32x16_bf16(ka, qb, P, 0, 0, 0);
                    }
#pragma unroll
                    for (int j = 0; j < 16; ++j) { const int srow = (j & 3) + 8 * (j >> 2) + 4 * hh; P[j] = (srow <= l31) ? P[j] : 0.f; }
                    f32x16 o;
#pragma unroll
                    for (int j = 0; j < 16; ++j) o[j] = 0.f;
#pragma unroll
                    for (int s8 = 0; s8 < 2; ++s8) {
                        const LAS unsigned char* vb = D + T_V + (16 * s8 + 4 * hh + gq) * V_RS + (32 * wg + vcol + 4 * gp) * 2;
                        const bf16x8 vf = tr_pair(vb, vb + 8 * V_RS);
                        o = __builtin_amdgcn_mfma_f32_32x32x16_bf16(pack_acc8(P, s8), vf, o, 0, 0, 0);
                    }
#pragma unroll
                    for (int t4 = 0; t4 < 4; ++t4)
#pragma unroll
                        for (int s8 = 0; s8 < 2; ++s8) {
                            const LAS unsigned char* qp = D + T_QP + l31 * QP_RS + (32 * t4 + 16 * s8 + 4 * hh) * 2;
                            const u32x2 lo = *(const LAS u32x2*)qp, hi = *(const LAS u32x2*)(qp + 16);
                            const u32x4 aw = {lo.x, lo.y, hi.x, hi.y};
                            o = __builtin_amdgcn_mfma_f32_32x32x16_bf16(__builtin_bit_cast(bf16x8, aw), pack_acc8(S[t4], s8), o, 0, 0, 0);
                        }
                    const int jsc = dir ? 7 - i : i;
                    LAS unsigned short* ob = (LAS unsigned short*)(OB + (32 * jsc + (dir ? 31 - 4 * hh : 4 * hh)) * 256 + (32 * wg + l31) * 2);
                    const int rs = dir ? -128 : 128;
                    if (i >= 4) {
                        unsigned short pv[16];
#pragma unroll
                        for (int j = 0; j < 16; ++j) pv[j] = ob[((j & 3) + 8 * (j >> 2)) * rs];
#pragma unroll
                        for (int j = 0; j < 16; ++j) o[j] += bf2f(pv[j]);
                    }
#pragma unroll
                    for (int j = 0; j < 16; ++j) ob[((j & 3) + 8 * (j >> 2)) * rs] = (unsigned short)cvt_pk_bf16(o[j], o[j]);
                }
                __builtin_amdgcn_sched_barrier(0);
#pragma unroll
                for (int t4 = 0; t4 < 4; ++t4) {
#pragma unroll
                    for (int g = 0; g < 4; ++g) { const f32x4 f = *(const LAS f32x4*)(D + T_EL + (32 * t4 + 8 * g + 4 * hh) * 4);
                        S[t4][4 * g + 0] *= f[0]; S[t4][4 * g + 1] *= f[1]; S[t4][4 * g + 2] *= f[2]; S[t4][4 * g + 3] *= f[3]; }
#pragma unroll
                    for (int s8 = 0; s8 < 2; ++s8) {
                        const LAS unsigned char* kb = D + T_KPP + (16 * s8 + 8 * hh + gq) * KPP_RS + (32 * t4 + vcol + 4 * gp) * 2;
                        const LAS unsigned char* vb = D + T_V + (16 * s8 + 8 * hh + gq) * V_RS + (32 * wg + vcol + 4 * gp) * 2;
                        const bf16x8 ka = tr_pair(kb, kb + 4 * KPP_RS), vf = tr_pair(vb, vb + 4 * V_RS);
                        S[t4] = __builtin_amdgcn_mfma_f32_32x32x16_bf16(ka, vf, S[t4], 0, 0, 0);
                    }
                    if (t4 == 1) __builtin_amdgcn_sched_barrier(0);
                }
                PROF_END(3);
            }
        }
        PROF_BEGIN();
        __syncthreads();
        PROF_END(4);
    }
#undef SCAN_LOAD
    SCAN_MFMA_ROLE; SCAN_LANE(lane); PROF_BEGIN();
    if (FULL) {
        float* fin = dir ? fin1 : fin0;
        if (fin && act) {
#pragma unroll
            for (int t4 = 0; t4 < 4; ++t4)
#pragma unroll
                for (int j = 0; j < 16; ++j) fin[(size_t)(32 * t4 + (j & 3) + 8 * (j >> 2) + 4 * hh) * 128 + 32 * wg + l31] = S[t4][j];
        }
        const int cv = tid & 15;
        f32x4 gn0 = *(const f32x4*)(T.gnorm + 8 * cv), gn1 = *(const f32x4*)(T.gnorm + 8 * cv + 4);
        u32x4 gwv[8];
#pragma unroll
        for (int pass = 0; pass < 8; ++pass) gwv[pass] = *(const u32x4*)(T.sg + (size_t)(tok0 + 32 * pass + (tid >> 4)) * 1024 + h * 128 + 8 * cv);
#pragma unroll
        for (int pass = 0; pass < 8; ++pass) {
            const int row = 32 * pass + (tid >> 4);
            const u32x4 ow = *(const LAS u32x4*)(OB + row * 256 + cv * 16);
            bf16_t* gp_ = T.sg + (size_t)(tok0 + row) * 1024 + h * 128 + 8 * cv;
            const u32x4 gw = gwv[pass];
            float ov[8], gv[8];
            const unsigned o4[4] = {ow.x, ow.y, ow.z, ow.w}, g4[4] = {gw.x, gw.y, gw.z, gw.w};
            float ss = 0.f;
#pragma unroll
            for (int j = 0; j < 4; ++j) { ov[2 * j] = __builtin_bit_cast(float, o4[j] << 16); ov[2 * j + 1] = __builtin_bit_cast(float, o4[j] & 0xffff0000u);
                gv[2 * j] = __builtin_bit_cast(float, g4[j] << 16); gv[2 * j + 1] = __builtin_bit_cast(float, g4[j] & 0xffff0000u);
                ss += ov[2 * j] * ov[2 * j] + ov[2 * j + 1] * ov[2 * j + 1]; }
            ss += __shfl_xor(ss, 1); ss += __shfl_xor(ss, 2); ss += __shfl_xor(ss, 4); ss += __shfl_xor(ss, 8);
            const float rstd = rsqrtf(ss * (1.f / 128.f) + 1e-6f);
            u32x4 w;
            w.x = cvt_pk_bf16(ov[0] * rstd * gn0[0] * gv[0], ov[1] * rstd * gn0[1] * gv[1]); w.y = cvt_pk_bf16(ov[2] * rstd * gn0[2] * gv[2], ov[3] * rstd * gn0[3] * gv[3]);
            w.z = cvt_pk_bf16(ov[4] * rstd * gn1[0] * gv[4], ov[5] * rstd * gn1[1] * gv[5]); w.w = cvt_pk_bf16(ov[6] * rstd * gn1[2] * gv[6], ov[7] * rstd * gn1[3] * gv[7]);
            *(u32x4*)gp_ = w;
        }
#if defined(PROF_ID)
        asm volatile("s_waitcnt vmcnt(0)" ::: "memory");
#endif
        __syncthreads(); PROF_END(5);
    } else {
        bf16_t* outs = dir ? outs1 : outs0; float* outd = dir ? outd1 : outd0;
        if (act) {
#pragma unroll
            for (int t4 = 0; t4 < 4; ++t4) {
                u32x4 a, b;
                a.x = cvt_pk_bf16(S[t4][0], S[t4][1]); a.y = cvt_pk_bf16(S[t4][2], S[t4][3]); a.z = cvt_pk_bf16(S[t4][4], S[t4][5]); a.w = cvt_pk_bf16(S[t4][6], S[t4][7]);
                b.x = cvt_pk_bf16(S[t4][8], S[t4][9]); b.y = cvt_pk_bf16(S[t4][10], S[t4][11]); b.z = cvt_pk_bf16(S[t4][12], S[t4][13]); b.w = cvt_pk_bf16(S[t4][14], S[t4][15]);
                u32x4* sp = (u32x4*)(outs + ((size_t)(wg * 4 + t4) * 64 + lane) * 16); sp[0] = a; sp[1] = b;
            }
            const int pp = 16 * wg + (lane & 15); if ((lane >> 4) == 0) { outd[2 * pp] = __builtin_amdgcn_exp2f(dsum0); outd[2 * pp + 1] = __builtin_amdgcn_exp2f(dsum1); }
        }
    }
}
__device__ __forceinline__ size_t slot_of(int dir, int b, int h, int sc) { return (size_t)((dir * 4 + b) * 8 + h) * 16 + sc; }

__device__ __forceinline__ void scan_phase_a(LAS unsigned char* lds, const ScanT& T, int G, int bx) {
    for (int it = bx; it < 512; it += G) {
        const int sc = it & 15, h = (it >> 4) & 7, b = it >> 7;
        const size_t sf = slot_of(0, b, h, sc < 15 ? sc + 1 : 0), sb = slot_of(1, b, h, sc > 0 ? sc - 1 : 0);
        scan_item<false>(lds, T, 4096 + b * 4096 + sc * 256, h, sc < 15, sc > 0, nullptr, nullptr, nullptr, nullptr, T.slots + sf * SLOT_ELEMS, T.slots + sb * SLOT_ELEMS, T.dvec + sf * 128, T.dvec + sb * 128);
    }
}
__device__ __forceinline__ void scan_phase_b(const ScanT& T, int G, int bx, int tid) {
    for (int gid = bx * NTHREADS + tid; gid < 64 * 2048; gid += G * NTHREADS) {
        const int combo = gid >> 11, e = (gid & 2047) * 8, dir = combo >> 5, b = (combo >> 3) & 3, h = combo & 7;
        const int reg0 = e & 15, ln = (e >> 4) & 63, t4 = (e >> 10) & 3, w = (e >> 12) & 3;
        const int v = 32 * w + (ln & 31);
        float s[8]; int kk[8];
#pragma unroll
        for (int j = 0; j < 8; ++j) { const int rg = reg0 + j; kk[j] = 32 * t4 + (rg & 3) + 8 * (rg >> 2) + 4 * (ln >> 5); s[j] = T.state_in[((size_t)((b * 2 + dir) * 8 + h) * 128 + kk[j]) * 128 + v]; }
        for (int st = 0; st < 16; ++st) {
            const int sc = dir ? 15 - st : st;
            const size_t sl = slot_of(dir, b, h, sc);
            u32x4* sp = (u32x4*)(T.slots + sl * SLOT_ELEMS + e);
            if (st > 0) {
                const u32x4 lw = *sp; const unsigned l4[4] = {lw.x, lw.y, lw.z, lw.w};
#pragma unroll
                for (int j = 0; j < 4; ++j) { s[2 * j] = T.dvec[sl * 128 + kk[2 * j]] * s[2 * j] + __builtin_bit_cast(float, l4[j] << 16);
                    s[2 * j + 1] = T.dvec[sl * 128 + kk[2 * j + 1]] * s[2 * j + 1] + __builtin_bit_cast(float, l4[j] & 0xffff0000u); }
            }
            u32x4 o; o.x = cvt_pk_bf16(s[0], s[1]); o.y = cvt_pk_bf16(s[2], s[3]); o.z = cvt_pk_bf16(s[4], s[5]); o.w = cvt_pk_bf16(s[6], s[7]);
            *sp = o;
        }
    }
}
__device__ __forceinline__ void scan_phase_c(LAS unsigned char* lds, const ScanT& T, int G, int bx) {
    for (int it = bx; it < 640; it += G) {
        if (it < 512) {
            const int sc = it & 15, h = (it >> 4) & 7, b = it >> 7;
            scan_item<true>(lds, T, 4096 + b * 4096 + sc * 256, h, true, true, T.slots + slot_of(0, b, h, sc) * SLOT_ELEMS, T.slots + slot_of(1, b, h, sc) * SLOT_ELEMS,
                            nullptr, nullptr, nullptr, nullptr, nullptr, nullptr);
        } else {
            const int h = (it - 512) & 7, b = (it - 512) >> 3;
            float* ns = T.new_state + (size_t)(b * 2) * 8 * 16384 + (size_t)h * 16384;
            scan_item<true>(lds, T, b * 256, h, true, true, nullptr, nullptr, ns, ns + (size_t)8 * 16384, nullptr, nullptr, nullptr, nullptr);
        }
    }
}


#define XB_TMO      128
#define XB_XCNT(j)  (256  + 64 * (j))
#define XB_XSUB(j)  (1280 + 64 * (j))
#define XB_XGEN(j)  (2304 + 64 * (j))
#define XB_TOP      3328
#define XB_TOPGEN   3392
#define XCD_BAR_WORDS 3456
#define XB_SPIN_CAP (1u << 18)
__device__ __forceinline__ unsigned xb_ld(unsigned* p)              { return __hip_atomic_load(p, __ATOMIC_RELAXED, __HIP_MEMORY_SCOPE_AGENT); }
__device__ __forceinline__ unsigned xb_add(unsigned* p, unsigned v) { return __hip_atomic_fetch_add(p, v, __ATOMIC_RELAXED, __HIP_MEMORY_SCOPE_AGENT); }
__device__ __forceinline__ unsigned xb_xcc_id() { return (unsigned)__builtin_amdgcn_s_getreg((3 << 11) | 20) & 0xFu; }
#define XB_SPIN(cond, bar) do { unsigned _sp = 0; while (cond) { __builtin_amdgcn_s_sleep(1); \
    if ((++_sp & 255u) == 0u) { if (xb_ld(&(bar)[XB_TMO])) break; if (_sp > XB_SPIN_CAP) { atomicAdd(&(bar)[XB_TMO], 1u); break; } } } } while (0)
struct XcdBarrier { unsigned* bar; unsigned x; volatile LAS unsigned* st; };
__device__ __forceinline__ XcdBarrier xcd_barrier_post(unsigned* bar, volatile LAS unsigned* st) {
    XcdBarrier b; b.bar = bar; b.x = xb_xcc_id(); b.st = st;
    if (threadIdx.x == 0) (void)xb_add(&bar[XB_XCNT(b.x)], 1u);
    return b;
}
__device__ __forceinline__ void xcd_barrier_complete(unsigned* bar, unsigned x, unsigned& nloc, unsigned& nx) {
    const unsigned G = gridDim.x * gridDim.y * gridDim.z;
    unsigned sum, cnt, mine, sp = 0u;
    for (;;) {
        sum = 0u; cnt = 0u; mine = 0u;
#pragma unroll
        for (unsigned j = 0; j < 16; ++j) { const unsigned c = xb_ld(&bar[XB_XCNT(j)]); sum += c; cnt += (c > 0u) ? 1u : 0u; mine = (j == x) ? c : mine; }
        if (sum == G) break;
        __builtin_amdgcn_s_sleep(1);
        if ((++sp & 255u) == 0u) { if (xb_ld(&bar[XB_TMO])) break; if (sp > XB_SPIN_CAP) { atomicAdd(&bar[XB_TMO], 1u); break; } }
    }
    nloc = mine > 0u ? mine : 1u; nx = cnt > 0u ? cnt : 1u;
}
__device__ __forceinline__ void xcd_barrier(const XcdBarrier& b) {
    asm volatile("s_waitcnt vmcnt(0)" ::: "memory");
    __syncthreads();
    if (threadIdx.x == 0) {
        unsigned* bar = b.bar;
        __builtin_amdgcn_s_waitcnt(0);
        unsigned nloc = b.st[0], nx = b.st[1];
        if (nloc == 0u) { xcd_barrier_complete(bar, b.x, nloc, nx); b.st[0] = nloc; b.st[1] = nx; }
        const unsigned old = xb_add(&bar[XB_XSUB(b.x)], 1u);
        const unsigned gen = old / nloc;
        if (old + 1u == (gen + 1u) * nloc) {
            __builtin_amdgcn_fence(__ATOMIC_RELEASE, "agent");
            asm volatile("s_waitcnt vmcnt(0)" ::: "memory");
            const unsigned og = xb_add(&bar[XB_TOP], 1u);
            const unsigned tg = og / nx;
            if (og + 1u == (tg + 1u) * nx) xb_add(&bar[XB_TOPGEN], 1u);
            else XB_SPIN(xb_ld(&bar[XB_TOPGEN]) == tg, bar);
            __builtin_amdgcn_fence(__ATOMIC_ACQUIRE, "agent");
            xb_add(&bar[XB_XGEN(b.x)], 1u);
            asm volatile("s_waitcnt vmcnt(0)" ::: "memory");
        } else {
            XB_SPIN(xb_ld(&bar[XB_XGEN(b.x)]) == gen, bar);
            __builtin_amdgcn_fence(__ATOMIC_ACQUIRE, "agent");
            asm volatile("s_waitcnt vmcnt(0)" ::: "memory");
        }
    }
    __syncthreads();
}

struct Args { const float* in[17]; float* out; unsigned char* ws; int ph_lo, ph_hi; };
enum { PH_PREP = 0, PH_EMBED = 1, PH_FN_CHAN = 2, PH_FN_POS1 = 3, PH_FN_POS2 = 4, PH_FN_WO = 5, PH_NORM_MLP0 = 6, PH_MLP1_0 = 7, PH_MLP2_0 = 8, PH_NORM_MIX1 = 9, PH_WIN = 10,
       PH_SCAN_A = 11, PH_SCAN_B = 12, PH_SCAN_C = 13, PH_HG_WO = 14, PH_NORM_MLP1 = 15, PH_MLP1_1 = 16, PH_MLP2_1 = 17, PH_FINAL = 18, PH_END = 19 };
constexpr int LDS_BYTES = 160 * 1024, MISC_OFF = LDS_BYTES - 512;

__global__ void __launch_bounds__(NTHREADS, 2) fwd(Args a) {
    extern __shared__ __attribute__((aligned(16))) unsigned char lds_raw[];
    LAS unsigned char* lds = (LAS unsigned char*)lds_raw;
    const int tid = threadIdx.x, lane = tid & 63, wave = __builtin_amdgcn_readfirstlane(tid >> 6);
    const int G = gridDim.x, bx = blockIdx.x;
    const int gw = bx * NWAVES + wave, ngw = G * NWAVES;
    unsigned char* ws = a.ws;
    const float* mod = (const float*)(ws + WM.mod);
    bf16_t* Hb = (bf16_t*)(ws + WM.h);
    bf16_t* Big = (bf16_t*)(ws + WM.big[0]); bf16_t* Big1 = (bf16_t*)(ws + WM.big[1]);
    const float* norm_mlp = a.in[8];
    const float* w1 = a.in[14]; const float* w2 = a.in[15];
    const float* norm_mix = a.in[7]; const float* fnet_wo = a.in[9];
    float* modw = (float*)(ws + WM.mod);
#define IN(k) (a.ph_lo <= (k) && (k) < a.ph_hi)
    if (tid < 128) ((LAS unsigned*)(lds + MISC_OFF))[tid] = 0u;
    __syncthreads();
    XcdBarrier bar = xcd_barrier_post((unsigned*)ws, (volatile LAS unsigned*)(lds + MISC_OFF));
#if defined(PROBE_A)
#define STAMP(k) do { if (bx == 0 && tid == 0) ((LAS unsigned long long*)(lds + MISC_OFF + 64))[(k)] = __builtin_amdgcn_s_memrealtime(); } while (0)
#else
#define STAMP(k) do { } while (0)
#endif
    STAMP(0);
#define SEAM(k) do { if (IN(k) && IN((k) + 1)) xcd_barrier(bar); STAMP((k) + 1); } while (0)
    if (IN(PH_PREP)) {
        LAS float* scr = (LAS float*)(lds + wave * 16384);
        constexpr int I_1 = (1024 / 64) * (4096 / 32), I_2 = (4096 / 64) * (1024 / 32);
        constexpr int I_F = (1024 / 64) * (1024 / 32), I_W = (1024 / 64) * (5120 / 32);
        constexpr int NITEMS = I_1 + I_2 + I_F + I_F + I_W;
        for (int un = bx; un < 384; un += G) mod_unit(lds, un, a.in[3], a.in[4], a.in[5], a.in[6], modw, tid, wave, lane);
        if (bx == G - 1) for (int i = tid; i < 2048; i += NTHREADS) { const int dir = i >> 10, ch = i & 1023; const float l0 = a.in[11][(dir * 2 + 0) * 1024 + ch], l1 = a.in[11][(dir * 2 + 1) * 1024 + ch];
            const float mx = fmaxf(l0, l1), e0 = __expf(l0 - mx), e1 = __expf(l1 - mx); ((float*)(ws + WM.lb))[i] = e1 / (e0 + e1); }
        gen_tables(ws, (long)bx * NTHREADS + tid, (long)G * NTHREADS);
        for (int it = gw; it < NITEMS; it += ngw) {
            int r = it;
            if (r < I_F) { transpose_item(fnet_wo, 1024, 1024, (bf16_t*)(ws + WM.wfnet), scr, r, lane); continue; } r -= I_F;
            if (r < I_F) { transpose_item(a.in[13], 1024, 1024, (bf16_t*)(ws + WM.who), scr, r, lane); continue; } r -= I_F;
            if (r < I_W) { transpose_item(a.in[10], 1024, 5120, (bf16_t*)(ws + WM.win), scr, r, lane); continue; } r -= I_W;
            if (r < I_1) { transpose_item(w1, 1024, 4096, (bf16_t*)(ws + WM.w1[0]), scr, r, lane); continue; } r -= I_1;
            transpose_item(w2, 4096, 1024, (bf16_t*)(ws + WM.w2[0]), scr, r, lane);
        }
    }
    SEAM(PH_PREP);
    if (IN(PH_EMBED)) embed_rows(a.in[0], a.in[1], (const float*)(ws + WM.pos), (const float*)(ws + WM.pos) + 64 * 512, norm_mix, mod, Hb, gw, ngw, lane);
    SEAM(PH_EMBED);
    if (IN(PH_FN_CHAN)) {
        { ProbChan p; p.init(0, ws + WM.dftc, Hb, (bf16_t*)(ws + WM.yctx), G, bx); gemm_phase<ProbChan, true, true>(lds, p); }
        { ProbChan p; p.init(1, ws + WM.dftc, Hb, (bf16_t*)(ws + WM.ysmp), G, bx); gemm_phase<ProbChan, true, true>(lds, p); }
    }
    SEAM(PH_FN_CHAN);
    if (IN(PH_FN_POS1)) {
        { ProbPosCtx p; p.init(ws + WM.dl256, (const bf16_t*)(ws + WM.yctx), Hb, G, bx); gemm_phase<ProbPosCtx, true, true>(lds, p); }
        { ProbSmpA p; p.init(ws + WM.fa2, (const bf16_t*)(ws + WM.ysmp), (bf16_t*)(ws + WM.u), G, bx); gemm_phase<ProbSmpA, true, true>(lds, p); }
    }
    SEAM(PH_FN_POS1);
    if (IN(PH_FN_POS2)) { ProbSmpB p; p.init(ws + WM.mb, (const bf16_t*)(ws + WM.u), Hb, G, bx); gemm_phase<ProbSmpB, true, true>(lds, p); }
    SEAM(PH_FN_POS2);
    if (IN(PH_FN_WO)) { ProbResidFirst p; p.init_tok(Hb, 1024, ws + WM.wfnet, 1024, 0, 80, 4, G, bx); p.X = (bf16_t*)a.out; p.mod = mod; p.layer = 0; p.gidx = 2; p.init_split(G, bx, (unsigned short*)(ws + SLAB_FN)); p.xp = a.in[0]; p.xs = a.in[1]; p.er = (const float*)(ws + WM.pos); p.ec = p.er + 64 * 512; gemm_phase<ProbResidFirst, true, true>(lds, p); }
    SEAM(PH_FN_WO);
    if (IN(PH_NORM_MLP0)) { build_split_table(lds, G, tid); norm_rows((bf16_t*)a.out, 0, 20480, norm_mlp, mod, 0, 3, Hb, gw, ngw, lane, lds, (const unsigned short*)(ws + SLAB_FN)); }
    SEAM(PH_NORM_MLP0);
    if (IN(PH_MLP1_0)) { ProbMlp1 p; p.init_tok(Hb, 1024, ws + WM.w1[0], 1024, 0, 80, 4096 / BM, G, bx); p.O = Big; p.ldc = 4096; gemm_phase<ProbMlp1, true, true>(lds, p); }
    SEAM(PH_MLP1_0);
    if (IN(PH_MLP2_0)) { ProbResid p; p.init_tok(Big, 4096, ws + WM.w2[0], 4096, 0, 80, 1024 / BM, G, bx); p.X = (bf16_t*)a.out; p.mod = mod; p.layer = 0; p.gidx = 5; p.init_split(G, bx, (unsigned short*)(ws + SLAB_M0)); gemm_phase<ProbResid, true, true>(lds, p); }
    SEAM(PH_MLP2_0);
    if (IN(PH_NORM_MIX1)) { build_split_table(lds, G, tid); norm_rows((bf16_t*)a.out, 0, 20480, norm_mix + 1024, mod, 1, 0, Hb, gw, ngw, lane, lds, (const unsigned short*)(ws + SLAB_M0)); }
    SEAM(PH_NORM_MIX1);
    if (IN(PH_WIN)) { ProbWin p; p.init_tok(Hb, 1024, ws + WM.win, 1024, 0, 80, 20, G, bx); p.Oq = (bf16_t*)(ws + WM.q); p.Offw = (bf16_t*)(ws + WM.lffw); p.Ofbw = (bf16_t*)(ws + WM.lfbw);
        p.Ov = (bf16_t*)(ws + WM.v); p.Osg = (bf16_t*)(ws + WM.sg); p.lb = (const float*)(ws + WM.lb); gemm_phase<ProbWin, true, true>(lds, p); }
    SEAM(PH_WIN);
    if (IN(PH_SCAN_A) || IN(PH_SCAN_B) || IN(PH_SCAN_C)) {
        ScanT st; st.q = (const bf16_t*)(ws + WM.q); st.lffw = (const bf16_t*)(ws + WM.lffw); st.lfbw = (const bf16_t*)(ws + WM.lfbw); st.v = (const bf16_t*)(ws + WM.v); st.sg = (bf16_t*)(ws + WM.sg);
        st.slots = (bf16_t*)(ws + WM.slots); st.dvec = (float*)(ws + WM.dvec); st.gnorm = a.in[12]; st.state_in = a.in[2]; st.new_state = a.out + (size_t)20480 * 1024;
        if (IN(PH_SCAN_A)) scan_phase_a(lds, st, G, bx);
        SEAM(PH_SCAN_A);
        if (IN(PH_SCAN_B)) scan_phase_b(st, G, bx, tid);
        SEAM(PH_SCAN_B);
        if (IN(PH_SCAN_C)) scan_phase_c(lds, st, G, bx);
    }
    SEAM(PH_SCAN_C);
    if (IN(PH_HG_WO)) {
        { LAS float* scr = (LAS float*)(lds + wave * 16384);
          constexpr int I_1 = (1024 / 64) * (4096 / 32), I_2 = (4096 / 64) * (1024 / 32);
          for (int it = gw; it < I_1 + I_2; it += ngw) {
              if (it < I_1) transpose_item(w1 + (size_t)1024 * 4096, 1024, 4096, (bf16_t*)(ws + WM.w1[1]), scr, it, lane);
              else transpose_item(w2 + (size_t)4096 * 1024, 4096, 1024, (bf16_t*)(ws + WM.w2[1]), scr, it - I_1, lane);
          }
          __syncthreads(); }
        ProbResid p; p.init_tok((bf16_t*)(ws + WM.sg), 1024, ws + WM.who, 1024, 0, 80, 4, G, bx); p.X = (bf16_t*)a.out; p.mod = mod; p.layer = 1; p.gidx = 2; p.init_split(G, bx, (unsigned short*)(ws + SLAB_HG)); gemm_phase<ProbResid, true, true>(lds, p); }
    SEAM(PH_HG_WO);
    if (IN(PH_NORM_MLP1)) { build_split_table(lds, G, tid); norm_rows((bf16_t*)a.out, 0, 20480, norm_mlp + 1024, mod, 1, 3, Hb, gw, ngw, lane, lds, (const unsigned short*)(ws + SLAB_HG)); }
    SEAM(PH_NORM_MLP1);
    if (IN(PH_MLP1_1)) { ProbMlp1 p; p.init_tok(Hb, 1024, ws + WM.w1[1], 1024, 0, 80, 4096 / BM, G, bx); p.O = Big1; p.ldc = 4096; gemm_phase<ProbMlp1, true, true>(lds, p); }
    SEAM(PH_MLP1_1);
    if (IN(PH_MLP2_1)) { ProbResid p; p.init_tok(Big1, 4096, ws + WM.w2[1], 4096, 0, 80, 1024 / BM, G, bx); p.X = (bf16_t*)a.out; p.mod = mod; p.layer = 1; p.gidx = 5; p.init_split(G, bx, (unsigned short*)(ws + SLAB_M1)); gemm_phase<ProbResid, true, true>(lds, p); }
    SEAM(PH_MLP2_1);
    if (IN(PH_FINAL)) { build_split_table(lds, G, tid); final_rows(a.out, 0, 20480, a.in[16], gw, ngw, lane, lds, (const unsigned short*)(ws + SLAB_M1)); }
#if defined(PROF_ID)
    if (bx == 0 && tid == 0) { const unsigned long long d = *(LAS unsigned long long*)(lds + LDS_BYTES - 512 + 256); const unsigned long long t0 = __builtin_amdgcn_s_memrealtime(); while (__builtin_amdgcn_s_memrealtime() - t0 < 16ull * d) __builtin_amdgcn_s_sleep(8); }
#endif
#if defined(PROBE_A)
    if (bx == 0 && tid == 0) { asm volatile("s_waitcnt vmcnt(0)" ::: "memory"); STAMP(PH_END); const unsigned long long d = ((LAS unsigned long long*)(lds + MISC_OFF + 64))[PROBE_B] - ((LAS unsigned long long*)(lds + MISC_OFF + 64))[PROBE_A];
        const unsigned long long t0 = __builtin_amdgcn_s_memrealtime(); while (__builtin_amdgcn_s_memrealtime() - t0 < 4ull * d) __builtin_amdgcn_s_sleep(8); }
#endif
#undef IN
}
}
#ifndef MK_N_LAUNCHES
#define MK_N_LAUNCHES 1
#endif
extern "C" void kernel_launch(void* const* d_in, const int* in_sizes, int n_in, void* d_out, int out_size, void* d_ws, size_t ws_size, hipStream_t stream) {
    static int grid = 0;
    if (grid == 0) {
        int dev = 0, cus = 0;
        if (hipGetDevice(&dev) != hipSuccess || hipDeviceGetAttribute(&cus, hipDeviceAttributeMultiprocessorCount, dev) != hipSuccess || cus <= 0) cus = 256;
        hipFuncSetAttribute((const void*)fk::fwd, hipFuncAttributeMaxDynamicSharedMemorySize, fk::LDS_BYTES);
        int per_cu = 0;
        if (hipOccupancyMaxActiveBlocksPerMultiprocessor(&per_cu, (const void*)fk::fwd, fk::NTHREADS, fk::LDS_BYTES) != hipSuccess || per_cu < 1)
            fprintf(stderr, "kernel_launch: occupancy query reports %d workgroups per CU\n", per_cu);
        (void)hipGetLastError();
        grid = cus;
    }
    hipMemsetAsync(d_ws, 0, fk::CTL_BYTES, stream);
    fk::Args a{};
    for (int i = 0; i < 17; ++i) a.in[i] = (const float*)d_in[i];
    a.out = (float*)d_out; a.ws = (unsigned char*)d_ws;
#if MK_N_LAUNCHES == 1
    a.ph_lo = 0; a.ph_hi = fk::PH_END;
    hipLaunchKernelGGL(fk::fwd, dim3(grid), dim3(fk::NTHREADS), fk::LDS_BYTES, stream, a);
#else
    for (int ph = 0; ph < fk::PH_END; ++ph) { a.ph_lo = ph; a.ph_hi = ph + 1; hipLaunchKernelGGL(fk::fwd, dim3(grid), dim3(fk::NTHREADS), fk::LDS_BYTES, stream, a); }
#endif
}
```

```cpp
#include <hip/hip_runtime.h>
#include <cstdint>
#include <cstdio>
namespace fk {
#define LAS __attribute__((address_space(3)))
#define GAS __attribute__((address_space(1)))
typedef unsigned short bf16_t;
typedef short bf16x8 __attribute__((ext_vector_type(8)));
typedef float f32x4 __attribute__((ext_vector_type(4)));
typedef float f32x2 __attribute__((ext_vector_type(2)));
typedef unsigned u32x4 __attribute__((ext_vector_type(4)));
typedef unsigned u32x2 __attribute__((ext_vector_type(2)));
constexpr int BM = 256, BK = 64, HALF = 128, HTB = HALF * BK * 2, STAGE_BYTES = 8 * HTB, NXCD = 8, WGM = 8;
constexpr int NWAVES = 8, NTHREADS = 512;

__device__ __forceinline__ int lds_byte(int r, int c) { const int st = (r >> 4) * 2 + (c >> 5), rr = r & 15, cc = c & 31, ob = rr * 64 + cc * 2; return st * 1024 + (ob ^ (((ob >> 9) & 1) << 5)); }
__device__ __forceinline__ void stage_rc(int b, int& R, int& C) { const int st = b / 1024, sb = b % 1024, swz = sb ^ (((sb >> 9) & 1) << 5); R = (st >> 1) * 16 + swz / 64; C = (st & 1) * 32 + (swz % 64) / 2; }
__device__ __forceinline__ int perm32(int rho) { const int n = rho >> 4, i = rho & 15; return 8 * (i >> 2) + 4 * n + (i & 3); }
__device__ __forceinline__ unsigned cvt_pk_bf16(float lo, float hi) { unsigned r; asm volatile("v_cvt_pk_bf16_f32 %0, %1, %2" : "=v"(r) : "v"(lo), "v"(hi)); return r; }
__device__ __forceinline__ unsigned f2bf(float f) { unsigned u = __builtin_bit_cast(unsigned, f); return (u + 0x7fffu + ((u >> 16) & 1u)) >> 16; }
__device__ __forceinline__ unsigned pk2(float lo, float hi) { return f2bf(lo) | (f2bf(hi) << 16); }
__device__ __forceinline__ float bf2f(unsigned short b) { return __builtin_bit_cast(float, (unsigned)b << 16); }
__device__ __forceinline__ unsigned pk2h(float lo, float hi) { const _Float16 a = (_Float16)lo, b = (_Float16)hi; return (unsigned)__builtin_bit_cast(unsigned short, a) | ((unsigned)__builtin_bit_cast(unsigned short, b) << 16); }
__device__ __forceinline__ float h2f_(unsigned short b) { return (float)__builtin_bit_cast(_Float16, b); }
__device__ __forceinline__ f32x4 ld_bf4(const void* p) { const u32x2 w = *(const u32x2*)p; return (f32x4){__builtin_bit_cast(float, w.x << 16), __builtin_bit_cast(float, w.x & 0xffff0000u), __builtin_bit_cast(float, w.y << 16), __builtin_bit_cast(float, w.y & 0xffff0000u)}; }
__device__ __forceinline__ void st_bf4(void* p, const f32x4& v) { u32x2 w; w.x = cvt_pk_bf16(v[0], v[1]); w.y = cvt_pk_bf16(v[2], v[3]); *(u32x2*)p = w; }
__device__ __forceinline__ float silu(float x) { return x / (1.f + __expf(-x)); }
__device__ __forceinline__ float wave_sum(float v) {
#pragma unroll
    for (int o = 1; o < 64; o <<= 1) v += __shfl_xor(v, o);
    return v;
}

constexpr unsigned long long KiB = 1024ull, MiB = 1ull << 20;
struct WsMapT { unsigned long long slots, dvec, lb, q, lffw, lfbw, v, sg, mod, pos, dftc, dl256, fa2, mb, wfnet, who, win, w1[2], w2[2], h, yctx, ysmp, u, big[2]; };
constexpr WsMapT WM = {   13 * MiB,   45 * MiB,   320 * KiB,   53 * MiB,   93 * MiB,   133 * MiB,   173 * MiB,   213 * MiB,   64 * KiB,   512 * KiB,
      53 * MiB,   53 * MiB + 256 * KiB,   53 * MiB + 512 * KiB,   54 * MiB,   59 * MiB,   1 * MiB,   3 * MiB,   {61 * MiB, 53 * MiB},   {237 * MiB, 61 * MiB},
      13 * MiB,   77 * MiB,   93 * MiB,   157 * MiB,   {77 * MiB, 69 * MiB} };
constexpr unsigned long long SLAB_FN = 77 * MiB, SLAB_M0 = 53 * MiB, SLAB_HG = 69 * MiB, SLAB_M1 = 13 * MiB;
constexpr unsigned long long CTL_BYTES = 16 * KiB;
#if defined(PROF_ID)
#define PROF_DECL unsigned long long prof_t0_ = 0ull; const bool prof_on_ = (blockIdx.x == 0) && (__builtin_amdgcn_readfirstlane(threadIdx.x >> 6) == 0)
#define PROF_BEGIN() do { if (prof_on_) prof_t0_ = __builtin_amdgcn_s_memrealtime(); } while (0)
#define PROF_END(id) do { if (prof_on_ && (id) == PROF_ID) { const unsigned long long d_ = __builtin_amdgcn_s_memrealtime() - prof_t0_; if (threadIdx.x == 0) *(LAS unsigned long long*)(prof_lds_ + 160 * 1024 - 512 + 256) += d_; } } while (0)
#else
#define PROF_DECL
#define PROF_BEGIN() do { } while (0)
#define PROF_END(id) do { } while (0)
#endif

struct Unit { size_t offA, offB; int p0, p1, p2, p3, nt; };
struct OpMap { int rm; unsigned s1, s2; };
__device__ __forceinline__ unsigned rowoff(const OpMap& m, int R) { return (unsigned)(R % m.rm) * m.s1 + (unsigned)(R / m.rm) * m.s2; }

template <class P, bool ALIGN_EPI, bool SP2>
__device__ __forceinline__ void gemm_phase(LAS unsigned char* lds, const P& pb) {
    const int tid = threadIdx.x, wid = __builtin_amdgcn_readfirstlane(tid >> 6), lane = tid & 63, wr = wid >> 2, wc = wid & 3, fr = lane & 15, fq = lane >> 4;
    unsigned voffA[2], voffB[2];
#pragma unroll
    for (int i = 0; i < 2; ++i) { int R, C; stage_rc(tid * 16 + i * 8192, R, C); const int Rb = P::PERM ? ((R & ~31) + perm32(R & 31)) : R;
        voffA[i] = rowoff(pb.ma, R) + (unsigned)C * 2u; voffB[i] = rowoff(pb.mb, Rb) + (unsigned)C * 2u; }
    const size_t kstepA = pb.kstepA, kstepB = pb.kstepB, hstepA = pb.hstepA, hstepB = pb.hstepB;
    const unsigned ldsw = (unsigned)wid * 1024u;
    const int aoff = lds_byte(wr * 64 + fr, fq * 8), boff = lds_byte(wc * 32 + fr, fq * 8);
#define PG8_SA(b, h) (((b) * 2 + (h)) * HTB)
#define PG8_SB(b, h) ((4 + (b) * 2 + (h)) * HTB)
#define PG8_STAGE(bufoff, gbase, voff) do { _Pragma("unroll") for (int _i = 0; _i < 2; ++_i) \
        __builtin_amdgcn_global_load_lds((const unsigned*)((const char*)(gbase) + (voff)[_i]), (LAS unsigned*)(lds + (bufoff) + ldsw + _i * 8192), 16, 0, 0); } while (0)
#define PG8_LDA(dst, b, h) do { _Pragma("unroll") for (int m = 0; m < 4; ++m) _Pragma("unroll") for (int k = 0; k < 2; ++k) dst[m][k] = *(const LAS bf16x8*)(lds + PG8_SA(b, h) + aoff + m * 2048 + k * 1024); } while (0)
#define PG8_LDB(dst, b, h) do { _Pragma("unroll") for (int n = 0; n < 2; ++n) _Pragma("unroll") for (int k = 0; k < 2; ++k) dst[n][k] = *(const LAS bf16x8*)(lds + PG8_SB(b, h) + boff + n * 2048 + k * 1024); } while (0)
#define PG8_MMA(ai, bj, At, Bt) do { __builtin_amdgcn_s_setprio(1); _Pragma("unroll") for (int m = 0; m < 4; ++m) _Pragma("unroll") for (int n = 0; n < 2; ++n) _Pragma("unroll") for (int k = 0; k < 2; ++k) \
        acc[ai][bj][m][n] = __builtin_amdgcn_mfma_f32_16x16x32_bf16(Bt[n][k], At[m][k], acc[ai][bj][m][n], 0, 0, 0); __builtin_amdgcn_s_setprio(0); } while (0)
#define PG8_WAIT_V(n) asm volatile("s_waitcnt vmcnt(" #n ")" ::: "memory")
#define PG8_WAIT_L(n) asm volatile("s_waitcnt lgkmcnt(" #n ")" ::: "memory")
#define PG8_BAR __builtin_amdgcn_s_barrier()
#define PG8_SCHED __builtin_amdgcn_sched_barrier(0)
    LAS unsigned char* prof_lds_ = (LAS unsigned char*)0; (void)prof_lds_; PROF_DECL; PROF_BEGIN();
    Unit cur, nxt; int ui = 0;
    if (!pb.next(0, cur)) return;
    f32x4 acc[2][2][4][2];
#pragma unroll
    for (int a = 0; a < 2; ++a)
#pragma unroll
        for (int b = 0; b < 2; ++b)
#pragma unroll
            for (int m = 0; m < 4; ++m)
#pragma unroll
                for (int n = 0; n < 2; ++n) acc[a][b][m][n] = (f32x4){0.f, 0.f, 0.f, 0.f};
    bf16x8 At[4][2], B0[2][2], B1[2][2];
    const char* cA = pb.A + cur.offA; const char* cB = pb.B + cur.offB;
    if constexpr (SP2) {
        PG8_STAGE(PG8_SB(0, 0), cB, voffB); PG8_STAGE(PG8_SB(0, 1), cB + hstepB, voffB); PG8_STAGE(PG8_SA(0, 0), cA, voffA); PG8_STAGE(PG8_SA(0, 1), cA + hstepA, voffA);
        if (wr == 1) PG8_BAR;
        PG8_WAIT_V(2); PG8_BAR;
        PG8_STAGE(PG8_SB(1, 0), cB + kstepB, voffB); PG8_STAGE(PG8_SA(1, 0), cA + kstepA, voffA); PG8_STAGE(PG8_SB(1, 1), cB + hstepB + kstepB, voffB);
        PG8_WAIT_V(6); PG8_BAR;
    } else {
        PG8_STAGE(PG8_SB(0, 0), cB, voffB); PG8_STAGE(PG8_SA(0, 0), cA, voffA); PG8_STAGE(PG8_SB(0, 1), cB + hstepB, voffB); PG8_STAGE(PG8_SA(0, 1), cA + hstepA, voffA);
        if (wr == 1) PG8_BAR;
        PG8_WAIT_V(4); PG8_BAR;
        PG8_STAGE(PG8_SB(1, 0), cB + kstepB, voffB); PG8_STAGE(PG8_SA(1, 0), cA + kstepA, voffA); PG8_STAGE(PG8_SB(1, 1), cB + hstepB + kstepB, voffB);
        PG8_WAIT_V(6); PG8_BAR;
    }
    for (;;) {
        const bool has_next = pb.next(ui + 1, nxt);
        const char* nA = has_next ? pb.A + nxt.offA : cA; const char* nB = has_next ? pb.B + nxt.offB : cB;
        const int nt = cur.nt;
        for (int t = 0; t < nt; t += 2) {
            const bool last = (t == nt - 2);
            const char* a1 = cA + (size_t)(t + 1) * kstepA;
            const char* a2 = last ? nA : cA + (size_t)(t + 2) * kstepA; const char* b2 = last ? nB : cB + (size_t)(t + 2) * kstepB;
            const char* a3 = a2 + kstepA; const char* b3 = b2 + kstepB;
            if constexpr (SP2) {
            PG8_LDB(B0, 0, 0); PG8_LDB(B1, 0, 1); PG8_SCHED; PG8_LDA(At, 0, 0); PG8_STAGE(PG8_SA(1, 1), a1 + hstepA, voffA);
            PG8_WAIT_V(8); PG8_WAIT_L(0); PG8_BAR; PG8_MMA(0, 0, At, B0); PG8_MMA(0, 1, At, B1); PG8_BAR; PG8_SCHED;
            PG8_LDA(At, 0, 1); PG8_STAGE(PG8_SB(0, 0), b2, voffB); PG8_STAGE(PG8_SB(0, 1), b2 + hstepB, voffB); PG8_STAGE(PG8_SA(0, 0), a2, voffA);
            PG8_WAIT_V(8); PG8_WAIT_L(0); PG8_BAR; PG8_MMA(1, 0, At, B0); PG8_MMA(1, 1, At, B1); PG8_BAR; PG8_SCHED;
            PG8_LDB(B0, 1, 0); PG8_LDB(B1, 1, 1); PG8_SCHED; PG8_LDA(At, 1, 0); PG8_STAGE(PG8_SA(0, 1), a2 + hstepA, voffA);
            PG8_WAIT_V(8); PG8_WAIT_L(0); PG8_BAR; PG8_MMA(0, 0, At, B0); PG8_MMA(0, 1, At, B1); PG8_BAR; PG8_SCHED;
            PG8_LDA(At, 1, 1); PG8_STAGE(PG8_SB(1, 0), b3, voffB); PG8_STAGE(PG8_SB(1, 1), b3 + hstepB, voffB); PG8_STAGE(PG8_SA(1, 0), a3, voffA);
            PG8_WAIT_V(8); PG8_WAIT_L(0); PG8_BAR; PG8_MMA(1, 0, At, B0); PG8_MMA(1, 1, At, B1); PG8_BAR; PG8_SCHED;
            } else {
            PG8_LDB(B0, 0, 0); PG8_SCHED; PG8_LDA(At, 0, 0); PG8_STAGE(PG8_SA(1, 1), a1 + hstepA, voffA);
            PG8_WAIT_L(8); PG8_BAR; PG8_WAIT_L(0); PG8_MMA(0, 0, At, B0); PG8_BAR; PG8_SCHED;
            PG8_LDB(B1, 0, 1); PG8_STAGE(PG8_SB(0, 0), b2, voffB);
            PG8_BAR; PG8_WAIT_L(0); PG8_MMA(0, 1, At, B1); PG8_BAR;
            PG8_LDA(At, 0, 1); PG8_STAGE(PG8_SA(0, 0), a2, voffA);
            PG8_BAR; PG8_WAIT_L(0); PG8_MMA(1, 0, At, B0); PG8_BAR; PG8_SCHED;
            PG8_STAGE(PG8_SB(0, 1), b2 + hstepB, voffB);
            PG8_WAIT_V(6); PG8_BAR; PG8_MMA(1, 1, At, B1); PG8_BAR;
            PG8_LDB(B0, 1, 0); PG8_SCHED; PG8_LDA(At, 1, 0); PG8_STAGE(PG8_SA(0, 1), a2 + hstepA, voffA);
            PG8_WAIT_L(8); PG8_BAR; PG8_WAIT_L(0); PG8_MMA(0, 0, At, B0); PG8_BAR; PG8_SCHED;
            PG8_LDB(B1, 1, 1); PG8_STAGE(PG8_SB(1, 0), b3, voffB);
            PG8_BAR; PG8_WAIT_L(0); PG8_MMA(0, 1, At, B1); PG8_BAR;
            PG8_LDA(At, 1, 1); PG8_STAGE(PG8_SA(1, 0), a3, voffA);
            PG8_BAR; PG8_WAIT_L(0); PG8_MMA(1, 0, At, B0); PG8_BAR; PG8_SCHED;
            PG8_STAGE(PG8_SB(1, 1), b3 + hstepB, voffB);
            PG8_WAIT_V(6); PG8_BAR; PG8_MMA(1, 1, At, B1); PG8_BAR;
            }
        }
        if constexpr (ALIGN_EPI) { if (wr == 0) PG8_BAR; }
        PROF_END(pb.prof_id); PROF_BEGIN();
        pb.epi(acc, cur, wr, wc, fr, fq);
#if defined(PROF_ID)
        asm volatile("s_waitcnt vmcnt(0)" ::: "memory");
#endif
        PROF_END(pb.prof_id + 1); PROF_BEGIN();
        if (!has_next) break;
#pragma unroll
        for (int a = 0; a < 2; ++a)
#pragma unroll
            for (int b = 0; b < 2; ++b)
#pragma unroll
                for (int m = 0; m < 4; ++m)
#pragma unroll
                    for (int n = 0; n < 2; ++n) acc[a][b][m][n] = (f32x4){0.f, 0.f, 0.f, 0.f};
        cur = nxt; cA = nA; cB = nB; ++ui;
        if constexpr (ALIGN_EPI) { if (wr == 1) PG8_BAR; }
    }
    PG8_WAIT_V(0);
    if constexpr (!ALIGN_EPI) { if (wr == 0) PG8_BAR; }
    PG8_BAR;
#undef PG8_SA
#undef PG8_SB
#undef PG8_STAGE
#undef PG8_LDA
#undef PG8_LDB
#undef PG8_MMA
#undef PG8_WAIT_V
#undef PG8_WAIT_L
#undef PG8_BAR
#undef PG8_SCHED
}

struct StaticOrder {
    int nM, nN, nwg, G, c;
    __device__ void init(int nM_, int nN_, int G_, int c_) { nM = nM_; nN = nN_; nwg = nM * nN; G = G_; c = c_; }
    __device__ bool next(int i, int& pm, int& pn) const { const long L = (long)i * G + c; if (L >= nwg) return false; map((int)L, pm, pn); return true; }
    __device__ void map(int L, int& pm, int& pn) const {
        int wgid = L; { const int q = nwg / NXCD, r = nwg % NXCD, xcd = wgid % NXCD, off = wgid / NXCD; wgid = (xcd < r ? xcd * (q + 1) : r * (q + 1) + (xcd - r) * q) + off; }
        const int nig = WGM * nN, gid = wgid / nig, fm = gid * WGM, gsz = (nM - fm) < WGM ? (nM - fm) : WGM;
        pm = fm + ((wgid % nig) % gsz); pn = (wgid % nig) / gsz;
    }
};

struct ProbBase {
    const char* A; const char* B; OpMap ma, mb; size_t hstepA, hstepB, kstepA, kstepB; int nt; int prof_id = -100;
    __device__ void std_operands(const void* A_, int lda, const void* B_, int ldb, int K) {
        A = (const char*)A_; B = (const char*)B_; ma = OpMap{128, (unsigned)lda * 2u, 0u}; mb = OpMap{128, (unsigned)ldb * 2u, 0u};
        hstepA = (size_t)HALF * lda * 2; hstepB = (size_t)HALF * ldb * 2; kstepA = kstepB = BK * 2; nt = K / BK;
    }
};

template <class F> __device__ __forceinline__ void epi_rows_perm(const f32x4 (&acc)[2][2][4][2], int wr, int wc, int fr, int fq, F f) {
    asm volatile("" : "+v"(fr), "+v"(fq));
#pragma unroll
    for (int ai = 0; ai < 2; ++ai)
#pragma unroll
        for (int m = 0; m < 4; ++m)
#pragma unroll
            for (int bj = 0; bj < 2; ++bj) f(ai * HALF + wr * 64 + m * 16 + fr, bj * HALF + wc * 32 + 8 * fq, acc[ai][bj][m][0], acc[ai][bj][m][1]);
}
template <class F> __device__ __forceinline__ void epi_rows_f32(const f32x4 (&acc)[2][2][4][2], int wr, int wc, int fr, int fq, F f) {
    asm volatile("" : "+v"(fr), "+v"(fq));
#pragma unroll
    for (int ai = 0; ai < 2; ++ai)
#pragma unroll
        for (int m = 0; m < 4; ++m)
#pragma unroll
            for (int bj = 0; bj < 2; ++bj)
#pragma unroll
                for (int n = 0; n < 2; ++n) f(ai * HALF + wr * 64 + m * 16 + fr, bj * HALF + wc * 32 + 16 * n + 4 * fq, acc[ai][bj][m][n]);
}
__device__ __forceinline__ u32x4 pack8(const f32x4& v0, const f32x4& v1) { u32x4 w; w.x = cvt_pk_bf16(v0[0], v0[1]); w.y = cvt_pk_bf16(v0[2], v0[3]); w.z = cvt_pk_bf16(v1[0], v1[1]); w.w = cvt_pk_bf16(v1[2], v1[3]); return w; }

struct TokOrder : ProbBase {
    StaticOrder so; int row0, lda, ldb;
    __device__ void init_tok(const void* Act, int lda_, const void* Wt, int K, int row0_, int nM, int nN, int G, int c) { std_operands(Act, lda_, Wt, K, K); row0 = row0_; lda = lda_; ldb = K; so.init(nM, nN, G, c); }
    __device__ bool next(int i, Unit& u) const { int pm, pn; if (!so.next(i, pm, pn)) return false; u.p0 = pm; u.p1 = pn; u.p2 = -1; u.nt = nt; u.offA = (size_t)(row0 + pm * BM) * lda * 2; u.offB = (size_t)pn * BM * ldb * 2; return true; }
};
struct ProbMlp1 : TokOrder {
    static constexpr bool PERM = true;
    bf16_t* O; int ldc;
    __device__ __forceinline__ void epi(const f32x4 (&acc)[2][2][4][2], const Unit& u, int wr, int wc, int fr, int fq) const {
        bf16_t* base = O + (size_t)(row0 + u.p0 * BM) * ldc + u.p1 * BM;
        epi_rows_perm(acc, wr, wc, fr, fq, [&](int r, int c, f32x4 v0, f32x4 v1) {
#pragma unroll
            for (int j = 0; j < 4; ++j) { const float a = fmaxf(v0[j], 0.f), b = fmaxf(v1[j], 0.f); v0[j] = a * a; v1[j] = b * b; }
            *(u32x4*)(base + (size_t)r * ldc + c) = pack8(v0, v1); });
    }
};
template <bool FIRST> struct ProbResidT : TokOrder {
    static constexpr bool PERM = false;
    bf16_t* X; const float* mod; int layer, gidx; unsigned short* slab; int G2, c2;
    const float* xp; const float* xs; const float* er; const float* ec;
    __device__ void init_split(int G_, int c_, unsigned short* slab_) { G2 = G_; c2 = c_; slab = slab_; xp = nullptr; xs = nullptr; er = nullptr; ec = nullptr; }
    __device__ bool next(int i, Unit& u) const {
        if (G2 != 256) return TokOrder::next(i, u);
        int pm, pn;
        if (i > 1) return false;
        const int which = (c2 & 1) ? 1 - i : i;
        if (which == 0) { so.map(c2, pm, pn); u.p2 = -1; u.p3 = 0; u.nt = nt; u.offA = (size_t)(row0 + pm * BM) * lda * 2; u.offB = (size_t)pn * BM * ldb * 2; }
        else { const int L = 256 + (c2 >> 2), kq = c2 & 3, ntq = nt >> 2; so.map(L, pm, pn); u.p2 = kq; u.p3 = L - 256; u.nt = ntq;
            u.offA = (size_t)(row0 + pm * BM) * lda * 2 + (size_t)kq * ntq * BK * 2; u.offB = (size_t)pn * BM * ldb * 2 + (size_t)kq * ntq * BK * 2; }
        u.p0 = pm; u.p1 = pn; return true;
    }
    __device__ __forceinline__ void epi(const f32x4 (&acc)[2][2][4][2], const Unit& u, int wr, int wc, int fr, int fq) const {
        asm volatile("" : "+v"(fr), "+v"(fq));
        const int rowt = row0 + u.p0 * BM, cond = rowt >> 12, colt = u.p1 * BM;
        const float* gate = mod + ((size_t)(cond * 2 + layer) * 6 + gidx) * 1024 + colt + wc * 32 + 4 * fq;
        f32x4 gt[2][2];
#pragma unroll
        for (int bj = 0; bj < 2; ++bj)
#pragma unroll
            for (int n = 0; n < 2; ++n) gt[bj][n] = *(const f32x4*)(gate + bj * HALF + 16 * n);
        if (u.p2 <= 0) {
            bf16_t* base = X + (size_t)(rowt + wr * 64 + fr) * 2048 + (fr & 1) * 1024 + colt + wc * 32 + 4 * fq;
            if constexpr (FIRST) {
                const bool smp = rowt >= 4096, use_er = colt < 512; const int t0 = (rowt & 4095) + wr * 64 + fr;
                const float* xsrc = (smp ? xs + (size_t)(rowt - 4096) * 1024 : xp + (size_t)rowt * 1024) + (size_t)(wr * 64 + fr) * 1024 + colt + wc * 32 + 4 * fq;
                const float* pbase = (use_er ? er + colt : ec + colt - 512) + wc * 32 + 4 * fq;
#pragma unroll
                for (int ai = 0; ai < 2; ++ai)
#pragma unroll
                    for (int mp = 0; mp < 2; ++mp) {
                        f32x4 xv[2][2][2], pv[2][2][2];
#pragma unroll
                        for (int mm = 0; mm < 2; ++mm) { const int ro = ai * HALF + (2 * mp + mm) * 16; const int t = t0 + ro;
#pragma unroll
                            for (int bj = 0; bj < 2; ++bj)
#pragma unroll
                                for (int n = 0; n < 2; ++n) { xv[mm][bj][n] = *(const f32x4*)(xsrc + (size_t)ro * 1024 + bj * HALF + 16 * n);
                                    pv[mm][bj][n] = smp ? *(const f32x4*)(pbase + (use_er ? (t >> 6) : (t & 63)) * 512 + bj * HALF + 16 * n) : (f32x4){0.f, 0.f, 0.f, 0.f}; } }
#pragma unroll
                        for (int mm = 0; mm < 2; ++mm) { const int ro = ai * HALF + (2 * mp + mm) * 16;
#pragma unroll
                            for (int bj = 0; bj < 2; ++bj)
#pragma unroll
                                for (int n = 0; n < 2; ++n) st_bf4(base + (size_t)ro * 2048 + bj * HALF + 16 * n, xv[mm][bj][n] + pv[mm][bj][n] + gt[bj][n] * acc[ai][bj][2 * mp + mm][n]); }
                    }
            } else {
#pragma unroll
                for (int ai = 0; ai < 2; ++ai) {
                    u32x2 xw[4][2][2];
#pragma unroll
                    for (int m = 0; m < 4; ++m)
#pragma unroll
                        for (int bj = 0; bj < 2; ++bj)
#pragma unroll
                            for (int n = 0; n < 2; ++n) xw[m][bj][n] = *(const u32x2*)(base + (size_t)(ai * HALF + m * 16) * 2048 + bj * HALF + 16 * n);
#pragma unroll
                    for (int m = 0; m < 4; ++m)
#pragma unroll
                        for (int bj = 0; bj < 2; ++bj)
#pragma unroll
                            for (int n = 0; n < 2; ++n) { const u32x2 w = xw[m][bj][n];
                                const f32x4 x0 = (f32x4){__builtin_bit_cast(float, w.x << 16), __builtin_bit_cast(float, w.x & 0xffff0000u), __builtin_bit_cast(float, w.y << 16), __builtin_bit_cast(float, w.y & 0xffff0000u)};
                                st_bf4(base + (size_t)(ai * HALF + m * 16) * 2048 + bj * HALF + 16 * n, x0 + gt[bj][n] * acc[ai][bj][m][n]); }
                }
            }
        } else {
            unsigned short* base = slab + (size_t)(u.p3 * 3 + u.p2 - 1) * 65536 + (size_t)(wr * 64 + fr) * 256 + wc * 32 + 4 * fq;
#pragma unroll
            for (int ai = 0; ai < 2; ++ai)
#pragma unroll
                for (int m = 0; m < 4; ++m)
#pragma unroll
                    for (int bj = 0; bj < 2; ++bj)
#pragma unroll
                        for (int n = 0; n < 2; ++n) { const f32x4 w = gt[bj][n] * acc[ai][bj][m][n]; u32x2 o; o.x = pk2h(w[0], w[1]); o.y = pk2h(w[2], w[3]); *(u32x2*)(base + (size_t)(ai * HALF + m * 16) * 256 + bj * HALF + 16 * n) = o; }
        }
    }
};
typedef ProbResidT<false> ProbResid; typedef ProbResidT<true> ProbResidFirst;
__device__ __forceinline__ void build_split_table(LAS unsigned char* tab, int G, int tid) {
    for (int i = tid; i < 320; i += NTHREADS) tab[i] = 255;
    __syncthreads();
    if (G == 256) { StaticOrder so; so.init(80, 4, G, 0); for (int L = 256 + tid; L < 320; L += NTHREADS) { int pm, pn; so.map(L, pm, pn); tab[pm * 4 + pn] = (unsigned char)(L - 256); } }
    __syncthreads();
}
struct SlabRaw { u32x2 w[3]; };
__device__ __forceinline__ SlabRaw slab_load(const unsigned short* slab, int idx, int r255, int col) { SlabRaw s;
#pragma unroll
    for (int q = 0; q < 3; ++q) s.w[q] = *(const u32x2*)(slab + (size_t)(idx * 3 + q) * 65536 + (size_t)r255 * 256 + col);
    return s; }
__device__ __forceinline__ f32x4 slab_add(const SlabRaw& r) { f32x4 s = (f32x4){0.f, 0.f, 0.f, 0.f};
#pragma unroll
    for (int q = 0; q < 3; ++q) { s[0] += h2f_((unsigned short)(r.w[q].x & 0xffffu)); s[1] += h2f_((unsigned short)(r.w[q].x >> 16)); s[2] += h2f_((unsigned short)(r.w[q].y & 0xffffu)); s[3] += h2f_((unsigned short)(r.w[q].y >> 16)); }
    return s; }
__device__ __forceinline__ f32x4 slab_sum(const unsigned short* slab, int idx, int r255, int col) {
    f32x4 s = (f32x4){0.f, 0.f, 0.f, 0.f};
#pragma unroll
    for (int q = 0; q < 3; ++q) { const u32x2 w = *(const u32x2*)(slab + (size_t)(idx * 3 + q) * 65536 + (size_t)r255 * 256 + col);
        s[0] += h2f_((unsigned short)(w.x & 0xffffu)); s[1] += h2f_((unsigned short)(w.x >> 16)); s[2] += h2f_((unsigned short)(w.y & 0xffffu)); s[3] += h2f_((unsigned short)(w.y >> 16)); }
    return s;
}

struct ProbWin : TokOrder {
    static constexpr bool PERM = true;
    bf16_t* Oq; bf16_t* Offw; bf16_t* Ofbw; bf16_t* Ov; bf16_t* Osg; const float* lb;
    __device__ __forceinline__ void epi(const f32x4 (&acc)[2][2][4][2], const Unit& u, int wr, int wc, int fr, int fq) const {
        const int t = u.p1 >> 2, col0 = (u.p1 & 3) * BM;
        bf16_t* O = t == 0 ? Oq : t == 1 ? Offw : t == 2 ? Ofbw : t == 3 ? Ov : Osg;
        bf16_t* base = O + (size_t)(row0 + u.p0 * BM) * 1024 + col0;
        if (t == 1 || t == 2) {
            const float* lbp = lb + (t - 1) * 1024 + col0 + wc * 32 + 8 * fq;
            f32x4 lbv[2][2];
#pragma unroll
            for (int bj = 0; bj < 2; ++bj) { lbv[bj][0] = *(const f32x4*)(lbp + bj * HALF); lbv[bj][1] = *(const f32x4*)(lbp + bj * HALF + 4); }
            epi_rows_perm(acc, wr, wc, fr, fq, [&](int r, int c, f32x4 v0, f32x4 v1) {
                const f32x4 l0 = lbv[c >> 7][0], l1 = lbv[c >> 7][1];
#pragma unroll
                for (int j = 0; j < 4; ++j) { v0[j] = __builtin_amdgcn_logf(l0[j] + (1.f - l0[j]) * __builtin_amdgcn_rcpf(1.f + __builtin_amdgcn_exp2f(-1.44269504f * v0[j]))); v1[j] = __builtin_amdgcn_logf(l1[j] + (1.f - l1[j]) * __builtin_amdgcn_rcpf(1.f + __builtin_amdgcn_exp2f(-1.44269504f * v1[j]))); }
                u32x4 w; w.x = pk2h(v0[0], v0[1]); w.y = pk2h(v0[2], v0[3]); w.z = pk2h(v1[0], v1[1]); w.w = pk2h(v1[2], v1[3]);
                *(u32x4*)(base + (size_t)r * 1024 + c) = w; });
        } else if (t == 3) {
            epi_rows_perm(acc, wr, wc, fr, fq, [&](int r, int c, f32x4 v0, f32x4 v1) { *(u32x4*)(base + (size_t)r * 1024 + c) = pack8(v0, v1); });
        } else {
            epi_rows_perm(acc, wr, wc, fr, fq, [&](int r, int c, f32x4 v0, f32x4 v1) {
#pragma unroll
                for (int j = 0; j < 4; ++j) { v0[j] = silu(v0[j]); v1[j] = silu(v1[j]); }
                *(u32x4*)(base + (size_t)r * 1024 + c) = pack8(v0, v1); });
        }
    }
};

struct ProbChan : ProbBase {
    static constexpr bool PERM = true;
    int mode, G, c, nunits; bf16_t* Y;
    __device__ void init(int mode_, const void* dftc, const bf16_t* h0, bf16_t* Y_, int G_, int c_) {
        mode = mode_; G = G_; c = c_; Y = Y_; A = (const char*)dftc; B = (const char*)h0; ma = OpMap{128, 512u, 0u}; hstepA = (size_t)HALF * 512; kstepA = kstepB = BK * 2; nt = 4;
        if (mode == 0) { mb = OpMap{128, 2048u, 0u}; hstepB = (size_t)HALF * 2048; nunits = 16 * 4 * 2; }
        else { mb = OpMap{64, 64u * 2048u, 2048u}; hstepB = 2 * 2048; nunits = 4 * 4 * 16 * 2; }
    }
    __device__ bool next(int i, Unit& u) const {
        const int L = i * G + c; if (L >= nunits) return false;
        const int mt = L & 1; u.p0 = mt; u.nt = nt; u.offA = (size_t)mt * 256 * 512;
        if (mode == 0) { const int g = (L >> 1) & 3, b = L >> 3; u.p1 = b * 2048 + g * 512; u.p2 = 0; u.offB = ((size_t)(b * 256) * 1024 + g * 256) * 2; }
        else { const int j = (L >> 1) & 15, g = (L >> 5) & 3, b = L >> 7; u.p1 = b * 2048 + g * 512; u.p2 = j * 256; u.offB = ((size_t)(4096 + b * 4096 + 4 * j) * 1024 + g * 256) * 2; }
        return true;
    }
    __device__ __forceinline__ void epi(const f32x4 (&acc)[2][2][4][2], const Unit& u, int wr, int wc, int fr, int fq) const {
        const int ldc = mode == 0 ? 256 : 4096;
        bf16_t* base = Y + (size_t)(u.p1 + u.p0 * 256) * ldc + u.p2;
        epi_rows_perm(acc, wr, wc, fr, fq, [&](int r, int cc, f32x4 v0, f32x4 v1) { *(u32x4*)(base + (size_t)r * ldc + cc) = pack8(v0, v1); });
    }
};
struct ProbPosCtx : ProbBase {
    static constexpr bool PERM = true;
    int G, c; bf16_t* Z;
    __device__ void init(const void* dl, const bf16_t* yctx, bf16_t* Z_, int G_, int c_) { std_operands(dl, 512, yctx, 512, 512); G = G_; c = c_; Z = Z_; }
    __device__ bool next(int i, Unit& u) const {
        const int L = i * G + c; if (L >= 64) return false;
        const int pn = L & 3, b = L >> 2; u.p0 = b; u.p1 = pn; u.nt = nt; u.offA = 0; u.offB = ((size_t)b * 2048 * 256 + (size_t)pn * 256 * 512) * 2; return true;
    }
    __device__ __forceinline__ void epi(const f32x4 (&acc)[2][2][4][2], const Unit& u, int wr, int wc, int fr, int fq) const {
        bf16_t* base = Z + (size_t)(u.p0 * 256) * 1024 + u.p1 * 256;
        epi_rows_perm(acc, wr, wc, fr, fq, [&](int r, int cc, f32x4 v0, f32x4 v1) { *(u32x4*)(base + (size_t)r * 1024 + cc) = pack8(v0, v1); });
    }
};
struct ProbSmpA : ProbBase {
    static constexpr bool PERM = true;
    int G, c; bf16_t* U;
    __device__ void init(const void* fa2, const bf16_t* yt, bf16_t* U_, int G_, int c_) {
        A = (const char*)fa2; B = (const char*)yt; ma = OpMap{128, 512u, 0u}; hstepA = (size_t)HALF * 512; kstepA = BK * 2;
        mb = OpMap{32, 128u, 16384u}; hstepB = 4 * 16384; kstepB = 4096; nt = 4; G = G_; c = c_; U = U_;
    }
    __device__ bool next(int i, Unit& u) const {
        const int L = i * G + c; if (L >= 512) return false;
        const int tau = L & 127, b = L >> 7; u.p0 = b; u.p1 = tau; u.nt = nt; u.offA = 0; u.offB = ((size_t)(b * 2048 + 16 * tau) * 4096) * 2; return true;
    }
    __device__ __forceinline__ void epi(const f32x4 (&acc)[2][2][4][2], const Unit& u, int wr, int wc, int fr, int fq) const {
        bf16_t* base = U + (size_t)(u.p0 * 1024 + 8 * u.p1) * 8192;
        epi_rows_perm(acc, wr, wc, fr, fq, [&](int r, int cc, f32x4 v0, f32x4 v1) {
            *(u32x4*)(base + (size_t)(cc >> 5) * 8192 + (r & 127) * 64 + (r >> 7) * 32 + (cc & 31)) = pack8(v0, v1); });
    }
};
struct ProbSmpB : ProbBase {
    static constexpr bool PERM = true;
    int G, c; bf16_t* Z;
    __device__ void init(const void* mbm, const bf16_t* Uin, bf16_t* Z_, int G_, int c_) { std_operands(mbm, 512, Uin, 8192, 512); G = G_; c = c_; Z = Z_; }
    __device__ bool next(int i, Unit& u) const {
        const int L = i * G + c; if (L >= 256) return false;
        const int pn = L & 3, q = (L >> 2) & 15, b = L >> 6; u.p0 = b; u.p1 = q; u.p2 = pn; u.nt = nt;
        u.offA = (size_t)q * 256 * 512 * 2; u.offB = ((size_t)(b * 1024 + pn * 256) * 8192 + q * 512) * 2; return true;
    }
    __device__ __forceinline__ void epi(const f32x4 (&acc)[2][2][4][2], const Unit& u, int wr, int wc, int fr, int fq) const {
        bf16_t* base = Z + (size_t)(4096 + u.p0 * 4096 + 4 * u.p1) * 1024 + u.p2 * 256;
        epi_rows_perm(acc, wr, wc, fr, fq, [&](int r, int cc, f32x4 v0, f32x4 v1) {
            const int l = (r >> 6) + 64 * (r & 63); *(u32x4*)(base + (size_t)l * 1024 + cc) = pack8(v0, v1); });
    }
};

__device__ __forceinline__ void norm_rows(bf16_t* X, int row0, int nrows, const float* g, const float* mod, int layer, int ish, bf16_t* H, int gw, int ngw, int lane, const LAS unsigned char* stab, const unsigned short* slab) {
    constexpr int NB = 5;
    LAS unsigned char* prof_lds_ = (LAS unsigned char*)0; (void)prof_lds_; PROF_DECL; PROF_BEGIN();
    f32x4 gv[4], gm[4], shv[4];
#pragma unroll
    for (int j = 0; j < 4; ++j) gv[j] = *(const f32x4*)(g + 4 * lane + 256 * j);
    const int rpw = (nrows + ngw - 1) / ngw, rbeg = row0 + gw * rpw, rend = (rbeg + rpw < row0 + nrows) ? rbeg + rpw : row0 + nrows;
    int ccur = -1;
    for (int rb = rbeg; rb < rend; rb += NB) {
        u32x2 nx[NB][4];
#pragma unroll
        for (int b = 0; b < NB; ++b) { const int r = rb + b; if (r < rend) { const u32x2* p = (const u32x2*)(X + (size_t)r * 2048 + (r & 1) * 1024) + lane;
#pragma unroll
            for (int j = 0; j < 4; ++j) nx[b][j] = p[64 * j]; } }
#pragma unroll
        for (int b = 0; b < NB; ++b) {
            const int r = rb + b; if (r >= rend) break;
            if ((r >> 12) != ccur) { ccur = r >> 12; const float* mrow = mod + ((size_t)(ccur * 2 + layer) * 6) * 1024;
#pragma unroll
                for (int j = 0; j < 4; ++j) { shv[j] = *(const f32x4*)(mrow + (size_t)ish * 1024 + 4 * lane + 256 * j); gm[j] = gv[j] * (*(const f32x4*)(mrow + (size_t)(ish + 1) * 1024 + 4 * lane + 256 * j) + 1.f); } }
            u32x2* xr = (u32x2*)(X + (size_t)r * 2048 + (r & 1) * 1024) + lane;
            f32x4 v[4]; float s = 0.f;
            int si4[4]; SlabRaw sr[4];
#pragma unroll
            for (int j = 0; j < 4; ++j) { si4[j] = stab[(r >> 8) * 4 + j]; if (si4[j] != 255) sr[j] = slab_load(slab, si4[j], r & 255, 4 * lane); }
#pragma unroll
            for (int j = 0; j < 4; ++j) { v[j] = (f32x4){__builtin_bit_cast(float, nx[b][j].x << 16), __builtin_bit_cast(float, nx[b][j].x & 0xffff0000u), __builtin_bit_cast(float, nx[b][j].y << 16), __builtin_bit_cast(float, nx[b][j].y & 0xffff0000u)}; if (si4[j] != 255) { v[j] = v[j] + slab_add(sr[j]); st_bf4(xr + 64 * j, v[j]); }
                s += (v[j].x * v[j].x + v[j].y * v[j].y) + (v[j].z * v[j].z + v[j].w * v[j].w); }
            const float rstd = rsqrtf(wave_sum(s) * (1.f / 1024.f) + 1e-6f);
            unsigned long long* o8 = (unsigned long long*)(H + (size_t)r * 1024) + lane;
#pragma unroll
            for (int j = 0; j < 4; ++j) { const f32x4 o = v[j] * rstd * gm[j] + shv[j]; o8[64 * j] = (unsigned long long)cvt_pk_bf16(o.x, o.y) | ((unsigned long long)cvt_pk_bf16(o.z, o.w) << 32); }
        }
    }
    PROF_END(11);
}


__device__ __forceinline__ void embed_rows(const float* xp, const float* xs, const float* er, const float* ec, const float* g, const float* mod, bf16_t* H, int gw, int ngw, int lane) {
    constexpr int NB = 4;
    f32x4 gv[4], gm[4], shv[4];
#pragma unroll
    for (int j = 0; j < 4; ++j) gv[j] = *(const f32x4*)(g + 4 * lane + 256 * j);
    const int rpw = (20480 + ngw - 1) / ngw, rbeg = gw * rpw, rend = (rbeg + rpw < 20480) ? rbeg + rpw : 20480;
    int ccur = -1;
    int prow = -1; f32x4 pr0 = (f32x4){0.f, 0.f, 0.f, 0.f}, pr1 = pr0;
    for (int rb = rbeg; rb < rend; rb += NB) {
        f32x4 nx[NB][4], pc[NB][2];
#pragma unroll
        for (int b = 0; b < NB; ++b) { const int r = rb + b; if (r < rend) { const f32x4* xr = (const f32x4*)(r < 4096 ? xp + (size_t)r * 1024 : xs + (size_t)(r - 4096) * 1024) + lane;
#pragma unroll
            for (int j = 0; j < 4; ++j) nx[b][j] = xr[64 * j];
            if (r >= 4096) { const int col = r & 63; pc[b][0] = *(const f32x4*)(ec + col * 512 + 4 * lane); pc[b][1] = *(const f32x4*)(ec + col * 512 + 256 + 4 * lane); } } }
#pragma unroll
        for (int b = 0; b < NB; ++b) {
            const int r = rb + b; if (r >= rend) break;
            if ((r >> 12) != ccur) { ccur = r >> 12; const float* mrow = mod + ((size_t)(ccur * 2 + 0) * 6) * 1024;
#pragma unroll
                for (int j = 0; j < 4; ++j) { shv[j] = *(const f32x4*)(mrow + 4 * lane + 256 * j); gm[j] = gv[j] * (*(const f32x4*)(mrow + 1024 + 4 * lane + 256 * j) + 1.f); } }
            f32x4 v[4]; float s = 0.f;
#pragma unroll
            for (int j = 0; j < 4; ++j) v[j] = nx[b][j];
            if (r >= 4096) { const int row = (r & 4095) >> 6;
                if (row != prow) { prow = row; pr0 = *(const f32x4*)(er + row * 512 + 4 * lane); pr1 = *(const f32x4*)(er + row * 512 + 256 + 4 * lane); }
                v[0] = v[0] + pr0; v[1] = v[1] + pr1; v[2] = v[2] + pc[b][0]; v[3] = v[3] + pc[b][1]; }
#pragma unroll
            for (int j = 0; j < 4; ++j) s += (v[j].x * v[j].x + v[j].y * v[j].y) + (v[j].z * v[j].z + v[j].w * v[j].w);
            const float rstd = rsqrtf(wave_sum(s) * (1.f / 1024.f) + 1e-6f);
            unsigned long long* o8 = (unsigned long long*)(H + (size_t)r * 1024) + lane;
#pragma unroll
            for (int j = 0; j < 4; ++j) { const f32x4 o = v[j] * rstd * gm[j] + shv[j]; o8[64 * j] = (unsigned long long)cvt_pk_bf16(o.x, o.y) | ((unsigned long long)cvt_pk_bf16(o.z, o.w) << 32); }
        }
    }
}
__device__ __forceinline__ void gen_tables(unsigned char* ws, long e0, long estride) {
    bf16_t* dftc = (bf16_t*)(ws + WM.dftc); bf16_t* dl = (bf16_t*)(ws + WM.dl256); bf16_t* fa2 = (bf16_t*)(ws + WM.fa2); bf16_t* mbm = (bf16_t*)(ws + WM.mb);
    float* er = (float*)(ws + WM.pos); float* ec = er + 64 * 512;
    constexpr long N0 = 512 * 256, N1 = 256 * 512, N2 = 256 * 256, N3 = 16L * 256 * 512, N4 = 2 * 64 * 512;
    for (long e = e0; e < N0 + N1 + N2 + N3 + N4; e += estride) {
        long r = e;
        if (r < N0) { const int mrow = (int)(r >> 8), cp = (int)(r & 255), cc = mrow >> 1, ri = mrow & 1; const float x = 2.f * (float)((cc * cp) & 255) / 256.f;
            dftc[r] = (bf16_t)f2bf(ri == 0 ? cospif(x) : -sinpif(x)); continue; } r -= N0;
        if (r < N1) { const int l = (int)(r >> 9), k = (int)(r & 511), ri = k >> 8, lp = k & 255; const float x = 2.f * (float)((l * lp) & 255) / 256.f;
            dl[r] = (bf16_t)f2bf((ri == 0 ? cospif(x) : sinpif(x)) * (1.f / 256.f)); continue; } r -= N1;
        if (r < N2) { const int mrow = (int)(r >> 8), k = (int)(r & 255), sA = mrow >> 7, k1 = (mrow >> 1) & 63, ro = mrow & 1, ri = k >> 7, sB = (k >> 6) & 1, l1 = k & 63;
            const float x = 2.f * (float)((k1 * l1) & 63) / 64.f; float v = 0.f;
            if (sA == sB) v = (ro == ri) ? cospif(x) : (ro == 0 ? sinpif(x) : -sinpif(x));
            fa2[r] = (bf16_t)f2bf(v); continue; } r -= N2;
        if (r < N3) { const int q = (int)(r >> 17), mrow = (int)(r >> 9) & 255, k = (int)(r & 511), ko = mrow >> 6, k2 = mrow & 63, kop = k >> 7, ro = (k >> 6) & 1, l2 = k & 63;
            const int l = 4 * q + ko + 64 * k2; const float x = 2.f * (float)((l * l2) & 4095) / 4096.f; float v = 0.f;
            if (ko == kop) v = (ro == 0 ? cospif(x) : sinpif(x)) * (1.f / 1024.f);
            mbm[r] = (bf16_t)f2bf(v); continue; } r -= N3;
        { const int which = (int)(r >> 15), p = (int)(r >> 9) & 63, j = (int)(r & 511), i = j & 255;
            const float omega = 1.0f / powf(10000.0f, (float)i / 256.0f); const float ang = (float)p * omega;
            (which == 0 ? er : ec)[p * 512 + j] = (j < 256) ? sinf(ang) : cosf(ang); }
    }
}


__device__ __forceinline__ void final_rows(float* X, int row0, int nrows, const float* g, int gw, int ngw, int lane, const LAS unsigned char* stab, const unsigned short* slab) {
    constexpr int NB = 5;
    f32x4 gv[4];
#pragma unroll
    for (int j = 0; j < 4; ++j) gv[j] = *(const f32x4*)(g + 4 * lane + 256 * j);
    for (int rb = row0 + gw; rb < row0 + nrows; rb += NB * ngw) {
        u32x2 nx[NB][4];
#pragma unroll
        for (int b = 0; b < NB; ++b) { const int r = rb + b * ngw; if (r < row0 + nrows) { const u32x2* p = (const u32x2*)(X + (size_t)r * 1024) + (r & 1) * 256 + lane;
#pragma unroll
            for (int j = 0; j < 4; ++j) nx[b][j] = p[64 * j]; } }
#pragma unroll
        for (int b = 0; b < NB; ++b) {
            const int r = rb + b * ngw; if (r >= row0 + nrows) break;
            f32x4* xr = (f32x4*)(X + (size_t)r * 1024) + lane;
            f32x4 v[4]; float s = 0.f;
            int si4[4]; SlabRaw sr[4];
#pragma unroll
            for (int j = 0; j < 4; ++j) { si4[j] = stab[(r >> 8) * 4 + j]; if (si4[j] != 255) sr[j] = slab_load(slab, si4[j], r & 255, 4 * lane); }
#pragma unroll
            for (int j = 0; j < 4; ++j) { v[j] = (f32x4){__builtin_bit_cast(float, nx[b][j].x << 16), __builtin_bit_cast(float, nx[b][j].x & 0xffff0000u), __builtin_bit_cast(float, nx[b][j].y << 16), __builtin_bit_cast(float, nx[b][j].y & 0xffff0000u)}; if (si4[j] != 255) v[j] = v[j] + slab_add(sr[j]);
                s += (v[j].x * v[j].x + v[j].y * v[j].y) + (v[j].z * v[j].z + v[j].w * v[j].w); }
            const float rstd = rsqrtf(wave_sum(s) * (1.f / 1024.f) + 1e-6f);
#pragma unroll
            for (int j = 0; j < 4; ++j) xr[64 * j] = v[j] * rstd * gv[j];
        }
    }
}
__device__ __forceinline__ void mod_unit(LAS unsigned char* lds, int unit, const float* c, const float* c_ctx, const float* ada_w, const float* ada_b, float* mod, int tid, int wave, int lane) {
    LAS float* sc = (LAS float*)lds;
    LAS float* red = (LAS float*)(lds + 20480);
    const int layer = unit / 192, n0 = (unit % 192) * 32, col = lane & 31, kh = lane >> 5;
    for (int i = tid; i < 5 * 1024; i += NTHREADS) { const int cond = i >> 10, k = i & 1023; const float x = cond == 0 ? c_ctx[k] : c[(cond - 1) * 1024 + k]; sc[i] = silu(x); }
    __syncthreads();
    const float* w = ada_w + ((size_t)layer * 1024 + wave * 128 + kh) * 6144 + n0 + col;
    float acc[5];
#pragma unroll
    for (int q = 0; q < 5; ++q) acc[q] = 0.f;
#pragma unroll 1
    for (int kb = 0; kb < 64; kb += 32) {
        float wv[32];
#pragma unroll
        for (int k = 0; k < 32; ++k) wv[k] = w[(size_t)(2 * (kb + k)) * 6144];
#pragma unroll
        for (int k = 0; k < 32; ++k) {
#pragma unroll
            for (int q = 0; q < 5; ++q) acc[q] += wv[k] * sc[q * 1024 + wave * 128 + 2 * (kb + k) + kh];
        }
    }
#pragma unroll
    for (int q = 0; q < 5; ++q) { acc[q] += __shfl_xor(acc[q], 32); if (kh == 0) red[(wave * 5 + q) * 32 + col] = acc[q]; }
    __syncthreads();
    for (int i = tid; i < 5 * 32; i += NTHREADS) { const int q = i >> 5, n = i & 31; float s = 0.f;
#pragma unroll
        for (int ww = 0; ww < 8; ++ww) s += red[(ww * 5 + q) * 32 + n];
        mod[((size_t)q * 2 + layer) * 6144 + n0 + n] = s + ada_b[(size_t)layer * 6144 + n0 + n]; }
    __syncthreads();
}

struct TrItem { const float* W; bf16_t* WT; int K, N, item; };
__device__ __forceinline__ void transpose_load(const TrItem& t, f32x4 (&ld)[8], int lane) {
    const int nblk = t.N / 32, kb = t.item / nblk, nb = t.item % nblk, k0 = 64 * kb, n0 = 32 * nb;
#pragma unroll
    for (int i = 0; i < 8; ++i) ld[i] = *(const f32x4*)(t.W + (size_t)(k0 + 8 * i + (lane >> 3)) * t.N + n0 + 4 * (lane & 7));
}
__device__ __forceinline__ void transpose_finish(const TrItem& t, const f32x4 (&ld)[8], LAS float* scr, int lane) {
    const int nblk = t.N / 32, kb = t.item / nblk, nb = t.item % nblk, k0 = 64 * kb, n0 = 32 * nb;
#pragma unroll
    for (int i = 0; i < 8; ++i) { LAS float* d = scr + (8 * i + (lane >> 3)) * 33 + 4 * (lane & 7); d[0] = ld[i][0]; d[1] = ld[i][1]; d[2] = ld[i][2]; d[3] = ld[i][3]; }
    asm volatile("s_waitcnt lgkmcnt(0)" ::: "memory");
    const int c = lane & 7;
#pragma unroll
    for (int j = 0; j < 4; ++j) { const int n = (lane >> 3) + 8 * j; const LAS float* s = scr + (8 * c) * 33 + n;
        u32x4 o; o.x = pk2(s[0 * 33], s[1 * 33]); o.y = pk2(s[2 * 33], s[3 * 33]); o.z = pk2(s[4 * 33], s[5 * 33]); o.w = pk2(s[6 * 33], s[7 * 33]);
        *(u32x4*)(t.WT + (size_t)(n0 + n) * t.K + k0 + 8 * c) = o; }
    asm volatile("s_waitcnt lgkmcnt(0)" ::: "memory");
}
template <class Dec> __device__ __forceinline__ void transpose_stream(int first, int count, int stride, Dec dec, LAS float* scr, int lane) {
    if (first >= count) return;
    f32x4 cur[8], nxt[8]; TrItem tc = dec(first), tn = tc;
    transpose_load(tc, cur, lane);
    for (int it = first; it < count; it += stride) {
        const bool more = it + stride < count;
        if (more) { tn = dec(it + stride); transpose_load(tn, nxt, lane); }
        transpose_finish(tc, cur, scr, lane);
        if (more) { tc = tn;
#pragma unroll
            for (int i = 0; i < 8; ++i) cur[i] = nxt[i]; }
    }
}


typedef float f32x16 __attribute__((ext_vector_type(16)));
typedef short v4i16_t __attribute__((ext_vector_type(4)));
constexpr int QA_RS = 272, QP_RS = 264, KB_RS = 272, KPP_RS = 320, V_RS = 320;
constexpr int T_QA = 0, T_QP = T_QA + 32 * QA_RS, T_KB = T_QP + 32 * QP_RS, T_KPP = T_KB + 32 * KB_RS, T_V = T_KPP + 32 * KPP_RS, T_EL = T_V + 32 * V_RS, DIR_BYTES = T_EL + 512;
constexpr int OBUF_OFF = 2 * DIR_BYTES, OBUF_BYTES = 256 * 256;
static_assert(OBUF_OFF + OBUF_BYTES <= 160 * 1024 - 512 && (DIR_BYTES % 16) == 0 && (T_QP % 16) == 0 && (T_KB % 16) == 0 && (T_KPP % 16) == 0 && (T_V % 16) == 0 && (T_EL % 16) == 0, "scan LDS map");
constexpr int SLOT_ELEMS = 128 * 128;
#ifndef SCAN_STAGGER
#define SCAN_STAGGER 0
#endif

struct ScanT { const bf16_t* q; const bf16_t* lffw; const bf16_t* lfbw; const bf16_t* v; bf16_t* sg; bf16_t* slots; float* dvec; const float* gnorm; const float* state_in; float* new_state; };

__device__ __forceinline__ bf16x8 tr_pair(const LAS unsigned char* p0, const LAS unsigned char* p1) {
    const v4i16_t lo = __builtin_amdgcn_ds_read_tr16_b64_v4i16((LAS v4i16_t*)p0), hi = __builtin_amdgcn_ds_read_tr16_b64_v4i16((LAS v4i16_t*)p1);
    return (bf16x8){lo[0], lo[1], lo[2], lo[3], hi[0], hi[1], hi[2], hi[3]};
}
__device__ __forceinline__ bf16x8 pack_acc8(const f32x16& x, int s8) {
    u32x4 w; w.x = cvt_pk_bf16(x[8 * s8 + 0], x[8 * s8 + 1]); w.y = cvt_pk_bf16(x[8 * s8 + 2], x[8 * s8 + 3]); w.z = cvt_pk_bf16(x[8 * s8 + 4], x[8 * s8 + 5]); w.w = cvt_pk_bf16(x[8 * s8 + 6], x[8 * s8 + 7]);
    return __builtin_bit_cast(bf16x8, w);
}
__device__ __forceinline__ float h2f(unsigned short b) { return (float)__builtin_bit_cast(_Float16, b); }

template <bool FULL>
__device__ __forceinline__ void scan_item(LAS unsigned char* lds, const ScanT& T, int tok0, int h, bool act0, bool act1, const bf16_t* init0, const bf16_t* init1,
                                          float* fin0, float* fin1, bf16_t* outs0, bf16_t* outs1, float* outd0, float* outd1) {
    const int tid = threadIdx.x, wave = __builtin_amdgcn_readfirstlane(tid >> 6), dir = wave >> 2, wg = wave & 3;
    LAS unsigned char* prof_lds_ = lds; (void)prof_lds_; PROF_DECL; PROF_BEGIN();
    const bool act = dir ? act1 : act0;
    const bf16_t* init = dir ? init1 : init0;
    LAS unsigned char* D = lds + dir * DIR_BYTES;
    LAS unsigned char* OB = lds + OBUF_OFF;
    const bf16_t* lfp = dir ? T.lfbw : T.lffw;
#define SCAN_LANE(x) int x; asm volatile("v_mbcnt_lo_u32_b32 %0, -1, 0\n\tv_mbcnt_hi_u32_b32 %0, -1, %0" : "=v"(x))
#define SCAN_PREP_ROLE SCAN_LANE(ln_); const int pp = 16 * wg + (ln_ & 15), uu = ln_ >> 4, gt_ = wg * 64 + ln_, vt = gt_ >> 3, vc2 = gt_ & 7
#define SCAN_MFMA_ROLE SCAN_LANE(ln_); const int l31 = ln_ & 31, hh = ln_ >> 5, gq = (ln_ & 15) >> 2, gp = ln_ & 3, vcol = 16 * ((ln_ >> 4) & 1)
    f32x16 S[4];
#pragma unroll
    for (int t4 = 0; t4 < 4; ++t4) {
        if (init && act) { SCAN_LANE(lane); const u32x4* sp = (const u32x4*)(init + ((size_t)(wg * 4 + t4) * 64 + lane) * 16); const u32x4 a = sp[0], b = sp[1];
            const unsigned w8[8] = {a.x, a.y, a.z, a.w, b.x, b.y, b.z, b.w};
#pragma unroll
            for (int j = 0; j < 8; ++j) { S[t4][2 * j] = __builtin_bit_cast(float, w8[j] << 16); S[t4][2 * j + 1] = __builtin_bit_cast(float, w8[j] & 0xffff0000u); } }
        else {
#pragma unroll
            for (int j = 0; j < 16; ++j) S[t4][j] = 0.f; }
    }
    float dsum0 = 0.f, dsum1 = 0.f;
    unsigned qreg[8], lfreg[8]; u32x4 vreg[2];
#define SCAN_LOAD(i) do { const int jsc_ = dir ? 7 - (i) : (i); \
        _Pragma("unroll") for (int e = 0; e < 8; ++e) { const int tl = 8 * uu + e; const size_t tk = (size_t)(tok0 + 32 * jsc_ + (dir ? 31 - tl : tl)) * 1024 + h * 128 + 2 * pp; \
            if (FULL) qreg[e] = *(const unsigned*)(T.q + tk); lfreg[e] = *(const unsigned*)(lfp + tk); } \
        { const size_t tk = (size_t)(tok0 + 32 * jsc_ + (dir ? 31 - vt : vt)) * 1024 + h * 128 + 16 * vc2; vreg[0] = *(const u32x4*)(T.v + tk); vreg[1] = *(const u32x4*)(T.v + tk + 8); } } while (0)
    if (act) { SCAN_PREP_ROLE; SCAN_LOAD(0); }
    PROF_END(6);
    for (int s = 0; s < 16 + SCAN_STAGGER; ++s) {
        const int ph = s - (SCAN_STAGGER ? dir : 0);
        if (act && ph >= 0 && ph < 16) {
            const int i = ph >> 1;
            if ((ph & 1) == 0) {
                SCAN_PREP_ROLE; const int lane = ln_;
#if defined(PROF_ID)
                PROF_BEGIN(); asm volatile("s_waitcnt vmcnt(0)" ::: "memory"); PROF_END(1); PROF_BEGIN();
#endif
                *(LAS u32x4*)(D + T_V + vt * V_RS + vc2 * 32) = vreg[0]; *(LAS u32x4*)(D + T_V + vt * V_RS + vc2 * 32 + 16) = vreg[1];
                f32x2 cc[8]; f32x2 aa = (f32x2){0.f, 0.f};
#pragma unroll
                for (int e = 0; e < 8; ++e) { aa += (f32x2){h2f((unsigned short)(lfreg[e] & 0xffffu)), h2f((unsigned short)(lfreg[e] >> 16))}; cc[e] = aa; }
                f32x2 tq[4];
#pragma unroll
                for (int u2 = 0; u2 < 4; ++u2) { tq[u2].x = __shfl(aa.x, (lane & 15) + 16 * u2); tq[u2].y = __shfl(aa.y, (lane & 15) + 16 * u2); }
                const f32x2 zz = (f32x2){0.f, 0.f};
                const f32x2 pre = (uu > 0 ? tq[0] : zz) + (uu > 1 ? tq[1] : zz) + (uu > 2 ? tq[2] : zz);
                const f32x2 rr = tq[0] + tq[1], bl = rr + tq[2] + tq[3];
#define EX2V(v) ((f32x2){__builtin_amdgcn_exp2f((v).x), __builtin_amdgcn_exp2f((v).y)})
                if (FULL) {
                    const f32x2 er = EX2V(rr), elr = EX2V(bl - rr), base = pre - rr;
#pragma unroll
                    for (int e = 0; e < 8; ++e) {
                        const int tl = 8 * uu + e;
                        const f32x2 d = base + cc[e];
                        const f32x2 ea = EX2V(d), eb = EX2V(-d);
                        const f32x2 lfv = (f32x2){h2f((unsigned short)(lfreg[e] & 0xffffu)), h2f((unsigned short)(lfreg[e] >> 16))};
                        const f32x2 kk = 1.f - EX2V(lfv);
                        const f32x2 qq = (f32x2){__builtin_bit_cast(float, qreg[e] << 16), __builtin_bit_cast(float, qreg[e] & 0xffff0000u)};
                        const f32x2 qa = qq * ea, kb = kk * eb, qp = qa * er, kpp = kb * elr;
                        *(LAS unsigned*)(D + T_QA + tl * QA_RS + 4 * pp) = cvt_pk_bf16(qa.x, qa.y);
                        *(LAS unsigned*)(D + T_QP + tl * QP_RS + 4 * pp) = cvt_pk_bf16(qp.x, qp.y);
                        *(LAS unsigned*)(D + T_KB + tl * KB_RS + 4 * pp) = cvt_pk_bf16(kb.x, kb.y);
                        *(LAS unsigned*)(D + T_KPP + tl * KPP_RS + 4 * pp) = cvt_pk_bf16(kpp.x, kpp.y);
                        if (e & 1) __builtin_amdgcn_sched_barrier(0);
                    }
                } else {
                    const f32x2 base = bl - pre;
#pragma unroll
                    for (int e = 0; e < 8; ++e) {
                        const int tl = 8 * uu + e;
                        const f32x2 d = base - cc[e];
                        const f32x2 lfv = (f32x2){h2f((unsigned short)(lfreg[e] & 0xffffu)), h2f((unsigned short)(lfreg[e] >> 16))};
                        const f32x2 kpp = (1.f - EX2V(lfv)) * EX2V(d);
                        *(LAS unsigned*)(D + T_KPP + tl * KPP_RS + 4 * pp) = cvt_pk_bf16(kpp.x, kpp.y);
                    }
                    dsum0 += bl.x; dsum1 += bl.y;
                }
                if (uu == 0) { *(LAS f32x2*)(D + T_EL + 8 * pp) = EX2V(bl); }
                __builtin_amdgcn_sched_barrier(0);
#if defined(PROF_ID)
                asm volatile("s_waitcnt lgkmcnt(0)" ::: "memory"); PROF_END(2);
#endif
                if (i < 7) SCAN_LOAD(i + 1);
            } else {
                SCAN_MFMA_ROLE; PROF_BEGIN();
                if (FULL) {
                    f32x16 P;
#pragma unroll
                    for (int j = 0; j < 16; ++j) P[j] = 0.f;
#pragma unroll
                    for (int ks = 0; ks < 8; ++ks) {
                        const bf16x8 ka = *(const LAS bf16x8*)(D + T_KB + l31 * KB_RS + (16 * ks + 8 * hh) * 2);
                        const bf16x8 qb = *(const LAS bf16x8*)(D + T_QA + l31 * QA_RS + (16 * ks + 8 * hh) * 2);
                        P = __builtin_amdgcn_mfma_f32_32x32x16_bf16(ka, qb, P, 0, 0, 0);
                    }
#pragma unroll
                    for (int j = 0; j < 16; ++j) { const int srow = (j & 3) + 8 * (j >> 2) + 4 * hh; P[j] = (srow <= l31) ? P[j] : 0.f; }
                    f32x16 o;
#pragma unroll
                    for (int j = 0; j < 16; ++j) o[j] = 0.f;
#pragma unroll
                    for (int s8 = 0; s8 < 2; ++s8) {
                        const LAS unsigned char* vb = D + T_V + (16 * s8 + 4 * hh + gq) * V_RS + (32 * wg + vcol + 4 * gp) * 2;
                        const bf16x8 vf = tr_pair(vb, vb + 8 * V_RS);
                        o = __builtin_amdgcn_mfma_f32_32x32x16_bf16(pack_acc8(P, s8), vf, o, 0, 0, 0);
                    }
#pragma unroll
                    for (int t4 = 0; t4 < 4; ++t4)
#pragma unroll
                        for (int s8 = 0; s8 < 2; ++s8) {
                            const LAS unsigned char* qp = D + T_QP + l31 * QP_RS + (32 * t4 + 16 * s8 + 4 * hh) * 2;
                            const u32x2 lo = *(const LAS u32x2*)qp, hi = *(const LAS u32x2*)(qp + 16);
                            const u32x4 aw = {lo.x, lo.y, hi.x, hi.y};
                            o = __builtin_amdgcn_mfma_f32_32x32x16_bf16(__builtin_bit_cast(bf16x8, aw), pack_acc8(S[t4], s8), o, 0, 0, 0);
                        }
                    const int jsc = dir ? 7 - i : i;
                    LAS unsigned short* ob = (LAS unsigned short*)(OB + (32 * jsc + (dir ? 31 - 4 * hh : 4 * hh)) * 256 + (32 * wg + l31) * 2);
                    const int rs = dir ? -128 : 128;
                    if (i >= 4) {
                        unsigned short pv[16];
#pragma unroll
                        for (int j = 0; j < 16; ++j) pv[j] = ob[((j & 3) + 8 * (j >> 2)) * rs];
#pragma unroll
                        for (int j = 0; j < 16; ++j) o[j] += bf2f(pv[j]);
                    }
#pragma unroll
                    for (int j = 0; j < 16; ++j) ob[((j & 3) + 8 * (j >> 2)) * rs] = (unsigned short)cvt_pk_bf16(o[j], o[j]);
                }
                __builtin_amdgcn_sched_barrier(0);
#pragma unroll
                for (int t4 = 0; t4 < 4; ++t4) {
#pragma unroll
                    for (int g = 0; g < 4; ++g) { const f32x4 f = *(const LAS f32x4*)(D + T_EL + (32 * t4 + 8 * g + 4 * hh) * 4);
                        S[t4][4 * g + 0] *= f[0]; S[t4][4 * g + 1] *= f[1]; S[t4][4 * g + 2] *= f[2]; S[t4][4 * g + 3] *= f[3]; }
#pragma unroll
                    for (int s8 = 0; s8 < 2; ++s8) {
                        const LAS unsigned char* kb = D + T_KPP + (16 * s8 + 8 * hh + gq) * KPP_RS + (32 * t4 + vcol + 4 * gp) * 2;
                        const LAS unsigned char* vb = D + T_V + (16 * s8 + 8 * hh + gq) * V_RS + (32 * wg + vcol + 4 * gp) * 2;
                        const bf16x8 ka = tr_pair(kb, kb + 4 * KPP_RS), vf = tr_pair(vb, vb + 4 * V_RS);
                        S[t4] = __builtin_amdgcn_mfma_f32_32x32x16_bf16(ka, vf, S[t4], 0, 0, 0);
                    }
                    if (t4 == 1) __builtin_amdgcn_sched_barrier(0);
                }
                PROF_END(3);
            }
        }
        PROF_BEGIN();
        __syncthreads();
        PROF_END(4);
    }
#undef SCAN_LOAD
    SCAN_MFMA_ROLE; SCAN_LANE(lane); PROF_BEGIN();
    if (FULL) {
        float* fin = dir ? fin1 : fin0;
        if (fin && act) {
#pragma unroll
            for (int t4 = 0; t4 < 4; ++t4)
#pragma unroll
                for (int j = 0; j < 16; ++j) fin[(size_t)(32 * t4 + (j & 3) + 8 * (j >> 2) + 4 * hh) * 128 + 32 * wg + l31] = S[t4][j];
        }
        const int cv = tid & 15;
        f32x4 gn0 = *(const f32x4*)(T.gnorm + 8 * cv), gn1 = *(const f32x4*)(T.gnorm + 8 * cv + 4);
        u32x4 gwv[8];
#pragma unroll
        for (int pass = 0; pass < 8; ++pass) gwv[pass] = *(const u32x4*)(T.sg + (size_t)(tok0 + 32 * pass + (tid >> 4)) * 1024 + h * 128 + 8 * cv);
#pragma unroll
        for (int pass = 0; pass < 8; ++pass) {
            const int row = 32 * pass + (tid >> 4);
            const u32x4 ow = *(const LAS u32x4*)(OB + row * 256 + cv * 16);
            bf16_t* gp_ = T.sg + (size_t)(tok0 + row) * 1024 + h * 128 + 8 * cv;
            const u32x4 gw = gwv[pass];
            float ov[8], gv[8];
            const unsigned o4[4] = {ow.x, ow.y, ow.z, ow.w}, g4[4] = {gw.x, gw.y, gw.z, gw.w};
            float ss = 0.f;
#pragma unroll
            for (int j = 0; j < 4; ++j) { ov[2 * j] = __builtin_bit_cast(float, o4[j] << 16); ov[2 * j + 1] = __builtin_bit_cast(float, o4[j] & 0xffff0000u);
                gv[2 * j] = __builtin_bit_cast(float, g4[j] << 16); gv[2 * j + 1] = __builtin_bit_cast(float, g4[j] & 0xffff0000u);
                ss += ov[2 * j] * ov[2 * j] + ov[2 * j + 1] * ov[2 * j + 1]; }
            ss += __shfl_xor(ss, 1); ss += __shfl_xor(ss, 2); ss += __shfl_xor(ss, 4); ss += __shfl_xor(ss, 8);
            const float rstd = rsqrtf(ss * (1.f / 128.f) + 1e-6f);
            u32x4 w;
            w.x = cvt_pk_bf16(ov[0] * rstd * gn0[0] * gv[0], ov[1] * rstd * gn0[1] * gv[1]); w.y = cvt_pk_bf16(ov[2] * rstd * gn0[2] * gv[2], ov[3] * rstd * gn0[3] * gv[3]);
            w.z = cvt_pk_bf16(ov[4] * rstd * gn1[0] * gv[4], ov[5] * rstd * gn1[1] * gv[5]); w.w = cvt_pk_bf16(ov[6] * rstd * gn1[2] * gv[6], ov[7] * rstd * gn1[3] * gv[7]);
            *(u32x4*)gp_ = w;
        }
#if defined(PROF_ID)
        asm volatile("s_waitcnt vmcnt(0)" ::: "memory");
#endif
        __syncthreads(); PROF_END(5);
    } else {
        bf16_t* outs = dir ? outs1 : outs0; float* outd = dir ? outd1 : outd0;
        if (act) {
#pragma unroll
            for (int t4 = 0; t4 < 4; ++t4) {
                u32x4 a, b;
                a.x = cvt_pk_bf16(S[t4][0], S[t4][1]); a.y = cvt_pk_bf16(S[t4][2], S[t4][3]); a.z = cvt_pk_bf16(S[t4][4], S[t4][5]); a.w = cvt_pk_bf16(S[t4][6], S[t4][7]);
                b.x = cvt_pk_bf16(S[t4][8], S[t4][9]); b.y = cvt_pk_bf16(S[t4][10], S[t4][11]); b.z = cvt_pk_bf16(S[t4][12], S[t4][13]); b.w = cvt_pk_bf16(S[t4][14], S[t4][15]);
                u32x4* sp = (u32x4*)(outs + ((size_t)(wg * 4 + t4) * 64 + lane) * 16); sp[0] = a; sp[1] = b;
            }
            const int pp = 16 * wg + (lane & 15); if ((lane >> 4) == 0) { outd[2 * pp] = __builtin_amdgcn_exp2f(dsum0); outd[2 * pp + 1] = __builtin_amdgcn_exp2f(dsum1); }
        }
    }
}
__device__ __forceinline__ size_t slot_of(int dir, int b, int h, int sc) { return (size_t)((dir * 4 + b) * 8 + h) * 16 + sc; }

__device__ __forceinline__ void scan_phase_a(LAS unsigned char* lds, const ScanT& T, int G, int bx) {
    for (int it = bx; it < 512; it += G) {
        const int sc = it & 15, h = (it >> 4) & 7, b = it >> 7;
        const size_t sf = slot_of(0, b, h, sc < 15 ? sc + 1 : 0), sb = slot_of(1, b, h, sc > 0 ? sc - 1 : 0);
        scan_item<false>(lds, T, 4096 + b * 4096 + sc * 256, h, sc < 15, sc > 0, nullptr, nullptr, nullptr, nullptr, T.slots + sf * SLOT_ELEMS, T.slots + sb * SLOT_ELEMS, T.dvec + sf * 128, T.dvec + sb * 128);
    }
}
__device__ __forceinline__ void scan_phase_b(const ScanT& T, int G, int bx, int tid) {
    for (int gid = bx * NTHREADS + tid; gid < 64 * 2048; gid += G * NTHREADS) {
        const int combo = gid >> 11, e = (gid & 2047) * 8, dir = combo >> 5, b = (combo >> 3) & 3, h = combo & 7;
        const int reg0 = e & 15, ln = (e >> 4) & 63, t4 = (e >> 10) & 3, w = (e >> 12) & 3;
        const int v = 32 * w + (ln & 31);
        float s[8]; int kk[8];
#pragma unroll
        for (int j = 0; j < 8; ++j) { const int rg = reg0 + j; kk[j] = 32 * t4 + (rg & 3) + 8 * (rg >> 2) + 4 * (ln >> 5); s[j] = T.state_in[((size_t)((b * 2 + dir) * 8 + h) * 128 + kk[j]) * 128 + v]; }
        for (int st = 0; st < 16; ++st) {
            const int sc = dir ? 15 - st : st;
            const size_t sl = slot_of(dir, b, h, sc);
            u32x4* sp = (u32x4*)(T.slots + sl * SLOT_ELEMS + e);
            if (st > 0) {
                const u32x4 lw = *sp; const unsigned l4[4] = {lw.x, lw.y, lw.z, lw.w};
#pragma unroll
                for (int j = 0; j < 4; ++j) { s[2 * j] = T.dvec[sl * 128 + kk[2 * j]] * s[2 * j] + __builtin_bit_cast(float, l4[j] << 16);
                    s[2 * j + 1] = T.dvec[sl * 128 + kk[2 * j + 1]] * s[2 * j + 1] + __builtin_bit_cast(float, l4[j] & 0xffff0000u); }
            }
            u32x4 o; o.x = cvt_pk_bf16(s[0], s[1]); o.y = cvt_pk_bf16(s[2], s[3]); o.z = cvt_pk_bf16(s[4], s[5]); o.w = cvt_pk_bf16(s[6], s[7]);
            *sp = o;
        }
    }
}
__device__ __forceinline__ void scan_phase_c(LAS unsigned char* lds, const ScanT& T, int G, int bx) {
    for (int it = bx; it < 640; it += G) {
        if (it < 512) {
            const int sc = it & 15, h = (it >> 4) & 7, b = it >> 7;
            scan_item<true>(lds, T, 4096 + b * 4096 + sc * 256, h, true, true, T.slots + slot_of(0, b, h, sc) * SLOT_ELEMS, T.slots + slot_of(1, b, h, sc) * SLOT_ELEMS,
                            nullptr, nullptr, nullptr, nullptr, nullptr, nullptr);
        } else {
            const int h = (it - 512) & 7, b = (it - 512) >> 3;
            float* ns = T.new_state + (size_t)(b * 2) * 8 * 16384 + (size_t)h * 16384;
            scan_item<true>(lds, T, b * 256, h, true, true, nullptr, nullptr, ns, ns + (size_t)8 * 16384, nullptr, nullptr, nullptr, nullptr);
        }
    }
}


#define XB_TMO      128
#define XB_XCNT(j)  (256  + 64 * (j))
#define XB_XSUB(j)  (1280 + 64 * (j))
#define XB_XGEN(j)  (2304 + 64 * (j))
#define XB_TOP      3328
#define XB_TOPGEN   3392
#define XCD_BAR_WORDS 3456
#define XB_SPIN_CAP (1u << 18)
__device__ __forceinline__ unsigned xb_ld(unsigned* p)              { return __hip_atomic_load(p, __ATOMIC_RELAXED, __HIP_MEMORY_SCOPE_AGENT); }
__device__ __forceinline__ unsigned xb_add(unsigned* p, unsigned v) { return __hip_atomic_fetch_add(p, v, __ATOMIC_RELAXED, __HIP_MEMORY_SCOPE_AGENT); }
__device__ __forceinline__ unsigned xb_xcc_id() { return (unsigned)__builtin_amdgcn_s_getreg((3 << 11) | 20) & 0xFu; }
#define XB_SPIN(cond, bar) do { unsigned _sp = 0; while (cond) { __builtin_amdgcn_s_sleep(1); \
    if ((++_sp & 255u) == 0u) { if (xb_ld(&(bar)[XB_TMO])) break; if (_sp > XB_SPIN_CAP) { atomicAdd(&(bar)[XB_TMO], 1u); break; } } } } while (0)
struct XcdBarrier { unsigned* bar; unsigned x; volatile LAS unsigned* st; };
__device__ __forceinline__ XcdBarrier xcd_barrier_post(unsigned* bar, volatile LAS unsigned* st) {
    XcdBarrier b; b.bar = bar; b.x = xb_xcc_id(); b.st = st;
    if (threadIdx.x == 0) (void)xb_add(&bar[XB_XCNT(b.x)], 1u);
    return b;
}
__device__ __forceinline__ void xcd_barrier_complete(unsigned* bar, unsigned x, unsigned& nloc, unsigned& nx) {
    const unsigned G = gridDim.x * gridDim.y * gridDim.z;
    unsigned sum, cnt, mine, sp = 0u;
    for (;;) {
        sum = 0u; cnt = 0u; mine = 0u;
#pragma unroll
        for (unsigned j = 0; j < 16; ++j) { const unsigned c = xb_ld(&bar[XB_XCNT(j)]); sum += c; cnt += (c > 0u) ? 1u : 0u; mine = (j == x) ? c : mine; }
        if (sum == G) break;
        __builtin_amdgcn_s_sleep(1);
        if ((++sp & 255u) == 0u) { if (xb_ld(&bar[XB_TMO])) break; if (sp > XB_SPIN_CAP) { atomicAdd(&bar[XB_TMO], 1u); break; } }
    }
    nloc = mine > 0u ? mine : 1u; nx = cnt > 0u ? cnt : 1u;
}
__device__ __forceinline__ void xcd_barrier(const XcdBarrier& b) {
    asm volatile("s_waitcnt vmcnt(0)" ::: "memory");
    __syncthreads();
    if (threadIdx.x == 0) {
        unsigned* bar = b.bar;
        __builtin_amdgcn_s_waitcnt(0);
        unsigned nloc = b.st[0], nx = b.st[1];
        if (nloc == 0u) { xcd_barrier_complete(bar, b.x, nloc, nx); b.st[0] = nloc; b.st[1] = nx; }
        const unsigned old = xb_add(&bar[XB_XSUB(b.x)], 1u);
        const unsigned gen = old / nloc;
        if (old + 1u == (gen + 1u) * nloc) {
            __builtin_amdgcn_fence(__ATOMIC_RELEASE, "agent");
            asm volatile("s_waitcnt vmcnt(0)" ::: "memory");
            const unsigned og = xb_add(&bar[XB_TOP], 1u);
            const unsigned tg = og / nx;
            if (og + 1u == (tg + 1u) * nx) xb_add(&bar[XB_TOPGEN], 1u);
            else XB_SPIN(xb_ld(&bar[XB_TOPGEN]) == tg, bar);
            __builtin_amdgcn_fence(__ATOMIC_ACQUIRE, "agent");
            xb_add(&bar[XB_XGEN(b.x)], 1u);
            asm volatile("s_waitcnt vmcnt(0)" ::: "memory");
        } else {
            XB_SPIN(xb_ld(&bar[XB_XGEN(b.x)]) == gen, bar);
            __builtin_amdgcn_fence(__ATOMIC_ACQUIRE, "agent");
            asm volatile("s_waitcnt vmcnt(0)" ::: "memory");
        }
    }
    __syncthreads();
}

struct Args { const float* in[17]; float* out; unsigned char* ws; int ph_lo, ph_hi; };
enum { PH_PREP = 0, PH_EMBED = 1, PH_FN_CHAN = 2, PH_FN_POS1 = 3, PH_FN_POS2 = 4, PH_FN_WO = 5, PH_NORM_MLP0 = 6, PH_MLP1_0 = 7, PH_MLP2_0 = 8, PH_NORM_MIX1 = 9, PH_WIN = 10,
       PH_SCAN_A = 11, PH_SCAN_B = 12, PH_SCAN_C = 13, PH_HG_WO = 14, PH_NORM_MLP1 = 15, PH_MLP1_1 = 16, PH_MLP2_1 = 17, PH_FINAL = 18, PH_END = 19 };
constexpr int LDS_BYTES = 160 * 1024, MISC_OFF = LDS_BYTES - 512;

__global__ void __launch_bounds__(NTHREADS, 2) fwd(Args a) {
    extern __shared__ __attribute__((aligned(16))) unsigned char lds_raw[];
    LAS unsigned char* lds = (LAS unsigned char*)lds_raw;
    const int tid = threadIdx.x, lane = tid & 63, wave = __builtin_amdgcn_readfirstlane(tid >> 6);
    const int G = gridDim.x, bx = blockIdx.x;
    const int gw = bx * NWAVES + wave, ngw = G * NWAVES;
    unsigned char* ws = a.ws;
    const float* mod = (const float*)(ws + WM.mod);
    bf16_t* Hb = (bf16_t*)(ws + WM.h);
    bf16_t* Big = (bf16_t*)(ws + WM.big[0]); bf16_t* Big1 = (bf16_t*)(ws + WM.big[1]);
    const float* norm_mlp = a.in[8];
    const float* w1 = a.in[14]; const float* w2 = a.in[15];
    const float* norm_mix = a.in[7]; const float* fnet_wo = a.in[9];
    float* modw = (float*)(ws + WM.mod);
#define IN(k) (a.ph_lo <= (k) && (k) < a.ph_hi)
    if (tid < 128) ((LAS unsigned*)(lds + MISC_OFF))[tid] = 0u;
    __syncthreads();
    XcdBarrier bar = xcd_barrier_post((unsigned*)ws, (volatile LAS unsigned*)(lds + MISC_OFF));
#if defined(PROBE_A)
#define STAMP(k) do { if (bx == 0 && tid == 0) ((LAS unsigned long long*)(lds + MISC_OFF + 64))[(k)] = __builtin_amdgcn_s_memrealtime(); } while (0)
#else
#define STAMP(k) do { } while (0)
#endif
    STAMP(0);
#define SEAM(k) do { if (IN(k) && IN((k) + 1)) xcd_barrier(bar); STAMP((k) + 1); } while (0)
    if (IN(PH_PREP)) {
        LAS float* scr = (LAS float*)(lds + wave * 16384);
        constexpr int I_1 = (1024 / 64) * (4096 / 32), I_2 = (4096 / 64) * (1024 / 32);
        constexpr int I_F = (1024 / 64) * (1024 / 32), I_W = (1024 / 64) * (5120 / 32);
        constexpr int NITEMS = I_1 + I_2 + I_F + I_F + I_W;
        LAS unsigned char* prof_lds_ = (LAS unsigned char*)0; (void)prof_lds_; PROF_DECL; PROF_BEGIN();
        for (int un = bx; un < 384; un += G) mod_unit(lds, un, a.in[3], a.in[4], a.in[5], a.in[6], modw, tid, wave, lane);
        if (bx == G - 1) for (int i = tid; i < 2048; i += NTHREADS) { const int dir = i >> 10, ch = i & 1023; const float l0 = a.in[11][(dir * 2 + 0) * 1024 + ch], l1 = a.in[11][(dir * 2 + 1) * 1024 + ch];
            const float mx = fmaxf(l0, l1), e0 = __expf(l0 - mx), e1 = __expf(l1 - mx); ((float*)(ws + WM.lb))[i] = e1 / (e0 + e1); }
        PROF_END(60); PROF_BEGIN();
        gen_tables(ws, (long)bx * NTHREADS + tid, (long)G * NTHREADS);
        PROF_END(61); PROF_BEGIN();
        transpose_stream(gw, NITEMS, ngw, [&](int it) -> TrItem {
            int r = it;
            if (r < I_F) return TrItem{fnet_wo, (bf16_t*)(ws + WM.wfnet), 1024, 1024, r}; r -= I_F;
            if (r < I_F) return TrItem{a.in[13], (bf16_t*)(ws + WM.who), 1024, 1024, r}; r -= I_F;
            if (r < I_W) return TrItem{a.in[10], (bf16_t*)(ws + WM.win), 1024, 5120, r}; r -= I_W;
            if (r < I_1) return TrItem{w1, (bf16_t*)(ws + WM.w1[0]), 1024, 4096, r}; r -= I_1;
            return TrItem{w2, (bf16_t*)(ws + WM.w2[0]), 4096, 1024, r}; }, scr, lane);
        PROF_END(62);
    }
    SEAM(PH_PREP);
    if (IN(PH_EMBED)) embed_rows(a.in[0], a.in[1], (const float*)(ws + WM.pos), (const float*)(ws + WM.pos) + 64 * 512, norm_mix, mod, Hb, gw, ngw, lane);
    SEAM(PH_EMBED);
    if (IN(PH_FN_CHAN)) {
        { ProbChan p; p.init(0, ws + WM.dftc, Hb, (bf16_t*)(ws + WM.yctx), G, bx); gemm_phase<ProbChan, true, true>(lds, p); }
        { ProbChan p; p.init(1, ws + WM.dftc, Hb, (bf16_t*)(ws + WM.ysmp), G, bx); gemm_phase<ProbChan, true, true>(lds, p); }
    }
    SEAM(PH_FN_CHAN);
    if (IN(PH_FN_POS1)) {
        { ProbPosCtx p; p.init(ws + WM.dl256, (const bf16_t*)(ws + WM.yctx), Hb, G, bx); gemm_phase<ProbPosCtx, true, true>(lds, p); }
        { ProbSmpA p; p.init(ws + WM.fa2, (const bf16_t*)(ws + WM.ysmp), (bf16_t*)(ws + WM.u), G, bx); gemm_phase<ProbSmpA, true, true>(lds, p); }
    }
    SEAM(PH_FN_POS1);
    if (IN(PH_FN_POS2)) { ProbSmpB p; p.init(ws + WM.mb, (const bf16_t*)(ws + WM.u), Hb, G, bx); gemm_phase<ProbSmpB, true, true>(lds, p); }
    SEAM(PH_FN_POS2);
    if (IN(PH_FN_WO)) { ProbResidFirst p; p.init_tok(Hb, 1024, ws + WM.wfnet, 1024, 0, 80, 4, G, bx); p.X = (bf16_t*)a.out; p.mod = mod; p.layer = 0; p.gidx = 2; p.init_split(G, bx, (unsigned short*)(ws + SLAB_FN)); p.xp = a.in[0]; p.xs = a.in[1]; p.er = (const float*)(ws + WM.pos); p.ec = p.er + 64 * 512; p.prof_id = 20; gemm_phase<ProbResidFirst, true, true>(lds, p); }
    SEAM(PH_FN_WO);
    if (IN(PH_NORM_MLP0)) { build_split_table(lds, G, tid); norm_rows((bf16_t*)a.out, 0, 20480, norm_mlp, mod, 0, 3, Hb, gw, ngw, lane, lds, (const unsigned short*)(ws + SLAB_FN)); }
    SEAM(PH_NORM_MLP0);
    if (IN(PH_MLP1_0)) { ProbMlp1 p; p.init_tok(Hb, 1024, ws + WM.w1[0], 1024, 0, 80, 4096 / BM, G, bx); p.O = Big; p.ldc = 4096; p.prof_id = 40; gemm_phase<ProbMlp1, true, true>(lds, p); }
    SEAM(PH_MLP1_0);
    if (IN(PH_MLP2_0)) { ProbResid p; p.init_tok(Big, 4096, ws + WM.w2[0], 4096, 0, 80, 1024 / BM, G, bx); p.X = (bf16_t*)a.out; p.mod = mod; p.layer = 0; p.gidx = 5; p.init_split(G, bx, (unsigned short*)(ws + SLAB_M0)); gemm_phase<ProbResid, true, true>(lds, p); }
    SEAM(PH_MLP2_0);
    if (IN(PH_NORM_MIX1)) { build_split_table(lds, G, tid); norm_rows((bf16_t*)a.out, 0, 20480, norm_mix + 1024, mod, 1, 0, Hb, gw, ngw, lane, lds, (const unsigned short*)(ws + SLAB_M0)); }
    SEAM(PH_NORM_MIX1);
    if (IN(PH_WIN)) { ProbWin p; p.init_tok(Hb, 1024, ws + WM.win, 1024, 0, 80, 20, G, bx); p.Oq = (bf16_t*)(ws + WM.q); p.Offw = (bf16_t*)(ws + WM.lffw); p.Ofbw = (bf16_t*)(ws + WM.lfbw);
        p.Ov = (bf16_t*)(ws + WM.v); p.Osg = (bf16_t*)(ws + WM.sg); p.lb = (const float*)(ws + WM.lb); p.prof_id = 50; gemm_phase<ProbWin, true, true>(lds, p); }
    SEAM(PH_WIN);
    if (IN(PH_SCAN_A) || IN(PH_SCAN_B) || IN(PH_SCAN_C)) {
        ScanT st; st.q = (const bf16_t*)(ws + WM.q); st.lffw = (const bf16_t*)(ws + WM.lffw); st.lfbw = (const bf16_t*)(ws + WM.lfbw); st.v = (const bf16_t*)(ws + WM.v); st.sg = (bf16_t*)(ws + WM.sg);
        st.slots = (bf16_t*)(ws + WM.slots); st.dvec = (float*)(ws + WM.dvec); st.gnorm = a.in[12]; st.state_in = a.in[2]; st.new_state = a.out + (size_t)20480 * 1024;
        if (IN(PH_SCAN_A)) scan_phase_a(lds, st, G, bx);
        SEAM(PH_SCAN_A);
        if (IN(PH_SCAN_B)) scan_phase_b(st, G, bx, tid);
        SEAM(PH_SCAN_B);
        if (IN(PH_SCAN_C)) scan_phase_c(lds, st, G, bx);
    }
    SEAM(PH_SCAN_C);
    if (IN(PH_HG_WO)) {
        { LAS float* scr = (LAS float*)(lds + wave * 16384);
          constexpr int I_1 = (1024 / 64) * (4096 / 32), I_2 = (4096 / 64) * (1024 / 32);
          transpose_stream(gw, I_1 + I_2, ngw, [&](int it) -> TrItem {
              if (it < I_1) return TrItem{w1 + (size_t)1024 * 4096, (bf16_t*)(ws + WM.w1[1]), 1024, 4096, it};
              return TrItem{w2 + (size_t)4096 * 1024, (bf16_t*)(ws + WM.w2[1]), 4096, 1024, it - I_1}; }, scr, lane);
          __syncthreads(); }
        ProbResid p; p.init_tok((bf16_t*)(ws + WM.sg), 1024, ws + WM.who, 1024, 0, 80, 4, G, bx); p.X = (bf16_t*)a.out; p.mod = mod; p.layer = 1; p.gidx = 2; p.init_split(G, bx, (unsigned short*)(ws + SLAB_HG)); gemm_phase<ProbResid, true, true>(lds, p); }
    SEAM(PH_HG_WO);
    if (IN(PH_NORM_MLP1)) { build_split_table(lds, G, tid); norm_rows((bf16_t*)a.out, 0, 20480, norm_mlp + 1024, mod, 1, 3, Hb, gw, ngw, lane, lds, (const unsigned short*)(ws + SLAB_HG)); }
    SEAM(PH_NORM_MLP1);
    if (IN(PH_MLP1_1)) { ProbMlp1 p; p.init_tok(Hb, 1024, ws + WM.w1[1], 1024, 0, 80, 4096 / BM, G, bx); p.O = Big1; p.ldc = 4096; gemm_phase<ProbMlp1, true, true>(lds, p); }
    SEAM(PH_MLP1_1);
    if (IN(PH_MLP2_1)) { ProbResid p; p.init_tok(Big1, 4096, ws + WM.w2[1], 4096, 0, 80, 1024 / BM, G, bx); p.X = (bf16_t*)a.out; p.mod = mod; p.layer = 1; p.gidx = 5; p.init_split(G, bx, (unsigned short*)(ws + SLAB_M1)); gemm_phase<ProbResid, true, true>(lds, p); }
    SEAM(PH_MLP2_1);
    if (IN(PH_FINAL)) { build_split_table(lds, G, tid); final_rows(a.out, 0, 20480, a.in[16], gw, ngw, lane, lds, (const unsigned short*)(ws + SLAB_M1)); }
#if defined(PROF_ID)
    if (bx == 0 && tid == 0) { const unsigned long long d = *(LAS unsigned long long*)(lds + LDS_BYTES - 512 + 256); const unsigned long long t0 = __builtin_amdgcn_s_memrealtime(); while (__builtin_amdgcn_s_memrealtime() - t0 < 16ull * d) __builtin_amdgcn_s_sleep(8); }
#endif
#if defined(PROBE_A)
    if (bx == 0 && tid == 0) { asm volatile("s_waitcnt vmcnt(0)" ::: "memory"); STAMP(PH_END); const unsigned long long d = ((LAS unsigned long long*)(lds + MISC_OFF + 64))[PROBE_B] - ((LAS unsigned long long*)(lds + MISC_OFF + 64))[PROBE_A];
        const unsigned long long t0 = __builtin_amdgcn_s_memrealtime(); while (__builtin_amdgcn_s_memrealtime() - t0 < 4ull * d) __builtin_amdgcn_s_sleep(8); }
#endif
#undef IN
}
}
#ifndef MK_N_LAUNCHES
#define MK_N_LAUNCHES 1
#endif
extern "C" void kernel_launch(void* const* d_in, const int* in_sizes, int n_in, void* d_out, int out_size, void* d_ws, size_t ws_size, hipStream_t stream) {
    static int grid = 0;
    if (grid == 0) {
        int dev = 0, cus = 0;
        if (hipGetDevice(&dev) != hipSuccess || hipDeviceGetAttribute(&cus, hipDeviceAttributeMultiprocessorCount, dev) != hipSuccess || cus <= 0) cus = 256;
        hipFuncSetAttribute((const void*)fk::fwd, hipFuncAttributeMaxDynamicSharedMemorySize, fk::LDS_BYTES);
        int per_cu = 0;
        if (hipOccupancyMaxActiveBlocksPerMultiprocessor(&per_cu, (const void*)fk::fwd, fk::NTHREADS, fk::LDS_BYTES) != hipSuccess || per_cu < 1)
            fprintf(stderr, "kernel_launch: occupancy query reports %d workgroups per CU\n", per_cu);
        (void)hipGetLastError();
        grid = cus;
    }
    hipMemsetAsync(d_ws, 0, fk::CTL_BYTES, stream);
    fk::Args a{};
    for (int i = 0; i < 17; ++i) a.in[i] = (const float*)d_in[i];
    a.out = (float*)d_out; a.ws = (unsigned char*)d_ws;
#if MK_N_LAUNCHES == 1
    a.ph_lo = 0; a.ph_hi = fk::PH_END;
    hipLaunchKernelGGL(fk::fwd, dim3(grid), dim3(fk::NTHREADS), fk::LDS_BYTES, stream, a);
#else
    for (int ph = 0; ph < fk::PH_END; ++ph) { a.ph_lo = ph; a.ph_hi = ph + 1; hipLaunchKernelGGL(fk::fwd, dim3(grid), dim3(fk::NTHREADS), fk::LDS_BYTES, stream, a); }
#endif
}
```

```cpp
#include <hip/hip_runtime.h>
#include <cstdint>
#include <cstdio>
namespace fk {
#define LAS __attribute__((address_space(3)))
#define GAS __attribute__((address_space(1)))
typedef unsigned short bf16_t;
typedef short bf16x8 __attribute__((ext_vector_type(8)));
typedef float f32x4 __attribute__((ext_vector_type(4)));
typedef float f32x2 __attribute__((ext_vector_type(2)));
typedef unsigned u32x4 __attribute__((ext_vector_type(4)));
typedef unsigned u32x2 __attribute__((ext_vector_type(2)));
constexpr int BM = 256, BK = 64, HALF = 128, HTB = HALF * BK * 2, STAGE_BYTES = 8 * HTB, NXCD = 8, WGM = 8;
constexpr int NWAVES = 8, NTHREADS = 512;

__device__ __forceinline__ int lds_byte(int r, int c) { const int st = (r >> 4) * 2 + (c >> 5), rr = r & 15, cc = c & 31, ob = rr * 64 + cc * 2; return st * 1024 + (ob ^ (((ob >> 9) & 1) << 5)); }
__device__ __forceinline__ void stage_rc(int b, int& R, int& C) { const int st = b / 1024, sb = b % 1024, swz = sb ^ (((sb >> 9) & 1) << 5); R = (st >> 1) * 16 + swz / 64; C = (st & 1) * 32 + (swz % 64) / 2; }
__device__ __forceinline__ int perm32(int rho) { const int n = rho >> 4, i = rho & 15; return 8 * (i >> 2) + 4 * n + (i & 3); }
__device__ __forceinline__ unsigned cvt_pk_bf16(float lo, float hi) { unsigned r; asm volatile("v_cvt_pk_bf16_f32 %0, %1, %2" : "=v"(r) : "v"(lo), "v"(hi)); return r; }
__device__ __forceinline__ unsigned f2bf(float f) { unsigned u = __builtin_bit_cast(unsigned, f); return (u + 0x7fffu + ((u >> 16) & 1u)) >> 16; }
__device__ __forceinline__ unsigned pk2(float lo, float hi) { return f2bf(lo) | (f2bf(hi) << 16); }
__device__ __forceinline__ float bf2f(unsigned short b) { return __builtin_bit_cast(float, (unsigned)b << 16); }
__device__ __forceinline__ unsigned pk2h(float lo, float hi) { const _Float16 a = (_Float16)lo, b = (_Float16)hi; return (unsigned)__builtin_bit_cast(unsigned short, a) | ((unsigned)__builtin_bit_cast(unsigned short, b) << 16); }
__device__ __forceinline__ float h2f_(unsigned short b) { return (float)__builtin_bit_cast(_Float16, b); }
__device__ __forceinline__ f32x4 ld_bf4(const void* p) { const u32x2 w = *(const u32x2*)p; return (f32x4){__builtin_bit_cast(float, w.x << 16), __builtin_bit_cast(float, w.x & 0xffff0000u), __builtin_bit_cast(float, w.y << 16), __builtin_bit_cast(float, w.y & 0xffff0000u)}; }
__device__ __forceinline__ void st_bf4(void* p, const f32x4& v) { u32x2 w; w.x = cvt_pk_bf16(v[0], v[1]); w.y = cvt_pk_bf16(v[2], v[3]); *(u32x2*)p = w; }
__device__ __forceinline__ float silu(float x) { return x / (1.f + __expf(-x)); }
__device__ __forceinline__ float wave_sum(float v) {
#pragma unroll
    for (int o = 1; o < 64; o <<= 1) v += __shfl_xor(v, o);
    return v;
}

constexpr unsigned long long KiB = 1024ull, MiB = 1ull << 20;
struct WsMapT { unsigned long long slots, dvec, lb, q, lffw, lfbw, v, sg, mod, pos, dftc, dl256, fa2, mb, wfnet, who, win, w1[2], w2[2], h, yctx, ysmp, u, big[2]; };
constexpr WsMapT WM = {   13 * MiB,   45 * MiB,   320 * KiB,   53 * MiB,   93 * MiB,   133 * MiB,   173 * MiB,   213 * MiB,   64 * KiB,   512 * KiB,
      53 * MiB,   53 * MiB + 256 * KiB,   53 * MiB + 512 * KiB,   54 * MiB,   59 * MiB,   1 * MiB,   3 * MiB,   {61 * MiB, 53 * MiB},   {237 * MiB, 61 * MiB},
      13 * MiB,   77 * MiB,   93 * MiB,   157 * MiB,   {77 * MiB, 69 * MiB} };
constexpr unsigned long long SLAB_FN = 77 * MiB, SLAB_M0 = 53 * MiB, SLAB_HG = 69 * MiB, SLAB_M1 = 13 * MiB;
constexpr unsigned long long CTL_BYTES = 16 * KiB;
#if defined(PROF_ID)
#define PROF_DECL unsigned long long prof_t0_ = 0ull; const bool prof_on_ = (blockIdx.x == 0) && (__builtin_amdgcn_readfirstlane(threadIdx.x >> 6) == 0)
#define PROF_BEGIN() do { if (prof_on_) prof_t0_ = __builtin_amdgcn_s_memrealtime(); } while (0)
#define PROF_END(id) do { if (prof_on_ && (id) == PROF_ID) { const unsigned long long d_ = __builtin_amdgcn_s_memrealtime() - prof_t0_; if (threadIdx.x == 0) *(LAS unsigned long long*)(prof_lds_ + 160 * 1024 - 512 + 256) += d_; } } while (0)
#else
#define PROF_DECL
#define PROF_BEGIN() do { } while (0)
#define PROF_END(id) do { } while (0)
#endif

struct Unit { size_t offA, offB; int p0, p1, p2, p3, nt; };
struct OpMap { int rm; unsigned s1, s2; };
__device__ __forceinline__ unsigned rowoff(const OpMap& m, int R) { return (unsigned)(R % m.rm) * m.s1 + (unsigned)(R / m.rm) * m.s2; }

template <class P, bool ALIGN_EPI, bool SP2>
__device__ __forceinline__ void gemm_phase(LAS unsigned char* lds, const P& pb) {
    const int tid = threadIdx.x, wid = __builtin_amdgcn_readfirstlane(tid >> 6), lane = tid & 63, wr = wid >> 2, wc = wid & 3, fr = lane & 15, fq = lane >> 4;
    unsigned voffA[2], voffB[2];
#pragma unroll
    for (int i = 0; i < 2; ++i) { int R, C; stage_rc(tid * 16 + i * 8192, R, C); const int Rb = P::PERM ? ((R & ~31) + perm32(R & 31)) : R;
        voffA[i] = rowoff(pb.ma, R) + (unsigned)C * 2u; voffB[i] = rowoff(pb.mb, Rb) + (unsigned)C * 2u; }
    const size_t kstepA = pb.kstepA, kstepB = pb.kstepB, hstepA = pb.hstepA, hstepB = pb.hstepB;
    const unsigned ldsw = (unsigned)wid * 1024u;
    const int aoff = lds_byte(wr * 64 + fr, fq * 8), boff = lds_byte(wc * 32 + fr, fq * 8);
#define PG8_SA(b, h) (((b) * 2 + (h)) * HTB)
#define PG8_SB(b, h) ((4 + (b) * 2 + (h)) * HTB)
#define PG8_STAGE(bufoff, gbase, voff) do { _Pragma("unroll") for (int _i = 0; _i < 2; ++_i) \
        __builtin_amdgcn_global_load_lds((const unsigned*)((const char*)(gbase) + (voff)[_i]), (LAS unsigned*)(lds + (bufoff) + ldsw + _i * 8192), 16, 0, 0); } while (0)
#define PG8_LDA(dst, b, h) do { _Pragma("unroll") for (int m = 0; m < 4; ++m) _Pragma("unroll") for (int k = 0; k < 2; ++k) dst[m][k] = *(const LAS bf16x8*)(lds + PG8_SA(b, h) + aoff + m * 2048 + k * 1024); } while (0)
#define PG8_LDB(dst, b, h) do { _Pragma("unroll") for (int n = 0; n < 2; ++n) _Pragma("unroll") for (int k = 0; k < 2; ++k) dst[n][k] = *(const LAS bf16x8*)(lds + PG8_SB(b, h) + boff + n * 2048 + k * 1024); } while (0)
#define PG8_MMA(ai, bj, At, Bt) do { __builtin_amdgcn_s_setprio(1); _Pragma("unroll") for (int m = 0; m < 4; ++m) _Pragma("unroll") for (int n = 0; n < 2; ++n) _Pragma("unroll") for (int k = 0; k < 2; ++k) \
        acc[ai][bj][m][n] = __builtin_amdgcn_mfma_f32_16x16x32_bf16(Bt[n][k], At[m][k], acc[ai][bj][m][n], 0, 0, 0); __builtin_amdgcn_s_setprio(0); } while (0)
#define PG8_WAIT_V(n) asm volatile("s_waitcnt vmcnt(" #n ")" ::: "memory")
#define PG8_WAIT_L(n) asm volatile("s_waitcnt lgkmcnt(" #n ")" ::: "memory")
#define PG8_BAR __builtin_amdgcn_s_barrier()
#define PG8_SCHED __builtin_amdgcn_sched_barrier(0)
    LAS unsigned char* prof_lds_ = (LAS unsigned char*)0; (void)prof_lds_; PROF_DECL; PROF_BEGIN();
    Unit cur, nxt; int ui = 0;
    if (!pb.next(0, cur)) return;
    f32x4 acc[2][2][4][2];
#pragma unroll
    for (int a = 0; a < 2; ++a)
#pragma unroll
        for (int b = 0; b < 2; ++b)
#pragma unroll
            for (int m = 0; m < 4; ++m)
#pragma unroll
                for (int n = 0; n < 2; ++n) acc[a][b][m][n] = (f32x4){0.f, 0.f, 0.f, 0.f};
    bf16x8 At[4][2], B0[2][2], B1[2][2];
    const char* cA = pb.A + cur.offA; const char* cB = pb.B + cur.offB;
    if constexpr (SP2) {
        PG8_STAGE(PG8_SB(0, 0), cB, voffB); PG8_STAGE(PG8_SB(0, 1), cB + hstepB, voffB); PG8_STAGE(PG8_SA(0, 0), cA, voffA); PG8_STAGE(PG8_SA(0, 1), cA + hstepA, voffA);
        if (wr == 1) PG8_BAR;
        PG8_WAIT_V(2); PG8_BAR;
        PG8_STAGE(PG8_SB(1, 0), cB + kstepB, voffB); PG8_STAGE(PG8_SA(1, 0), cA + kstepA, voffA); PG8_STAGE(PG8_SB(1, 1), cB + hstepB + kstepB, voffB);
        PG8_WAIT_V(6); PG8_BAR;
    } else {
        PG8_STAGE(PG8_SB(0, 0), cB, voffB); PG8_STAGE(PG8_SA(0, 0), cA, voffA); PG8_STAGE(PG8_SB(0, 1), cB + hstepB, voffB); PG8_STAGE(PG8_SA(0, 1), cA + hstepA, voffA);
        if (wr == 1) PG8_BAR;
        PG8_WAIT_V(4); PG8_BAR;
        PG8_STAGE(PG8_SB(1, 0), cB + kstepB, voffB); PG8_STAGE(PG8_SA(1, 0), cA + kstepA, voffA); PG8_STAGE(PG8_SB(1, 1), cB + hstepB + kstepB, voffB);
        PG8_WAIT_V(6); PG8_BAR;
    }
    for (;;) {
        const bool has_next = pb.next(ui + 1, nxt);
        const char* nA = has_next ? pb.A + nxt.offA : cA; const char* nB = has_next ? pb.B + nxt.offB : cB;
        const int nt = cur.nt;
        for (int t = 0; t < nt; t += 2) {
            const bool last = (t == nt - 2);
            const char* a1 = cA + (size_t)(t + 1) * kstepA;
            const char* a2 = last ? nA : cA + (size_t)(t + 2) * kstepA; const char* b2 = last ? nB : cB + (size_t)(t + 2) * kstepB;
            const char* a3 = a2 + kstepA; const char* b3 = b2 + kstepB;
            if constexpr (SP2) {
            PG8_LDB(B0, 0, 0); PG8_LDB(B1, 0, 1); PG8_SCHED; PG8_LDA(At, 0, 0); PG8_STAGE(PG8_SA(1, 1), a1 + hstepA, voffA);
            PG8_WAIT_V(8); PG8_WAIT_L(0); PG8_BAR; PG8_MMA(0, 0, At, B0); PG8_MMA(0, 1, At, B1); PG8_BAR; PG8_SCHED;
            PG8_LDA(At, 0, 1); PG8_STAGE(PG8_SB(0, 0), b2, voffB); PG8_STAGE(PG8_SB(0, 1), b2 + hstepB, voffB); PG8_STAGE(PG8_SA(0, 0), a2, voffA);
            PG8_WAIT_V(8); PG8_WAIT_L(0); PG8_BAR; PG8_MMA(1, 0, At, B0); PG8_MMA(1, 1, At, B1); PG8_BAR; PG8_SCHED;
            PG8_LDB(B0, 1, 0); PG8_LDB(B1, 1, 1); PG8_SCHED; PG8_LDA(At, 1, 0); PG8_STAGE(PG8_SA(0, 1), a2 + hstepA, voffA);
            PG8_WAIT_V(8); PG8_WAIT_L(0); PG8_BAR; PG8_MMA(0, 0, At, B0); PG8_MMA(0, 1, At, B1); PG8_BAR; PG8_SCHED;
            PG8_LDA(At, 1, 1); PG8_STAGE(PG8_SB(1, 0), b3, voffB); PG8_STAGE(PG8_SB(1, 1), b3 + hstepB, voffB); PG8_STAGE(PG8_SA(1, 0), a3, voffA);
            PG8_WAIT_V(8); PG8_WAIT_L(0); PG8_BAR; PG8_MMA(1, 0, At, B0); PG8_MMA(1, 1, At, B1); PG8_BAR; PG8_SCHED;
            } else {
            PG8_LDB(B0, 0, 0); PG8_SCHED; PG8_LDA(At, 0, 0); PG8_STAGE(PG8_SA(1, 1), a1 + hstepA, voffA);
            PG8_WAIT_L(8); PG8_BAR; PG8_WAIT_L(0); PG8_MMA(0, 0, At, B0); PG8_BAR; PG8_SCHED;
            PG8_LDB(B1, 0, 1); PG8_STAGE(PG8_SB(0, 0), b2, voffB);
            PG8_BAR; PG8_WAIT_L(0); PG8_MMA(0, 1, At, B1); PG8_BAR;
            PG8_LDA(At, 0, 1); PG8_STAGE(PG8_SA(0, 0), a2, voffA);
            PG8_BAR; PG8_WAIT_L(0); PG8_MMA(1, 0, At, B0); PG8_BAR; PG8_SCHED;
            PG8_STAGE(PG8_SB(0, 1), b2 + hstepB, voffB);
            PG8_WAIT_V(6); PG8_BAR; PG8_MMA(1, 1, At, B1); PG8_BAR;
            PG8_LDB(B0, 1, 0); PG8_SCHED; PG8_LDA(At, 1, 0); PG8_STAGE(PG8_SA(0, 1), a2 + hstepA, voffA);
            PG8_WAIT_L(8); PG8_BAR; PG8_WAIT_L(0); PG8_MMA(0, 0, At, B0); PG8_BAR; PG8_SCHED;
            PG8_LDB(B1, 1, 1); PG8_STAGE(PG8_SB(1, 0), b3, voffB);
            PG8_BAR; PG8_WAIT_L(0); PG8_MMA(0, 1, At, B1); PG8_BAR;
            PG8_LDA(At, 1, 1); PG8_STAGE(PG8_SA(1, 0), a3, voffA);
            PG8_BAR; PG8_WAIT_L(0); PG8_MMA(1, 0, At, B0); PG8_BAR; PG8_SCHED;
            PG8_STAGE(PG8_SB(1, 1), b3 + hstepB, voffB);
            PG8_WAIT_V(6); PG8_BAR; PG8_MMA(1, 1, At, B1); PG8_BAR;
            }
        }
        if constexpr (ALIGN_EPI) { if (wr == 0) PG8_BAR; }
        PROF_END(pb.prof_id); PROF_BEGIN();
        pb.epi(acc, cur, wr, wc, fr, fq);
#if defined(PROF_ID)
        asm volatile("s_waitcnt vmcnt(0)" ::: "memory");
#endif
        PROF_END(pb.prof_id + 1); PROF_BEGIN();
        if (!has_next) break;
#pragma unroll
        for (int a = 0; a < 2; ++a)
#pragma unroll
            for (int b = 0; b < 2; ++b)
#pragma unroll
                for (int m = 0; m < 4; ++m)
#pragma unroll
                    for (int n = 0; n < 2; ++n) acc[a][b][m][n] = (f32x4){0.f, 0.f, 0.f, 0.f};
        cur = nxt; cA = nA; cB = nB; ++ui;
        if constexpr (ALIGN_EPI) { if (wr == 1) PG8_BAR; }
    }
    PG8_WAIT_V(0);
    if constexpr (!ALIGN_EPI) { if (wr == 0) PG8_BAR; }
    PG8_BAR;
#undef PG8_SA
#undef PG8_SB
#undef PG8_STAGE
#undef PG8_LDA
#undef PG8_LDB
#undef PG8_MMA
#undef PG8_WAIT_V
#undef PG8_WAIT_L
#undef PG8_BAR
#undef PG8_SCHED
}

struct StaticOrder {
    int nM, nN, nwg, G, c;
    __device__ void init(int nM_, int nN_, int G_, int c_) { nM = nM_; nN = nN_; nwg = nM * nN; G = G_; c = c_; }
    __device__ bool next(int i, int& pm, int& pn) const { const long L = (long)i * G + c; if (L >= nwg) return false; map((int)L, pm, pn); return true; }
    __device__ void map(int L, int& pm, int& pn) const {
        int wgid = L; { const int q = nwg / NXCD, r = nwg % NXCD, xcd = wgid % NXCD, off = wgid / NXCD; wgid = (xcd < r ? xcd * (q + 1) : r * (q + 1) + (xcd - r) * q) + off; }
        const int nig = WGM * nN, gid = wgid / nig, fm = gid * WGM, gsz = (nM - fm) < WGM ? (nM - fm) : WGM;
        pm = fm + ((wgid % nig) % gsz); pn = (wgid % nig) / gsz;
    }
};

struct ProbBase {
    const char* A; const char* B; OpMap ma, mb; size_t hstepA, hstepB, kstepA, kstepB; int nt; int prof_id = -100;
    __device__ void std_operands(const void* A_, int lda, const void* B_, int ldb, int K) {
        A = (const char*)A_; B = (const char*)B_; ma = OpMap{128, (unsigned)lda * 2u, 0u}; mb = OpMap{128, (unsigned)ldb * 2u, 0u};
        hstepA = (size_t)HALF * lda * 2; hstepB = (size_t)HALF * ldb * 2; kstepA = kstepB = BK * 2; nt = K / BK;
    }
};

template <class F> __device__ __forceinline__ void epi_rows_perm(const f32x4 (&acc)[2][2][4][2], int wr, int wc, int fr, int fq, F f) {
    asm volatile("" : "+v"(fr), "+v"(fq));
#pragma unroll
    for (int ai = 0; ai < 2; ++ai)
#pragma unroll
        for (int m = 0; m < 4; ++m)
#pragma unroll
            for (int bj = 0; bj < 2; ++bj) f(ai * HALF + wr * 64 + m * 16 + fr, bj * HALF + wc * 32 + 8 * fq, acc[ai][bj][m][0], acc[ai][bj][m][1]);
}
template <class F> __device__ __forceinline__ void epi_rows_f32(const f32x4 (&acc)[2][2][4][2], int wr, int wc, int fr, int fq, F f) {
    asm volatile("" : "+v"(fr), "+v"(fq));
#pragma unroll
    for (int ai = 0; ai < 2; ++ai)
#pragma unroll
        for (int m = 0; m < 4; ++m)
#pragma unroll
            for (int bj = 0; bj < 2; ++bj)
#pragma unroll
                for (int n = 0; n < 2; ++n) f(ai * HALF + wr * 64 + m * 16 + fr, bj * HALF + wc * 32 + 16 * n + 4 * fq, acc[ai][bj][m][n]);
}
__device__ __forceinline__ u32x4 pack8(const f32x4& v0, const f32x4& v1) { u32x4 w; w.x = cvt_pk_bf16(v0[0], v0[1]); w.y = cvt_pk_bf16(v0[2], v0[3]); w.z = cvt_pk_bf16(v1[0], v1[1]); w.w = cvt_pk_bf16(v1[2], v1[3]); return w; }

struct TokOrder : ProbBase {
    StaticOrder so; int row0, lda, ldb;
    __device__ void init_tok(const void* Act, int lda_, const void* Wt, int K, int row0_, int nM, int nN, int G, int c) { std_operands(Act, lda_, Wt, K, K); row0 = row0_; lda = lda_; ldb = K; so.init(nM, nN, G, c); }
    __device__ bool next(int i, Unit& u) const { int pm, pn; if (!so.next(i, pm, pn)) return false; u.p0 = pm; u.p1 = pn; u.p2 = -1; u.nt = nt; u.offA = (size_t)(row0 + pm * BM) * lda * 2; u.offB = (size_t)pn * BM * ldb * 2; return true; }
};
struct ProbMlp1 : TokOrder {
    static constexpr bool PERM = true;
    bf16_t* O; int ldc;
    __device__ __forceinline__ void epi(const f32x4 (&acc)[2][2][4][2], const Unit& u, int wr, int wc, int fr, int fq) const {
        bf16_t* base = O + (size_t)(row0 + u.p0 * BM) * ldc + u.p1 * BM;
        epi_rows_perm(acc, wr, wc, fr, fq, [&](int r, int c, f32x4 v0, f32x4 v1) {
#pragma unroll
            for (int j = 0; j < 4; ++j) { const float a = fmaxf(v0[j], 0.f), b = fmaxf(v1[j], 0.f); v0[j] = a * a; v1[j] = b * b; }
            *(u32x4*)(base + (size_t)r * ldc + c) = pack8(v0, v1); });
    }
};
template <bool FIRST> struct ProbResidT : TokOrder {
    static constexpr bool PERM = false;
    bf16_t* X; const float* mod; int layer, gidx; unsigned short* slab; int G2, c2;
    const float* xp; const float* xs; const float* er; const float* ec;
    __device__ void init_split(int G_, int c_, unsigned short* slab_) { G2 = G_; c2 = c_; slab = slab_; xp = nullptr; xs = nullptr; er = nullptr; ec = nullptr; }
    __device__ bool next(int i, Unit& u) const {
        if (G2 != 256) return TokOrder::next(i, u);
        int pm, pn;
        if (i > 1) return false;
        const int which = (c2 & 1) ? 1 - i : i;
        if (which == 0) { so.map(c2, pm, pn); u.p2 = -1; u.p3 = 0; u.nt = nt; u.offA = (size_t)(row0 + pm * BM) * lda * 2; u.offB = (size_t)pn * BM * ldb * 2; }
        else { const int L = 256 + (c2 >> 2), kq = c2 & 3, ntq = nt >> 2; so.map(L, pm, pn); u.p2 = kq; u.p3 = L - 256; u.nt = ntq;
            u.offA = (size_t)(row0 + pm * BM) * lda * 2 + (size_t)kq * ntq * BK * 2; u.offB = (size_t)pn * BM * ldb * 2 + (size_t)kq * ntq * BK * 2; }
        u.p0 = pm; u.p1 = pn; return true;
    }
    __device__ __forceinline__ void epi(const f32x4 (&acc)[2][2][4][2], const Unit& u, int wr, int wc, int fr, int fq) const {
        asm volatile("" : "+v"(fr), "+v"(fq));
        const int rowt = row0 + u.p0 * BM, cond = rowt >> 12, colt = u.p1 * BM;
        const float* gate = mod + ((size_t)(cond * 2 + layer) * 6 + gidx) * 1024 + colt + wc * 32 + 4 * fq;
        f32x4 gt[2][2];
#pragma unroll
        for (int bj = 0; bj < 2; ++bj)
#pragma unroll
            for (int n = 0; n < 2; ++n) gt[bj][n] = *(const f32x4*)(gate + bj * HALF + 16 * n);
        if (u.p2 <= 0) {
            bf16_t* base = X + (size_t)(rowt + wr * 64 + fr) * 2048 + (fr & 1) * 1024 + colt + wc * 32 + 4 * fq;
            if constexpr (FIRST) {
                const bool smp = rowt >= 4096, use_er = colt < 512; const int t0 = (rowt & 4095) + wr * 64 + fr;
                const float* xsrc = (smp ? xs + (size_t)(rowt - 4096) * 1024 : xp + (size_t)rowt * 1024) + (size_t)(wr * 64 + fr) * 1024 + colt + wc * 32 + 4 * fq;
                const float* pbase = (use_er ? er + colt : ec + colt - 512) + wc * 32 + 4 * fq;
#pragma unroll
                for (int ai = 0; ai < 2; ++ai)
#pragma unroll
                    for (int mp = 0; mp < 2; ++mp) {
                        f32x4 xv[2][2][2], pv[2][2][2];
#pragma unroll
                        for (int mm = 0; mm < 2; ++mm) { const int ro = ai * HALF + (2 * mp + mm) * 16; const int t = t0 + ro;
#pragma unroll
                            for (int bj = 0; bj < 2; ++bj)
#pragma unroll
                                for (int n = 0; n < 2; ++n) { xv[mm][bj][n] = *(const f32x4*)(xsrc + (size_t)ro * 1024 + bj * HALF + 16 * n);
                                    pv[mm][bj][n] = smp ? *(const f32x4*)(pbase + (use_er ? (t >> 6) : (t & 63)) * 512 + bj * HALF + 16 * n) : (f32x4){0.f, 0.f, 0.f, 0.f}; } }
#pragma unroll
                        for (int mm = 0; mm < 2; ++mm) { const int ro = ai * HALF + (2 * mp + mm) * 16;
#pragma unroll
                            for (int bj = 0; bj < 2; ++bj)
#pragma unroll
                                for (int n = 0; n < 2; ++n) st_bf4(base + (size_t)ro * 2048 + bj * HALF + 16 * n, xv[mm][bj][n] + pv[mm][bj][n] + gt[bj][n] * acc[ai][bj][2 * mp + mm][n]); }
                    }
            } else {
#pragma unroll
                for (int ai = 0; ai < 2; ++ai) {
                    u32x2 xw[4][2][2];
#pragma unroll
                    for (int m = 0; m < 4; ++m)
#pragma unroll
                        for (int bj = 0; bj < 2; ++bj)
#pragma unroll
                            for (int n = 0; n < 2; ++n) xw[m][bj][n] = *(const u32x2*)(base + (size_t)(ai * HALF + m * 16) * 2048 + bj * HALF + 16 * n);
#pragma unroll
                    for (int m = 0; m < 4; ++m)
#pragma unroll
                        for (int bj = 0; bj < 2; ++bj)
#pragma unroll
                            for (int n = 0; n < 2; ++n) { const u32x2 w = xw[m][bj][n];
                                const f32x4 x0 = (f32x4){__builtin_bit_cast(float, w.x << 16), __builtin_bit_cast(float, w.x & 0xffff0000u), __builtin_bit_cast(float, w.y << 16), __builtin_bit_cast(float, w.y & 0xffff0000u)};
                                st_bf4(base + (size_t)(ai * HALF + m * 16) * 2048 + bj * HALF + 16 * n, x0 + gt[bj][n] * acc[ai][bj][m][n]); }
                }
            }
        } else {
            unsigned short* base = slab + (size_t)(u.p3 * 3 + u.p2 - 1) * 65536 + (size_t)(wr * 64 + fr) * 256 + wc * 32 + 4 * fq;
#pragma unroll
            for (int ai = 0; ai < 2; ++ai)
#pragma unroll
                for (int m = 0; m < 4; ++m)
#pragma unroll
                    for (int bj = 0; bj < 2; ++bj)
#pragma unroll
                        for (int n = 0; n < 2; ++n) { const f32x4 w = gt[bj][n] * acc[ai][bj][m][n]; u32x2 o; o.x = pk2h(w[0], w[1]); o.y = pk2h(w[2], w[3]); *(u32x2*)(base + (size_t)(ai * HALF + m * 16) * 256 + bj * HALF + 16 * n) = o; }
        }
    }
};
typedef ProbResidT<false> ProbResid; typedef ProbResidT<true> ProbResidFirst;
__device__ __forceinline__ void build_split_table(LAS unsigned char* tab, int G, int tid) {
    for (int i = tid; i < 320; i += NTHREADS) tab[i] = 255;
    __syncthreads();
    if (G == 256) { StaticOrder so; so.init(80, 4, G, 0); for (int L = 256 + tid; L < 320; L += NTHREADS) { int pm, pn; so.map(L, pm, pn); tab[pm * 4 + pn] = (unsigned char)(L - 256); } }
    __syncthreads();
}
struct SlabRaw { u32x2 w[3]; };
__device__ __forceinline__ SlabRaw slab_load(const unsigned short* slab, int idx, int r255, int col) { SlabRaw s;
#pragma unroll
    for (int q = 0; q < 3; ++q) s.w[q] = *(const u32x2*)(slab + (size_t)(idx * 3 + q) * 65536 + (size_t)r255 * 256 + col);
    return s; }
__device__ __forceinline__ f32x4 slab_add(const SlabRaw& r) { f32x4 s = (f32x4){0.f, 0.f, 0.f, 0.f};
#pragma unroll
    for (int q = 0; q < 3; ++q) { s[0] += h2f_((unsigned short)(r.w[q].x & 0xffffu)); s[1] += h2f_((unsigned short)(r.w[q].x >> 16)); s[2] += h2f_((unsigned short)(r.w[q].y & 0xffffu)); s[3] += h2f_((unsigned short)(r.w[q].y >> 16)); }
    return s; }
__device__ __forceinline__ f32x4 slab_sum(const unsigned short* slab, int idx, int r255, int col) {
    f32x4 s = (f32x4){0.f, 0.f, 0.f, 0.f};
#pragma unroll
    for (int q = 0; q < 3; ++q) { const u32x2 w = *(const u32x2*)(slab + (size_t)(idx * 3 + q) * 65536 + (size_t)r255 * 256 + col);
        s[0] += h2f_((unsigned short)(w.x & 0xffffu)); s[1] += h2f_((unsigned short)(w.x >> 16)); s[2] += h2f_((unsigned short)(w.y & 0xffffu)); s[3] += h2f_((unsigned short)(w.y >> 16)); }
    return s;
}

struct ProbWin : TokOrder {
    static constexpr bool PERM = true;
    bf16_t* Oq; bf16_t* Offw; bf16_t* Ofbw; bf16_t* Ov; bf16_t* Osg; const float* lb;
    __device__ __forceinline__ void epi(const f32x4 (&acc)[2][2][4][2], const Unit& u, int wr, int wc, int fr, int fq) const {
        const int t = u.p1 >> 2, col0 = (u.p1 & 3) * BM;
        bf16_t* O = t == 0 ? Oq : t == 1 ? Offw : t == 2 ? Ofbw : t == 3 ? Ov : Osg;
        bf16_t* base = O + (size_t)(row0 + u.p0 * BM) * 1024 + col0;
        if (t == 1 || t == 2) {
            const float* lbp = lb + (t - 1) * 1024 + col0 + wc * 32 + 8 * fq;
            f32x4 lbv[2][2];
#pragma unroll
            for (int bj = 0; bj < 2; ++bj) { lbv[bj][0] = *(const f32x4*)(lbp + bj * HALF); lbv[bj][1] = *(const f32x4*)(lbp + bj * HALF + 4); }
            epi_rows_perm(acc, wr, wc, fr, fq, [&](int r, int c, f32x4 v0, f32x4 v1) {
                const f32x4 l0 = lbv[c >> 7][0], l1 = lbv[c >> 7][1];
#pragma unroll
                for (int j = 0; j < 4; ++j) { v0[j] = __builtin_amdgcn_logf(l0[j] + (1.f - l0[j]) * __builtin_amdgcn_rcpf(1.f + __builtin_amdgcn_exp2f(-1.44269504f * v0[j]))); v1[j] = __builtin_amdgcn_logf(l1[j] + (1.f - l1[j]) * __builtin_amdgcn_rcpf(1.f + __builtin_amdgcn_exp2f(-1.44269504f * v1[j]))); }
                u32x4 w; w.x = pk2h(v0[0], v0[1]); w.y = pk2h(v0[2], v0[3]); w.z = pk2h(v1[0], v1[1]); w.w = pk2h(v1[2], v1[3]);
                *(u32x4*)(base + (size_t)r * 1024 + c) = w; });
        } else if (t == 3) {
            epi_rows_perm(acc, wr, wc, fr, fq, [&](int r, int c, f32x4 v0, f32x4 v1) { *(u32x4*)(base + (size_t)r * 1024 + c) = pack8(v0, v1); });
        } else {
            epi_rows_perm(acc, wr, wc, fr, fq, [&](int r, int c, f32x4 v0, f32x4 v1) {
#pragma unroll
                for (int j = 0; j < 4; ++j) { v0[j] = silu(v0[j]); v1[j] = silu(v1[j]); }
                *(u32x4*)(base + (size_t)r * 1024 + c) = pack8(v0, v1); });
        }
    }
};

struct ProbChan : ProbBase {
    static constexpr bool PERM = true;
    int mode, G, c, nunits; bf16_t* Y;
    __device__ void init(int mode_, const void* dftc, const bf16_t* h0, bf16_t* Y_, int G_, int c_) {
        mode = mode_; G = G_; c = c_; Y = Y_; A = (const char*)dftc; B = (const char*)h0; ma = OpMap{128, 512u, 0u}; hstepA = (size_t)HALF * 512; kstepA = kstepB = BK * 2; nt = 4;
        if (mode == 0) { mb = OpMap{128, 2048u, 0u}; hstepB = (size_t)HALF * 2048; nunits = 16 * 4 * 2; }
        else { mb = OpMap{64, 64u * 2048u, 2048u}; hstepB = 2 * 2048; nunits = 4 * 4 * 16 * 2; }
    }
    __device__ bool next(int i, Unit& u) const {
        const int L = i * G + c; if (L >= nunits) return false;
        const int mt = L & 1; u.p0 = mt; u.nt = nt; u.offA = (size_t)mt * 256 * 512;
        if (mode == 0) { const int g = (L >> 1) & 3, b = L >> 3; u.p1 = b * 2048 + g * 512; u.p2 = 0; u.offB = ((size_t)(b * 256) * 1024 + g * 256) * 2; }
        else { const int j = (L >> 1) & 15, g = (L >> 5) & 3, b = L >> 7; u.p1 = b * 2048 + g * 512; u.p2 = j * 256; u.offB = ((size_t)(4096 + b * 4096 + 4 * j) * 1024 + g * 256) * 2; }
        return true;
    }
    __device__ __forceinline__ void epi(const f32x4 (&acc)[2][2][4][2], const Unit& u, int wr, int wc, int fr, int fq) const {
        const int ldc = mode == 0 ? 256 : 4096;
        bf16_t* base = Y + (size_t)(u.p1 + u.p0 * 256) * ldc + u.p2;
        epi_rows_perm(acc, wr, wc, fr, fq, [&](int r, int cc, f32x4 v0, f32x4 v1) { *(u32x4*)(base + (size_t)r * ldc + cc) = pack8(v0, v1); });
    }
};
struct ProbPosCtx : ProbBase {
    static constexpr bool PERM = true;
    int G, c; bf16_t* Z;
    __device__ void init(const void* dl, const bf16_t* yctx, bf16_t* Z_, int G_, int c_) { std_operands(dl, 512, yctx, 512, 512); G = G_; c = c_; Z = Z_; }
    __device__ bool next(int i, Unit& u) const {
        const int L = i * G + c; if (L >= 64) return false;
        const int pn = L & 3, b = L >> 2; u.p0 = b; u.p1 = pn; u.nt = nt; u.offA = 0; u.offB = ((size_t)b * 2048 * 256 + (size_t)pn * 256 * 512) * 2; return true;
    }
    __device__ __forceinline__ void epi(const f32x4 (&acc)[2][2][4][2], const Unit& u, int wr, int wc, int fr, int fq) const {
        bf16_t* base = Z + (size_t)(u.p0 * 256) * 1024 + u.p1 * 256;
        epi_rows_perm(acc, wr, wc, fr, fq, [&](int r, int cc, f32x4 v0, f32x4 v1) { *(u32x4*)(base + (size_t)r * 1024 + cc) = pack8(v0, v1); });
    }
};
struct ProbSmpA : ProbBase {
    static constexpr bool PERM = true;
    int G, c; bf16_t* U;
    __device__ void init(const void* fa2, const bf16_t* yt, bf16_t* U_, int G_, int c_) {
        A = (const char*)fa2; B = (const char*)yt; ma = OpMap{128, 512u, 0u}; hstepA = (size_t)HALF * 512; kstepA = BK * 2;
        mb = OpMap{32, 128u, 16384u}; hstepB = 4 * 16384; kstepB = 4096; nt = 4; G = G_; c = c_; U = U_;
    }
    __device__ bool next(int i, Unit& u) const {
        const int L = i * G + c; if (L >= 512) return false;
        const int tau = L & 127, b = L >> 7; u.p0 = b; u.p1 = tau; u.nt = nt; u.offA = 0; u.offB = ((size_t)(b * 2048 + 16 * tau) * 4096) * 2; return true;
    }
    __device__ __forceinline__ void epi(const f32x4 (&acc)[2][2][4][2], const Unit& u, int wr, int wc, int fr, int fq) const {
        bf16_t* base = U + (size_t)(u.p0 * 1024 + 8 * u.p1) * 8192;
        epi_rows_perm(acc, wr, wc, fr, fq, [&](int r, int cc, f32x4 v0, f32x4 v1) {
            *(u32x4*)(base + (size_t)(cc >> 5) * 8192 + (r & 127) * 64 + (r >> 7) * 32 + (cc & 31)) = pack8(v0, v1); });
    }
};
struct ProbSmpB : ProbBase {
    static constexpr bool PERM = true;
    int G, c; bf16_t* Z;
    __device__ void init(const void* mbm, const bf16_t* Uin, bf16_t* Z_, int G_, int c_) { std_operands(mbm, 512, Uin, 8192, 512); G = G_; c = c_; Z = Z_; }
    __device__ bool next(int i, Unit& u) const {
        const int L = i * G + c; if (L >= 256) return false;
        const int pn = L & 3, q = (L >> 2) & 15, b = L >> 6; u.p0 = b; u.p1 = q; u.p2 = pn; u.nt = nt;
        u.offA = (size_t)q * 256 * 512 * 2; u.offB = ((size_t)(b * 1024 + pn * 256) * 8192 + q * 512) * 2; return true;
    }
    __device__ __forceinline__ void epi(const f32x4 (&acc)[2][2][4][2], const Unit& u, int wr, int wc, int fr, int fq) const {
        bf16_t* base = Z + (size_t)(4096 + u.p0 * 4096 + 4 * u.p1) * 1024 + u.p2 * 256;
        epi_rows_perm(acc, wr, wc, fr, fq, [&](int r, int cc, f32x4 v0, f32x4 v1) {
            const int l = (r >> 6) + 64 * (r & 63); *(u32x4*)(base + (size_t)l * 1024 + cc) = pack8(v0, v1); });
    }
};

__device__ __forceinline__ void norm_rows(bf16_t* X, int row0, int nrows, const float* g, const float* mod, int layer, int ish, bf16_t* H, int gw, int ngw, int lane, const LAS unsigned char* stab, const unsigned short* slab) {
    constexpr int NB = 5;
    LAS unsigned char* prof_lds_ = (LAS unsigned char*)0; (void)prof_lds_; PROF_DECL; PROF_BEGIN();
    f32x4 gv[4], gm[4], shv[4];
#pragma unroll
    for (int j = 0; j < 4; ++j) gv[j] = *(const f32x4*)(g + 4 * lane + 256 * j);
    const int rpw = (nrows + ngw - 1) / ngw, rbeg = row0 + gw * rpw, rend = (rbeg + rpw < row0 + nrows) ? rbeg + rpw : row0 + nrows;
    int ccur = -1;
    for (int rb = rbeg; rb < rend; rb += NB) {
        u32x2 nx[NB][4];
#pragma unroll
        for (int b = 0; b < NB; ++b) { const int r = rb + b; if (r < rend) { const u32x2* p = (const u32x2*)(X + (size_t)r * 2048 + (r & 1) * 1024) + lane;
#pragma unroll
            for (int j = 0; j < 4; ++j) nx[b][j] = p[64 * j]; } }
#pragma unroll
        for (int b = 0; b < NB; ++b) {
            const int r = rb + b; if (r >= rend) break;
            if ((r >> 12) != ccur) { ccur = r >> 12; const float* mrow = mod + ((size_t)(ccur * 2 + layer) * 6) * 1024;
#pragma unroll
                for (int j = 0; j < 4; ++j) { shv[j] = *(const f32x4*)(mrow + (size_t)ish * 1024 + 4 * lane + 256 * j); gm[j] = gv[j] * (*(const f32x4*)(mrow + (size_t)(ish + 1) * 1024 + 4 * lane + 256 * j) + 1.f); } }
            u32x2* xr = (u32x2*)(X + (size_t)r * 2048 + (r & 1) * 1024) + lane;
            f32x4 v[4]; float s = 0.f;
            int si4[4]; SlabRaw sr[4];
#pragma unroll
            for (int j = 0; j < 4; ++j) { si4[j] = stab[(r >> 8) * 4 + j]; if (si4[j] != 255) sr[j] = slab_load(slab, si4[j], r & 255, 4 * lane); }
#pragma unroll
            for (int j = 0; j < 4; ++j) { v[j] = (f32x4){__builtin_bit_cast(float, nx[b][j].x << 16), __builtin_bit_cast(float, nx[b][j].x & 0xffff0000u), __builtin_bit_cast(float, nx[b][j].y << 16), __builtin_bit_cast(float, nx[b][j].y & 0xffff0000u)}; if (si4[j] != 255) { v[j] = v[j] + slab_add(sr[j]); st_bf4(xr + 64 * j, v[j]); }
                s += (v[j].x * v[j].x + v[j].y * v[j].y) + (v[j].z * v[j].z + v[j].w * v[j].w); }
            const float rstd = rsqrtf(wave_sum(s) * (1.f / 1024.f) + 1e-6f);
            unsigned long long* o8 = (unsigned long long*)(H + (size_t)r * 1024) + lane;
#pragma unroll
            for (int j = 0; j < 4; ++j) { const f32x4 o = v[j] * rstd * gm[j] + shv[j]; o8[64 * j] = (unsigned long long)cvt_pk_bf16(o.x, o.y) | ((unsigned long long)cvt_pk_bf16(o.z, o.w) << 32); }
        }
    }
    PROF_END(11);
}


__device__ __forceinline__ void embed_rows(const float* xp, const float* xs, const float* er, const float* ec, const float* g, const float* mod, bf16_t* H, int gw, int ngw, int lane) {
    constexpr int NB = 4;
    f32x4 gv[4], gm[4], shv[4];
#pragma unroll
    for (int j = 0; j < 4; ++j) gv[j] = *(const f32x4*)(g + 4 * lane + 256 * j);
    const int rpw = (20480 + ngw - 1) / ngw, rbeg = gw * rpw, rend = (rbeg + rpw < 20480) ? rbeg + rpw : 20480;
    int ccur = -1;
    int prow = -1; f32x4 pr0 = (f32x4){0.f, 0.f, 0.f, 0.f}, pr1 = pr0;
    for (int rb = rbeg; rb < rend; rb += NB) {
        f32x4 nx[NB][4], pc[NB][2];
#pragma unroll
        for (int b = 0; b < NB; ++b) { const int r = rb + b; if (r < rend) { const f32x4* xr = (const f32x4*)(r < 4096 ? xp + (size_t)r * 1024 : xs + (size_t)(r - 4096) * 1024) + lane;
#pragma unroll
            for (int j = 0; j < 4; ++j) nx[b][j] = xr[64 * j];
            if (r >= 4096) { const int col = r & 63; pc[b][0] = *(const f32x4*)(ec + col * 512 + 4 * lane); pc[b][1] = *(const f32x4*)(ec + col * 512 + 256 + 4 * lane); } } }
#pragma unroll
        for (int b = 0; b < NB; ++b) {
            const int r = rb + b; if (r >= rend) break;
            if ((r >> 12) != ccur) { ccur = r >> 12; const float* mrow = mod + ((size_t)(ccur * 2 + 0) * 6) * 1024;
#pragma unroll
                for (int j = 0; j < 4; ++j) { shv[j] = *(const f32x4*)(mrow + 4 * lane + 256 * j); gm[j] = gv[j] * (*(const f32x4*)(mrow + 1024 + 4 * lane + 256 * j) + 1.f); } }
            f32x4 v[4]; float s = 0.f;
#pragma unroll
            for (int j = 0; j < 4; ++j) v[j] = nx[b][j];
            if (r >= 4096) { const int row = (r & 4095) >> 6;
                if (row != prow) { prow = row; pr0 = *(const f32x4*)(er + row * 512 + 4 * lane); pr1 = *(const f32x4*)(er + row * 512 + 256 + 4 * lane); }
                v[0] = v[0] + pr0; v[1] = v[1] + pr1; v[2] = v[2] + pc[b][0]; v[3] = v[3] + pc[b][1]; }
#pragma unroll
            for (int j = 0; j < 4; ++j) s += (v[j].x * v[j].x + v[j].y * v[j].y) + (v[j].z * v[j].z + v[j].w * v[j].w);
            const float rstd = rsqrtf(wave_sum(s) * (1.f / 1024.f) + 1e-6f);
            unsigned long long* o8 = (unsigned long long*)(H + (size_t)r * 1024) + lane;
#pragma unroll
            for (int j = 0; j < 4; ++j) { const f32x4 o = v[j] * rstd * gm[j] + shv[j]; o8[64 * j] = (unsigned long long)cvt_pk_bf16(o.x, o.y) | ((unsigned long long)cvt_pk_bf16(o.z, o.w) << 32); }
        }
    }
}
__device__ __forceinline__ void gen_tables(unsigned char* ws, long e0, long estride) {
    bf16_t* dftc = (bf16_t*)(ws + WM.dftc); bf16_t* dl = (bf16_t*)(ws + WM.dl256); bf16_t* fa2 = (bf16_t*)(ws + WM.fa2); bf16_t* mbm = (bf16_t*)(ws + WM.mb);
    float* er = (float*)(ws + WM.pos); float* ec = er + 64 * 512;
    constexpr long N0 = 512 * 256, N1 = 256 * 512, N2 = 256 * 256, N3 = 16L * 256 * 512, N4 = 2 * 64 * 512;
    for (long e = e0; e < N0 + N1 + N2 + N3 + N4; e += estride) {
        long r = e;
        if (r < N0) { const int mrow = (int)(r >> 8), cp = (int)(r & 255), cc = mrow >> 1, ri = mrow & 1; const float x = 2.f * (float)((cc * cp) & 255) / 256.f;
            dftc[r] = (bf16_t)f2bf(ri == 0 ? cospif(x) : -sinpif(x)); continue; } r -= N0;
        if (r < N1) { const int l = (int)(r >> 9), k = (int)(r & 511), ri = k >> 8, lp = k & 255; const float x = 2.f * (float)((l * lp) & 255) / 256.f;
            dl[r] = (bf16_t)f2bf((ri == 0 ? cospif(x) : sinpif(x)) * (1.f / 256.f)); continue; } r -= N1;
        if (r < N2) { const int mrow = (int)(r >> 8), k = (int)(r & 255), sA = mrow >> 7, k1 = (mrow >> 1) & 63, ro = mrow & 1, ri = k >> 7, sB = (k >> 6) & 1, l1 = k & 63;
            const float x = 2.f * (float)((k1 * l1) & 63) / 64.f; float v = 0.f;
            if (sA == sB) v = (ro == ri) ? cospif(x) : (ro == 0 ? sinpif(x) : -sinpif(x));
            fa2[r] = (bf16_t)f2bf(v); continue; } r -= N2;
        if (r < N3) { const int q = (int)(r >> 17), mrow = (int)(r >> 9) & 255, k = (int)(r & 511), ko = mrow >> 6, k2 = mrow & 63, kop = k >> 7, ro = (k >> 6) & 1, l2 = k & 63;
            const int l = 4 * q + ko + 64 * k2; const float x = 2.f * (float)((l * l2) & 4095) / 4096.f; float v = 0.f;
            if (ko == kop) v = (ro == 0 ? cospif(x) : sinpif(x)) * (1.f / 1024.f);
            mbm[r] = (bf16_t)f2bf(v); continue; } r -= N3;
        { const int which = (int)(r >> 15), p = (int)(r >> 9) & 63, j = (int)(r & 511), i = j & 255;
            const float omega = 1.0f / powf(10000.0f, (float)i / 256.0f); const float ang = (float)p * omega;
            (which == 0 ? er : ec)[p * 512 + j] = (j < 256) ? sinf(ang) : cosf(ang); }
    }
}


__device__ __forceinline__ void final_rows(float* X, int row0, int nrows, const float* g, int gw, int ngw, int lane, const LAS unsigned char* stab, const unsigned short* slab) {
    constexpr int NB = 5;
    f32x4 gv[4];
#pragma unroll
    for (int j = 0; j < 4; ++j) gv[j] = *(const f32x4*)(g + 4 * lane + 256 * j);
    for (int rb = row0 + gw; rb < row0 + nrows; rb += NB * ngw) {
        u32x2 nx[NB][4];
#pragma unroll
        for (int b = 0; b < NB; ++b) { const int r = rb + b * ngw; if (r < row0 + nrows) { const u32x2* p = (const u32x2*)(X + (size_t)r * 1024) + (r & 1) * 256 + lane;
#pragma unroll
            for (int j = 0; j < 4; ++j) nx[b][j] = p[64 * j]; } }
#pragma unroll
        for (int b = 0; b < NB; ++b) {
            const int r = rb + b * ngw; if (r >= row0 + nrows) break;
            f32x4* xr = (f32x4*)(X + (size_t)r * 1024) + lane;
            f32x4 v[4]; float s = 0.f;
            int si4[4]; SlabRaw sr[4];
#pragma unroll
            for (int j = 0; j < 4; ++j) { si4[j] = stab[(r >> 8) * 4 + j]; if (si4[j] != 255) sr[j] = slab_load(slab, si4[j], r & 255, 4 * lane); }
#pragma unroll
            for (int j = 0; j < 4; ++j) { v[j] = (f32x4){__builtin_bit_cast(float, nx[b][j].x << 16), __builtin_bit_cast(float, nx[b][j].x & 0xffff0000u), __builtin_bit_cast(float, nx[b][j].y << 16), __builtin_bit_cast(float, nx[b][j].y & 0xffff0000u)}; if (si4[j] != 255) v[j] = v[j] + slab_add(sr[j]);
                s += (v[j].x * v[j].x + v[j].y * v[j].y) + (v[j].z * v[j].z + v[j].w * v[j].w); }
            const float rstd = rsqrtf(wave_sum(s) * (1.f / 1024.f) + 1e-6f);
#pragma unroll
            for (int j = 0; j < 4; ++j) xr[64 * j] = v[j] * rstd * gv[j];
        }
    }
}
__device__ __forceinline__ void mod_unit(LAS unsigned char* lds, int unit, const float* c, const float* c_ctx, const float* ada_w, const float* ada_b, float* mod, int tid, int wave, int lane) {
    LAS float* sc = (LAS float*)lds;
    LAS float* red = (LAS float*)(lds + 20480);
    const int layer = unit / 192, n0 = (unit % 192) * 32, col = lane & 31, kh = lane >> 5;
    for (int i = tid; i < 5 * 1024; i += NTHREADS) { const int cond = i >> 10, k = i & 1023; const float x = cond == 0 ? c_ctx[k] : c[(cond - 1) * 1024 + k]; sc[i] = silu(x); }
    __syncthreads();
    const float* w = ada_w + ((size_t)layer * 1024 + wave * 128 + kh) * 6144 + n0 + col;
    float acc[5];
#pragma unroll
    for (int q = 0; q < 5; ++q) acc[q] = 0.f;
#pragma unroll 1
    for (int kb = 0; kb < 64; kb += 32) {
        float wv[32];
#pragma unroll
        for (int k = 0; k < 32; ++k) wv[k] = w[(size_t)(2 * (kb + k)) * 6144];
#pragma unroll
        for (int k = 0; k < 32; ++k) {
#pragma unroll
            for (int q = 0; q < 5; ++q) acc[q] += wv[k] * sc[q * 1024 + wave * 128 + 2 * (kb + k) + kh];
        }
    }
#pragma unroll
    for (int q = 0; q < 5; ++q) { acc[q] += __shfl_xor(acc[q], 32); if (kh == 0) red[(wave * 5 + q) * 32 + col] = acc[q]; }
    __syncthreads();
    for (int i = tid; i < 5 * 32; i += NTHREADS) { const int q = i >> 5, n = i & 31; float s = 0.f;
#pragma unroll
        for (int ww = 0; ww < 8; ++ww) s += red[(ww * 5 + q) * 32 + n];
        mod[((size_t)q * 2 + layer) * 6144 + n0 + n] = s + ada_b[(size_t)layer * 6144 + n0 + n]; }
    __syncthreads();
}

struct TrItem { const float* W; bf16_t* WT; int K, N, item; };
__device__ __forceinline__ void transpose_load(const TrItem& t, f32x4 (&ld)[8], int lane) {
    const int nblk = t.N / 32, kb = t.item / nblk, nb = t.item % nblk, k0 = 64 * kb, n0 = 32 * nb;
#pragma unroll
    for (int i = 0; i < 8; ++i) ld[i] = *(const f32x4*)(t.W + (size_t)(k0 + 8 * i + (lane >> 3)) * t.N + n0 + 4 * (lane & 7));
}
__device__ __forceinline__ void transpose_finish(const TrItem& t, const f32x4 (&ld)[8], LAS float* scr, int lane) {
    const int nblk = t.N / 32, kb = t.item / nblk, nb = t.item % nblk, k0 = 64 * kb, n0 = 32 * nb;
#pragma unroll
    for (int i = 0; i < 8; ++i) { LAS float* d = scr + (8 * i + (lane >> 3)) * 33 + 4 * (lane & 7); d[0] = ld[i][0]; d[1] = ld[i][1]; d[2] = ld[i][2]; d[3] = ld[i][3]; }
    asm volatile("s_waitcnt lgkmcnt(0)" ::: "memory");
    const int c = lane & 7;
#pragma unroll
    for (int j = 0; j < 4; ++j) { const int n = (lane >> 3) + 8 * j; const LAS float* s = scr + (8 * c) * 33 + n;
        u32x4 o; o.x = pk2(s[0 * 33], s[1 * 33]); o.y = pk2(s[2 * 33], s[3 * 33]); o.z = pk2(s[4 * 33], s[5 * 33]); o.w = pk2(s[6 * 33], s[7 * 33]);
        *(u32x4*)(t.WT + (size_t)(n0 + n) * t.K + k0 + 8 * c) = o; }
    asm volatile("s_waitcnt lgkmcnt(0)" ::: "memory");
}
template <class Dec> __device__ __forceinline__ void transpose_stream(int first, int count, int stride, Dec dec, LAS float* scr, int lane) {
    if (first >= count) return;
    f32x4 cur[8], nxt[8]; TrItem tc = dec(first), tn = tc;
    transpose_load(tc, cur, lane);
    for (int it = first; it < count; it += stride) {
        const bool more = it + stride < count;
        if (more) { tn = dec(it + stride); transpose_load(tn, nxt, lane); }
        transpose_finish(tc, cur, scr, lane);
        if (more) { tc = tn;
#pragma unroll
            for (int i = 0; i < 8; ++i) cur[i] = nxt[i]; }
    }
}


typedef float f32x16 __attribute__((ext_vector_type(16)));
typedef short v4i16_t __attribute__((ext_vector_type(4)));
constexpr int QA_RS = 272, QP_RS = 264, KB_RS = 272, KPP_RS = 320, V_RS = 320;
constexpr int T_QA = 0, T_QP = T_QA + 32 * QA_RS, T_KB = T_QP + 32 * QP_RS, T_KPP = T_KB + 32 * KB_RS, T_V = T_KPP + 32 * KPP_RS, T_EL = T_V + 32 * V_RS, DIR_BYTES = T_EL + 512;
constexpr int OBUF_OFF = 2 * DIR_BYTES, OBUF_BYTES = 256 * 256;
static_assert(OBUF_OFF + OBUF_BYTES <= 160 * 1024 - 512 && (DIR_BYTES % 16) == 0 && (T_QP % 16) == 0 && (T_KB % 16) == 0 && (T_KPP % 16) == 0 && (T_V % 16) == 0 && (T_EL % 16) == 0, "scan LDS map");
constexpr int SLOT_ELEMS = 128 * 128;
#ifndef SCAN_STAGGER
#define SCAN_STAGGER 0
#endif

struct ScanT { const bf16_t* q; const bf16_t* lffw; const bf16_t* lfbw; const bf16_t* v; bf16_t* sg; bf16_t* slots; float* dvec; const float* gnorm; const float* state_in; float* new_state; };

__device__ __forceinline__ bf16x8 tr_pair(const LAS unsigned char* p0, const LAS unsigned char* p1) {
    const v4i16_t lo = __builtin_amdgcn_ds_read_tr16_b64_v4i16((LAS v4i16_t*)p0), hi = __builtin_amdgcn_ds_read_tr16_b64_v4i16((LAS v4i16_t*)p1);
    return (bf16x8){lo[0], lo[1], lo[2], lo[3], hi[0], hi[1], hi[2], hi[3]};
}
__device__ __forceinline__ bf16x8 pack_acc8(const f32x16& x, int s8) {
    u32x4 w; w.x = cvt_pk_bf16(x[8 * s8 + 0], x[8 * s8 + 1]); w.y = cvt_pk_bf16(x[8 * s8 + 2], x[8 * s8 + 3]); w.z = cvt_pk_bf16(x[8 * s8 + 4], x[8 * s8 + 5]); w.w = cvt_pk_bf16(x[8 * s8 + 6], x[8 * s8 + 7]);
    return __builtin_bit_cast(bf16x8, w);
}
__device__ __forceinline__ float h2f(unsigned short b) { return (float)__builtin_bit_cast(_Float16, b); }

template <bool FULL>
__device__ __forceinline__ void scan_item(LAS unsigned char* lds, const ScanT& T, int tok0, int h, bool act0, bool act1, const bf16_t* init0, const bf16_t* init1,
                                          float* fin0, float* fin1, bf16_t* outs0, bf16_t* outs1, float* outd0, float* outd1) {
    const int tid = threadIdx.x, wave = __builtin_amdgcn_readfirstlane(tid >> 6), dir = wave >> 2, wg = wave & 3;
    LAS unsigned char* prof_lds_ = lds; (void)prof_lds_; PROF_DECL; PROF_BEGIN();
    const bool act = dir ? act1 : act0;
    const bf16_t* init = dir ? init1 : init0;
    LAS unsigned char* D = lds + dir * DIR_BYTES;
    LAS unsigned char* OB = lds + OBUF_OFF;
    const bf16_t* lfp = dir ? T.lfbw : T.lffw;
#define SCAN_LANE(x) int x; asm volatile("v_mbcnt_lo_u32_b32 %0, -1, 0\n\tv_mbcnt_hi_u32_b32 %0, -1, %0" : "=v"(x))
#define SCAN_PREP_ROLE SCAN_LANE(ln_); const int pp = 16 * wg + (ln_ & 15), uu = ln_ >> 4, gt_ = wg * 64 + ln_, vt = gt_ >> 3, vc2 = gt_ & 7
#define SCAN_MFMA_ROLE SCAN_LANE(ln_); const int l31 = ln_ & 31, hh = ln_ >> 5, gq = (ln_ & 15) >> 2, gp = ln_ & 3, vcol = 16 * ((ln_ >> 4) & 1)
    f32x16 S[4];
#pragma unroll
    for (int t4 = 0; t4 < 4; ++t4) {
        if (init && act) { SCAN_LANE(lane); const u32x4* sp = (const u32x4*)(init + ((size_t)(wg * 4 + t4) * 64 + lane) * 16); const u32x4 a = sp[0], b = sp[1];
            const unsigned w8[8] = {a.x, a.y, a.z, a.w, b.x, b.y, b.z, b.w};
#pragma unroll
            for (int j = 0; j < 8; ++j) { S[t4][2 * j] = __builtin_bit_cast(float, w8[j] << 16); S[t4][2 * j + 1] = __builtin_bit_cast(float, w8[j] & 0xffff0000u); } }
        else {
#pragma unroll
            for (int j = 0; j < 16; ++j) S[t4][j] = 0.f; }
    }
    float dsum0 = 0.f, dsum1 = 0.f;
    unsigned qreg[8], lfreg[8]; u32x4 vreg[2];
#define SCAN_LOAD(i) do { const int jsc_ = dir ? 7 - (i) : (i); \
        _Pragma("unroll") for (int e = 0; e < 8; ++e) { const int tl = 8 * uu + e; const size_t tk = (size_t)(tok0 + 32 * jsc_ + (dir ? 31 - tl : tl)) * 1024 + h * 128 + 2 * pp; \
            if (FULL) qreg[e] = *(const unsigned*)(T.q + tk); lfreg[e] = *(const unsigned*)(lfp + tk); } \
        { const size_t tk = (size_t)(tok0 + 32 * jsc_ + (dir ? 31 - vt : vt)) * 1024 + h * 128 + 16 * vc2; vreg[0] = *(const u32x4*)(T.v + tk); vreg[1] = *(const u32x4*)(T.v + tk + 8); } } while (0)
    if (act) { SCAN_PREP_ROLE; SCAN_LOAD(0); }
    PROF_END(6);
    for (int s = 0; s < 16 + SCAN_STAGGER; ++s) {
        const int ph = s - (SCAN_STAGGER ? dir : 0);
        if (act && ph >= 0 && ph < 16) {
            const int i = ph >> 1;
            if ((ph & 1) == 0) {
                SCAN_PREP_ROLE; const int lane = ln_;
#if defined(PROF_ID)
                PROF_BEGIN(); asm volatile("s_waitcnt vmcnt(0)" ::: "memory"); PROF_END(1); PROF_BEGIN();
#endif
                *(LAS u32x4*)(D + T_V + vt * V_RS + vc2 * 32) = vreg[0]; *(LAS u32x4*)(D + T_V + vt * V_RS + vc2 * 32 + 16) = vreg[1];
                f32x2 cc[8]; f32x2 aa = (f32x2){0.f, 0.f};
#pragma unroll
                for (int e = 0; e < 8; ++e) { aa += (f32x2){h2f((unsigned short)(lfreg[e] & 0xffffu)), h2f((unsigned short)(lfreg[e] >> 16))}; cc[e] = aa; }
                f32x2 tq[4];
#pragma unroll
                for (int u2 = 0; u2 < 4; ++u2) { tq[u2].x = __shfl(aa.x, (lane & 15) + 16 * u2); tq[u2].y = __shfl(aa.y, (lane & 15) + 16 * u2); }
                const f32x2 zz = (f32x2){0.f, 0.f};
                const f32x2 pre = (uu > 0 ? tq[0] : zz) + (uu > 1 ? tq[1] : zz) + (uu > 2 ? tq[2] : zz);
                const f32x2 rr = tq[0] + tq[1], bl = rr + tq[2] + tq[3];
#define EX2V(v) ((f32x2){__builtin_amdgcn_exp2f((v).x), __builtin_amdgcn_exp2f((v).y)})
                if (FULL) {
                    const f32x2 er = EX2V(rr), elr = EX2V(bl - rr), base = pre - rr;
#pragma unroll
                    for (int e = 0; e < 8; ++e) {
                        const int tl = 8 * uu + e;
                        const f32x2 d = base + cc[e];
                        const f32x2 ea = EX2V(d), eb = EX2V(-d);
                        const f32x2 lfv = (f32x2){h2f((unsigned short)(lfreg[e] & 0xffffu)), h2f((unsigned short)(lfreg[e] >> 16))};
                        const f32x2 kk = 1.f - EX2V(lfv);
                        const f32x2 qq = (f32x2){__builtin_bit_cast(float, qreg[e] << 16), __builtin_bit_cast(float, qreg[e] & 0xffff0000u)};
                        const f32x2 qa = qq * ea, kb = kk * eb, qp = qa * er, kpp = kb * elr;
                        *(LAS unsigned*)(D + T_QA + tl * QA_RS + 4 * pp) = cvt_pk_bf16(qa.x, qa.y);
                        *(LAS unsigned*)(D + T_QP + tl * QP_RS + 4 * pp) = cvt_pk_bf16(qp.x, qp.y);
                        *(LAS unsigned*)(D + T_KB + tl * KB_RS + 4 * pp) = cvt_pk_bf16(kb.x, kb.y);
                        *(LAS unsigned*)(D + T_KPP + tl * KPP_RS + 4 * pp) = cvt_pk_bf16(kpp.x, kpp.y);
                        if (e & 1) __builtin_amdgcn_sched_barrier(0);
                    }
                } else {
                    const f32x2 base = bl - pre;
#pragma unroll
                    for (int e = 0; e < 8; ++e) {
                        const int tl = 8 * uu + e;
                        const f32x2 d = base - cc[e];
                        const f32x2 lfv = (f32x2){h2f((unsigned short)(lfreg[e] & 0xffffu)), h2f((unsigned short)(lfreg[e] >> 16))};
                        const f32x2 kpp = (1.f - EX2V(lfv)) * EX2V(d);
                        *(LAS unsigned*)(D + T_KPP + tl * KPP_RS + 4 * pp) = cvt_pk_bf16(kpp.x, kpp.y);
                    }
                    dsum0 += bl.x; dsum1 += bl.y;
                }
                if (uu == 0) { *(LAS f32x2*)(D + T_EL + 8 * pp) = EX2V(bl); }
                __builtin_amdgcn_sched_barrier(0);
#if defined(PROF_ID)
                asm volatile("s_waitcnt lgkmcnt(0)" ::: "memory"); PROF_END(2);
#endif
                if (i < 7) SCAN_LOAD(i + 1);
            } else {
                SCAN_MFMA_ROLE; PROF_BEGIN();
                if (FULL) {
                    f32x16 P;
#pragma unroll
                    for (int j = 0; j < 16; ++j) P[j] = 0.f;
#pragma unroll
                    for (int ks = 0; ks < 8; ++ks) {
                        const bf16x8 ka = *(const LAS bf16x8*)(D + T_KB + l31 * KB_RS + (16 * ks + 8 * hh) * 2);
                        const bf16x8 qb = *(const LAS bf16x8*)(D + T_QA + l31 * QA_RS + (16 * ks + 8 * hh) * 2);
                        P = __builtin_amdgcn_mfma_f32_32x32x16_bf16(ka, qb, P, 0, 0, 0);
                    }
#pragma unroll
                    for (int j = 0; j < 16; ++j) { const int srow = (j & 3) + 8 * (j >> 2) + 4 * hh; P[j] = (srow <= l31) ? P[j] : 0.f; }
                    f32x16 o;
#pragma unroll
                    for (int j = 0; j < 16; ++j) o[j] = 0.f;
#pragma unroll
                    for (int s8 = 0; s8 < 2; ++s8) {
                        const LAS unsigned char* vb = D + T_V + (16 * s8 + 4 * hh + gq) * V_RS + (32 * wg + vcol + 4 * gp) * 2;
                        const bf16x8 vf = tr_pair(vb, vb + 8 * V_RS);
                        o = __builtin_amdgcn_mfma_f32_32x32x16_bf16(pack_acc8(P, s8), vf, o, 0, 0, 0);
                    }
#pragma unroll
                    for (int t4 = 0; t4 < 4; ++t4)
#pragma unroll
                        for (int s8 = 0; s8 < 2; ++s8) {
                            const LAS unsigned char* qp = D + T_QP + l31 * QP_RS + (32 * t4 + 16 * s8 + 4 * hh) * 2;
                            const u32x2 lo = *(const LAS u32x2*)qp, hi = *(const LAS u32x2*)(qp + 16);
                            const u32x4 aw = {lo.x, lo.y, hi.x, hi.y};
                            o = __builtin_amdgcn_mfma_f32_32x32x16_bf16(__builtin_bit_cast(bf16x8, aw), pack_acc8(S[t4], s8), o, 0, 0, 0);
                        }
                    const int jsc = dir ? 7 - i : i;
                    LAS unsigned short* ob = (LAS unsigned short*)(OB + (32 * jsc + (dir ? 31 - 4 * hh : 4 * hh)) * 256 + (32 * wg + l31) * 2);
                    const int rs = dir ? -128 : 128;
                    if (i >= 4) {
                        unsigned short pv[16];
#pragma unroll
                        for (int j = 0; j < 16; ++j) pv[j] = ob[((j & 3) + 8 * (j >> 2)) * rs];
#pragma unroll
                        for (int j = 0; j < 16; ++j) o[j] += bf2f(pv[j]);
                    }
#pragma unroll
                    for (int j = 0; j < 16; ++j) ob[((j & 3) + 8 * (j >> 2)) * rs] = (unsigned short)cvt_pk_bf16(o[j], o[j]);
                }
                __builtin_amdgcn_sched_barrier(0);
#pragma unroll
                for (int t4 = 0; t4 < 4; ++t4) {
#pragma unroll
                    for (int g = 0; g < 4; ++g) { const f32x4 f = *(const LAS f32x4*)(D + T_EL + (32 * t4 + 8 * g + 4 * hh) * 4);
                        S[t4][4 * g + 0] *= f[0]; S[t4][4 * g + 1] *= f[1]; S[t4][4 * g + 2] *= f[2]; S[t4][4 * g + 3] *= f[3]; }
#pragma unroll
                    for (int s8 = 0; s8 < 2; ++s8) {
                        const LAS unsigned char* kb = D + T_KPP + (16 * s8 + 8 * hh + gq) * KPP_RS + (32 * t4 + vcol + 4 * gp) * 2;
                        const LAS unsigned char* vb = D + T_V + (16 * s8 + 8 * hh + gq) * V_RS + (32 * wg + vcol + 4 * gp) * 2;
                        const bf16x8 ka = tr_pair(kb, kb + 4 * KPP_RS), vf = tr_pair(vb, vb + 4 * V_RS);
                        S[t4] = __builtin_amdgcn_mfma_f32_32x32x16_bf16(ka, vf, S[t4], 0, 0, 0);
                    }
                    if (t4 == 1) __builtin_amdgcn_sched_barrier(0);
                }
                PROF_END(3);
            }
        }
        PROF_BEGIN();
        __syncthreads();
        PROF_END(4);
    }
#undef SCAN_LOAD
    SCAN_MFMA_ROLE; SCAN_LANE(lane); PROF_BEGIN();
    if (FULL) {
        float* fin = dir ? fin1 : fin0;
        if (fin && act) {
#pragma unroll
            for (int t4 = 0; t4 < 4; ++t4)
#pragma unroll
                for (int j = 0; j < 16; ++j) fin[(size_t)(32 * t4 + (j & 3) + 8 * (j >> 2) + 4 * hh) * 128 + 32 * wg + l31] = S[t4][j];
        }
        const int cv = tid & 15;
        f32x4 gn0 = *(const f32x4*)(T.gnorm + 8 * cv), gn1 = *(const f32x4*)(T.gnorm + 8 * cv + 4);
        u32x4 gwv[8];
#pragma unroll
        for (int pass = 0; pass < 8; ++pass) gwv[pass] = *(const u32x4*)(T.sg + (size_t)(tok0 + 32 * pass + (tid >> 4)) * 1024 + h * 128 + 8 * cv);
#pragma unroll
        for (int pass = 0; pass < 8; ++pass) {
            const int row = 32 * pass + (tid >> 4);
            const u32x4 ow = *(const LAS u32x4*)(OB + row * 256 + cv * 16);
            bf16_t* gp_ = T.sg + (size_t)(tok0 + row) * 1024 + h * 128 + 8 * cv;
            const u32x4 gw = gwv[pass];
            float ov[8], gv[8];
            const unsigned o4[4] = {ow.x, ow.y, ow.z, ow.w}, g4[4] = {gw.x, gw.y, gw.z, gw.w};
            float ss = 0.f;
#pragma unroll
            for (int j = 0; j < 4; ++j) { ov[2 * j] = __builtin_bit_cast(float, o4[j] << 16); ov[2 * j + 1] = __builtin_bit_cast(float, o4[j] & 0xffff0000u);
                gv[2 * j] = __builtin_bit_cast(float, g4[j] << 16); gv[2 * j + 1] = __builtin_bit_cast(float, g4[j] & 0xffff0000u);
                ss += ov[2 * j] * ov[2 * j] + ov[2 * j + 1] * ov[2 * j + 1]; }
            ss += __shfl_xor(ss, 1); ss += __shfl_xor(ss, 2); ss += __shfl_xor(ss, 4); ss += __shfl_xor(ss, 8);
            const float rstd = rsqrtf(ss * (1.f / 128.f) + 1e-6f);
            u32x4 w;
            w.x = cvt_pk_bf16(ov[0] * rstd * gn0[0] * gv[0], ov[1] * rstd * gn0[1] * gv[1]); w.y = cvt_pk_bf16(ov[2] * rstd * gn0[2] * gv[2], ov[3] * rstd * gn0[3] * gv[3]);
            w.z = cvt_pk_bf16(ov[4] * rstd * gn1[0] * gv[4], ov[5] * rstd * gn1[1] * gv[5]); w.w = cvt_pk_bf16(ov[6] * rstd * gn1[2] * gv[6], ov[7] * rstd * gn1[3] * gv[7]);
            *(u32x4*)gp_ = w;
        }
#if defined(PROF_ID)
        asm volatile("s_waitcnt vmcnt(0)" ::: "memory");
#endif
        __syncthreads(); PROF_END(5);
    } else {
        bf16_t* outs = dir ? outs1 : outs0; float* outd = dir ? outd1 : outd0;
        if (act) {
#pragma unroll
            for (int t4 = 0; t4 < 4; ++t4) {
                u32x4 a, b;
                a.x = cvt_pk_bf16(S[t4][0], S[t4][1]); a.y = cvt_pk_bf16(S[t4][2], S[t4][3]); a.z = cvt_pk_bf16(S[t4][4], S[t4][5]); a.w = cvt_pk_bf16(S[t4][6], S[t4][7]);
                b.x = cvt_pk_bf16(S[t4][8], S[t4][9]); b.y = cvt_pk_bf16(S[t4][10], S[t4][11]); b.z = cvt_pk_bf16(S[t4][12], S[t4][13]); b.w = cvt_pk_bf16(S[t4][14], S[t4][15]);
                u32x4* sp = (u32x4*)(outs + ((size_t)(wg * 4 + t4) * 64 + lane) * 16); sp[0] = a; sp[1] = b;
            }
            const int pp = 16 * wg + (lane & 15); if ((lane >> 4) == 0) { outd[2 * pp] = __builtin_amdgcn_exp2f(dsum0); outd[2 * pp + 1] = __builtin_amdgcn_exp2f(dsum1); }
        }
    }
}
__device__ __forceinline__ size_t slot_of(int dir, int b, int h, int sc) { return (size_t)((dir * 4 + b) * 8 + h) * 16 + sc; }

__device__ __forceinline__ void scan_a_item(LAS unsigned char* lds, const ScanT& T, int it) {
    const int sc = it & 15, h = (it >> 4) & 7, b = it >> 7;
    const size_t sf = slot_of(0, b, h, sc < 15 ? sc + 1 : 0), sb = slot_of(1, b, h, sc > 0 ? sc - 1 : 0);
    scan_item<false>(lds, T, 4096 + b * 4096 + sc * 256, h, sc < 15, sc > 0, nullptr, nullptr, nullptr, nullptr, T.slots + sf * SLOT_ELEMS, T.slots + sb * SLOT_ELEMS, T.dvec + sf * 128, T.dvec + sb * 128);
}
__device__ __forceinline__ void scan_ctx_item(LAS unsigned char* lds, const ScanT& T, int ci) {
    const int h = ci & 7, b = ci >> 3;
    float* ns = T.new_state + (size_t)(b * 2) * 8 * 16384 + (size_t)h * 16384;
    scan_item<true>(lds, T, b * 256, h, true, true, nullptr, nullptr, ns, ns + (size_t)8 * 16384, nullptr, nullptr, nullptr, nullptr);
}
__device__ __forceinline__ void scan_phase_a(LAS unsigned char* lds, const ScanT& T, int G, int bx) {
    if (G == 256) {
        if (bx < 128) { scan_ctx_item(lds, T, bx); scan_a_item(lds, T, 384 + bx); }
        else { for (int k = 0; k < 3; ++k) scan_a_item(lds, T, (bx - 128) * 3 + k); }
    } else {
        for (int it = bx; it < 640; it += G) { if (it < 512) scan_a_item(lds, T, it); else scan_ctx_item(lds, T, it - 512); }
    }
}
__device__ __forceinline__ void scan_phase_b(const ScanT& T, int G, int bx, int tid) {
    for (int gid = bx * NTHREADS + tid; gid < 64 * 2048; gid += G * NTHREADS) {
        const int combo = gid >> 11, e = (gid & 2047) * 8, dir = combo >> 5, b = (combo >> 3) & 3, h = combo & 7;
        const int reg0 = e & 15, ln = (e >> 4) & 63, t4 = (e >> 10) & 3, w = (e >> 12) & 3;
        const int v = 32 * w + (ln & 31);
        float s[8]; int kk[8];
#pragma unroll
        for (int j = 0; j < 8; ++j) { const int rg = reg0 + j; kk[j] = 32 * t4 + (rg & 3) + 8 * (rg >> 2) + 4 * (ln >> 5); s[j] = T.state_in[((size_t)((b * 2 + dir) * 8 + h) * 128 + kk[j]) * 128 + v]; }
        for (int st = 0; st < 16; ++st) {
            const int sc = dir ? 15 - st : st;
            const size_t sl = slot_of(dir, b, h, sc);
            u32x4* sp = (u32x4*)(T.slots + sl * SLOT_ELEMS + e);
            if (st > 0) {
                const u32x4 lw = *sp; const unsigned l4[4] = {lw.x, lw.y, lw.z, lw.w};
#pragma unroll
                for (int j = 0; j < 4; ++j) { s[2 * j] = T.dvec[sl * 128 + kk[2 * j]] * s[2 * j] + __builtin_bit_cast(float, l4[j] << 16);
                    s[2 * j + 1] = T.dvec[sl * 128 + kk[2 * j + 1]] * s[2 * j + 1] + __builtin_bit_cast(float, l4[j] & 0xffff0000u); }
            }
            u32x4 o; o.x = cvt_pk_bf16(s[0], s[1]); o.y = cvt_pk_bf16(s[2], s[3]); o.z = cvt_pk_bf16(s[4], s[5]); o.w = cvt_pk_bf16(s[6], s[7]);
            *sp = o;
        }
    }
}
__device__ __forceinline__ void scan_phase_c(LAS unsigned char* lds, const ScanT& T, int G, int bx) {
    for (int it = bx; it < 512; it += G) {
        const int sc = it & 15, h = (it >> 4) & 7, b = it >> 7;
        scan_item<true>(lds, T, 4096 + b * 4096 + sc * 256, h, true, true, T.slots + slot_of(0, b, h, sc) * SLOT_ELEMS, T.slots + slot_of(1, b, h, sc) * SLOT_ELEMS,
                        nullptr, nullptr, nullptr, nullptr, nullptr, nullptr);
    }
}

#define XB_TMO      128
#define XB_XCNT(j)  (256  + 64 * (j))
#define XB_XSUB(j)  (1280 + 64 * (j))
#define XB_XGEN(j)  (2304 + 64 * (j))
#define XB_TOP      3328
#define XB_TOPGEN   3392
#define XCD_BAR_WORDS 3456
#define XB_SPIN_CAP (1u << 18)
__device__ __forceinline__ unsigned xb_ld(unsigned* p)              { return __hip_atomic_load(p, __ATOMIC_RELAXED, __HIP_MEMORY_SCOPE_AGENT); }
__device__ __forceinline__ unsigned xb_add(unsigned* p, unsigned v) { return __hip_atomic_fetch_add(p, v, __ATOMIC_RELAXED, __HIP_MEMORY_SCOPE_AGENT); }
__device__ __forceinline__ unsigned xb_xcc_id() { return (unsigned)__builtin_amdgcn_s_getreg((3 << 11) | 20) & 0xFu; }
#define XB_SPIN(cond, bar) do { unsigned _sp = 0; while (cond) { __builtin_amdgcn_s_sleep(1); \
    if ((++_sp & 255u) == 0u) { if (xb_ld(&(bar)[XB_TMO])) break; if (_sp > XB_SPIN_CAP) { atomicAdd(&(bar)[XB_TMO], 1u); break; } } } } while (0)
struct XcdBarrier { unsigned* bar; unsigned x; volatile LAS unsigned* st; };
__device__ __forceinline__ XcdBarrier xcd_barrier_post(unsigned* bar, volatile LAS unsigned* st) {
    XcdBarrier b; b.bar = bar; b.x = xb_xcc_id(); b.st = st;
    if (threadIdx.x == 0) (void)xb_add(&bar[XB_XCNT(b.x)], 1u);
    return b;
}
__device__ __forceinline__ void xcd_barrier_complete(unsigned* bar, unsigned x, unsigned& nloc, unsigned& nx) {
    const unsigned G = gridDim.x * gridDim.y * gridDim.z;
    unsigned sum, cnt, mine, sp = 0u;
    for (;;) {
        sum = 0u; cnt = 0u; mine = 0u;
#pragma unroll
        for (unsigned j = 0; j < 16; ++j) { const unsigned c = xb_ld(&bar[XB_XCNT(j)]); sum += c; cnt += (c > 0u) ? 1u : 0u; mine = (j == x) ? c : mine; }
        if (sum == G) break;
        __builtin_amdgcn_s_sleep(1);
        if ((++sp & 255u) == 0u) { if (xb_ld(&bar[XB_TMO])) break; if (sp > XB_SPIN_CAP) { atomicAdd(&bar[XB_TMO], 1u); break; } }
    }
    nloc = mine > 0u ? mine : 1u; nx = cnt > 0u ? cnt : 1u;
}
__device__ __forceinline__ void xcd_barrier(const XcdBarrier& b) {
    asm volatile("s_waitcnt vmcnt(0)" ::: "memory");
    __syncthreads();
    if (threadIdx.x == 0) {
        unsigned* bar = b.bar;
        __builtin_amdgcn_s_waitcnt(0);
        unsigned nloc = b.st[0], nx = b.st[1];
        if (nloc == 0u) { xcd_barrier_complete(bar, b.x, nloc, nx); b.st[0] = nloc; b.st[1] = nx; }
        const unsigned old = xb_add(&bar[XB_XSUB(b.x)], 1u);
        const unsigned gen = old / nloc;
        if (old + 1u == (gen + 1u) * nloc) {
            __builtin_amdgcn_fence(__ATOMIC_RELEASE, "agent");
            asm volatile("s_waitcnt vmcnt(0)" ::: "memory");
            const unsigned og = xb_add(&bar[XB_TOP], 1u);
            const unsigned tg = og / nx;
            if (og + 1u == (tg + 1u) * nx) xb_add(&bar[XB_TOPGEN], 1u);
            else XB_SPIN(xb_ld(&bar[XB_TOPGEN]) == tg, bar);
            __builtin_amdgcn_fence(__ATOMIC_ACQUIRE, "agent");
            xb_add(&bar[XB_XGEN(b.x)], 1u);
            asm volatile("s_waitcnt vmcnt(0)" ::: "memory");
        } else {
            XB_SPIN(xb_ld(&bar[XB_XGEN(b.x)]) == gen, bar);
            __builtin_amdgcn_fence(__ATOMIC_ACQUIRE, "agent");
            asm volatile("s_waitcnt vmcnt(0)" ::: "memory");
        }
    }
    __syncthreads();
}

struct Args { const float* in[17]; float* out; unsigned char* ws; int ph_lo, ph_hi; };
enum { PH_PREP = 0, PH_EMBED = 1, PH_FN_CHAN = 2, PH_FN_POS1 = 3, PH_FN_POS2 = 4, PH_FN_WO = 5, PH_NORM_MLP0 = 6, PH_MLP1_0 = 7, PH_MLP2_0 = 8, PH_NORM_MIX1 = 9, PH_WIN = 10,
       PH_SCAN_A = 11, PH_SCAN_B = 12, PH_SCAN_C = 13, PH_HG_WO = 14, PH_NORM_MLP1 = 15, PH_MLP1_1 = 16, PH_MLP2_1 = 17, PH_FINAL = 18, PH_END = 19 };
constexpr int LDS_BYTES = 160 * 1024, MISC_OFF = LDS_BYTES - 512;

__global__ void __launch_bounds__(NTHREADS, 2) fwd(Args a) {
    extern __shared__ __attribute__((aligned(16))) unsigned char lds_raw[];
    LAS unsigned char* lds = (LAS unsigned char*)lds_raw;
    const int tid = threadIdx.x, lane = tid & 63, wave = __builtin_amdgcn_readfirstlane(tid >> 6);
    const int G = gridDim.x, bx = blockIdx.x;
    const int gw = bx * NWAVES + wave, ngw = G * NWAVES;
    unsigned char* ws = a.ws;
    const float* mod = (const float*)(ws + WM.mod);
    bf16_t* Hb = (bf16_t*)(ws + WM.h);
    bf16_t* Big = (bf16_t*)(ws + WM.big[0]); bf16_t* Big1 = (bf16_t*)(ws + WM.big[1]);
    const float* norm_mlp = a.in[8];
    const float* w1 = a.in[14]; const float* w2 = a.in[15];
    const float* norm_mix = a.in[7]; const float* fnet_wo = a.in[9];
    float* modw = (float*)(ws + WM.mod);
#define IN(k) (a.ph_lo <= (k) && (k) < a.ph_hi)
    if (tid < 128) ((LAS unsigned*)(lds + MISC_OFF))[tid] = 0u;
    __syncthreads();
    XcdBarrier bar = xcd_barrier_post((unsigned*)ws, (volatile LAS unsigned*)(lds + MISC_OFF));
#if defined(PROBE_A)
#define STAMP(k) do { if (bx == 0 && tid == 0) ((LAS unsigned long long*)(lds + MISC_OFF + 64))[(k)] = __builtin_amdgcn_s_memrealtime(); } while (0)
#else
#define STAMP(k) do { } while (0)
#endif
    STAMP(0);
#define SEAM(k) do { if (IN(k) && IN((k) + 1)) xcd_barrier(bar); STAMP((k) + 1); } while (0)
    if (IN(PH_PREP)) {
        LAS float* scr = (LAS float*)(lds + wave * 16384);
        constexpr int I_1 = (1024 / 64) * (4096 / 32), I_2 = (4096 / 64) * (1024 / 32);
        constexpr int I_F = (1024 / 64) * (1024 / 32), I_W = (1024 / 64) * (5120 / 32);
        constexpr int NITEMS = I_1 + I_2 + I_F + I_F + I_W;
        LAS unsigned char* prof_lds_ = (LAS unsigned char*)0; (void)prof_lds_; PROF_DECL; PROF_BEGIN();
        for (int un = bx; un < 384; un += G) mod_unit(lds, un, a.in[3], a.in[4], a.in[5], a.in[6], modw, tid, wave, lane);
        if (bx == G - 1) for (int i = tid; i < 2048; i += NTHREADS) { const int dir = i >> 10, ch = i & 1023; const float l0 = a.in[11][(dir * 2 + 0) * 1024 + ch], l1 = a.in[11][(dir * 2 + 1) * 1024 + ch];
            const float mx = fmaxf(l0, l1), e0 = __expf(l0 - mx), e1 = __expf(l1 - mx); ((float*)(ws + WM.lb))[i] = e1 / (e0 + e1); }
        PROF_END(60); PROF_BEGIN();
        gen_tables(ws, (long)bx * NTHREADS + tid, (long)G * NTHREADS);
        PROF_END(61); PROF_BEGIN();
        transpose_stream(gw, NITEMS, ngw, [&](int it) -> TrItem {
            int r = it;
            if (r < I_F) return TrItem{fnet_wo, (bf16_t*)(ws + WM.wfnet), 1024, 1024, r}; r -= I_F;
            if (r < I_F) return TrItem{a.in[13], (bf16_t*)(ws + WM.who), 1024, 1024, r}; r -= I_F;
            if (r < I_W) return TrItem{a.in[10], (bf16_t*)(ws + WM.win), 1024, 5120, r}; r -= I_W;
            if (r < I_1) return TrItem{w1, (bf16_t*)(ws + WM.w1[0]), 1024, 4096, r}; r -= I_1;
            return TrItem{w2, (bf16_t*)(ws + WM.w2[0]), 4096, 1024, r}; }, scr, lane);
        PROF_END(62);
    }
    SEAM(PH_PREP);
    if (IN(PH_EMBED)) embed_rows(a.in[0], a.in[1], (const float*)(ws + WM.pos), (const float*)(ws + WM.pos) + 64 * 512, norm_mix, mod, Hb, gw, ngw, lane);
    SEAM(PH_EMBED);
    if (IN(PH_FN_CHAN)) {
        { ProbChan p; p.init(0, ws + WM.dftc, Hb, (bf16_t*)(ws + WM.yctx), G, bx); gemm_phase<ProbChan, true, true>(lds, p); }
        { ProbChan p; p.init(1, ws + WM.dftc, Hb, (bf16_t*)(ws + WM.ysmp), G, bx); gemm_phase<ProbChan, true, true>(lds, p); }
    }
    SEAM(PH_FN_CHAN);
    if (IN(PH_FN_POS1)) {
        { ProbPosCtx p; p.init(ws + WM.dl256, (const bf16_t*)(ws + WM.yctx), Hb, G, bx); gemm_phase<ProbPosCtx, true, true>(lds, p); }
        { ProbSmpA p; p.init(ws + WM.fa2, (const bf16_t*)(ws + WM.ysmp), (bf16_t*)(ws + WM.u), G, bx); gemm_phase<ProbSmpA, true, true>(lds, p); }
    }
    SEAM(PH_FN_POS1);
    if (IN(PH_FN_POS2)) { ProbSmpB p; p.init(ws + WM.mb, (const bf16_t*)(ws + WM.u), Hb, G, bx); gemm_phase<ProbSmpB, true, true>(lds, p); }
    SEAM(PH_FN_POS2);
    if (IN(PH_FN_WO)) { ProbResidFirst p; p.init_tok(Hb, 1024, ws + WM.wfnet, 1024, 0, 80, 4, G, bx); p.X = (bf16_t*)a.out; p.mod = mod; p.layer = 0; p.gidx = 2; p.init_split(G, bx, (unsigned short*)(ws + SLAB_FN)); p.xp = a.in[0]; p.xs = a.in[1]; p.er = (const float*)(ws + WM.pos); p.ec = p.er + 64 * 512; p.prof_id = 20; gemm_phase<ProbResidFirst, true, true>(lds, p); }
    SEAM(PH_FN_WO);
    if (IN(PH_NORM_MLP0)) { build_split_table(lds, G, tid); norm_rows((bf16_t*)a.out, 0, 20480, norm_mlp, mod, 0, 3, Hb, gw, ngw, lane, lds, (const unsigned short*)(ws + SLAB_FN)); }
    SEAM(PH_NORM_MLP0);
    if (IN(PH_MLP1_0)) { ProbMlp1 p; p.init_tok(Hb, 1024, ws + WM.w1[0], 1024, 0, 80, 4096 / BM, G, bx); p.O = Big; p.ldc = 4096; p.prof_id = 40; gemm_phase<ProbMlp1, true, true>(lds, p); }
    SEAM(PH_MLP1_0);
    if (IN(PH_MLP2_0)) { ProbResid p; p.init_tok(Big, 4096, ws + WM.w2[0], 4096, 0, 80, 1024 / BM, G, bx); p.X = (bf16_t*)a.out; p.mod = mod; p.layer = 0; p.gidx = 5; p.init_split(G, bx, (unsigned short*)(ws + SLAB_M0)); gemm_phase<ProbResid, true, true>(lds, p); }
    SEAM(PH_MLP2_0);
    if (IN(PH_NORM_MIX1)) { build_split_table(lds, G, tid); norm_rows((bf16_t*)a.out, 0, 20480, norm_mix + 1024, mod, 1, 0, Hb, gw, ngw, lane, lds, (const unsigned short*)(ws + SLAB_M0)); }
    SEAM(PH_NORM_MIX1);
    if (IN(PH_WIN)) { ProbWin p; p.init_tok(Hb, 1024, ws + WM.win, 1024, 0, 80, 20, G, bx); p.Oq = (bf16_t*)(ws + WM.q); p.Offw = (bf16_t*)(ws + WM.lffw); p.Ofbw = (bf16_t*)(ws + WM.lfbw);
        p.Ov = (bf16_t*)(ws + WM.v); p.Osg = (bf16_t*)(ws + WM.sg); p.lb = (const float*)(ws + WM.lb); p.prof_id = 50; gemm_phase<ProbWin, true, true>(lds, p); }
    SEAM(PH_WIN);
    if (IN(PH_SCAN_A) || IN(PH_SCAN_B) || IN(PH_SCAN_C)) {
        ScanT st; st.q = (const bf16_t*)(ws + WM.q); st.lffw = (const bf16_t*)(ws + WM.lffw); st.lfbw = (const bf16_t*)(ws + WM.lfbw); st.v = (const bf16_t*)(ws + WM.v); st.sg = (bf16_t*)(ws + WM.sg);
        st.slots = (bf16_t*)(ws + WM.slots); st.dvec = (float*)(ws + WM.dvec); st.gnorm = a.in[12]; st.state_in = a.in[2]; st.new_state = a.out + (size_t)20480 * 1024;
        if (IN(PH_SCAN_A)) scan_phase_a(lds, st, G, bx);
        SEAM(PH_SCAN_A);
        if (IN(PH_SCAN_B)) scan_phase_b(st, G, bx, tid);
        SEAM(PH_SCAN_B);
        if (IN(PH_SCAN_C)) scan_phase_c(lds, st, G, bx);
    }
    SEAM(PH_SCAN_C);
    if (IN(PH_HG_WO)) {
        { LAS float* scr = (LAS float*)(lds + wave * 16384);
          constexpr int I_1 = (1024 / 64) * (4096 / 32), I_2 = (4096 / 64) * (1024 / 32);
          transpose_stream(gw, I_1 + I_2, ngw, [&](int it) -> TrItem {
              if (it < I_1) return TrItem{w1 + (size_t)1024 * 4096, (bf16_t*)(ws + WM.w1[1]), 1024, 4096, it};
              return TrItem{w2 + (size_t)4096 * 1024, (bf16_t*)(ws + WM.w2[1]), 4096, 1024, it - I_1}; }, scr, lane);
          __syncthreads(); }
        ProbResid p; p.init_tok((bf16_t*)(ws + WM.sg), 1024, ws + WM.who, 1024, 0, 80, 4, G, bx); p.X = (bf16_t*)a.out; p.mod = mod; p.layer = 1; p.gidx = 2; p.init_split(G, bx, (unsigned short*)(ws + SLAB_HG)); gemm_phase<ProbResid, true, true>(lds, p); }
    SEAM(PH_HG_WO);
    if (IN(PH_NORM_MLP1)) { build_split_table(lds, G, tid); norm_rows((bf16_t*)a.out, 0, 20480, norm_mlp + 1024, mod, 1, 3, Hb, gw, ngw, lane, lds, (const unsigned short*)(ws + SLAB_HG)); }
    SEAM(PH_NORM_MLP1);
    if (IN(PH_MLP1_1)) { ProbMlp1 p; p.init_tok(Hb, 1024, ws + WM.w1[1], 1024, 0, 80, 4096 / BM, G, bx); p.O = Big1; p.ldc = 4096; gemm_phase<ProbMlp1, true, true>(lds, p); }
    SEAM(PH_MLP1_1);
    if (IN(PH_MLP2_1)) { ProbResid p; p.init_tok(Big1, 4096, ws + WM.w2[1], 4096, 0, 80, 1024 / BM, G, bx); p.X = (bf16_t*)a.out; p.mod = mod; p.layer = 1; p.gidx = 5; p.init_split(G, bx, (unsigned short*)(ws + SLAB_M1)); gemm_phase<ProbResid, true, true>(lds, p); }
    SEAM(PH_MLP2_1);
    if (IN(PH_FINAL)) { build_split_table(lds, G, tid); final_rows(a.out, 0, 20480, a.in[16], gw, ngw, lane, lds, (const unsigned short*)(ws + SLAB_M1)); }
#if defined(PROF_ID)
    if (bx == 0 && tid == 0) { const unsigned long long d = *(LAS unsigned long long*)(lds + LDS_BYTES - 512 + 256); const unsigned long long t0 = __builtin_amdgcn_s_memrealtime(); while (__builtin_amdgcn_s_memrealtime() - t0 < 16ull * d) __builtin_amdgcn_s_sleep(8); }
#endif
#if defined(PROBE_A)
    if (bx == 0 && tid == 0) { asm volatile("s_waitcnt vmcnt(0)" ::: "memory"); STAMP(PH_END); const unsigned long long d = ((LAS unsigned long long*)(lds + MISC_OFF + 64))[PROBE_B] - ((LAS unsigned long long*)(lds + MISC_OFF + 64))[PROBE_A];
        const unsigned long long t0 = __builtin_amdgcn_s_memrealtime(); while (__builtin_amdgcn_s_memrealtime() - t0 < 4ull * d) __builtin_amdgcn_s_sleep(8); }
#endif
#undef IN
}
}
#ifndef MK_N_LAUNCHES
#define MK_N_LAUNCHES 1
#endif
extern "C" void kernel_launch(void* const* d_in, const int* in_sizes, int n_in, void* d_out, int out_size, void* d_ws, size_t ws_size, hipStream_t stream) {
    static int grid = 0;
    if (grid == 0) {
        int dev = 0, cus = 0;
        if (hipGetDevice(&dev) != hipSuccess || hipDeviceGetAttribute(&cus, hipDeviceAttributeMultiprocessorCount, dev) != hipSuccess || cus <= 0) cus = 256;
        hipFuncSetAttribute((const void*)fk::fwd, hipFuncAttributeMaxDynamicSharedMemorySize, fk::LDS_BYTES);
        int per_cu = 0;
        if (hipOccupancyMaxActiveBlocksPerMultiprocessor(&per_cu, (const void*)fk::fwd, fk::NTHREADS, fk::LDS_BYTES) != hipSuccess || per_cu < 1)
            fprintf(stderr, "kernel_launch: occupancy query reports %d workgroups per CU\n", per_cu);
        (void)hipGetLastError();
        grid = cus;
    }
    hipMemsetAsync(d_ws, 0, fk::CTL_BYTES, stream);
    fk::Args a{};
    for (int i = 0; i < 17; ++i) a.in[i] = (const float*)d_in[i];
    a.out = (float*)d_out; a.ws = (unsigned char*)d_ws;
#if MK_N_LAUNCHES == 1
    a.ph_lo = 0; a.ph_hi = fk::PH_END;
    hipLaunchKernelGGL(fk::fwd, dim3(grid), dim3(fk::NTHREADS), fk::LDS_BYTES, stream, a);
#else
    for (int ph = 0; ph < fk::PH_END; ++ph) { a.ph_lo = ph; a.ph_hi = ph + 1; hipLaunchKernelGGL(fk::fwd, dim3(grid), dim3(fk::NTHREADS), fk::LDS_BYTES, stream, a); }
#endif
}
```

```cpp
#include <hip/hip_runtime.h>
#include <cstdint>
#include <cstdio>
namespace fk {
#define LAS __attribute__((address_space(3)))
#define GAS __attribute__((address_space(1)))
typedef unsigned short bf16_t;
typedef short bf16x8 __attribute__((ext_vector_type(8)));
typedef float f32x4 __attribute__((ext_vector_type(4)));
typedef float f32x2 __attribute__((ext_vector_type(2)));
typedef unsigned u32x4 __attribute__((ext_vector_type(4)));
typedef unsigned u32x2 __attribute__((ext_vector_type(2)));
constexpr int BM = 256, BK = 64, HALF = 128, HTB = HALF * BK * 2, STAGE_BYTES = 8 * HTB, NXCD = 8, WGM = 8;
constexpr int NWAVES = 8, NTHREADS = 512;

__device__ __forceinline__ int lds_byte(int r, int c) { const int st = (r >> 4) * 2 + (c >> 5), rr = r & 15, cc = c & 31, ob = rr * 64 + cc * 2; return st * 1024 + (ob ^ (((ob >> 9) & 1) << 5)); }
__device__ __forceinline__ void stage_rc(int b, int& R, int& C) { const int st = b / 1024, sb = b % 1024, swz = sb ^ (((sb >> 9) & 1) << 5); R = (st >> 1) * 16 + swz / 64; C = (st & 1) * 32 + (swz % 64) / 2; }
__device__ __forceinline__ int perm32(int rho) { const int n = rho >> 4, i = rho & 15; return 8 * (i >> 2) + 4 * n + (i & 3); }
__device__ __forceinline__ unsigned cvt_pk_bf16(float lo, float hi) { unsigned r; asm volatile("v_cvt_pk_bf16_f32 %0, %1, %2" : "=v"(r) : "v"(lo), "v"(hi)); return r; }
__device__ __forceinline__ unsigned f2bf(float f) { unsigned u = __builtin_bit_cast(unsigned, f); return (u + 0x7fffu + ((u >> 16) & 1u)) >> 16; }
__device__ __forceinline__ unsigned pk2(float lo, float hi) { return f2bf(lo) | (f2bf(hi) << 16); }
__device__ __forceinline__ float bf2f(unsigned short b) { return __builtin_bit_cast(float, (unsigned)b << 16); }
__device__ __forceinline__ unsigned pk2h(float lo, float hi) { const _Float16 a = (_Float16)lo, b = (_Float16)hi; return (unsigned)__builtin_bit_cast(unsigned short, a) | ((unsigned)__builtin_bit_cast(unsigned short, b) << 16); }
__device__ __forceinline__ float h2f_(unsigned short b) { return (float)__builtin_bit_cast(_Float16, b); }
__device__ __forceinline__ f32x4 ld_bf4(const void* p) { const u32x2 w = *(const u32x2*)p; return (f32x4){__builtin_bit_cast(float, w.x << 16), __builtin_bit_cast(float, w.x & 0xffff0000u), __builtin_bit_cast(float, w.y << 16), __builtin_bit_cast(float, w.y & 0xffff0000u)}; }
__device__ __forceinline__ void st_bf4(void* p, const f32x4& v) { u32x2 w; w.x = cvt_pk_bf16(v[0], v[1]); w.y = cvt_pk_bf16(v[2], v[3]); *(u32x2*)p = w; }
__device__ __forceinline__ float silu(float x) { return x / (1.f + __expf(-x)); }
__device__ __forceinline__ float wave_sum(float v) {
#pragma unroll
    for (int o = 1; o < 64; o <<= 1) v += __shfl_xor(v, o);
    return v;
}

constexpr unsigned long long KiB = 1024ull, MiB = 1ull << 20;
struct WsMapT { unsigned long long slots, dvec, lb, q, lffw, lfbw, v, sg, mod, pos, dftc, dl256, fa2, mb, wfnet, who, win, w1[2], w2[2], h, yctx, ysmp, u, big[2]; };
constexpr WsMapT WM = {   13 * MiB,   45 * MiB,   320 * KiB,   53 * MiB,   93 * MiB,   133 * MiB,   173 * MiB,   213 * MiB,   64 * KiB,   512 * KiB,
      53 * MiB,   53 * MiB + 256 * KiB,   53 * MiB + 512 * KiB,   54 * MiB,   59 * MiB,   1 * MiB,   3 * MiB,   {61 * MiB, 53 * MiB},   {237 * MiB, 61 * MiB},
      13 * MiB,   77 * MiB,   93 * MiB,   157 * MiB,   {77 * MiB, 69 * MiB} };
constexpr unsigned long long SLAB_FN = 77 * MiB, SLAB_M0 = 53 * MiB, SLAB_HG = 69 * MiB, SLAB_M1 = 13 * MiB;
constexpr unsigned long long CTL_BYTES = 16 * KiB;
#if defined(PROF_ID)
#define PROF_DECL unsigned long long prof_t0_ = 0ull; const bool prof_on_ = (blockIdx.x == 0) && (__builtin_amdgcn_readfirstlane(threadIdx.x >> 6) == 0)
#define PROF_BEGIN() do { if (prof_on_) prof_t0_ = __builtin_amdgcn_s_memrealtime(); } while (0)
#define PROF_END(id) do { if (prof_on_ && (id) == PROF_ID) { const unsigned long long d_ = __builtin_amdgcn_s_memrealtime() - prof_t0_; if (threadIdx.x == 0) *(LAS unsigned long long*)(prof_lds_ + 160 * 1024 - 512 + 256) += d_; } } while (0)
#else
#define PROF_DECL
#define PROF_BEGIN() do { } while (0)
#define PROF_END(id) do { } while (0)
#endif

struct Unit { size_t offA, offB; int p0, p1, p2, p3, nt; };
struct OpMap { int rm; unsigned s1, s2; };
__device__ __forceinline__ unsigned rowoff(const OpMap& m, int R) { return (unsigned)(R % m.rm) * m.s1 + (unsigned)(R / m.rm) * m.s2; }

template <class P, bool ALIGN_EPI, bool SP2>
__device__ __forceinline__ void gemm_phase(LAS unsigned char* lds, const P& pb) {
    const int tid = threadIdx.x, wid = __builtin_amdgcn_readfirstlane(tid >> 6), lane = tid & 63, wr = wid >> 2, wc = wid & 3, fr = lane & 15, fq = lane >> 4;
    unsigned voffA[2], voffB[2];
#pragma unroll
    for (int i = 0; i < 2; ++i) { int R, C; stage_rc(tid * 16 + i * 8192, R, C); const int Rb = P::PERM ? ((R & ~31) + perm32(R & 31)) : R;
        voffA[i] = rowoff(pb.ma, R) + (unsigned)C * 2u; voffB[i] = rowoff(pb.mb, Rb) + (unsigned)C * 2u; }
    const size_t kstepA = pb.kstepA, kstepB = pb.kstepB, hstepA = pb.hstepA, hstepB = pb.hstepB;
    const unsigned ldsw = (unsigned)wid * 1024u;
    const int aoff = lds_byte(wr * 64 + fr, fq * 8), boff = lds_byte(wc * 32 + fr, fq * 8);
#define PG8_SA(b, h) (((b) * 2 + (h)) * HTB)
#define PG8_SB(b, h) ((4 + (b) * 2 + (h)) * HTB)
#define PG8_STAGE(bufoff, gbase, voff) do { _Pragma("unroll") for (int _i = 0; _i < 2; ++_i) \
        __builtin_amdgcn_global_load_lds((const unsigned*)((const char*)(gbase) + (voff)[_i]), (LAS unsigned*)(lds + (bufoff) + ldsw + _i * 8192), 16, 0, 0); } while (0)
#define PG8_LDA(dst, b, h) do { _Pragma("unroll") for (int m = 0; m < 4; ++m) _Pragma("unroll") for (int k = 0; k < 2; ++k) dst[m][k] = *(const LAS bf16x8*)(lds + PG8_SA(b, h) + aoff + m * 2048 + k * 1024); } while (0)
#define PG8_LDB(dst, b, h) do { _Pragma("unroll") for (int n = 0; n < 2; ++n) _Pragma("unroll") for (int k = 0; k < 2; ++k) dst[n][k] = *(const LAS bf16x8*)(lds + PG8_SB(b, h) + boff + n * 2048 + k * 1024); } while (0)
#define PG8_MMA(ai, bj, At, Bt) do { __builtin_amdgcn_s_setprio(1); _Pragma("unroll") for (int m = 0; m < 4; ++m) _Pragma("unroll") for (int n = 0; n < 2; ++n) _Pragma("unroll") for (int k = 0; k < 2; ++k) \
        acc[ai][bj][m][n] = __builtin_amdgcn_mfma_f32_16x16x32_bf16(Bt[n][k], At[m][k], acc[ai][bj][m][n], 0, 0, 0); __builtin_amdgcn_s_setprio(0); } while (0)
#define PG8_WAIT_V(n) asm volatile("s_waitcnt vmcnt(" #n ")" ::: "memory")
#define PG8_WAIT_L(n) asm volatile("s_waitcnt lgkmcnt(" #n ")" ::: "memory")
#define PG8_BAR __builtin_amdgcn_s_barrier()
#define PG8_SCHED __builtin_amdgcn_sched_barrier(0)
    LAS unsigned char* prof_lds_ = (LAS unsigned char*)0; (void)prof_lds_; PROF_DECL; PROF_BEGIN();
    Unit cur, nxt; int ui = 0;
    if (!pb.next(0, cur)) return;
    f32x4 acc[2][2][4][2];
#pragma unroll
    for (int a = 0; a < 2; ++a)
#pragma unroll
        for (int b = 0; b < 2; ++b)
#pragma unroll
            for (int m = 0; m < 4; ++m)
#pragma unroll
                for (int n = 0; n < 2; ++n) acc[a][b][m][n] = (f32x4){0.f, 0.f, 0.f, 0.f};
    bf16x8 At[4][2], B0[2][2], B1[2][2];
    const char* cA = pb.A + cur.offA; const char* cB = pb.B + cur.offB;
    if constexpr (SP2) {
        PG8_STAGE(PG8_SB(0, 0), cB, voffB); PG8_STAGE(PG8_SB(0, 1), cB + hstepB, voffB); PG8_STAGE(PG8_SA(0, 0), cA, voffA); PG8_STAGE(PG8_SA(0, 1), cA + hstepA, voffA);
        if (wr == 1) PG8_BAR;
        PG8_WAIT_V(2); PG8_BAR;
        PG8_STAGE(PG8_SB(1, 0), cB + kstepB, voffB); PG8_STAGE(PG8_SA(1, 0), cA + kstepA, voffA); PG8_STAGE(PG8_SB(1, 1), cB + hstepB + kstepB, voffB);
        PG8_WAIT_V(6); PG8_BAR;
    } else {
        PG8_STAGE(PG8_SB(0, 0), cB, voffB); PG8_STAGE(PG8_SA(0, 0), cA, voffA); PG8_STAGE(PG8_SB(0, 1), cB + hstepB, voffB); PG8_STAGE(PG8_SA(0, 1), cA + hstepA, voffA);
        if (wr == 1) PG8_BAR;
        PG8_WAIT_V(4); PG8_BAR;
        PG8_STAGE(PG8_SB(1, 0), cB + kstepB, voffB); PG8_STAGE(PG8_SA(1, 0), cA + kstepA, voffA); PG8_STAGE(PG8_SB(1, 1), cB + hstepB + kstepB, voffB);
        PG8_WAIT_V(6); PG8_BAR;
    }
    for (;;) {
        const bool has_next = pb.next(ui + 1, nxt);
        const char* nA = has_next ? pb.A + nxt.offA : cA; const char* nB = has_next ? pb.B + nxt.offB : cB;
        const int nt = cur.nt;
        for (int t = 0; t < nt; t += 2) {
            const bool last = (t == nt - 2);
            const char* a1 = cA + (size_t)(t + 1) * kstepA;
            const char* a2 = last ? nA : cA + (size_t)(t + 2) * kstepA; const char* b2 = last ? nB : cB + (size_t)(t + 2) * kstepB;
            const char* a3 = a2 + kstepA; const char* b3 = b2 + kstepB;
            if constexpr (SP2) {
            PG8_LDB(B0, 0, 0); PG8_LDB(B1, 0, 1); PG8_SCHED; PG8_LDA(At, 0, 0); PG8_STAGE(PG8_SA(1, 1), a1 + hstepA, voffA);
            PG8_WAIT_V(8); PG8_WAIT_L(0); PG8_BAR; PG8_MMA(0, 0, At, B0); PG8_MMA(0, 1, At, B1); PG8_BAR; PG8_SCHED;
            PG8_LDA(At, 0, 1); PG8_STAGE(PG8_SB(0, 0), b2, voffB); PG8_STAGE(PG8_SB(0, 1), b2 + hstepB, voffB); PG8_STAGE(PG8_SA(0, 0), a2, voffA);
            PG8_WAIT_V(8); PG8_WAIT_L(0); PG8_BAR; PG8_MMA(1, 0, At, B0); PG8_MMA(1, 1, At, B1); PG8_BAR; PG8_SCHED;
            PG8_LDB(B0, 1, 0); PG8_LDB(B1, 1, 1); PG8_SCHED; PG8_LDA(At, 1, 0); PG8_STAGE(PG8_SA(0, 1), a2 + hstepA, voffA);
            PG8_WAIT_V(8); PG8_WAIT_L(0); PG8_BAR; PG8_MMA(0, 0, At, B0); PG8_MMA(0, 1, At, B1); PG8_BAR; PG8_SCHED;
            PG8_LDA(At, 1, 1); PG8_STAGE(PG8_SB(1, 0), b3, voffB); PG8_STAGE(PG8_SB(1, 1), b3 + hstepB, voffB); PG8_STAGE(PG8_SA(1, 0), a3, voffA);
            PG8_WAIT_V(8); PG8_WAIT_L(0); PG8_BAR; PG8_MMA(1, 0, At, B0); PG8_MMA(1, 1, At, B1); PG8_BAR; PG8_SCHED;
            } else {
            PG8_LDB(B0, 0, 0); PG8_SCHED; PG8_LDA(At, 0, 0); PG8_STAGE(PG8_SA(1, 1), a1 + hstepA, voffA);
            PG8_WAIT_L(8); PG8_BAR; PG8_WAIT_L(0); PG8_MMA(0, 0, At, B0); PG8_BAR; PG8_SCHED;
            PG8_LDB(B1, 0, 1); PG8_STAGE(PG8_SB(0, 0), b2, voffB);
            PG8_BAR; PG8_WAIT_L(0); PG8_MMA(0, 1, At, B1); PG8_BAR;
            PG8_LDA(At, 0, 1); PG8_STAGE(PG8_SA(0, 0), a2, voffA);
            PG8_BAR; PG8_WAIT_L(0); PG8_MMA(1, 0, At, B0); PG8_BAR; PG8_SCHED;
            PG8_STAGE(PG8_SB(0, 1), b2 + hstepB, voffB);
            PG8_WAIT_V(6); PG8_BAR; PG8_MMA(1, 1, At, B1); PG8_BAR;
            PG8_LDB(B0, 1, 0); PG8_SCHED; PG8_LDA(At, 1, 0); PG8_STAGE(PG8_SA(0, 1), a2 + hstepA, voffA);
            PG8_WAIT_L(8); PG8_BAR; PG8_WAIT_L(0); PG8_MMA(0, 0, At, B0); PG8_BAR; PG8_SCHED;
            PG8_LDB(B1, 1, 1); PG8_STAGE(PG8_SB(1, 0), b3, voffB);
            PG8_BAR; PG8_WAIT_L(0); PG8_MMA(0, 1, At, B1); PG8_BAR;
            PG8_LDA(At, 1, 1); PG8_STAGE(PG8_SA(1, 0), a3, voffA);
            PG8_BAR; PG8_WAIT_L(0); PG8_MMA(1, 0, At, B0); PG8_BAR; PG8_SCHED;
            PG8_STAGE(PG8_SB(1, 1), b3 + hstepB, voffB);
            PG8_WAIT_V(6); PG8_BAR; PG8_MMA(1, 1, At, B1); PG8_BAR;
            }
        }
        if constexpr (ALIGN_EPI) { if (wr == 0) PG8_BAR; }
        PROF_END(pb.prof_id); PROF_BEGIN();
        pb.epi(acc, cur, wr, wc, fr, fq);
#if defined(PROF_ID)
        asm volatile("s_waitcnt vmcnt(0)" ::: "memory");
#endif
        PROF_END(pb.prof_id + 1); PROF_BEGIN();
        if (!has_next) break;
#pragma unroll
        for (int a = 0; a < 2; ++a)
#pragma unroll
            for (int b = 0; b < 2; ++b)
#pragma unroll
                for (int m = 0; m < 4; ++m)
#pragma unroll
                    for (int n = 0; n < 2; ++n) acc[a][b][m][n] = (f32x4){0.f, 0.f, 0.f, 0.f};
        cur = nxt; cA = nA; cB = nB; ++ui;
        if constexpr (ALIGN_EPI) { if (wr == 1) PG8_BAR; }
    }
    PG8_WAIT_V(0);
    if constexpr (!ALIGN_EPI) { if (wr == 0) PG8_BAR; }
    PG8_BAR;
#undef PG8_SA
#undef PG8_SB
#undef PG8_STAGE
#undef PG8_LDA
#undef PG8_LDB
#undef PG8_MMA
#undef PG8_WAIT_V
#undef PG8_WAIT_L
#undef PG8_BAR
#undef PG8_SCHED
}

struct StaticOrder {
    int nM, nN, nwg, G, c;
    __device__ void init(int nM_, int nN_, int G_, int c_) { nM = nM_; nN = nN_; nwg = nM * nN; G = G_; c = c_; }
    __device__ bool next(int i, int& pm, int& pn) const { const long L = (long)i * G + c; if (L >= nwg) return false; map((int)L, pm, pn); return true; }
    __device__ void map(int L, int& pm, int& pn) const {
        int wgid = L; { const int q = nwg / NXCD, r = nwg % NXCD, xcd = wgid % NXCD, off = wgid / NXCD; wgid = (xcd < r ? xcd * (q + 1) : r * (q + 1) + (xcd - r) * q) + off; }
        const int nig = WGM * nN, gid = wgid / nig, fm = gid * WGM, gsz = (nM - fm) < WGM ? (nM - fm) : WGM;
        pm = fm + ((wgid % nig) % gsz); pn = (wgid % nig) / gsz;
    }
};

struct ProbBase {
    const char* A; const char* B; OpMap ma, mb; size_t hstepA, hstepB, kstepA, kstepB; int nt; int prof_id = -100;
    __device__ void std_operands(const void* A_, int lda, const void* B_, int ldb, int K) {
        A = (const char*)A_; B = (const char*)B_; ma = OpMap{128, (unsigned)lda * 2u, 0u}; mb = OpMap{128, (unsigned)ldb * 2u, 0u};
        hstepA = (size_t)HALF * lda * 2; hstepB = (size_t)HALF * ldb * 2; kstepA = kstepB = BK * 2; nt = K / BK;
    }
};

template <class F> __device__ __forceinline__ void epi_rows_perm(const f32x4 (&acc)[2][2][4][2], int wr, int wc, int fr, int fq, F f) {
    asm volatile("" : "+v"(fr), "+v"(fq));
#pragma unroll
    for (int ai = 0; ai < 2; ++ai)
#pragma unroll
        for (int m = 0; m < 4; ++m)
#pragma unroll
            for (int bj = 0; bj < 2; ++bj) f(ai * HALF + wr * 64 + m * 16 + fr, bj * HALF + wc * 32 + 8 * fq, acc[ai][bj][m][0], acc[ai][bj][m][1]);
}
template <class F> __device__ __forceinline__ void epi_rows_f32(const f32x4 (&acc)[2][2][4][2], int wr, int wc, int fr, int fq, F f) {
    asm volatile("" : "+v"(fr), "+v"(fq));
#pragma unroll
    for (int ai = 0; ai < 2; ++ai)
#pragma unroll
        for (int m = 0; m < 4; ++m)
#pragma unroll
            for (int bj = 0; bj < 2; ++bj)
#pragma unroll
                for (int n = 0; n < 2; ++n) f(ai * HALF + wr * 64 + m * 16 + fr, bj * HALF + wc * 32 + 16 * n + 4 * fq, acc[ai][bj][m][n]);
}
__device__ __forceinline__ u32x4 pack8(const f32x4& v0, const f32x4& v1) { u32x4 w; w.x = cvt_pk_bf16(v0[0], v0[1]); w.y = cvt_pk_bf16(v0[2], v0[3]); w.z = cvt_pk_bf16(v1[0], v1[1]); w.w = cvt_pk_bf16(v1[2], v1[3]); return w; }

struct TokOrder : ProbBase {
    StaticOrder so; int row0, lda, ldb;
    __device__ void init_tok(const void* Act, int lda_, const void* Wt, int K, int row0_, int nM, int nN, int G, int c) { std_operands(Act, lda_, Wt, K, K); row0 = row0_; lda = lda_; ldb = K; so.init(nM, nN, G, c); }
    __device__ bool next(int i, Unit& u) const { int pm, pn; if (!so.next(i, pm, pn)) return false; u.p0 = pm; u.p1 = pn; u.p2 = -1; u.nt = nt; u.offA = (size_t)(row0 + pm * BM) * lda * 2; u.offB = (size_t)pn * BM * ldb * 2; return true; }
};
struct ProbMlp1 : TokOrder {
    static constexpr bool PERM = true;
    bf16_t* O; int ldc;
    __device__ __forceinline__ void epi(const f32x4 (&acc)[2][2][4][2], const Unit& u, int wr, int wc, int fr, int fq) const {
        bf16_t* base = O + (size_t)(row0 + u.p0 * BM) * ldc + u.p1 * BM;
        epi_rows_perm(acc, wr, wc, fr, fq, [&](int r, int c, f32x4 v0, f32x4 v1) {
#pragma unroll
            for (int j = 0; j < 4; ++j) { const float a = fmaxf(v0[j], 0.f), b = fmaxf(v1[j], 0.f); v0[j] = a * a; v1[j] = b * b; }
            *(u32x4*)(base + (size_t)r * ldc + c) = pack8(v0, v1); });
    }
};
template <bool FIRST> struct ProbResidT : TokOrder {
    static constexpr bool PERM = false;
    bf16_t* X; const float* mod; int layer, gidx; unsigned short* slab; int G2, c2;
    const float* xp; const float* xs; const float* er; const float* ec;
    __device__ void init_split(int G_, int c_, unsigned short* slab_) { G2 = G_; c2 = c_; slab = slab_; xp = nullptr; xs = nullptr; er = nullptr; ec = nullptr; }
    __device__ bool next(int i, Unit& u) const {
        if (G2 != 256) return TokOrder::next(i, u);
        int pm, pn;
        if (i > 1) return false;
        const int which = (c2 & 1) ? 1 - i : i;
        if (which == 0) { so.map(c2, pm, pn); u.p2 = -1; u.p3 = 0; u.nt = nt; u.offA = (size_t)(row0 + pm * BM) * lda * 2; u.offB = (size_t)pn * BM * ldb * 2; }
        else { const int L = 256 + (c2 >> 2), kq = c2 & 3, ntq = nt >> 2; so.map(L, pm, pn); u.p2 = kq; u.p3 = L - 256; u.nt = ntq;
            u.offA = (size_t)(row0 + pm * BM) * lda * 2 + (size_t)kq * ntq * BK * 2; u.offB = (size_t)pn * BM * ldb * 2 + (size_t)kq * ntq * BK * 2; }
        u.p0 = pm; u.p1 = pn; return true;
    }
    __device__ __forceinline__ void epi(const f32x4 (&acc)[2][2][4][2], const Unit& u, int wr, int wc, int fr, int fq) const {
        asm volatile("" : "+v"(fr), "+v"(fq));
        const int rowt = row0 + u.p0 * BM, cond = rowt >> 12, colt = u.p1 * BM;
        const float* gate = mod + ((size_t)(cond * 2 + layer) * 6 + gidx) * 1024 + colt + wc * 32 + 4 * fq;
        f32x4 gt[2][2];
#pragma unroll
        for (int bj = 0; bj < 2; ++bj)
#pragma unroll
            for (int n = 0; n < 2; ++n) gt[bj][n] = *(const f32x4*)(gate + bj * HALF + 16 * n);
        if (u.p2 <= 0) {
            bf16_t* base = X + (size_t)(rowt + wr * 64 + fr) * 2048 + (fr & 1) * 1024 + colt + wc * 32 + 4 * fq;
            if constexpr (FIRST) {
                const bool smp = rowt >= 4096, use_er = colt < 512; const int t0 = (rowt & 4095) + wr * 64 + fr;
                const float* xsrc = (smp ? xs + (size_t)(rowt - 4096) * 1024 : xp + (size_t)rowt * 1024) + (size_t)(wr * 64 + fr) * 1024 + colt + wc * 32 + 4 * fq;
                const float* pbase = (use_er ? er + colt : ec + colt - 512) + wc * 32 + 4 * fq;
#pragma unroll
                for (int ai = 0; ai < 2; ++ai)
#pragma unroll
                    for (int mp = 0; mp < 2; ++mp) {
                        f32x4 xv[2][2][2], pv[2][2][2];
#pragma unroll
                        for (int mm = 0; mm < 2; ++mm) { const int ro = ai * HALF + (2 * mp + mm) * 16; const int t = t0 + ro;
#pragma unroll
                            for (int bj = 0; bj < 2; ++bj)
#pragma unroll
                                for (int n = 0; n < 2; ++n) { xv[mm][bj][n] = *(const f32x4*)(xsrc + (size_t)ro * 1024 + bj * HALF + 16 * n);
                                    pv[mm][bj][n] = smp ? *(const f32x4*)(pbase + (use_er ? (t >> 6) : (t & 63)) * 512 + bj * HALF + 16 * n) : (f32x4){0.f, 0.f, 0.f, 0.f}; } }
#pragma unroll
                        for (int mm = 0; mm < 2; ++mm) { const int ro = ai * HALF + (2 * mp + mm) * 16;
#pragma unroll
                            for (int bj = 0; bj < 2; ++bj)
#pragma unroll
                                for (int n = 0; n < 2; ++n) st_bf4(base + (size_t)ro * 2048 + bj * HALF + 16 * n, xv[mm][bj][n] + pv[mm][bj][n] + gt[bj][n] * acc[ai][bj][2 * mp + mm][n]); }
                    }
            } else {
#pragma unroll
                for (int ai = 0; ai < 2; ++ai) {
                    u32x2 xw[4][2][2];
#pragma unroll
                    for (int m = 0; m < 4; ++m)
#pragma unroll
                        for (int bj = 0; bj < 2; ++bj)
#pragma unroll
                            for (int n = 0; n < 2; ++n) xw[m][bj][n] = *(const u32x2*)(base + (size_t)(ai * HALF + m * 16) * 2048 + bj * HALF + 16 * n);
#pragma unroll
                    for (int m = 0; m < 4; ++m)
#pragma unroll
                        for (int bj = 0; bj < 2; ++bj)
#pragma unroll
                            for (int n = 0; n < 2; ++n) { const u32x2 w = xw[m][bj][n];
                                const f32x4 x0 = (f32x4){__builtin_bit_cast(float, w.x << 16), __builtin_bit_cast(float, w.x & 0xffff0000u), __builtin_bit_cast(float, w.y << 16), __builtin_bit_cast(float, w.y & 0xffff0000u)};
                                st_bf4(base + (size_t)(ai * HALF + m * 16) * 2048 + bj * HALF + 16 * n, x0 + gt[bj][n] * acc[ai][bj][m][n]); }
                }
            }
        } else {
            unsigned short* base = slab + (size_t)(u.p3 * 3 + u.p2 - 1) * 65536 + (size_t)(wr * 64 + fr) * 256 + wc * 32 + 4 * fq;
#pragma unroll
            for (int ai = 0; ai < 2; ++ai)
#pragma unroll
                for (int m = 0; m < 4; ++m)
#pragma unroll
                    for (int bj = 0; bj < 2; ++bj)
#pragma unroll
                        for (int n = 0; n < 2; ++n) { const f32x4 w = gt[bj][n] * acc[ai][bj][m][n]; u32x2 o; o.x = pk2h(w[0], w[1]); o.y = pk2h(w[2], w[3]); *(u32x2*)(base + (size_t)(ai * HALF + m * 16) * 256 + bj * HALF + 16 * n) = o; }
        }
    }
};
typedef ProbResidT<false> ProbResid; typedef ProbResidT<true> ProbResidFirst;
__device__ __forceinline__ void build_split_table(LAS unsigned char* tab, int G, int tid) {
    for (int i = tid; i < 320; i += NTHREADS) tab[i] = 255;
    __syncthreads();
    if (G == 256) { StaticOrder so; so.init(80, 4, G, 0); for (int L = 256 + tid; L < 320; L += NTHREADS) { int pm, pn; so.map(L, pm, pn); tab[pm * 4 + pn] = (unsigned char)(L - 256); } }
    __syncthreads();
}
struct SlabRaw { u32x2 w[3]; };
__device__ __forceinline__ SlabRaw slab_load(const unsigned short* slab, int idx, int r255, int col) { SlabRaw s;
#pragma unroll
    for (int q = 0; q < 3; ++q) s.w[q] = *(const u32x2*)(slab + (size_t)(idx * 3 + q) * 65536 + (size_t)r255 * 256 + col);
    return s; }
__device__ __forceinline__ f32x4 slab_add(const SlabRaw& r) { f32x4 s = (f32x4){0.f, 0.f, 0.f, 0.f};
#pragma unroll
    for (int q = 0; q < 3; ++q) { s[0] += h2f_((unsigned short)(r.w[q].x & 0xffffu)); s[1] += h2f_((unsigned short)(r.w[q].x >> 16)); s[2] += h2f_((unsigned short)(r.w[q].y & 0xffffu)); s[3] += h2f_((unsigned short)(r.w[q].y >> 16)); }
    return s; }
__device__ __forceinline__ f32x4 slab_sum(const unsigned short* slab, int idx, int r255, int col) {
    f32x4 s = (f32x4){0.f, 0.f, 0.f, 0.f};
#pragma unroll
    for (int q = 0; q < 3; ++q) { const u32x2 w = *(const u32x2*)(slab + (size_t)(idx * 3 + q) * 65536 + (size_t)r255 * 256 + col);
        s[0] += h2f_((unsigned short)(w.x & 0xffffu)); s[1] += h2f_((unsigned short)(w.x >> 16)); s[2] += h2f_((unsigned short)(w.y & 0xffffu)); s[3] += h2f_((unsigned short)(w.y >> 16)); }
    return s;
}

struct ProbWin : TokOrder {
    static constexpr bool PERM = true;
    bf16_t* Oq; bf16_t* Offw; bf16_t* Ofbw; bf16_t* Ov; bf16_t* Osg; const float* lb;
    __device__ __forceinline__ void epi(const f32x4 (&acc)[2][2][4][2], const Unit& u, int wr, int wc, int fr, int fq) const {
        const int t = u.p1 >> 2, col0 = (u.p1 & 3) * BM;
        bf16_t* O = t == 0 ? Oq : t == 1 ? Offw : t == 2 ? Ofbw : t == 3 ? Ov : Osg;
        bf16_t* base = O + (size_t)(row0 + u.p0 * BM) * 1024 + col0;
        if (t == 1 || t == 2) {
            const float* lbp = lb + (t - 1) * 1024 + col0 + wc * 32 + 8 * fq;
            f32x4 lbv[2][2];
#pragma unroll
            for (int bj = 0; bj < 2; ++bj) { lbv[bj][0] = *(const f32x4*)(lbp + bj * HALF); lbv[bj][1] = *(const f32x4*)(lbp + bj * HALF + 4); }
            epi_rows_perm(acc, wr, wc, fr, fq, [&](int r, int c, f32x4 v0, f32x4 v1) {
                const f32x4 l0 = lbv[c >> 7][0], l1 = lbv[c >> 7][1];
#pragma unroll
                for (int j = 0; j < 4; ++j) { v0[j] = __builtin_amdgcn_logf(l0[j] + (1.f - l0[j]) * __builtin_amdgcn_rcpf(1.f + __builtin_amdgcn_exp2f(-1.44269504f * v0[j]))); v1[j] = __builtin_amdgcn_logf(l1[j] + (1.f - l1[j]) * __builtin_amdgcn_rcpf(1.f + __builtin_amdgcn_exp2f(-1.44269504f * v1[j]))); }
                u32x4 w; w.x = pk2h(v0[0], v0[1]); w.y = pk2h(v0[2], v0[3]); w.z = pk2h(v1[0], v1[1]); w.w = pk2h(v1[2], v1[3]);
                *(u32x4*)(base + (size_t)r * 1024 + c) = w; });
        } else if (t == 3) {
            epi_rows_perm(acc, wr, wc, fr, fq, [&](int r, int c, f32x4 v0, f32x4 v1) { *(u32x4*)(base + (size_t)r * 1024 + c) = pack8(v0, v1); });
        } else {
            epi_rows_perm(acc, wr, wc, fr, fq, [&](int r, int c, f32x4 v0, f32x4 v1) {
#pragma unroll
                for (int j = 0; j < 4; ++j) { v0[j] = silu(v0[j]); v1[j] = silu(v1[j]); }
                *(u32x4*)(base + (size_t)r * 1024 + c) = pack8(v0, v1); });
        }
    }
};

struct ProbChan : ProbBase {
    static constexpr bool PERM = true;
    int mode, G, c, nunits; bf16_t* Y;
    __device__ void init(int mode_, const void* dftc, const bf16_t* h0, bf16_t* Y_, int G_, int c_) {
        mode = mode_; G = G_; c = c_; Y = Y_; A = (const char*)dftc; B = (const char*)h0; ma = OpMap{128, 512u, 0u}; hstepA = (size_t)HALF * 512; kstepA = kstepB = BK * 2; nt = 4;
        if (mode == 0) { mb = OpMap{128, 2048u, 0u}; hstepB = (size_t)HALF * 2048; nunits = 16 * 4 * 2; }
        else { mb = OpMap{64, 64u * 2048u, 2048u}; hstepB = 2 * 2048; nunits = 4 * 4 * 16 * 2; }
    }
    __device__ bool next(int i, Unit& u) const {
        const int L = i * G + c; if (L >= nunits) return false;
        const int mt = L & 1; u.p0 = mt; u.nt = nt; u.offA = (size_t)mt * 256 * 512;
        if (mode == 0) { const int g = (L >> 1) & 3, b = L >> 3; u.p1 = b * 2048 + g * 512; u.p2 = 0; u.offB = ((size_t)(b * 256) * 1024 + g * 256) * 2; }
        else { const int j = (L >> 1) & 15, g = (L >> 5) & 3, b = L >> 7; u.p1 = b * 2048 + g * 512; u.p2 = j * 256; u.offB = ((size_t)(4096 + b * 4096 + 4 * j) * 1024 + g * 256) * 2; }
        return true;
    }
    __device__ __forceinline__ void epi(const f32x4 (&acc)[2][2][4][2], const Unit& u, int wr, int wc, int fr, int fq) const {
        const int ldc = mode == 0 ? 256 : 4096;
        bf16_t* base = Y + (size_t)(u.p1 + u.p0 * 256) * ldc + u.p2;
        epi_rows_perm(acc, wr, wc, fr, fq, [&](int r, int cc, f32x4 v0, f32x4 v1) { *(u32x4*)(base + (size_t)r * ldc + cc) = pack8(v0, v1); });
    }
};
struct ProbPosCtx : ProbBase {
    static constexpr bool PERM = true;
    int G, c; bf16_t* Z;
    __device__ void init(const void* dl, const bf16_t* yctx, bf16_t* Z_, int G_, int c_) { std_operands(dl, 512, yctx, 512, 512); G = G_; c = c_; Z = Z_; }
    __device__ bool next(int i, Unit& u) const {
        const int L = i * G + c; if (L >= 64) return false;
        const int pn = L & 3, b = L >> 2; u.p0 = b; u.p1 = pn; u.nt = nt; u.offA = 0; u.offB = ((size_t)b * 2048 * 256 + (size_t)pn * 256 * 512) * 2; return true;
    }
    __device__ __forceinline__ void epi(const f32x4 (&acc)[2][2][4][2], const Unit& u, int wr, int wc, int fr, int fq) const {
        bf16_t* base = Z + (size_t)(u.p0 * 256) * 1024 + u.p1 * 256;
        epi_rows_perm(acc, wr, wc, fr, fq, [&](int r, int cc, f32x4 v0, f32x4 v1) { *(u32x4*)(base + (size_t)r * 1024 + cc) = pack8(v0, v1); });
    }
};
struct ProbSmpA : ProbBase {
    static constexpr bool PERM = true;
    int G, c; bf16_t* U;
    __device__ void init(const void* fa2, const bf16_t* yt, bf16_t* U_, int G_, int c_) {
        A = (const char*)fa2; B = (const char*)yt; ma = OpMap{128, 512u, 0u}; hstepA = (size_t)HALF * 512; kstepA = BK * 2;
        mb = OpMap{32, 128u, 16384u}; hstepB = 4 * 16384; kstepB = 4096; nt = 4; G = G_; c = c_; U = U_;
    }
    __device__ bool next(int i, Unit& u) const {
        const int L = i * G + c; if (L >= 512) return false;
        const int tau = L & 127, b = L >> 7; u.p0 = b; u.p1 = tau; u.nt = nt; u.offA = 0; u.offB = ((size_t)(b * 2048 + 16 * tau) * 4096) * 2; return true;
    }
    __device__ __forceinline__ void epi(const f32x4 (&acc)[2][2][4][2], const Unit& u, int wr, int wc, int fr, int fq) const {
        bf16_t* base = U + (size_t)(u.p0 * 1024 + 8 * u.p1) * 8192;
        epi_rows_perm(acc, wr, wc, fr, fq, [&](int r, int cc, f32x4 v0, f32x4 v1) {
            *(u32x4*)(base + (size_t)(cc >> 5) * 8192 + (r & 127) * 64 + (r >> 7) * 32 + (cc & 31)) = pack8(v0, v1); });
    }
};
struct ProbSmpB : ProbBase {
    static constexpr bool PERM = true;
    int G, c; bf16_t* Z;
    __device__ void init(const void* mbm, const bf16_t* Uin, bf16_t* Z_, int G_, int c_) { std_operands(mbm, 512, Uin, 8192, 512); G = G_; c = c_; Z = Z_; }
    __device__ bool next(int i, Unit& u) const {
        const int L = i * G + c; if (L >= 256) return false;
        const int pn = L & 3, q = (L >> 2) & 15, b = L >> 6; u.p0 = b; u.p1 = q; u.p2 = pn; u.nt = nt;
        u.offA = (size_t)q * 256 * 512 * 2; u.offB = ((size_t)(b * 1024 + pn * 256) * 8192 + q * 512) * 2; return true;
    }
    __device__ __forceinline__ void epi(const f32x4 (&acc)[2][2][4][2], const Unit& u, int wr, int wc, int fr, int fq) const {
        bf16_t* base = Z + (size_t)(4096 + u.p0 * 4096 + 4 * u.p1) * 1024 + u.p2 * 256;
        epi_rows_perm(acc, wr, wc, fr, fq, [&](int r, int cc, f32x4 v0, f32x4 v1) {
            const int l = (r >> 6) + 64 * (r & 63); *(u32x4*)(base + (size_t)l * 1024 + cc) = pack8(v0, v1); });
    }
};

__device__ __forceinline__ void norm_rows(bf16_t* X, int row0, int nrows, const float* g, const float* mod, int layer, int ish, bf16_t* H, int gw, int ngw, int lane, const LAS unsigned char* stab, const unsigned short* slab) {
    constexpr int NB = 5;
    LAS unsigned char* prof_lds_ = (LAS unsigned char*)0; (void)prof_lds_; PROF_DECL; PROF_BEGIN();
    f32x4 gv[4], gm[4], shv[4];
#pragma unroll
    for (int j = 0; j < 4; ++j) gv[j] = *(const f32x4*)(g + 4 * lane + 256 * j);
    const int rpw = (nrows + ngw - 1) / ngw, rbeg = row0 + gw * rpw, rend = (rbeg + rpw < row0 + nrows) ? rbeg + rpw : row0 + nrows;
    int ccur = -1;
    for (int rb = rbeg; rb < rend; rb += NB) {
        u32x2 nx[NB][4];
#pragma unroll
        for (int b = 0; b < NB; ++b) { const int r = rb + b; if (r < rend) { const u32x2* p = (const u32x2*)(X + (size_t)r * 2048 + (r & 1) * 1024) + lane;
#pragma unroll
            for (int j = 0; j < 4; ++j) nx[b][j] = p[64 * j]; } }
#pragma unroll
        for (int b = 0; b < NB; ++b) {
            const int r = rb + b; if (r >= rend) break;
            if ((r >> 12) != ccur) { ccur = r >> 12; const float* mrow = mod + ((size_t)(ccur * 2 + layer) * 6) * 1024;
#pragma unroll
                for (int j = 0; j < 4; ++j) { shv[j] = *(const f32x4*)(mrow + (size_t)ish * 1024 + 4 * lane + 256 * j); gm[j] = gv[j] * (*(const f32x4*)(mrow + (size_t)(ish + 1) * 1024 + 4 * lane + 256 * j) + 1.f); } }
            u32x2* xr = (u32x2*)(X + (size_t)r * 2048 + (r & 1) * 1024) + lane;
            f32x4 v[4]; float s = 0.f;
            int si4[4]; SlabRaw sr[4];
#pragma unroll
            for (int j = 0; j < 4; ++j) { si4[j] = stab[(r >> 8) * 4 + j]; if (si4[j] != 255) sr[j] = slab_load(slab, si4[j], r & 255, 4 * lane); }
#pragma unroll
            for (int j = 0; j < 4; ++j) { v[j] = (f32x4){__builtin_bit_cast(float, nx[b][j].x << 16), __builtin_bit_cast(float, nx[b][j].x & 0xffff0000u), __builtin_bit_cast(float, nx[b][j].y << 16), __builtin_bit_cast(float, nx[b][j].y & 0xffff0000u)}; if (si4[j] != 255) { v[j] = v[j] + slab_add(sr[j]); st_bf4(xr + 64 * j, v[j]); }
                s += (v[j].x * v[j].x + v[j].y * v[j].y) + (v[j].z * v[j].z + v[j].w * v[j].w); }
            const float rstd = rsqrtf(wave_sum(s) * (1.f / 1024.f) + 1e-6f);
            unsigned long long* o8 = (unsigned long long*)(H + (size_t)r * 1024) + lane;
#pragma unroll
            for (int j = 0; j < 4; ++j) { const f32x4 o = v[j] * rstd * gm[j] + shv[j]; o8[64 * j] = (unsigned long long)cvt_pk_bf16(o.x, o.y) | ((unsigned long long)cvt_pk_bf16(o.z, o.w) << 32); }
        }
    }
    PROF_END(11);
}


__device__ __forceinline__ void embed_rows(const float* xp, const float* xs, const float* er, const float* ec, const float* g, const float* mod, bf16_t* H, int gw, int ngw, int lane) {
    constexpr int NB = 4;
    f32x4 gv[4], gm[4], shv[4];
#pragma unroll
    for (int j = 0; j < 4; ++j) gv[j] = *(const f32x4*)(g + 4 * lane + 256 * j);
    const int rpw = (20480 + ngw - 1) / ngw, rbeg = gw * rpw, rend = (rbeg + rpw < 20480) ? rbeg + rpw : 20480;
    int ccur = -1;
    int prow = -1; f32x4 pr0 = (f32x4){0.f, 0.f, 0.f, 0.f}, pr1 = pr0;
    for (int rb = rbeg; rb < rend; rb += NB) {
        f32x4 nx[NB][4], pc[NB][2];
#pragma unroll
        for (int b = 0; b < NB; ++b) { const int r = rb + b; if (r < rend) { const f32x4* xr = (const f32x4*)(r < 4096 ? xp + (size_t)r * 1024 : xs + (size_t)(r - 4096) * 1024) + lane;
#pragma unroll
            for (int j = 0; j < 4; ++j) nx[b][j] = xr[64 * j];
            if (r >= 4096) { const int col = r & 63; pc[b][0] = *(const f32x4*)(ec + col * 512 + 4 * lane); pc[b][1] = *(const f32x4*)(ec + col * 512 + 256 + 4 * lane); } } }
#pragma unroll
        for (int b = 0; b < NB; ++b) {
            const int r = rb + b; if (r >= rend) break;
            if ((r >> 12) != ccur) { ccur = r >> 12; const float* mrow = mod + ((size_t)(ccur * 2 + 0) * 6) * 1024;
#pragma unroll
                for (int j = 0; j < 4; ++j) { shv[j] = *(const f32x4*)(mrow + 4 * lane + 256 * j); gm[j] = gv[j] * (*(const f32x4*)(mrow + 1024 + 4 * lane + 256 * j) + 1.f); } }
            f32x4 v[4]; float s = 0.f;
#pragma unroll
            for (int j = 0; j < 4; ++j) v[j] = nx[b][j];
            if (r >= 4096) { const int row = (r & 4095) >> 6;
                if (row != prow) { prow = row; pr0 = *(const f32x4*)(er + row * 512 + 4 * lane); pr1 = *(const f32x4*)(er + row * 512 + 256 + 4 * lane); }
                v[0] = v[0] + pr0; v[1] = v[1] + pr1; v[2] = v[2] + pc[b][0]; v[3] = v[3] + pc[b][1]; }
#pragma unroll
            for (int j = 0; j < 4; ++j) s += (v[j].x * v[j].x + v[j].y * v[j].y) + (v[j].z * v[j].z + v[j].w * v[j].w);
            const float rstd = rsqrtf(wave_sum(s) * (1.f / 1024.f) + 1e-6f);
            unsigned long long* o8 = (unsigned long long*)(H + (size_t)r * 1024) + lane;
#pragma unroll
            for (int j = 0; j < 4; ++j) { const f32x4 o = v[j] * rstd * gm[j] + shv[j]; o8[64 * j] = (unsigned long long)cvt_pk_bf16(o.x, o.y) | ((unsigned long long)cvt_pk_bf16(o.z, o.w) << 32); }
        }
    }
}
__device__ __forceinline__ void gen_tables(unsigned char* ws, long e0, long estride) {
    bf16_t* dftc = (bf16_t*)(ws + WM.dftc); bf16_t* dl = (bf16_t*)(ws + WM.dl256); bf16_t* fa2 = (bf16_t*)(ws + WM.fa2); bf16_t* mbm = (bf16_t*)(ws + WM.mb);
    float* er = (float*)(ws + WM.pos); float* ec = er + 64 * 512;
    constexpr long N0 = 512 * 256, N1 = 256 * 512, N2 = 256 * 256, N3 = 16L * 256 * 512, N4 = 2 * 64 * 512;
    for (long e = e0; e < N0 + N1 + N2 + N3 + N4; e += estride) {
        long r = e;
        if (r < N0) { const int mrow = (int)(r >> 8), cp = (int)(r & 255), cc = mrow >> 1, ri = mrow & 1; const float x = 2.f * (float)((cc * cp) & 255) / 256.f;
            dftc[r] = (bf16_t)f2bf(ri == 0 ? cospif(x) : -sinpif(x)); continue; } r -= N0;
        if (r < N1) { const int l = (int)(r >> 9), k = (int)(r & 511), ri = k >> 8, lp = k & 255; const float x = 2.f * (float)((l * lp) & 255) / 256.f;
            dl[r] = (bf16_t)f2bf((ri == 0 ? cospif(x) : sinpif(x)) * (1.f / 256.f)); continue; } r -= N1;
        if (r < N2) { const int mrow = (int)(r >> 8), k = (int)(r & 255), sA = mrow >> 7, k1 = (mrow >> 1) & 63, ro = mrow & 1, ri = k >> 7, sB = (k >> 6) & 1, l1 = k & 63;
            const float x = 2.f * (float)((k1 * l1) & 63) / 64.f; float v = 0.f;
            if (sA == sB) v = (ro == ri) ? cospif(x) : (ro == 0 ? sinpif(x) : -sinpif(x));
            fa2[r] = (bf16_t)f2bf(v); continue; } r -= N2;
        if (r < N3) { const int q = (int)(r >> 17), mrow = (int)(r >> 9) & 255, k = (int)(r & 511), ko = mrow >> 6, k2 = mrow & 63, kop = k >> 7, ro = (k >> 6) & 1, l2 = k & 63;
            const int l = 4 * q + ko + 64 * k2; const float x = 2.f * (float)((l * l2) & 4095) / 4096.f; float v = 0.f;
            if (ko == kop) v = (ro == 0 ? cospif(x) : sinpif(x)) * (1.f / 1024.f);
            mbm[r] = (bf16_t)f2bf(v); continue; } r -= N3;
        { const int which = (int)(r >> 15), p = (int)(r >> 9) & 63, j = (int)(r & 511), i = j & 255;
            const float omega = 1.0f / powf(10000.0f, (float)i / 256.0f); const float ang = (float)p * omega;
            (which == 0 ? er : ec)[p * 512 + j] = (j < 256) ? sinf(ang) : cosf(ang); }
    }
}


__device__ __forceinline__ void final_rows(float* X, int row0, int nrows, const float* g, int gw, int ngw, int lane, const LAS unsigned char* stab, const unsigned short* slab) {
    constexpr int NB = 5;
    f32x4 gv[4];
#pragma unroll
    for (int j = 0; j < 4; ++j) gv[j] = *(const f32x4*)(g + 4 * lane + 256 * j);
    for (int rb = row0 + gw; rb < row0 + nrows; rb += NB * ngw) {
        u32x2 nx[NB][4];
#pragma unroll
        for (int b = 0; b < NB; ++b) { const int r = rb + b * ngw; if (r < row0 + nrows) { const u32x2* p = (const u32x2*)(X + (size_t)r * 1024) + (r & 1) * 256 + lane;
#pragma unroll
            for (int j = 0; j < 4; ++j) nx[b][j] = p[64 * j]; } }
#pragma unroll
        for (int b = 0; b < NB; ++b) {
            const int r = rb + b * ngw; if (r >= row0 + nrows) break;
            f32x4* xr = (f32x4*)(X + (size_t)r * 1024) + lane;
            f32x4 v[4]; float s = 0.f;
            int si4[4]; SlabRaw sr[4];
#pragma unroll
            for (int j = 0; j < 4; ++j) { si4[j] = stab[(r >> 8) * 4 + j]; if (si4[j] != 255) sr[j] = slab_load(slab, si4[j], r & 255, 4 * lane); }
#pragma unroll
            for (int j = 0; j < 4; ++j) { v[j] = (f32x4){__builtin_bit_cast(float, nx[b][j].x << 16), __builtin_bit_cast(float, nx[b][j].x & 0xffff0000u), __builtin_bit_cast(float, nx[b][j].y << 16), __builtin_bit_cast(float, nx[b][j].y & 0xffff0000u)}; if (si4[j] != 255) v[j] = v[j] + slab_add(sr[j]);
                s += (v[j].x * v[j].x + v[j].y * v[j].y) + (v[j].z * v[j].z + v[j].w * v[j].w); }
            const float rstd = rsqrtf(wave_sum(s) * (1.f / 1024.f) + 1e-6f);
#pragma unroll
            for (int j = 0; j < 4; ++j) xr[64 * j] = v[j] * rstd * gv[j];
        }
    }
}
__device__ __forceinline__ void mod_unit(LAS unsigned char* lds, int unit, const float* c, const float* c_ctx, const float* ada_w, const float* ada_b, float* mod, int tid, int wave, int lane) {
    LAS float* sc = (LAS float*)lds;
    LAS float* red = (LAS float*)(lds + 20480);
    const int layer = unit / 192, n0 = (unit % 192) * 32, col = lane & 31, kh = lane >> 5;
    for (int i = tid; i < 5 * 1024; i += NTHREADS) { const int cond = i >> 10, k = i & 1023; const float x = cond == 0 ? c_ctx[k] : c[(cond - 1) * 1024 + k]; sc[i] = silu(x); }
    __syncthreads();
    const float* w = ada_w + ((size_t)layer * 1024 + wave * 128 + kh) * 6144 + n0 + col;
    float acc[5];
#pragma unroll
    for (int q = 0; q < 5; ++q) acc[q] = 0.f;
#pragma unroll 1
    for (int kb = 0; kb < 64; kb += 32) {
        float wv[32];
#pragma unroll
        for (int k = 0; k < 32; ++k) wv[k] = w[(size_t)(2 * (kb + k)) * 6144];
#pragma unroll
        for (int k = 0; k < 32; ++k) {
#pragma unroll
            for (int q = 0; q < 5; ++q) acc[q] += wv[k] * sc[q * 1024 + wave * 128 + 2 * (kb + k) + kh];
        }
    }
#pragma unroll
    for (int q = 0; q < 5; ++q) { acc[q] += __shfl_xor(acc[q], 32); if (kh == 0) red[(wave * 5 + q) * 32 + col] = acc[q]; }
    __syncthreads();
    for (int i = tid; i < 5 * 32; i += NTHREADS) { const int q = i >> 5, n = i & 31; float s = 0.f;
#pragma unroll
        for (int ww = 0; ww < 8; ++ww) s += red[(ww * 5 + q) * 32 + n];
        mod[((size_t)q * 2 + layer) * 6144 + n0 + n] = s + ada_b[(size_t)layer * 6144 + n0 + n]; }
    __syncthreads();
}

struct TrItem { const float* W; bf16_t* WT; int K, N, item; };
__device__ __forceinline__ void transpose_load(const TrItem& t, f32x4 (&ld)[8], int lane) {
    const int nblk = t.N / 32, kb = t.item / nblk, nb = t.item % nblk, k0 = 64 * kb, n0 = 32 * nb;
#pragma unroll
    for (int i = 0; i < 8; ++i) ld[i] = *(const f32x4*)(t.W + (size_t)(k0 + 8 * i + (lane >> 3)) * t.N + n0 + 4 * (lane & 7));
}
__device__ __forceinline__ void transpose_finish(const TrItem& t, const f32x4 (&ld)[8], LAS float* scr, int lane) {
    const int nblk = t.N / 32, kb = t.item / nblk, nb = t.item % nblk, k0 = 64 * kb, n0 = 32 * nb;
#pragma unroll
    for (int i = 0; i < 8; ++i) { LAS float* d = scr + (8 * i + (lane >> 3)) * 33 + 4 * (lane & 7); d[0] = ld[i][0]; d[1] = ld[i][1]; d[2] = ld[i][2]; d[3] = ld[i][3]; }
    asm volatile("s_waitcnt lgkmcnt(0)" ::: "memory");
    const int c = lane & 7;
#pragma unroll
    for (int j = 0; j < 4; ++j) { const int n = (lane >> 3) + 8 * j; const LAS float* s = scr + (8 * c) * 33 + n;
        u32x4 o; o.x = pk2(s[0 * 33], s[1 * 33]); o.y = pk2(s[2 * 33], s[3 * 33]); o.z = pk2(s[4 * 33], s[5 * 33]); o.w = pk2(s[6 * 33], s[7 * 33]);
        *(u32x4*)(t.WT + (size_t)(n0 + n) * t.K + k0 + 8 * c) = o; }
    asm volatile("s_waitcnt lgkmcnt(0)" ::: "memory");
}
template <class Dec> __device__ __forceinline__ void transpose_stream(int first, int count, int stride, Dec dec, LAS float* scr, int lane) {
    if (first >= count) return;
    f32x4 cur[8], nxt[8]; TrItem tc = dec(first), tn = tc;
    transpose_load(tc, cur, lane);
    for (int it = first; it < count; it += stride) {
        const bool more = it + stride < count;
        if (more) { tn = dec(it + stride); transpose_load(tn, nxt, lane); }
        transpose_finish(tc, cur, scr, lane);
        if (more) { tc = tn;
#pragma unroll
            for (int i = 0; i < 8; ++i) cur[i] = nxt[i]; }
    }
}


typedef float f32x16 __attribute__((ext_vector_type(16)));
typedef short v4i16_t __attribute__((ext_vector_type(4)));
constexpr int QA_RS = 272, QP_RS = 264, KB_RS = 272, KPP_RS = 320, V_RS = 320;
constexpr int T_QA = 0, T_QP = T_QA + 32 * QA_RS, T_KB = T_QP + 32 * QP_RS, T_KPP = T_KB + 32 * KB_RS, T_V = T_KPP + 32 * KPP_RS, T_EL = T_V + 32 * V_RS, DIR_BYTES = T_EL + 512;
constexpr int OBUF_OFF = 2 * DIR_BYTES, OBUF_BYTES = 256 * 256;
static_assert(OBUF_OFF + OBUF_BYTES <= 160 * 1024 - 512 && (DIR_BYTES % 16) == 0 && (T_QP % 16) == 0 && (T_KB % 16) == 0 && (T_KPP % 16) == 0 && (T_V % 16) == 0 && (T_EL % 16) == 0, "scan LDS map");
constexpr int SLOT_ELEMS = 128 * 128;
#ifndef SCAN_STAGGER
#define SCAN_STAGGER 0
#endif

struct ScanT { const bf16_t* q; const bf16_t* lffw; const bf16_t* lfbw; const bf16_t* v; bf16_t* sg; bf16_t* slots; float* dvec; const float* gnorm; const float* state_in; float* new_state; };

__device__ __forceinline__ bf16x8 tr_pair(const LAS unsigned char* p0, const LAS unsigned char* p1) {
    const v4i16_t lo = __builtin_amdgcn_ds_read_tr16_b64_v4i16((LAS v4i16_t*)p0), hi = __builtin_amdgcn_ds_read_tr16_b64_v4i16((LAS v4i16_t*)p1);
    return (bf16x8){lo[0], lo[1], lo[2], lo[3], hi[0], hi[1], hi[2], hi[3]};
}
__device__ __forceinline__ bf16x8 pack_acc8(const f32x16& x, int s8) {
    u32x4 w; w.x = cvt_pk_bf16(x[8 * s8 + 0], x[8 * s8 + 1]); w.y = cvt_pk_bf16(x[8 * s8 + 2], x[8 * s8 + 3]); w.z = cvt_pk_bf16(x[8 * s8 + 4], x[8 * s8 + 5]); w.w = cvt_pk_bf16(x[8 * s8 + 6], x[8 * s8 + 7]);
    return __builtin_bit_cast(bf16x8, w);
}
__device__ __forceinline__ float h2f(unsigned short b) { return (float)__builtin_bit_cast(_Float16, b); }

template <bool FULL>
__device__ __forceinline__ void scan_item(LAS unsigned char* lds, const ScanT& T, int tok0, int h, bool act0, bool act1, const bf16_t* init0, const bf16_t* init1,
                                          float* fin0, float* fin1, bf16_t* outs0, bf16_t* outs1, float* outd0, float* outd1) {
    const int tid = threadIdx.x, wave = __builtin_amdgcn_readfirstlane(tid >> 6), dir = wave >> 2, wg = wave & 3;
    LAS unsigned char* prof_lds_ = lds; (void)prof_lds_; PROF_DECL; PROF_BEGIN();
    const bool act = dir ? act1 : act0;
    const bf16_t* init = dir ? init1 : init0;
    LAS unsigned char* D = lds + dir * DIR_BYTES;
    LAS unsigned char* OB = lds + OBUF_OFF;
    const bf16_t* lfp = dir ? T.lfbw : T.lffw;
#define SCAN_LANE(x) int x; asm volatile("v_mbcnt_lo_u32_b32 %0, -1, 0\n\tv_mbcnt_hi_u32_b32 %0, -1, %0" : "=v"(x))
#define SCAN_PREP_ROLE SCAN_LANE(ln_); const int pp = 16 * wg + (ln_ & 15), uu = ln_ >> 4, gt_ = wg * 64 + ln_, vt = gt_ >> 3, vc2 = gt_ & 7
#define SCAN_MFMA_ROLE SCAN_LANE(ln_); const int l31 = ln_ & 31, hh = ln_ >> 5, gq = (ln_ & 15) >> 2, gp = ln_ & 3, vcol = 16 * ((ln_ >> 4) & 1)
    f32x16 S[4];
#pragma unroll
    for (int t4 = 0; t4 < 4; ++t4) {
        if (init && act) { SCAN_LANE(lane); const u32x4* sp = (const u32x4*)(init + ((size_t)(wg * 4 + t4) * 64 + lane) * 16); const u32x4 a = sp[0], b = sp[1];
            const unsigned w8[8] = {a.x, a.y, a.z, a.w, b.x, b.y, b.z, b.w};
#pragma unroll
            for (int j = 0; j < 8; ++j) { S[t4][2 * j] = __builtin_bit_cast(float, w8[j] << 16); S[t4][2 * j + 1] = __builtin_bit_cast(float, w8[j] & 0xffff0000u); } }
        else {
#pragma unroll
            for (int j = 0; j < 16; ++j) S[t4][j] = 0.f; }
    }
    float dsum0 = 0.f, dsum1 = 0.f;
    unsigned qreg[8], lfreg[8]; u32x4 vreg[2];
#define SCAN_LOAD(i) do { const int jsc_ = dir ? 7 - (i) : (i); \
        _Pragma("unroll") for (int e = 0; e < 8; ++e) { const int tl = 8 * uu + e; const size_t tk = (size_t)(tok0 + 32 * jsc_ + (dir ? 31 - tl : tl)) * 1024 + h * 128 + 2 * pp; \
            if (FULL) qreg[e] = *(const unsigned*)(T.q + tk); lfreg[e] = *(const unsigned*)(lfp + tk); } \
        { const size_t tk = (size_t)(tok0 + 32 * jsc_ + (dir ? 31 - vt : vt)) * 1024 + h * 128 + 16 * vc2; vreg[0] = *(const u32x4*)(T.v + tk); vreg[1] = *(const u32x4*)(T.v + tk + 8); } } while (0)
    if (act) { SCAN_PREP_ROLE; SCAN_LOAD(0); }
    PROF_END(6);
    for (int s = 0; s < 16 + SCAN_STAGGER; ++s) {
        const int ph = s - (SCAN_STAGGER ? dir : 0);
        if (act && ph >= 0 && ph < 16) {
            const int i = ph >> 1;
            if ((ph & 1) == 0) {
                SCAN_PREP_ROLE; const int lane = ln_;
#if defined(PROF_ID)
                PROF_BEGIN(); asm volatile("s_waitcnt vmcnt(0)" ::: "memory"); PROF_END(1); PROF_BEGIN();
#endif
                *(LAS u32x4*)(D + T_V + vt * V_RS + vc2 * 32) = vreg[0]; *(LAS u32x4*)(D + T_V + vt * V_RS + vc2 * 32 + 16) = vreg[1];
                f32x2 cc[8]; f32x2 aa = (f32x2){0.f, 0.f};
#pragma unroll
                for (int e = 0; e < 8; ++e) { aa += (f32x2){h2f((unsigned short)(lfreg[e] & 0xffffu)), h2f((unsigned short)(lfreg[e] >> 16))}; cc[e] = aa; }
                f32x2 tq[4];
#pragma unroll
                for (int u2 = 0; u2 < 4; ++u2) { tq[u2].x = __shfl(aa.x, (lane & 15) + 16 * u2); tq[u2].y = __shfl(aa.y, (lane & 15) + 16 * u2); }
                const f32x2 zz = (f32x2){0.f, 0.f};
                const f32x2 pre = (uu > 0 ? tq[0] : zz) + (uu > 1 ? tq[1] : zz) + (uu > 2 ? tq[2] : zz);
                const f32x2 rr = tq[0] + tq[1], bl = rr + tq[2] + tq[3];
#define EX2V(v) ((f32x2){__builtin_amdgcn_exp2f((v).x), __builtin_amdgcn_exp2f((v).y)})
                if (FULL) {
                    const f32x2 er = EX2V(rr), elr = EX2V(bl - rr), base = pre - rr;
#pragma unroll
                    for (int e = 0; e < 8; ++e) {
                        const int tl = 8 * uu + e;
                        const f32x2 d = base + cc[e];
                        const f32x2 ea = EX2V(d), eb = EX2V(-d);
                        const f32x2 lfv = (f32x2){h2f((unsigned short)(lfreg[e] & 0xffffu)), h2f((unsigned short)(lfreg[e] >> 16))};
                        const f32x2 kk = 1.f - EX2V(lfv);
                        const f32x2 qq = (f32x2){__builtin_bit_cast(float, qreg[e] << 16), __builtin_bit_cast(float, qreg[e] & 0xffff0000u)};
                        const f32x2 qa = qq * ea, kb = kk * eb, qp = qa * er, kpp = kb * elr;
                        *(LAS unsigned*)(D + T_QA + tl * QA_RS + 4 * pp) = cvt_pk_bf16(qa.x, qa.y);
                        *(LAS unsigned*)(D + T_QP + tl * QP_RS + 4 * pp) = cvt_pk_bf16(qp.x, qp.y);
                        *(LAS unsigned*)(D + T_KB + tl * KB_RS + 4 * pp) = cvt_pk_bf16(kb.x, kb.y);
                        *(LAS unsigned*)(D + T_KPP + tl * KPP_RS + 4 * pp) = cvt_pk_bf16(kpp.x, kpp.y);
                        if (e & 1) __builtin_amdgcn_sched_barrier(0);
                    }
                } else {
                    const f32x2 base = bl - pre;
#pragma unroll
                    for (int e = 0; e < 8; ++e) {
                        const int tl = 8 * uu + e;
                        const f32x2 d = base - cc[e];
                        const f32x2 lfv = (f32x2){h2f((unsigned short)(lfreg[e] & 0xffffu)), h2f((unsigned short)(lfreg[e] >> 16))};
                        const f32x2 kpp = (1.f - EX2V(lfv)) * EX2V(d);
                        *(LAS unsigned*)(D + T_KPP + tl * KPP_RS + 4 * pp) = cvt_pk_bf16(kpp.x, kpp.y);
                    }
                    dsum0 += bl.x; dsum1 += bl.y;
                }
                if (uu == 0) { *(LAS f32x2*)(D + T_EL + 8 * pp) = EX2V(bl); }
                __builtin_amdgcn_sched_barrier(0);
#if defined(PROF_ID)
                asm volatile("s_waitcnt lgkmcnt(0)" ::: "memory"); PROF_END(2);
#endif
                if (i < 7) SCAN_LOAD(i + 1);
            } else {
                SCAN_MFMA_ROLE; PROF_BEGIN();
                if (FULL) {
                    f32x16 P;
#pragma unroll
                    for (int j = 0; j < 16; ++j) P[j] = 0.f;
#pragma unroll
                    for (int ks = 0; ks < 8; ++ks) {
                        const bf16x8 ka = *(const LAS bf16x8*)(D + T_KB + l31 * KB_RS + (16 * ks + 8 * hh) * 2);
                        const bf16x8 qb = *(const LAS bf16x8*)(D + T_QA + l31 * QA_RS + (16 * ks + 8 * hh) * 2);
                        P = __builtin_amdgcn_mfma_f32_32x32x16_bf16(ka, qb, P, 0, 0, 0);
                    }
#pragma unroll
                    for (int j = 0; j < 16; ++j) { const int srow = (j & 3) + 8 * (j >> 2) + 4 * hh; P[j] = (srow <= l31) ? P[j] : 0.f; }
                    f32x16 o;
#pragma unroll
                    for (int j = 0; j < 16; ++j) o[j] = 0.f;
#pragma unroll
                    for (int s8 = 0; s8 < 2; ++s8) {
                        const LAS unsigned char* vb = D + T_V + (16 * s8 + 4 * hh + gq) * V_RS + (32 * wg + vcol + 4 * gp) * 2;
                        const bf16x8 vf = tr_pair(vb, vb + 8 * V_RS);
                        o = __builtin_amdgcn_mfma_f32_32x32x16_bf16(pack_acc8(P, s8), vf, o, 0, 0, 0);
                    }
#pragma unroll
                    for (int t4 = 0; t4 < 4; ++t4)
#pragma unroll
                        for (int s8 = 0; s8 < 2; ++s8) {
                            const LAS unsigned char* qp = D + T_QP + l31 * QP_RS + (32 * t4 + 16 * s8 + 4 * hh) * 2;
                            const u32x2 lo = *(const LAS u32x2*)qp, hi = *(const LAS u32x2*)(qp + 16);
                            const u32x4 aw = {lo.x, lo.y, hi.x, hi.y};
                            o = __builtin_amdgcn_mfma_f32_32x32x16_bf16(__builtin_bit_cast(bf16x8, aw), pack_acc8(S[t4], s8), o, 0, 0, 0);
                        }
                    const int jsc = dir ? 7 - i : i;
                    LAS unsigned short* ob = (LAS unsigned short*)(OB + (32 * jsc + (dir ? 31 - 4 * hh : 4 * hh)) * 256 + (32 * wg + l31) * 2);
                    const int rs = dir ? -128 : 128;
                    if (i >= 4) {
                        unsigned short pv[16];
#pragma unroll
                        for (int j = 0; j < 16; ++j) pv[j] = ob[((j & 3) + 8 * (j >> 2)) * rs];
#pragma unroll
                        for (int j = 0; j < 16; ++j) o[j] += bf2f(pv[j]);
                    }
#pragma unroll
                    for (int j = 0; j < 16; ++j) ob[((j & 3) + 8 * (j >> 2)) * rs] = (unsigned short)cvt_pk_bf16(o[j], o[j]);
                }
                __builtin_amdgcn_sched_barrier(0);
#pragma unroll
                for (int t4 = 0; t4 < 4; ++t4) {
#pragma unroll
                    for (int g = 0; g < 4; ++g) { const f32x4 f = *(const LAS f32x4*)(D + T_EL + (32 * t4 + 8 * g + 4 * hh) * 4);
                        S[t4][4 * g + 0] *= f[0]; S[t4][4 * g + 1] *= f[1]; S[t4][4 * g + 2] *= f[2]; S[t4][4 * g + 3] *= f[3]; }
#pragma unroll
                    for (int s8 = 0; s8 < 2; ++s8) {
                        const LAS unsigned char* kb = D + T_KPP + (16 * s8 + 8 * hh + gq) * KPP_RS + (32 * t4 + vcol + 4 * gp) * 2;
                        const LAS unsigned char* vb = D + T_V + (16 * s8 + 8 * hh + gq) * V_RS + (32 * wg + vcol + 4 * gp) * 2;
                        const bf16x8 ka = tr_pair(kb, kb + 4 * KPP_RS), vf = tr_pair(vb, vb + 4 * V_RS);
                        S[t4] = __builtin_amdgcn_mfma_f32_32x32x16_bf16(ka, vf, S[t4], 0, 0, 0);
                    }
                    if (t4 == 1) __builtin_amdgcn_sched_barrier(0);
                }
                PROF_END(3);
            }
        }
        PROF_BEGIN();
        __syncthreads();
        PROF_END(4);
    }
#undef SCAN_LOAD
    SCAN_MFMA_ROLE; SCAN_LANE(lane); PROF_BEGIN();
    if (FULL) {
        float* fin = dir ? fin1 : fin0;
        if (fin && act) {
#pragma unroll
            for (int t4 = 0; t4 < 4; ++t4)
#pragma unroll
                for (int j = 0; j < 16; ++j) fin[(size_t)(32 * t4 + (j & 3) + 8 * (j >> 2) + 4 * hh) * 128 + 32 * wg + l31] = S[t4][j];
        }
        const int cv = tid & 15;
        f32x4 gn0 = *(const f32x4*)(T.gnorm + 8 * cv), gn1 = *(const f32x4*)(T.gnorm + 8 * cv + 4);
        u32x4 gwv[8];
#pragma unroll
        for (int pass = 0; pass < 8; ++pass) gwv[pass] = *(const u32x4*)(T.sg + (size_t)(tok0 + 32 * pass + (tid >> 4)) * 1024 + h * 128 + 8 * cv);
#pragma unroll
        for (int pass = 0; pass < 8; ++pass) {
            const int row = 32 * pass + (tid >> 4);
            const u32x4 ow = *(const LAS u32x4*)(OB + row * 256 + cv * 16);
            bf16_t* gp_ = T.sg + (size_t)(tok0 + row) * 1024 + h * 128 + 8 * cv;
            const u32x4 gw = gwv[pass];
            float ov[8], gv[8];
            const unsigned o4[4] = {ow.x, ow.y, ow.z, ow.w}, g4[4] = {gw.x, gw.y, gw.z, gw.w};
            float ss = 0.f;
#pragma unroll
            for (int j = 0; j < 4; ++j) { ov[2 * j] = __builtin_bit_cast(float, o4[j] << 16); ov[2 * j + 1] = __builtin_bit_cast(float, o4[j] & 0xffff0000u);
                gv[2 * j] = __builtin_bit_cast(float, g4[j] << 16); gv[2 * j + 1] = __builtin_bit_cast(float, g4[j] & 0xffff0000u);
                ss += ov[2 * j] * ov[2 * j] + ov[2 * j + 1] * ov[2 * j + 1]; }
            ss += __shfl_xor(ss, 1); ss += __shfl_xor(ss, 2); ss += __shfl_xor(ss, 4); ss += __shfl_xor(ss, 8);
            const float rstd = rsqrtf(ss * (1.f / 128.f) + 1e-6f);
            u32x4 w;
            w.x = cvt_pk_bf16(ov[0] * rstd * gn0[0] * gv[0], ov[1] * rstd * gn0[1] * gv[1]); w.y = cvt_pk_bf16(ov[2] * rstd * gn0[2] * gv[2], ov[3] * rstd * gn0[3] * gv[3]);
            w.z = cvt_pk_bf16(ov[4] * rstd * gn1[0] * gv[4], ov[5] * rstd * gn1[1] * gv[5]); w.w = cvt_pk_bf16(ov[6] * rstd * gn1[2] * gv[6], ov[7] * rstd * gn1[3] * gv[7]);
            *(u32x4*)gp_ = w;
        }
#if defined(PROF_ID)
        asm volatile("s_waitcnt vmcnt(0)" ::: "memory");
#endif
        __syncthreads(); PROF_END(5);
    } else {
        bf16_t* outs = dir ? outs1 : outs0; float* outd = dir ? outd1 : outd0;
        if (act) {
#pragma unroll
            for (int t4 = 0; t4 < 4; ++t4) {
                u32x4 a, b;
                a.x = cvt_pk_bf16(S[t4][0], S[t4][1]); a.y = cvt_pk_bf16(S[t4][2], S[t4][3]); a.z = cvt_pk_bf16(S[t4][4], S[t4][5]); a.w = cvt_pk_bf16(S[t4][6], S[t4][7]);
                b.x = cvt_pk_bf16(S[t4][8], S[t4][9]); b.y = cvt_pk_bf16(S[t4][10], S[t4][11]); b.z = cvt_pk_bf16(S[t4][12], S[t4][13]); b.w = cvt_pk_bf16(S[t4][14], S[t4][15]);
                u32x4* sp = (u32x4*)(outs + ((size_t)(wg * 4 + t4) * 64 + lane) * 16); sp[0] = a; sp[1] = b;
            }
            const int pp = 16 * wg + (lane & 15); if ((lane >> 4) == 0) { outd[2 * pp] = __builtin_amdgcn_exp2f(dsum0); outd[2 * pp + 1] = __builtin_amdgcn_exp2f(dsum1); }
        }
    }
}
__device__ __forceinline__ size_t slot_of(int dir, int b, int h, int sc) { return (size_t)((dir * 4 + b) * 8 + h) * 16 + sc; }

__device__ __forceinline__ void scan_a_item(LAS unsigned char* lds, const ScanT& T, int it) {
    const int sc = it & 15, h = (it >> 4) & 7, b = it >> 7;
    const size_t sf = slot_of(0, b, h, sc < 15 ? sc + 1 : 0), sb = slot_of(1, b, h, sc > 0 ? sc - 1 : 0);
    scan_item<false>(lds, T, 4096 + b * 4096 + sc * 256, h, sc < 15, sc > 0, nullptr, nullptr, nullptr, nullptr, T.slots + sf * SLOT_ELEMS, T.slots + sb * SLOT_ELEMS, T.dvec + sf * 128, T.dvec + sb * 128);
}
__device__ __forceinline__ void scan_ctx_item(LAS unsigned char* lds, const ScanT& T, int ci) {
    const int h = ci & 7, b = ci >> 3;
    float* ns = T.new_state + (size_t)(b * 2) * 8 * 16384 + (size_t)h * 16384;
    scan_item<true>(lds, T, b * 256, h, true, true, nullptr, nullptr, ns, ns + (size_t)8 * 16384, nullptr, nullptr, nullptr, nullptr);
}
__device__ __forceinline__ void scan_phase_a(LAS unsigned char* lds, const ScanT& T, int G, int bx) {
    if (G == 256) {
        if (bx < 128) { scan_ctx_item(lds, T, bx); scan_a_item(lds, T, 384 + bx); }
        else { for (int k = 0; k < 3; ++k) scan_a_item(lds, T, (bx - 128) * 3 + k); }
    } else {
        for (int it = bx; it < 640; it += G) { if (it < 512) scan_a_item(lds, T, it); else scan_ctx_item(lds, T, it - 512); }
    }
}
__device__ __forceinline__ void scan_phase_b(const ScanT& T, int G, int bx, int tid) {
    for (int gid = bx * NTHREADS + tid; gid < 64 * 2048; gid += G * NTHREADS) {
        const int combo = gid >> 11, e = (gid & 2047) * 8, dir = combo >> 5, b = (combo >> 3) & 3, h = combo & 7;
        const int reg0 = e & 15, ln = (e >> 4) & 63, t4 = (e >> 10) & 3, w = (e >> 12) & 3;
        const int v = 32 * w + (ln & 31);
        float s[8]; int kk[8];
#pragma unroll
        for (int j = 0; j < 8; ++j) { const int rg = reg0 + j; kk[j] = 32 * t4 + (rg & 3) + 8 * (rg >> 2) + 4 * (ln >> 5); s[j] = T.state_in[((size_t)((b * 2 + dir) * 8 + h) * 128 + kk[j]) * 128 + v]; }
        u32x4 lwn = (u32x4){0u, 0u, 0u, 0u}; float dn[8];
#pragma unroll
        for (int j = 0; j < 8; ++j) dn[j] = 0.f;
        { const size_t sl1 = slot_of(dir, b, h, dir ? 14 : 1); lwn = *(const u32x4*)(T.slots + sl1 * SLOT_ELEMS + e);
#pragma unroll
          for (int j = 0; j < 8; ++j) dn[j] = T.dvec[sl1 * 128 + kk[j]]; }
        for (int st = 0; st < 16; ++st) {
            const int sc = dir ? 15 - st : st;
            const size_t sl = slot_of(dir, b, h, sc);
            u32x4* sp = (u32x4*)(T.slots + sl * SLOT_ELEMS + e);
            if (st > 0) {
                const u32x4 lw = lwn; float dc[8];
#pragma unroll
                for (int j = 0; j < 8; ++j) dc[j] = dn[j];
                if (st < 15) { const size_t sl2 = slot_of(dir, b, h, dir ? 14 - st : st + 1); lwn = *(const u32x4*)(T.slots + sl2 * SLOT_ELEMS + e);
#pragma unroll
                    for (int j = 0; j < 8; ++j) dn[j] = T.dvec[sl2 * 128 + kk[j]]; }
                const unsigned l4[4] = {lw.x, lw.y, lw.z, lw.w};
#pragma unroll
                for (int j = 0; j < 4; ++j) { s[2 * j] = dc[2 * j] * s[2 * j] + __builtin_bit_cast(float, l4[j] << 16);
                    s[2 * j + 1] = dc[2 * j + 1] * s[2 * j + 1] + __builtin_bit_cast(float, l4[j] & 0xffff0000u); }
            }
            u32x4 o; o.x = cvt_pk_bf16(s[0], s[1]); o.y = cvt_pk_bf16(s[2], s[3]); o.z = cvt_pk_bf16(s[4], s[5]); o.w = cvt_pk_bf16(s[6], s[7]);
            *sp = o;
        }
    }
}
__device__ __forceinline__ void scan_phase_c(LAS unsigned char* lds, const ScanT& T, int G, int bx) {
    for (int it = bx; it < 512; it += G) {
        const int sc = it & 15, h = (it >> 4) & 7, b = it >> 7;
        scan_item<true>(lds, T, 4096 + b * 4096 + sc * 256, h, true, true, T.slots + slot_of(0, b, h, sc) * SLOT_ELEMS, T.slots + slot_of(1, b, h, sc) * SLOT_ELEMS,
                        nullptr, nullptr, nullptr, nullptr, nullptr, nullptr);
    }
}

#define XB_TMO      128
#define XB_XCNT(j)  (256  + 64 * (j))
#define XB_XSUB(j)  (1280 + 64 * (j))
#define XB_XGEN(j)  (2304 + 64 * (j))
#define XB_TOP      3328
#define XB_TOPGEN   3392
#define XCD_BAR_WORDS 3456
#define XB_SPIN_CAP (1u << 18)
__device__ __forceinline__ unsigned xb_ld(unsigned* p)              { return __hip_atomic_load(p, __ATOMIC_RELAXED, __HIP_MEMORY_SCOPE_AGENT); }
__device__ __forceinline__ unsigned xb_add(unsigned* p, unsigned v) { return __hip_atomic_fetch_add(p, v, __ATOMIC_RELAXED, __HIP_MEMORY_SCOPE_AGENT); }
__device__ __forceinline__ unsigned xb_xcc_id() { return (unsigned)__builtin_amdgcn_s_getreg((3 << 11) | 20) & 0xFu; }
#define XB_SPIN(cond, bar) do { unsigned _sp = 0; while (cond) { __builtin_amdgcn_s_sleep(1); \
    if ((++_sp & 255u) == 0u) { if (xb_ld(&(bar)[XB_TMO])) break; if (_sp > XB_SPIN_CAP) { atomicAdd(&(bar)[XB_TMO], 1u); break; } } } } while (0)
struct XcdBarrier { unsigned* bar; unsigned x; volatile LAS unsigned* st; };
__device__ __forceinline__ XcdBarrier xcd_barrier_post(unsigned* bar, volatile LAS unsigned* st) {
    XcdBarrier b; b.bar = bar; b.x = xb_xcc_id(); b.st = st;
    if (threadIdx.x == 0) (void)xb_add(&bar[XB_XCNT(b.x)], 1u);
    return b;
}
__device__ __forceinline__ void xcd_barrier_complete(unsigned* bar, unsigned x, unsigned& nloc, unsigned& nx) {
    const unsigned G = gridDim.x * gridDim.y * gridDim.z;
    unsigned sum, cnt, mine, sp = 0u;
    for (;;) {
        sum = 0u; cnt = 0u; mine = 0u;
#pragma unroll
        for (unsigned j = 0; j < 16; ++j) { const unsigned c = xb_ld(&bar[XB_XCNT(j)]); sum += c; cnt += (c > 0u) ? 1u : 0u; mine = (j == x) ? c : mine; }
        if (sum == G) break;
        __builtin_amdgcn_s_sleep(1);
        if ((++sp & 255u) == 0u) { if (xb_ld(&bar[XB_TMO])) break; if (sp > XB_SPIN_CAP) { atomicAdd(&bar[XB_TMO], 1u); break; } }
    }
    nloc = mine > 0u ? mine : 1u; nx = cnt > 0u ? cnt : 1u;
}
__device__ __forceinline__ void xcd_barrier(const XcdBarrier& b) {
    asm volatile("s_waitcnt vmcnt(0)" ::: "memory");
    __syncthreads();
    if (threadIdx.x == 0) {
        unsigned* bar = b.bar;
        __builtin_amdgcn_s_waitcnt(0);
        unsigned nloc = b.st[0], nx = b.st[1];
        if (nloc == 0u) { xcd_barrier_complete(bar, b.x, nloc, nx); b.st[0] = nloc; b.st[1] = nx; }
        const unsigned old = xb_add(&bar[XB_XSUB(b.x)], 1u);
        const unsigned gen = old / nloc;
        if (old + 1u == (gen + 1u) * nloc) {
            __builtin_amdgcn_fence(__ATOMIC_RELEASE, "agent");
            asm volatile("s_waitcnt vmcnt(0)" ::: "memory");
            const unsigned og = xb_add(&bar[XB_TOP], 1u);
            const unsigned tg = og / nx;
            if (og + 1u == (tg + 1u) * nx) xb_add(&bar[XB_TOPGEN], 1u);
            else XB_SPIN(xb_ld(&bar[XB_TOPGEN]) == tg, bar);
            __builtin_amdgcn_fence(__ATOMIC_ACQUIRE, "agent");
            xb_add(&bar[XB_XGEN(b.x)], 1u);
            asm volatile("s_waitcnt vmcnt(0)" ::: "memory");
        } else {
            XB_SPIN(xb_ld(&bar[XB_XGEN(b.x)]) == gen, bar);
            __builtin_amdgcn_fence(__ATOMIC_ACQUIRE, "agent");
            asm volatile("s_waitcnt vmcnt(0)" ::: "memory");
        }
    }
    __syncthreads();
}

struct Args { const float* in[17]; float* out; unsigned char* ws; int ph_lo, ph_hi; };
enum { PH_PREP = 0, PH_EMBED = 1, PH_FN_CHAN = 2, PH_FN_POS1 = 3, PH_FN_POS2 = 4, PH_FN_WO = 5, PH_NORM_MLP0 = 6, PH_MLP1_0 = 7, PH_MLP2_0 = 8, PH_NORM_MIX1 = 9, PH_WIN = 10,
       PH_SCAN_A = 11, PH_SCAN_B = 12, PH_SCAN_C = 13, PH_HG_WO = 14, PH_NORM_MLP1 = 15, PH_MLP1_1 = 16, PH_MLP2_1 = 17, PH_FINAL = 18, PH_END = 19 };
constexpr int LDS_BYTES = 160 * 1024, MISC_OFF = LDS_BYTES - 512;

__global__ void __launch_bounds__(NTHREADS, 2) fwd(Args a) {
    extern __shared__ __attribute__((aligned(16))) unsigned char lds_raw[];
    LAS unsigned char* lds = (LAS unsigned char*)lds_raw;
    const int tid = threadIdx.x, lane = tid & 63, wave = __builtin_amdgcn_readfirstlane(tid >> 6);
    const int G = gridDim.x, bx = blockIdx.x;
    const int gw = bx * NWAVES + wave, ngw = G * NWAVES;
    unsigned char* ws = a.ws;
    const float* mod = (const float*)(ws + WM.mod);
    bf16_t* Hb = (bf16_t*)(ws + WM.h);
    bf16_t* Big = (bf16_t*)(ws + WM.big[0]); bf16_t* Big1 = (bf16_t*)(ws + WM.big[1]);
    const float* norm_mlp = a.in[8];
    const float* w1 = a.in[14]; const float* w2 = a.in[15];
    const float* norm_mix = a.in[7]; const float* fnet_wo = a.in[9];
    float* modw = (float*)(ws + WM.mod);
#define IN(k) (a.ph_lo <= (k) && (k) < a.ph_hi)
    if (tid < 128) ((LAS unsigned*)(lds + MISC_OFF))[tid] = 0u;
    __syncthreads();
    XcdBarrier bar = xcd_barrier_post((unsigned*)ws, (volatile LAS unsigned*)(lds + MISC_OFF));
#if defined(PROBE_A)
#define STAMP(k) do { if (bx == 0 && tid == 0) ((LAS unsigned long long*)(lds + MISC_OFF + 64))[(k)] = __builtin_amdgcn_s_memrealtime(); } while (0)
#else
#define STAMP(k) do { } while (0)
#endif
    STAMP(0);
#define SEAM(k) do { if (IN(k) && IN((k) + 1)) xcd_barrier(bar); STAMP((k) + 1); } while (0)
    if (IN(PH_PREP)) {
        LAS float* scr = (LAS float*)(lds + wave * 16384);
        constexpr int I_1 = (1024 / 64) * (4096 / 32), I_2 = (4096 / 64) * (1024 / 32);
        constexpr int I_F = (1024 / 64) * (1024 / 32), I_W = (1024 / 64) * (5120 / 32);
        constexpr int NITEMS = I_1 + I_2 + I_F + I_F + I_W;
        LAS unsigned char* prof_lds_ = (LAS unsigned char*)0; (void)prof_lds_; PROF_DECL; PROF_BEGIN();
        for (int un = bx; un < 384; un += G) mod_unit(lds, un, a.in[3], a.in[4], a.in[5], a.in[6], modw, tid, wave, lane);
        if (bx == G - 1) for (int i = tid; i < 2048; i += NTHREADS) { const int dir = i >> 10, ch = i & 1023; const float l0 = a.in[11][(dir * 2 + 0) * 1024 + ch], l1 = a.in[11][(dir * 2 + 1) * 1024 + ch];
            const float mx = fmaxf(l0, l1), e0 = __expf(l0 - mx), e1 = __expf(l1 - mx); ((float*)(ws + WM.lb))[i] = e1 / (e0 + e1); }
        PROF_END(60); PROF_BEGIN();
        gen_tables(ws, (long)bx * NTHREADS + tid, (long)G * NTHREADS);
        PROF_END(61); PROF_BEGIN();
        transpose_stream(gw, NITEMS, ngw, [&](int it) -> TrItem {
            int r = it;
            if (r < I_F) return TrItem{fnet_wo, (bf16_t*)(ws + WM.wfnet), 1024, 1024, r}; r -= I_F;
            if (r < I_F) return TrItem{a.in[13], (bf16_t*)(ws + WM.who), 1024, 1024, r}; r -= I_F;
            if (r < I_W) return TrItem{a.in[10], (bf16_t*)(ws + WM.win), 1024, 5120, r}; r -= I_W;
            if (r < I_1) return TrItem{w1, (bf16_t*)(ws + WM.w1[0]), 1024, 4096, r}; r -= I_1;
            return TrItem{w2, (bf16_t*)(ws + WM.w2[0]), 4096, 1024, r}; }, scr, lane);
        PROF_END(62);
    }
    SEAM(PH_PREP);
    if (IN(PH_EMBED)) embed_rows(a.in[0], a.in[1], (const float*)(ws + WM.pos), (const float*)(ws + WM.pos) + 64 * 512, norm_mix, mod, Hb, gw, ngw, lane);
    SEAM(PH_EMBED);
    if (IN(PH_FN_CHAN)) {
        { ProbChan p; p.init(0, ws + WM.dftc, Hb, (bf16_t*)(ws + WM.yctx), G, bx); gemm_phase<ProbChan, true, true>(lds, p); }
        { ProbChan p; p.init(1, ws + WM.dftc, Hb, (bf16_t*)(ws + WM.ysmp), G, bx); gemm_phase<ProbChan, true, true>(lds, p); }
    }
    SEAM(PH_FN_CHAN);
    if (IN(PH_FN_POS1)) {
        { ProbPosCtx p; p.init(ws + WM.dl256, (const bf16_t*)(ws + WM.yctx), Hb, G, bx); gemm_phase<ProbPosCtx, true, true>(lds, p); }
        { ProbSmpA p; p.init(ws + WM.fa2, (const bf16_t*)(ws + WM.ysmp), (bf16_t*)(ws + WM.u), G, bx); gemm_phase<ProbSmpA, true, true>(lds, p); }
    }
    SEAM(PH_FN_POS1);
    if (IN(PH_FN_POS2)) { ProbSmpB p; p.init(ws + WM.mb, (const bf16_t*)(ws + WM.u), Hb, G, bx); gemm_phase<ProbSmpB, true, true>(lds, p); }
    SEAM(PH_FN_POS2);
    if (IN(PH_FN_WO)) { ProbResidFirst p; p.init_tok(Hb, 1024, ws + WM.wfnet, 1024, 0, 80, 4, G, bx); p.X = (bf16_t*)a.out; p.mod = mod; p.layer = 0; p.gidx = 2; p.init_split(G, bx, (unsigned short*)(ws + SLAB_FN)); p.xp = a.in[0]; p.xs = a.in[1]; p.er = (const float*)(ws + WM.pos); p.ec = p.er + 64 * 512; p.prof_id = 20; gemm_phase<ProbResidFirst, true, true>(lds, p); }
    SEAM(PH_FN_WO);
    if (IN(PH_NORM_MLP0)) { build_split_table(lds, G, tid); norm_rows((bf16_t*)a.out, 0, 20480, norm_mlp, mod, 0, 3, Hb, gw, ngw, lane, lds, (const unsigned short*)(ws + SLAB_FN)); }
    SEAM(PH_NORM_MLP0);
    if (IN(PH_MLP1_0)) { ProbMlp1 p; p.init_tok(Hb, 1024, ws + WM.w1[0], 1024, 0, 80, 4096 / BM, G, bx); p.O = Big; p.ldc = 4096; p.prof_id = 40; gemm_phase<ProbMlp1, true, true>(lds, p); }
    SEAM(PH_MLP1_0);
    if (IN(PH_MLP2_0)) { ProbResid p; p.init_tok(Big, 4096, ws + WM.w2[0], 4096, 0, 80, 1024 / BM, G, bx); p.X = (bf16_t*)a.out; p.mod = mod; p.layer = 0; p.gidx = 5; p.init_split(G, bx, (unsigned short*)(ws + SLAB_M0)); gemm_phase<ProbResid, true, true>(lds, p); }
    SEAM(PH_MLP2_0);
    if (IN(PH_NORM_MIX1)) { build_split_table(lds, G, tid); norm_rows((bf16_t*)a.out, 0, 20480, norm_mix + 1024, mod, 1, 0, Hb, gw, ngw, lane, lds, (const unsigned short*)(ws + SLAB_M0)); }
    SEAM(PH_NORM_MIX1);
    if (IN(PH_WIN)) { ProbWin p; p.init_tok(Hb, 1024, ws + WM.win, 1024, 0, 80, 20, G, bx); p.Oq = (bf16_t*)(ws + WM.q); p.Offw = (bf16_t*)(ws + WM.lffw); p.Ofbw = (bf16_t*)(ws + WM.lfbw);
        p.Ov = (bf16_t*)(ws + WM.v); p.Osg = (bf16_t*)(ws + WM.sg); p.lb = (const float*)(ws + WM.lb); p.prof_id = 50; gemm_phase<ProbWin, true, true>(lds, p); }
    SEAM(PH_WIN);
    if (IN(PH_SCAN_A) || IN(PH_SCAN_B) || IN(PH_SCAN_C)) {
        ScanT st; st.q = (const bf16_t*)(ws + WM.q); st.lffw = (const bf16_t*)(ws + WM.lffw); st.lfbw = (const bf16_t*)(ws + WM.lfbw); st.v = (const bf16_t*)(ws + WM.v); st.sg = (bf16_t*)(ws + WM.sg);
        st.slots = (bf16_t*)(ws + WM.slots); st.dvec = (float*)(ws + WM.dvec); st.gnorm = a.in[12]; st.state_in = a.in[2]; st.new_state = a.out + (size_t)20480 * 1024;
        if (IN(PH_SCAN_A)) scan_phase_a(lds, st, G, bx);
        SEAM(PH_SCAN_A);
        if (IN(PH_SCAN_B)) scan_phase_b(st, G, bx, tid);
        SEAM(PH_SCAN_B);
        if (IN(PH_SCAN_C)) scan_phase_c(lds, st, G, bx);
    }
    SEAM(PH_SCAN_C);
    if (IN(PH_HG_WO)) {
        { LAS float* scr = (LAS float*)(lds + wave * 16384);
          constexpr int I_1 = (1024 / 64) * (4096 / 32), I_2 = (4096 / 64) * (1024 / 32);
          transpose_stream(gw, I_1 + I_2, ngw, [&](int it) -> TrItem {
              if (it < I_1) return TrItem{w1 + (size_t)1024 * 4096, (bf16_t*)(ws + WM.w1[1]), 1024, 4096, it};
              return TrItem{w2 + (size_t)4096 * 1024, (bf16_t*)(ws + WM.w2[1]), 4096, 1024, it - I_1}; }, scr, lane);
          __syncthreads(); }
        ProbResid p; p.init_tok((bf16_t*)(ws + WM.sg), 1024, ws + WM.who, 1024, 0, 80, 4, G, bx); p.X = (bf16_t*)a.out; p.mod = mod; p.layer = 1; p.gidx = 2; p.init_split(G, bx, (unsigned short*)(ws + SLAB_HG)); gemm_phase<ProbResid, true, true>(lds, p); }
    SEAM(PH_HG_WO);
    if (IN(PH_NORM_MLP1)) { build_split_table(lds, G, tid); norm_rows((bf16_t*)a.out, 0, 20480, norm_mlp + 1024, mod, 1, 3, Hb, gw, ngw, lane, lds, (const unsigned short*)(ws + SLAB_HG)); }
    SEAM(PH_NORM_MLP1);
    if (IN(PH_MLP1_1)) { ProbMlp1 p; p.init_tok(Hb, 1024, ws + WM.w1[1], 1024, 0, 80, 4096 / BM, G, bx); p.O = Big1; p.ldc = 4096; gemm_phase<ProbMlp1, true, true>(lds, p); }
    SEAM(PH_MLP1_1);
    if (IN(PH_MLP2_1)) { ProbResid p; p.init_tok(Big1, 4096, ws + WM.w2[1], 4096, 0, 80, 1024 / BM, G, bx); p.X = (bf16_t*)a.out; p.mod = mod; p.layer = 1; p.gidx = 5; p.init_split(G, bx, (unsigned short*)(ws + SLAB_M1)); gemm_phase<ProbResid, true, true>(lds, p); }
    SEAM(PH_MLP2_1);
    if (IN(PH_FINAL)) { build_split_table(lds, G, tid); final_rows(a.out, 0, 20480, a.in[16], gw, ngw, lane, lds, (const unsigned short*)(ws + SLAB_M1)); }
#if defined(PROF_ID)
    if (bx == 0 && tid == 0) { const unsigned long long d = *(LAS unsigned long long*)(lds + LDS_BYTES - 512 + 256); const unsigned long long t0 = __builtin_amdgcn_s_memrealtime(); while (__builtin_amdgcn_s_memrealtime() - t0 < 16ull * d) __builtin_amdgcn_s_sleep(8); }
#endif
#if defined(PROBE_A)
    if (bx == 0 && tid == 0) { asm volatile("s_waitcnt vmcnt(0)" ::: "memory"); STAMP(PH_END); const unsigned long long d = ((LAS unsigned long long*)(lds + MISC_OFF + 64))[PROBE_B] - ((LAS unsigned long long*)(lds + MISC_OFF + 64))[PROBE_A];
        const unsigned long long t0 = __builtin_amdgcn_s_memrealtime(); while (__builtin_amdgcn_s_memrealtime() - t0 < 4ull * d) __builtin_amdgcn_s_sleep(8); }
#endif
#undef IN
}
}
#ifndef MK_N_LAUNCHES
#define MK_N_LAUNCHES 1
#endif
extern "C" void kernel_launch(void* const* d_in, const int* in_sizes, int n_in, void* d_out, int out_size, void* d_ws, size_t ws_size, hipStream_t stream) {
    static int grid = 0;
    if (grid == 0) {
        int dev = 0, cus = 0;
        if (hipGetDevice(&dev) != hipSuccess || hipDeviceGetAttribute(&cus, hipDeviceAttributeMultiprocessorCount, dev) != hipSuccess || cus <= 0) cus = 256;
        hipFuncSetAttribute((const void*)fk::fwd, hipFuncAttributeMaxDynamicSharedMemorySize, fk::LDS_BYTES);
        int per_cu = 0;
        if (hipOccupancyMaxActiveBlocksPerMultiprocessor(&per_cu, (const void*)fk::fwd, fk::NTHREADS, fk::LDS_BYTES) != hipSuccess || per_cu < 1)
            fprintf(stderr, "kernel_launch: occupancy query reports %d workgroups per CU\n", per_cu);
        (void)hipGetLastError();
        grid = cus;
    }
    hipMemsetAsync(d_ws, 0, fk::CTL_BYTES, stream);
    fk::Args a{};
    for (int i = 0; i < 17; ++i) a.in[i] = (const float*)d_in[i];
    a.out = (float*)d_out; a.ws = (unsigned char*)d_ws;
#if MK_N_LAUNCHES == 1
    a.ph_lo = 0; a.ph_hi = fk::PH_END;
    hipLaunchKernelGGL(fk::fwd, dim3(grid), dim3(fk::NTHREADS), fk::LDS_BYTES, stream, a);
#else
    for (int ph = 0; ph < fk::PH_END; ++ph) { a.ph_lo = ph; a.ph_hi = ph + 1; hipLaunchKernelGGL(fk::fwd, dim3(grid), dim3(fk::NTHREADS), fk::LDS_BYTES, stream, a); }
#endif
}
```

```cpp
#include <hip/hip_runtime.h>
#include <cstdint>
#include <cstdio>
namespace fk {
#define LAS __attribute__((address_space(3)))
#define GAS __attribute__((address_space(1)))
typedef unsigned short bf16_t;
typedef short bf16x8 __attribute__((ext_vector_type(8)));
typedef float f32x4 __attribute__((ext_vector_type(4)));
typedef float f32x2 __attribute__((ext_vector_type(2)));
typedef unsigned u32x4 __attribute__((ext_vector_type(4)));
typedef unsigned u32x2 __attribute__((ext_vector_type(2)));
constexpr int BM = 256, BK = 64, HALF = 128, HTB = HALF * BK * 2, STAGE_BYTES = 8 * HTB, NXCD = 8, WGM = 8;
constexpr int NWAVES = 8, NTHREADS = 512;

__device__ __forceinline__ int lds_byte(int r, int c) { const int st = (r >> 4) * 2 + (c >> 5), rr = r & 15, cc = c & 31, ob = rr * 64 + cc * 2; return st * 1024 + (ob ^ (((ob >> 9) & 1) << 5)); }
__device__ __forceinline__ void stage_rc(int b, int& R, int& C) { const int st = b / 1024, sb = b % 1024, swz = sb ^ (((sb >> 9) & 1) << 5); R = (st >> 1) * 16 + swz / 64; C = (st & 1) * 32 + (swz % 64) / 2; }
__device__ __forceinline__ int perm32(int rho) { const int n = rho >> 4, i = rho & 15; return 8 * (i >> 2) + 4 * n + (i & 3); }
typedef __bf16 bf16x2_cv __attribute__((ext_vector_type(2)));
__device__ __forceinline__ unsigned cvt_pk_bf16(float lo, float hi) { const f32x2 v = {lo, hi}; const bf16x2_cv b = __builtin_convertvector(v, bf16x2_cv); return __builtin_bit_cast(unsigned, b); }
__device__ __forceinline__ unsigned f2bf(float f) { unsigned u = __builtin_bit_cast(unsigned, f); return (u + 0x7fffu + ((u >> 16) & 1u)) >> 16; }
__device__ __forceinline__ unsigned pk2(float lo, float hi) { return f2bf(lo) | (f2bf(hi) << 16); }
__device__ __forceinline__ float bf2f(unsigned short b) { return __builtin_bit_cast(float, (unsigned)b << 16); }
__device__ __forceinline__ unsigned pk2h(float lo, float hi) { const _Float16 a = (_Float16)lo, b = (_Float16)hi; return (unsigned)__builtin_bit_cast(unsigned short, a) | ((unsigned)__builtin_bit_cast(unsigned short, b) << 16); }
__device__ __forceinline__ float h2f_(unsigned short b) { return (float)__builtin_bit_cast(_Float16, b); }
__device__ __forceinline__ f32x4 ld_bf4(const void* p) { const u32x2 w = *(const u32x2*)p; return (f32x4){__builtin_bit_cast(float, w.x << 16), __builtin_bit_cast(float, w.x & 0xffff0000u), __builtin_bit_cast(float, w.y << 16), __builtin_bit_cast(float, w.y & 0xffff0000u)}; }
__device__ __forceinline__ void st_bf4(void* p, const f32x4& v) { u32x2 w; w.x = cvt_pk_bf16(v[0], v[1]); w.y = cvt_pk_bf16(v[2], v[3]); *(u32x2*)p = w; }
__device__ __forceinline__ float silu(float x) { return x / (1.f + __expf(-x)); }
__device__ __forceinline__ float wave_sum(float v) {
#pragma unroll
    for (int o = 1; o < 64; o <<= 1) v += __shfl_xor(v, o);
    return v;
}

constexpr unsigned long long KiB = 1024ull, MiB = 1ull << 20;
struct WsMapT { unsigned long long slots, dvec, lb, q, lffw, lfbw, v, sg, mod, pos, dftc, dl256, fa2, mb, wfnet, who, win, w1[2], w2[2], h, yctx, ysmp, u, big[2]; };
constexpr WsMapT WM = {   13 * MiB,   45 * MiB,   320 * KiB,   53 * MiB,   93 * MiB,   133 * MiB,   173 * MiB,   213 * MiB,   64 * KiB,   512 * KiB,
      53 * MiB,   53 * MiB + 256 * KiB,   53 * MiB + 512 * KiB,   54 * MiB,   59 * MiB,   1 * MiB,   3 * MiB,   {61 * MiB, 53 * MiB},   {237 * MiB, 61 * MiB},
      13 * MiB,   77 * MiB,   93 * MiB,   157 * MiB,   {77 * MiB, 69 * MiB} };
constexpr unsigned long long SLAB_FN = 77 * MiB, SLAB_M0 = 53 * MiB, SLAB_HG = 69 * MiB, SLAB_M1 = 13 * MiB;
constexpr unsigned long long CTL_BYTES = 16 * KiB;
#if defined(PROF_ID)
#define PROF_DECL unsigned long long prof_t0_ = 0ull; const bool prof_on_ = (blockIdx.x == 0) && (__builtin_amdgcn_readfirstlane(threadIdx.x >> 6) == 0)
#define PROF_BEGIN() do { if (prof_on_) prof_t0_ = __builtin_amdgcn_s_memrealtime(); } while (0)
#define PROF_END(id) do { if (prof_on_ && (id) == PROF_ID) { const unsigned long long d_ = __builtin_amdgcn_s_memrealtime() - prof_t0_; if (threadIdx.x == 0) *(LAS unsigned long long*)(prof_lds_ + 160 * 1024 - 512 + 256) += d_; } } while (0)
#else
#define PROF_DECL
#define PROF_BEGIN() do { } while (0)
#define PROF_END(id) do { } while (0)
#endif

struct Unit { size_t offA, offB; int p0, p1, p2, p3, nt; };
struct OpMap { int rm; unsigned s1, s2; };
__device__ __forceinline__ unsigned rowoff(const OpMap& m, int R) { return (unsigned)(R % m.rm) * m.s1 + (unsigned)(R / m.rm) * m.s2; }

template <class P, bool ALIGN_EPI, bool SP2>
__device__ __forceinline__ void gemm_phase(LAS unsigned char* lds, const P& pb) {
    const int tid = threadIdx.x, wid = __builtin_amdgcn_readfirstlane(tid >> 6), lane = tid & 63, wr = wid >> 2, wc = wid & 3, fr = lane & 15, fq = lane >> 4;
    unsigned voffA[2], voffB[2];
#pragma unroll
    for (int i = 0; i < 2; ++i) { int R, C; stage_rc(tid * 16 + i * 8192, R, C); const int Rb = P::PERM ? ((R & ~31) + perm32(R & 31)) : R;
        voffA[i] = rowoff(pb.ma, R) + (unsigned)C * 2u; voffB[i] = rowoff(pb.mb, Rb) + (unsigned)C * 2u; }
    const size_t kstepA = pb.kstepA, kstepB = pb.kstepB, hstepA = pb.hstepA, hstepB = pb.hstepB;
    const unsigned ldsw = (unsigned)wid * 1024u;
    const int aoff = lds_byte(wr * 64 + fr, fq * 8), boff = lds_byte(wc * 32 + fr, fq * 8);
#define PG8_SA(b, h) (((b) * 2 + (h)) * HTB)
#define PG8_SB(b, h) ((4 + (b) * 2 + (h)) * HTB)
#define PG8_STAGE(bufoff, gbase, voff) do { _Pragma("unroll") for (int _i = 0; _i < 2; ++_i) \
        __builtin_amdgcn_global_load_lds((const unsigned*)((const char*)(gbase) + (voff)[_i]), (LAS unsigned*)(lds + (bufoff) + ldsw + _i * 8192), 16, 0, 0); } while (0)
#define PG8_LDA(dst, b, h) do { _Pragma("unroll") for (int m = 0; m < 4; ++m) _Pragma("unroll") for (int k = 0; k < 2; ++k) dst[m][k] = *(const LAS bf16x8*)(lds + PG8_SA(b, h) + aoff + m * 2048 + k * 1024); } while (0)
#define PG8_LDB(dst, b, h) do { _Pragma("unroll") for (int n = 0; n < 2; ++n) _Pragma("unroll") for (int k = 0; k < 2; ++k) dst[n][k] = *(const LAS bf16x8*)(lds + PG8_SB(b, h) + boff + n * 2048 + k * 1024); } while (0)
#define PG8_MMA(ai, bj, At, Bt) do { __builtin_amdgcn_s_setprio(1); _Pragma("unroll") for (int m = 0; m < 4; ++m) _Pragma("unroll") for (int n = 0; n < 2; ++n) _Pragma("unroll") for (int k = 0; k < 2; ++k) \
        acc[ai][bj][m][n] = __builtin_amdgcn_mfma_f32_16x16x32_bf16(Bt[n][k], At[m][k], acc[ai][bj][m][n], 0, 0, 0); __builtin_amdgcn_s_setprio(0); } while (0)
#define PG8_WAIT_V(n) asm volatile("s_waitcnt vmcnt(" #n ")" ::: "memory")
#define PG8_WAIT_L(n) asm volatile("s_waitcnt lgkmcnt(" #n ")" ::: "memory")
#define PG8_BAR __builtin_amdgcn_s_barrier()
#define PG8_SCHED __builtin_amdgcn_sched_barrier(0)
    LAS unsigned char* prof_lds_ = (LAS unsigned char*)0; (void)prof_lds_; PROF_DECL; PROF_BEGIN();
    Unit cur, nxt; int ui = 0;
    if (!pb.next(0, cur)) return;
    f32x4 acc[2][2][4][2];
#pragma unroll
    for (int a = 0; a < 2; ++a)
#pragma unroll
        for (int b = 0; b < 2; ++b)
#pragma unroll
            for (int m = 0; m < 4; ++m)
#pragma unroll
                for (int n = 0; n < 2; ++n) acc[a][b][m][n] = (f32x4){0.f, 0.f, 0.f, 0.f};
    bf16x8 At[4][2], B0[2][2], B1[2][2];
    const char* cA = pb.A + cur.offA; const char* cB = pb.B + cur.offB;
    if constexpr (SP2) {
        PG8_STAGE(PG8_SB(0, 0), cB, voffB); PG8_STAGE(PG8_SB(0, 1), cB + hstepB, voffB); PG8_STAGE(PG8_SA(0, 0), cA, voffA); PG8_STAGE(PG8_SA(0, 1), cA + hstepA, voffA);
        if (wr == 1) PG8_BAR;
        PG8_WAIT_V(2); PG8_BAR;
        PG8_STAGE(PG8_SB(1, 0), cB + kstepB, voffB); PG8_STAGE(PG8_SA(1, 0), cA + kstepA, voffA); PG8_STAGE(PG8_SB(1, 1), cB + hstepB + kstepB, voffB);
        PG8_WAIT_V(6); PG8_BAR;
    } else {
        PG8_STAGE(PG8_SB(0, 0), cB, voffB); PG8_STAGE(PG8_SA(0, 0), cA, voffA); PG8_STAGE(PG8_SB(0, 1), cB + hstepB, voffB); PG8_STAGE(PG8_SA(0, 1), cA + hstepA, voffA);
        if (wr == 1) PG8_BAR;
        PG8_WAIT_V(4); PG8_BAR;
        PG8_STAGE(PG8_SB(1, 0), cB + kstepB, voffB); PG8_STAGE(PG8_SA(1, 0), cA + kstepA, voffA); PG8_STAGE(PG8_SB(1, 1), cB + hstepB + kstepB, voffB);
        PG8_WAIT_V(6); PG8_BAR;
    }
    for (;;) {
        const bool has_next = pb.next(ui + 1, nxt);
        const char* nA = has_next ? pb.A + nxt.offA : cA; const char* nB = has_next ? pb.B + nxt.offB : cB;
        const int nt = cur.nt;
        for (int t = 0; t < nt; t += 2) {
            const bool last = (t == nt - 2);
            const char* a1 = cA + (size_t)(t + 1) * kstepA;
            const char* a2 = last ? nA : cA + (size_t)(t + 2) * kstepA; const char* b2 = last ? nB : cB + (size_t)(t + 2) * kstepB;
            const char* a3 = a2 + kstepA; const char* b3 = b2 + kstepB;
            if constexpr (SP2) {
            PG8_LDB(B0, 0, 0); PG8_LDB(B1, 0, 1); PG8_SCHED; PG8_LDA(At, 0, 0); PG8_STAGE(PG8_SA(1, 1), a1 + hstepA, voffA);
            PG8_WAIT_V(8); PG8_WAIT_L(0); PG8_BAR; PG8_MMA(0, 0, At, B0); PG8_MMA(0, 1, At, B1); PG8_BAR; PG8_SCHED;
            PG8_LDA(At, 0, 1); PG8_STAGE(PG8_SB(0, 0), b2, voffB); PG8_STAGE(PG8_SB(0, 1), b2 + hstepB, voffB); PG8_STAGE(PG8_SA(0, 0), a2, voffA);
            PG8_WAIT_V(8); PG8_WAIT_L(0); PG8_BAR; PG8_MMA(1, 0, At, B0); PG8_MMA(1, 1, At, B1); PG8_BAR; PG8_SCHED;
            PG8_LDB(B0, 1, 0); PG8_LDB(B1, 1, 1); PG8_SCHED; PG8_LDA(At, 1, 0); PG8_STAGE(PG8_SA(0, 1), a2 + hstepA, voffA);
            PG8_WAIT_V(8); PG8_WAIT_L(0); PG8_BAR; PG8_MMA(0, 0, At, B0); PG8_MMA(0, 1, At, B1); PG8_BAR; PG8_SCHED;
            PG8_LDA(At, 1, 1); PG8_STAGE(PG8_SB(1, 0), b3, voffB); PG8_STAGE(PG8_SB(1, 1), b3 + hstepB, voffB); PG8_STAGE(PG8_SA(1, 0), a3, voffA);
            PG8_WAIT_V(8); PG8_WAIT_L(0); PG8_BAR; PG8_MMA(1, 0, At, B0); PG8_MMA(1, 1, At, B1); PG8_BAR; PG8_SCHED;
            } else {
            PG8_LDB(B0, 0, 0); PG8_SCHED; PG8_LDA(At, 0, 0); PG8_STAGE(PG8_SA(1, 1), a1 + hstepA, voffA);
            PG8_WAIT_L(8); PG8_BAR; PG8_WAIT_L(0); PG8_MMA(0, 0, At, B0); PG8_BAR; PG8_SCHED;
            PG8_LDB(B1, 0, 1); PG8_STAGE(PG8_SB(0, 0), b2, voffB);
            PG8_BAR; PG8_WAIT_L(0); PG8_MMA(0, 1, At, B1); PG8_BAR;
            PG8_LDA(At, 0, 1); PG8_STAGE(PG8_SA(0, 0), a2, voffA);
            PG8_BAR; PG8_WAIT_L(0); PG8_MMA(1, 0, At, B0); PG8_BAR; PG8_SCHED;
            PG8_STAGE(PG8_SB(0, 1), b2 + hstepB, voffB);
            PG8_WAIT_V(6); PG8_BAR; PG8_MMA(1, 1, At, B1); PG8_BAR;
            PG8_LDB(B0, 1, 0); PG8_SCHED; PG8_LDA(At, 1, 0); PG8_STAGE(PG8_SA(0, 1), a2 + hstepA, voffA);
            PG8_WAIT_L(8); PG8_BAR; PG8_WAIT_L(0); PG8_MMA(0, 0, At, B0); PG8_BAR; PG8_SCHED;
            PG8_LDB(B1, 1, 1); PG8_STAGE(PG8_SB(1, 0), b3, voffB);
            PG8_BAR; PG8_WAIT_L(0); PG8_MMA(0, 1, At, B1); PG8_BAR;
            PG8_LDA(At, 1, 1); PG8_STAGE(PG8_SA(1, 0), a3, voffA);
            PG8_BAR; PG8_WAIT_L(0); PG8_MMA(1, 0, At, B0); PG8_BAR; PG8_SCHED;
            PG8_STAGE(PG8_SB(1, 1), b3 + hstepB, voffB);
            PG8_WAIT_V(6); PG8_BAR; PG8_MMA(1, 1, At, B1); PG8_BAR;
            }
        }
        if constexpr (ALIGN_EPI) { if (wr == 0) PG8_BAR; }
        PROF_END(pb.prof_id); PROF_BEGIN();
        pb.epi(acc, cur, wr, wc, fr, fq);
#if defined(PROF_ID)
        asm volatile("s_waitcnt vmcnt(0)" ::: "memory");
#endif
        PROF_END(pb.prof_id + 1); PROF_BEGIN();
        if (!has_next) break;
#pragma unroll
        for (int a = 0; a < 2; ++a)
#pragma unroll
            for (int b = 0; b < 2; ++b)
#pragma unroll
                for (int m = 0; m < 4; ++m)
#pragma unroll
                    for (int n = 0; n < 2; ++n) acc[a][b][m][n] = (f32x4){0.f, 0.f, 0.f, 0.f};
        cur = nxt; cA = nA; cB = nB; ++ui;
        if constexpr (ALIGN_EPI) { if (wr == 1) PG8_BAR; }
    }
    PG8_WAIT_V(0);
    if constexpr (!ALIGN_EPI) { if (wr == 0) PG8_BAR; }
    PG8_BAR;
#undef PG8_SA
#undef PG8_SB
#undef PG8_STAGE
#undef PG8_LDA
#undef PG8_LDB
#undef PG8_MMA
#undef PG8_WAIT_V
#undef PG8_WAIT_L
#undef PG8_BAR
#undef PG8_SCHED
}

struct StaticOrder {
    int nM, nN, nwg, G, c;
    __device__ void init(int nM_, int nN_, int G_, int c_) { nM = nM_; nN = nN_; nwg = nM * nN; G = G_; c = c_; }
    __device__ bool next(int i, int& pm, int& pn) const { const long L = (long)i * G + c; if (L >= nwg) return false; map((int)L, pm, pn); return true; }
    __device__ void map(int L, int& pm, int& pn) const {
        int wgid = L; { const int q = nwg / NXCD, r = nwg % NXCD, xcd = wgid % NXCD, off = wgid / NXCD; wgid = (xcd < r ? xcd * (q + 1) : r * (q + 1) + (xcd - r) * q) + off; }
        const int nig = WGM * nN, gid = wgid / nig, fm = gid * WGM, gsz = (nM - fm) < WGM ? (nM - fm) : WGM;
        pm = fm + ((wgid % nig) % gsz); pn = (wgid % nig) / gsz;
    }
};

struct ProbBase {
    const char* A; const char* B; OpMap ma, mb; size_t hstepA, hstepB, kstepA, kstepB; int nt; int prof_id = -100;
    __device__ void std_operands(const void* A_, int lda, const void* B_, int ldb, int K) {
        A = (const char*)A_; B = (const char*)B_; ma = OpMap{128, (unsigned)lda * 2u, 0u}; mb = OpMap{128, (unsigned)ldb * 2u, 0u};
        hstepA = (size_t)HALF * lda * 2; hstepB = (size_t)HALF * ldb * 2; kstepA = kstepB = BK * 2; nt = K / BK;
    }
};

template <class F> __device__ __forceinline__ void epi_rows_perm(const f32x4 (&acc)[2][2][4][2], int wr, int wc, int fr, int fq, F f) {
    asm volatile("" : "+v"(fr), "+v"(fq));
#pragma unroll
    for (int ai = 0; ai < 2; ++ai)
#pragma unroll
        for (int m = 0; m < 4; ++m)
#pragma unroll
            for (int bj = 0; bj < 2; ++bj) f(ai * HALF + wr * 64 + m * 16 + fr, bj * HALF + wc * 32 + 8 * fq, acc[ai][bj][m][0], acc[ai][bj][m][1]);
}
template <class F> __device__ __forceinline__ void epi_rows_f32(const f32x4 (&acc)[2][2][4][2], int wr, int wc, int fr, int fq, F f) {
    asm volatile("" : "+v"(fr), "+v"(fq));
#pragma unroll
    for (int ai = 0; ai < 2; ++ai)
#pragma unroll
        for (int m = 0; m < 4; ++m)
#pragma unroll
            for (int bj = 0; bj < 2; ++bj)
#pragma unroll
                for (int n = 0; n < 2; ++n) f(ai * HALF + wr * 64 + m * 16 + fr, bj * HALF + wc * 32 + 16 * n + 4 * fq, acc[ai][bj][m][n]);
}
__device__ __forceinline__ u32x4 pack8(const f32x4& v0, const f32x4& v1) { u32x4 w; w.x = cvt_pk_bf16(v0[0], v0[1]); w.y = cvt_pk_bf16(v0[2], v0[3]); w.z = cvt_pk_bf16(v1[0], v1[1]); w.w = cvt_pk_bf16(v1[2], v1[3]); return w; }

struct TokOrder : ProbBase {
    StaticOrder so; int row0, lda, ldb;
    __device__ void init_tok(const void* Act, int lda_, const void* Wt, int K, int row0_, int nM, int nN, int G, int c) { std_operands(Act, lda_, Wt, K, K); row0 = row0_; lda = lda_; ldb = K; so.init(nM, nN, G, c); }
    __device__ bool next(int i, Unit& u) const { int pm, pn; if (!so.next(i, pm, pn)) return false; u.p0 = pm; u.p1 = pn; u.p2 = -1; u.nt = nt; u.offA = (size_t)(row0 + pm * BM) * lda * 2; u.offB = (size_t)pn * BM * ldb * 2; return true; }
};
struct ProbMlp1 : TokOrder {
    static constexpr bool PERM = true;
    bf16_t* O; int ldc;
    __device__ __forceinline__ void epi(const f32x4 (&acc)[2][2][4][2], const Unit& u, int wr, int wc, int fr, int fq) const {
        bf16_t* base = O + (size_t)(row0 + u.p0 * BM) * ldc + u.p1 * BM;
        epi_rows_perm(acc, wr, wc, fr, fq, [&](int r, int c, f32x4 v0, f32x4 v1) {
#pragma unroll
            for (int j = 0; j < 4; ++j) { const float a = fmaxf(v0[j], 0.f), b = fmaxf(v1[j], 0.f); v0[j] = a * a; v1[j] = b * b; }
            *(u32x4*)(base + (size_t)r * ldc + c) = pack8(v0, v1); });
    }
};
template <bool FIRST> struct ProbResidT : TokOrder {
    static constexpr bool PERM = false;
    bf16_t* X; const float* mod; int layer, gidx; unsigned short* slab; int G2, c2;
    const float* xp; const float* xs; const float* er; const float* ec;
    __device__ void init_split(int G_, int c_, unsigned short* slab_) { G2 = G_; c2 = c_; slab = slab_; xp = nullptr; xs = nullptr; er = nullptr; ec = nullptr; }
    __device__ bool next(int i, Unit& u) const {
        if (G2 != 256) return TokOrder::next(i, u);
        int pm, pn;
        if (i > 1) return false;
        const int which = (c2 & 1) ? 1 - i : i;
        if (which == 0) { so.map(c2, pm, pn); u.p2 = -1; u.p3 = 0; u.nt = nt; u.offA = (size_t)(row0 + pm * BM) * lda * 2; u.offB = (size_t)pn * BM * ldb * 2; }
        else { const int L = 256 + (c2 >> 2), kq = c2 & 3, ntq = nt >> 2; so.map(L, pm, pn); u.p2 = kq; u.p3 = L - 256; u.nt = ntq;
            u.offA = (size_t)(row0 + pm * BM) * lda * 2 + (size_t)kq * ntq * BK * 2; u.offB = (size_t)pn * BM * ldb * 2 + (size_t)kq * ntq * BK * 2; }
        u.p0 = pm; u.p1 = pn; return true;
    }
    __device__ __forceinline__ void epi(const f32x4 (&acc)[2][2][4][2], const Unit& u, int wr, int wc, int fr, int fq) const {
        asm volatile("" : "+v"(fr), "+v"(fq));
        const int rowt = row0 + u.p0 * BM, cond = rowt >> 12, colt = u.p1 * BM;
        const float* gate = mod + ((size_t)(cond * 2 + layer) * 6 + gidx) * 1024 + colt + wc * 32 + 4 * fq;
        f32x4 gt[2][2];
#pragma unroll
        for (int bj = 0; bj < 2; ++bj)
#pragma unroll
            for (int n = 0; n < 2; ++n) gt[bj][n] = *(const f32x4*)(gate + bj * HALF + 16 * n);
        if (u.p2 <= 0) {
            bf16_t* base = X + (size_t)(rowt + wr * 64 + fr) * 2048 + (fr & 1) * 1024 + colt + wc * 32 + 4 * fq;
            if constexpr (FIRST) {
                const bool smp = rowt >= 4096, use_er = colt < 512; const int t0 = (rowt & 4095) + wr * 64 + fr;
                const float* xsrc = (smp ? xs + (size_t)(rowt - 4096) * 1024 : xp + (size_t)rowt * 1024) + (size_t)(wr * 64 + fr) * 1024 + colt + wc * 32 + 4 * fq;
                const float* pbase = (use_er ? er + colt : ec + colt - 512) + wc * 32 + 4 * fq;
#pragma unroll
                for (int ai = 0; ai < 2; ++ai)
#pragma unroll
                    for (int mp = 0; mp < 2; ++mp) {
                        f32x4 xv[2][2][2], pv[2][2][2];
#pragma unroll
                        for (int mm = 0; mm < 2; ++mm) { const int ro = ai * HALF + (2 * mp + mm) * 16; const int t = t0 + ro;
#pragma unroll
                            for (int bj = 0; bj < 2; ++bj)
#pragma unroll
                                for (int n = 0; n < 2; ++n) { xv[mm][bj][n] = *(const f32x4*)(xsrc + (size_t)ro * 1024 + bj * HALF + 16 * n);
                                    pv[mm][bj][n] = smp ? *(const f32x4*)(pbase + (use_er ? (t >> 6) : (t & 63)) * 512 + bj * HALF + 16 * n) : (f32x4){0.f, 0.f, 0.f, 0.f}; } }
#pragma unroll
                        for (int mm = 0; mm < 2; ++mm) { const int ro = ai * HALF + (2 * mp + mm) * 16;
#pragma unroll
                            for (int bj = 0; bj < 2; ++bj)
#pragma unroll
                                for (int n = 0; n < 2; ++n) st_bf4(base + (size_t)ro * 2048 + bj * HALF + 16 * n, xv[mm][bj][n] + pv[mm][bj][n] + gt[bj][n] * acc[ai][bj][2 * mp + mm][n]); }
                    }
            } else {
#pragma unroll
                for (int ai = 0; ai < 2; ++ai) {
                    u32x2 xw[4][2][2];
#pragma unroll
                    for (int m = 0; m < 4; ++m)
#pragma unroll
                        for (int bj = 0; bj < 2; ++bj)
#pragma unroll
                            for (int n = 0; n < 2; ++n) xw[m][bj][n] = *(const u32x2*)(base + (size_t)(ai * HALF + m * 16) * 2048 + bj * HALF + 16 * n);
#pragma unroll
                    for (int m = 0; m < 4; ++m)
#pragma unroll
                        for (int bj = 0; bj < 2; ++bj)
#pragma unroll
                            for (int n = 0; n < 2; ++n) { const u32x2 w = xw[m][bj][n];
                                const f32x4 x0 = (f32x4){__builtin_bit_cast(float, w.x << 16), __builtin_bit_cast(float, w.x & 0xffff0000u), __builtin_bit_cast(float, w.y << 16), __builtin_bit_cast(float, w.y & 0xffff0000u)};
                                st_bf4(base + (size_t)(ai * HALF + m * 16) * 2048 + bj * HALF + 16 * n, x0 + gt[bj][n] * acc[ai][bj][m][n]); }
                }
            }
        } else {
            unsigned short* base = slab + (size_t)(u.p3 * 3 + u.p2 - 1) * 65536 + (size_t)(wr * 64 + fr) * 256 + wc * 32 + 4 * fq;
#pragma unroll
            for (int ai = 0; ai < 2; ++ai)
#pragma unroll
                for (int m = 0; m < 4; ++m)
#pragma unroll
                    for (int bj = 0; bj < 2; ++bj)
#pragma unroll
                        for (int n = 0; n < 2; ++n) { const f32x4 w = gt[bj][n] * acc[ai][bj][m][n]; u32x2 o; o.x = pk2h(w[0], w[1]); o.y = pk2h(w[2], w[3]); *(u32x2*)(base + (size_t)(ai * HALF + m * 16) * 256 + bj * HALF + 16 * n) = o; }
        }
    }
};
typedef ProbResidT<false> ProbResid; typedef ProbResidT<true> ProbResidFirst;
__device__ __forceinline__ void build_split_table(LAS unsigned char* tab, int G, int tid) {
    for (int i = tid; i < 320; i += NTHREADS) tab[i] = 255;
    __syncthreads();
    if (G == 256) { StaticOrder so; so.init(80, 4, G, 0); for (int L = 256 + tid; L < 320; L += NTHREADS) { int pm, pn; so.map(L, pm, pn); tab[pm * 4 + pn] = (unsigned char)(L - 256); } }
    __syncthreads();
}
struct SlabRaw { u32x2 w[3]; };
__device__ __forceinline__ SlabRaw slab_load(const unsigned short* slab, int idx, int r255, int col) { SlabRaw s;
#pragma unroll
    for (int q = 0; q < 3; ++q) s.w[q] = *(const u32x2*)(slab + (size_t)(idx * 3 + q) * 65536 + (size_t)r255 * 256 + col);
    return s; }
__device__ __forceinline__ f32x4 slab_add(const SlabRaw& r) { f32x4 s = (f32x4){0.f, 0.f, 0.f, 0.f};
#pragma unroll
    for (int q = 0; q < 3; ++q) { s[0] += h2f_((unsigned short)(r.w[q].x & 0xffffu)); s[1] += h2f_((unsigned short)(r.w[q].x >> 16)); s[2] += h2f_((unsigned short)(r.w[q].y & 0xffffu)); s[3] += h2f_((unsigned short)(r.w[q].y >> 16)); }
    return s; }
__device__ __forceinline__ f32x4 slab_sum(const unsigned short* slab, int idx, int r255, int col) {
    f32x4 s = (f32x4){0.f, 0.f, 0.f, 0.f};
#pragma unroll
    for (int q = 0; q < 3; ++q) { const u32x2 w = *(const u32x2*)(slab + (size_t)(idx * 3 + q) * 65536 + (size_t)r255 * 256 + col);
        s[0] += h2f_((unsigned short)(w.x & 0xffffu)); s[1] += h2f_((unsigned short)(w.x >> 16)); s[2] += h2f_((unsigned short)(w.y & 0xffffu)); s[3] += h2f_((unsigned short)(w.y >> 16)); }
    return s;
}

struct ProbWin : TokOrder {
    static constexpr bool PERM = true;
    bf16_t* Oq; bf16_t* Offw; bf16_t* Ofbw; bf16_t* Ov; bf16_t* Osg; const float* lb;
    __device__ __forceinline__ void epi(const f32x4 (&acc)[2][2][4][2], const Unit& u, int wr, int wc, int fr, int fq) const {
        const int t = u.p1 >> 2, col0 = (u.p1 & 3) * BM;
        bf16_t* O = t == 0 ? Oq : t == 1 ? Offw : t == 2 ? Ofbw : t == 3 ? Ov : Osg;
        bf16_t* base = O + (size_t)(row0 + u.p0 * BM) * 1024 + col0;
        if (t == 1 || t == 2) {
            const float* lbp = lb + (t - 1) * 1024 + col0 + wc * 32 + 8 * fq;
            f32x4 lbv[2][2];
#pragma unroll
            for (int bj = 0; bj < 2; ++bj) { lbv[bj][0] = *(const f32x4*)(lbp + bj * HALF); lbv[bj][1] = *(const f32x4*)(lbp + bj * HALF + 4); }
            epi_rows_perm(acc, wr, wc, fr, fq, [&](int r, int c, f32x4 v0, f32x4 v1) {
                const f32x4 l0 = lbv[c >> 7][0], l1 = lbv[c >> 7][1];
#pragma unroll
                for (int j = 0; j < 4; ++j) { v0[j] = __builtin_amdgcn_logf(l0[j] + (1.f - l0[j]) * __builtin_amdgcn_rcpf(1.f + __builtin_amdgcn_exp2f(-1.44269504f * v0[j]))); v1[j] = __builtin_amdgcn_logf(l1[j] + (1.f - l1[j]) * __builtin_amdgcn_rcpf(1.f + __builtin_amdgcn_exp2f(-1.44269504f * v1[j]))); }
                u32x4 w; w.x = pk2h(v0[0], v0[1]); w.y = pk2h(v0[2], v0[3]); w.z = pk2h(v1[0], v1[1]); w.w = pk2h(v1[2], v1[3]);
                *(u32x4*)(base + (size_t)r * 1024 + c) = w; });
        } else if (t == 3) {
            epi_rows_perm(acc, wr, wc, fr, fq, [&](int r, int c, f32x4 v0, f32x4 v1) { *(u32x4*)(base + (size_t)r * 1024 + c) = pack8(v0, v1); });
        } else {
            epi_rows_perm(acc, wr, wc, fr, fq, [&](int r, int c, f32x4 v0, f32x4 v1) {
#pragma unroll
                for (int j = 0; j < 4; ++j) { v0[j] = silu(v0[j]); v1[j] = silu(v1[j]); }
                *(u32x4*)(base + (size_t)r * 1024 + c) = pack8(v0, v1); });
        }
    }
};

struct ProbChan : ProbBase {
    static constexpr bool PERM = true;
    int mode, G, c, nunits; bf16_t* Y;
    __device__ void init(int mode_, const void* dftc, const bf16_t* h0, bf16_t* Y_, int G_, int c_) {
        mode = mode_; G = G_; c = c_; Y = Y_; A = (const char*)dftc; B = (const char*)h0; ma = OpMap{128, 512u, 0u}; hstepA = (size_t)HALF * 512; kstepA = kstepB = BK * 2; nt = 4;
        if (mode == 0) { mb = OpMap{128, 2048u, 0u}; hstepB = (size_t)HALF * 2048; nunits = 16 * 4 * 2; }
        else { mb = OpMap{64, 64u * 2048u, 2048u}; hstepB = 2 * 2048; nunits = 4 * 4 * 16 * 2; }
    }
    __device__ bool next(int i, Unit& u) const {
        const int L = i * G + c; if (L >= nunits) return false;
        const int mt = L & 1; u.p0 = mt; u.nt = nt; u.offA = (size_t)mt * 256 * 512;
        if (mode == 0) { const int g = (L >> 1) & 3, b = L >> 3; u.p1 = b * 2048 + g * 512; u.p2 = 0; u.offB = ((size_t)(b * 256) * 1024 + g * 256) * 2; }
        else { const int j = (L >> 1) & 15, g = (L >> 5) & 3, b = L >> 7; u.p1 = b * 2048 + g * 512; u.p2 = j * 256; u.offB = ((size_t)(4096 + b * 4096 + 4 * j) * 1024 + g * 256) * 2; }
        return true;
    }
    __device__ __forceinline__ void epi(const f32x4 (&acc)[2][2][4][2], const Unit& u, int wr, int wc, int fr, int fq) const {
        const int ldc = mode == 0 ? 256 : 4096;
        bf16_t* base = Y + (size_t)(u.p1 + u.p0 * 256) * ldc + u.p2;
        epi_rows_perm(acc, wr, wc, fr, fq, [&](int r, int cc, f32x4 v0, f32x4 v1) { *(u32x4*)(base + (size_t)r * ldc + cc) = pack8(v0, v1); });
    }
};
struct ProbPosCtx : ProbBase {
    static constexpr bool PERM = true;
    int G, c; bf16_t* Z;
    __device__ void init(const void* dl, const bf16_t* yctx, bf16_t* Z_, int G_, int c_) { std_operands(dl, 512, yctx, 512, 512); G = G_; c = c_; Z = Z_; }
    __device__ bool next(int i, Unit& u) const {
        const int L = i * G + c; if (L >= 64) return false;
        const int pn = L & 3, b = L >> 2; u.p0 = b; u.p1 = pn; u.nt = nt; u.offA = 0; u.offB = ((size_t)b * 2048 * 256 + (size_t)pn * 256 * 512) * 2; return true;
    }
    __device__ __forceinline__ void epi(const f32x4 (&acc)[2][2][4][2], const Unit& u, int wr, int wc, int fr, int fq) const {
        bf16_t* base = Z + (size_t)(u.p0 * 256) * 1024 + u.p1 * 256;
        epi_rows_perm(acc, wr, wc, fr, fq, [&](int r, int cc, f32x4 v0, f32x4 v1) { *(u32x4*)(base + (size_t)r * 1024 + cc) = pack8(v0, v1); });
    }
};
struct ProbSmpA : ProbBase {
    static constexpr bool PERM = true;
    int G, c; bf16_t* U;
    __device__ void init(const void* fa2, const bf16_t* yt, bf16_t* U_, int G_, int c_) {
        A = (const char*)fa2; B = (const char*)yt; ma = OpMap{128, 512u, 0u}; hstepA = (size_t)HALF * 512; kstepA = BK * 2;
        mb = OpMap{32, 128u, 16384u}; hstepB = 4 * 16384; kstepB = 4096; nt = 4; G = G_; c = c_; U = U_;
    }
    __device__ bool next(int i, Unit& u) const {
        const int L = i * G + c; if (L >= 512) return false;
        const int tau = L & 127, b = L >> 7; u.p0 = b; u.p1 = tau; u.nt = nt; u.offA = 0; u.offB = ((size_t)(b * 2048 + 16 * tau) * 4096) * 2; return true;
    }
    __device__ __forceinline__ void epi(const f32x4 (&acc)[2][2][4][2], const Unit& u, int wr, int wc, int fr, int fq) const {
        bf16_t* base = U + (size_t)(u.p0 * 1024 + 8 * u.p1) * 8192;
        epi_rows_perm(acc, wr, wc, fr, fq, [&](int r, int cc, f32x4 v0, f32x4 v1) {
            *(u32x4*)(base + (size_t)(cc >> 5) * 8192 + (r & 127) * 64 + (r >> 7) * 32 + (cc & 31)) = pack8(v0, v1); });
    }
};
struct ProbSmpB : ProbBase {
    static constexpr bool PERM = true;
    int G, c; bf16_t* Z;
    __device__ void init(const void* mbm, const bf16_t* Uin, bf16_t* Z_, int G_, int c_) { std_operands(mbm, 512, Uin, 8192, 512); G = G_; c = c_; Z = Z_; }
    __device__ bool next(int i, Unit& u) const {
        const int L = i * G + c; if (L >= 256) return false;
        const int pn = L & 3, q = (L >> 2) & 15, b = L >> 6; u.p0 = b; u.p1 = q; u.p2 = pn; u.nt = nt;
        u.offA = (size_t)q * 256 * 512 * 2; u.offB = ((size_t)(b * 1024 + pn * 256) * 8192 + q * 512) * 2; return true;
    }
    __device__ __forceinline__ void epi(const f32x4 (&acc)[2][2][4][2], const Unit& u, int wr, int wc, int fr, int fq) const {
        bf16_t* base = Z + (size_t)(4096 + u.p0 * 4096 + 4 * u.p1) * 1024 + u.p2 * 256;
        epi_rows_perm(acc, wr, wc, fr, fq, [&](int r, int cc, f32x4 v0, f32x4 v1) {
            const int l = (r >> 6) + 64 * (r & 63); *(u32x4*)(base + (size_t)l * 1024 + cc) = pack8(v0, v1); });
    }
};

__device__ __forceinline__ void norm_rows(bf16_t* X, int row0, int nrows, const float* g, const float* mod, int layer, int ish, bf16_t* H, int gw, int ngw, int lane, const LAS unsigned char* stab, const unsigned short* slab) {
    constexpr int NB = 5;
    LAS unsigned char* prof_lds_ = (LAS unsigned char*)0; (void)prof_lds_; PROF_DECL; PROF_BEGIN();
    f32x4 gv[4], gm[4], shv[4];
#pragma unroll
    for (int j = 0; j < 4; ++j) gv[j] = *(const f32x4*)(g + 4 * lane + 256 * j);
    const int rpw = (nrows + ngw - 1) / ngw, rbeg = row0 + gw * rpw, rend = (rbeg + rpw < row0 + nrows) ? rbeg + rpw : row0 + nrows;
    int ccur = -1;
    for (int rb = rbeg; rb < rend; rb += NB) {
        u32x2 nx[NB][4];
#pragma unroll
        for (int b = 0; b < NB; ++b) { const int r = rb + b; if (r < rend) { const u32x2* p = (const u32x2*)(X + (size_t)r * 2048 + (r & 1) * 1024) + lane;
#pragma unroll
            for (int j = 0; j < 4; ++j) nx[b][j] = p[64 * j]; } }
#pragma unroll
        for (int b = 0; b < NB; ++b) {
            const int r = rb + b; if (r >= rend) break;
            if ((r >> 12) != ccur) { ccur = r >> 12; const float* mrow = mod + ((size_t)(ccur * 2 + layer) * 6) * 1024;
#pragma unroll
                for (int j = 0; j < 4; ++j) { shv[j] = *(const f32x4*)(mrow + (size_t)ish * 1024 + 4 * lane + 256 * j); gm[j] = gv[j] * (*(const f32x4*)(mrow + (size_t)(ish + 1) * 1024 + 4 * lane + 256 * j) + 1.f); } }
            u32x2* xr = (u32x2*)(X + (size_t)r * 2048 + (r & 1) * 1024) + lane;
            f32x4 v[4]; float s = 0.f;
            int si4[4]; SlabRaw sr[4];
#pragma unroll
            for (int j = 0; j < 4; ++j) { si4[j] = stab[(r >> 8) * 4 + j]; if (si4[j] != 255) sr[j] = slab_load(slab, si4[j], r & 255, 4 * lane); }
#pragma unroll
            for (int j = 0; j < 4; ++j) { v[j] = (f32x4){__builtin_bit_cast(float, nx[b][j].x << 16), __builtin_bit_cast(float, nx[b][j].x & 0xffff0000u), __builtin_bit_cast(float, nx[b][j].y << 16), __builtin_bit_cast(float, nx[b][j].y & 0xffff0000u)}; if (si4[j] != 255) { v[j] = v[j] + slab_add(sr[j]); st_bf4(xr + 64 * j, v[j]); }
                s += (v[j].x * v[j].x + v[j].y * v[j].y) + (v[j].z * v[j].z + v[j].w * v[j].w); }
            const float rstd = rsqrtf(wave_sum(s) * (1.f / 1024.f) + 1e-6f);
            unsigned long long* o8 = (unsigned long long*)(H + (size_t)r * 1024) + lane;
#pragma unroll
            for (int j = 0; j < 4; ++j) { const f32x4 o = v[j] * rstd * gm[j] + shv[j]; o8[64 * j] = (unsigned long long)cvt_pk_bf16(o.x, o.y) | ((unsigned long long)cvt_pk_bf16(o.z, o.w) << 32); }
        }
    }
    PROF_END(11);
}


__device__ __forceinline__ void embed_rows(const float* xp, const float* xs, const float* er, const float* ec, const float* g, const float* mod, bf16_t* H, int gw, int ngw, int lane) {
    constexpr int NB = 4;
    f32x4 gv[4], gm[4], shv[4];
#pragma unroll
    for (int j = 0; j < 4; ++j) gv[j] = *(const f32x4*)(g + 4 * lane + 256 * j);
    const int rpw = (20480 + ngw - 1) / ngw, rbeg = gw * rpw, rend = (rbeg + rpw < 20480) ? rbeg + rpw : 20480;
    int ccur = -1;
    int prow = -1; f32x4 pr0 = (f32x4){0.f, 0.f, 0.f, 0.f}, pr1 = pr0;
    for (int rb = rbeg; rb < rend; rb += NB) {
        f32x4 nx[NB][4], pc[NB][2];
#pragma unroll
        for (int b = 0; b < NB; ++b) { const int r = rb + b; if (r < rend) { const f32x4* xr = (const f32x4*)(r < 4096 ? xp + (size_t)r * 1024 : xs + (size_t)(r - 4096) * 1024) + lane;
#pragma unroll
            for (int j = 0; j < 4; ++j) nx[b][j] = xr[64 * j];
            if (r >= 4096) { const int col = r & 63; pc[b][0] = *(const f32x4*)(ec + col * 512 + 4 * lane); pc[b][1] = *(const f32x4*)(ec + col * 512 + 256 + 4 * lane); } } }
#pragma unroll
        for (int b = 0; b < NB; ++b) {
            const int r = rb + b; if (r >= rend) break;
            if ((r >> 12) != ccur) { ccur = r >> 12; const float* mrow = mod + ((size_t)(ccur * 2 + 0) * 6) * 1024;
#pragma unroll
                for (int j = 0; j < 4; ++j) { shv[j] = *(const f32x4*)(mrow + 4 * lane + 256 * j); gm[j] = gv[j] * (*(const f32x4*)(mrow + 1024 + 4 * lane + 256 * j) + 1.f); } }
            f32x4 v[4]; float s = 0.f;
#pragma unroll
            for (int j = 0; j < 4; ++j) v[j] = nx[b][j];
            if (r >= 4096) { const int row = (r & 4095) >> 6;
                if (row != prow) { prow = row; pr0 = *(const f32x4*)(er + row * 512 + 4 * lane); pr1 = *(const f32x4*)(er + row * 512 + 256 + 4 * lane); }
                v[0] = v[0] + pr0; v[1] = v[1] + pr1; v[2] = v[2] + pc[b][0]; v[3] = v[3] + pc[b][1]; }
#pragma unroll
            for (int j = 0; j < 4; ++j) s += (v[j].x * v[j].x + v[j].y * v[j].y) + (v[j].z * v[j].z + v[j].w * v[j].w);
            const float rstd = rsqrtf(wave_sum(s) * (1.f / 1024.f) + 1e-6f);
            unsigned long long* o8 = (unsigned long long*)(H + (size_t)r * 1024) + lane;
#pragma unroll
            for (int j = 0; j < 4; ++j) { const f32x4 o = v[j] * rstd * gm[j] + shv[j]; o8[64 * j] = (unsigned long long)cvt_pk_bf16(o.x, o.y) | ((unsigned long long)cvt_pk_bf16(o.z, o.w) << 32); }
        }
    }
}
__device__ __forceinline__ void gen_tables(unsigned char* ws, long e0, long estride) {
    bf16_t* dftc = (bf16_t*)(ws + WM.dftc); bf16_t* dl = (bf16_t*)(ws + WM.dl256); bf16_t* fa2 = (bf16_t*)(ws + WM.fa2); bf16_t* mbm = (bf16_t*)(ws + WM.mb);
    float* er = (float*)(ws + WM.pos); float* ec = er + 64 * 512;
    constexpr long N0 = 512 * 256, N1 = 256 * 512, N2 = 256 * 256, N3 = 16L * 256 * 512, N4 = 2 * 64 * 512;
    for (long e = e0; e < N0 + N1 + N2 + N3 + N4; e += estride) {
        long r = e;
        if (r < N0) { const int mrow = (int)(r >> 8), cp = (int)(r & 255), cc = mrow >> 1, ri = mrow & 1; const float x = 2.f * (float)((cc * cp) & 255) / 256.f;
            dftc[r] = (bf16_t)f2bf(ri == 0 ? cospif(x) : -sinpif(x)); continue; } r -= N0;
        if (r < N1) { const int l = (int)(r >> 9), k = (int)(r & 511), ri = k >> 8, lp = k & 255; const float x = 2.f * (float)((l * lp) & 255) / 256.f;
            dl[r] = (bf16_t)f2bf((ri == 0 ? cospif(x) : sinpif(x)) * (1.f / 256.f)); continue; } r -= N1;
        if (r < N2) { const int mrow = (int)(r >> 8), k = (int)(r & 255), sA = mrow >> 7, k1 = (mrow >> 1) & 63, ro = mrow & 1, ri = k >> 7, sB = (k >> 6) & 1, l1 = k & 63;
            const float x = 2.f * (float)((k1 * l1) & 63) / 64.f; float v = 0.f;
            if (sA == sB) v = (ro == ri) ? cospif(x) : (ro == 0 ? sinpif(x) : -sinpif(x));
            fa2[r] = (bf16_t)f2bf(v); continue; } r -= N2;
        if (r < N3) { const int q = (int)(r >> 17), mrow = (int)(r >> 9) & 255, k = (int)(r & 511), ko = mrow >> 6, k2 = mrow & 63, kop = k >> 7, ro = (k >> 6) & 1, l2 = k & 63;
            const int l = 4 * q + ko + 64 * k2; const float x = 2.f * (float)((l * l2) & 4095) / 4096.f; float v = 0.f;
            if (ko == kop) v = (ro == 0 ? cospif(x) : sinpif(x)) * (1.f / 1024.f);
            mbm[r] = (bf16_t)f2bf(v); continue; } r -= N3;
        { const int which = (int)(r >> 15), p = (int)(r >> 9) & 63, j = (int)(r & 511), i = j & 255;
            const float omega = 1.0f / powf(10000.0f, (float)i / 256.0f); const float ang = (float)p * omega;
            (which == 0 ? er : ec)[p * 512 + j] = (j < 256) ? sinf(ang) : cosf(ang); }
    }
}


__device__ __forceinline__ void final_rows(float* X, int row0, int nrows, const float* g, int gw, int ngw, int lane, const LAS unsigned char* stab, const unsigned short* slab) {
    constexpr int NB = 5;
    f32x4 gv[4];
#pragma unroll
    for (int j = 0; j < 4; ++j) gv[j] = *(const f32x4*)(g + 4 * lane + 256 * j);
    for (int rb = row0 + gw; rb < row0 + nrows; rb += NB * ngw) {
        u32x2 nx[NB][4];
#pragma unroll
        for (int b = 0; b < NB; ++b) { const int r = rb + b * ngw; if (r < row0 + nrows) { const u32x2* p = (const u32x2*)(X + (size_t)r * 1024) + (r & 1) * 256 + lane;
#pragma unroll
            for (int j = 0; j < 4; ++j) nx[b][j] = p[64 * j]; } }
#pragma unroll
        for (int b = 0; b < NB; ++b) {
            const int r = rb + b * ngw; if (r >= row0 + nrows) break;
            f32x4* xr = (f32x4*)(X + (size_t)r * 1024) + lane;
            f32x4 v[4]; float s = 0.f;
            int si4[4]; SlabRaw sr[4];
#pragma unroll
            for (int j = 0; j < 4; ++j) { si4[j] = stab[(r >> 8) * 4 + j]; if (si4[j] != 255) sr[j] = slab_load(slab, si4[j], r & 255, 4 * lane); }
#pragma unroll
            for (int j = 0; j < 4; ++j) { v[j] = (f32x4){__builtin_bit_cast(float, nx[b][j].x << 16), __builtin_bit_cast(float, nx[b][j].x & 0xffff0000u), __builtin_bit_cast(float, nx[b][j].y << 16), __builtin_bit_cast(float, nx[b][j].y & 0xffff0000u)}; if (si4[j] != 255) v[j] = v[j] + slab_add(sr[j]);
                s += (v[j].x * v[j].x + v[j].y * v[j].y) + (v[j].z * v[j].z + v[j].w * v[j].w); }
            const float rstd = rsqrtf(wave_sum(s) * (1.f / 1024.f) + 1e-6f);
#pragma unroll
            for (int j = 0; j < 4; ++j) xr[64 * j] = v[j] * rstd * gv[j];
        }
    }
}
__device__ __forceinline__ void mod_unit(LAS unsigned char* lds, int unit, const float* c, const float* c_ctx, const float* ada_w, const float* ada_b, float* mod, int tid, int wave, int lane) {
    LAS float* sc = (LAS float*)lds;
    LAS float* red = (LAS float*)(lds + 20480);
    const int layer = unit / 192, n0 = (unit % 192) * 32, col = lane & 31, kh = lane >> 5;
    for (int i = tid; i < 5 * 1024; i += NTHREADS) { const int cond = i >> 10, k = i & 1023; const float x = cond == 0 ? c_ctx[k] : c[(cond - 1) * 1024 + k]; sc[i] = silu(x); }
    __syncthreads();
    const float* w = ada_w + ((size_t)layer * 1024 + wave * 128 + kh) * 6144 + n0 + col;
    float acc[5];
#pragma unroll
    for (int q = 0; q < 5; ++q) acc[q] = 0.f;
#pragma unroll 1
    for (int kb = 0; kb < 64; kb += 32) {
        float wv[32];
#pragma unroll
        for (int k = 0; k < 32; ++k) wv[k] = w[(size_t)(2 * (kb + k)) * 6144];
#pragma unroll
        for (int k = 0; k < 32; ++k) {
#pragma unroll
            for (int q = 0; q < 5; ++q) acc[q] += wv[k] * sc[q * 1024 + wave * 128 + 2 * (kb + k) + kh];
        }
    }
#pragma unroll
    for (int q = 0; q < 5; ++q) { acc[q] += __shfl_xor(acc[q], 32); if (kh == 0) red[(wave * 5 + q) * 32 + col] = acc[q]; }
    __syncthreads();
    for (int i = tid; i < 5 * 32; i += NTHREADS) { const int q = i >> 5, n = i & 31; float s = 0.f;
#pragma unroll
        for (int ww = 0; ww < 8; ++ww) s += red[(ww * 5 + q) * 32 + n];
        mod[((size_t)q * 2 + layer) * 6144 + n0 + n] = s + ada_b[(size_t)layer * 6144 + n0 + n]; }
    __syncthreads();
}

struct TrItem { const float* W; bf16_t* WT; int K, N, item; };
__device__ __forceinline__ void transpose_load(const TrItem& t, f32x4 (&ld)[8], int lane) {
    const int nblk = t.N / 32, kb = t.item / nblk, nb = t.item % nblk, k0 = 64 * kb, n0 = 32 * nb;
#pragma unroll
    for (int i = 0; i < 8; ++i) ld[i] = *(const f32x4*)(t.W + (size_t)(k0 + 8 * i + (lane >> 3)) * t.N + n0 + 4 * (lane & 7));
}
__device__ __forceinline__ void transpose_finish(const TrItem& t, const f32x4 (&ld)[8], LAS float* scr, int lane) {
    const int nblk = t.N / 32, kb = t.item / nblk, nb = t.item % nblk, k0 = 64 * kb, n0 = 32 * nb;
#pragma unroll
    for (int i = 0; i < 8; ++i) { LAS float* d = scr + (8 * i + (lane >> 3)) * 33 + 4 * (lane & 7); d[0] = ld[i][0]; d[1] = ld[i][1]; d[2] = ld[i][2]; d[3] = ld[i][3]; }
    asm volatile("s_waitcnt lgkmcnt(0)" ::: "memory");
    const int c = lane & 7;
#pragma unroll
    for (int j = 0; j < 4; ++j) { const int n = (lane >> 3) + 8 * j; const LAS float* s = scr + (8 * c) * 33 + n;
        u32x4 o; o.x = pk2(s[0 * 33], s[1 * 33]); o.y = pk2(s[2 * 33], s[3 * 33]); o.z = pk2(s[4 * 33], s[5 * 33]); o.w = pk2(s[6 * 33], s[7 * 33]);
        *(u32x4*)(t.WT + (size_t)(n0 + n) * t.K + k0 + 8 * c) = o; }
    asm volatile("s_waitcnt lgkmcnt(0)" ::: "memory");
}
template <class Dec> __device__ __forceinline__ void transpose_stream(int first, int count, int stride, Dec dec, LAS float* scr, int lane) {
    if (first >= count) return;
    f32x4 cur[8], nxt[8]; TrItem tc = dec(first), tn = tc;
    transpose_load(tc, cur, lane);
    for (int it = first; it < count; it += stride) {
        const bool more = it + stride < count;
        if (more) { tn = dec(it + stride); transpose_load(tn, nxt, lane); }
        transpose_finish(tc, cur, scr, lane);
        if (more) { tc = tn;
#pragma unroll
            for (int i = 0; i < 8; ++i) cur[i] = nxt[i]; }
    }
}


typedef float f32x16 __attribute__((ext_vector_type(16)));
typedef short v4i16_t __attribute__((ext_vector_type(4)));
constexpr int QA_RS = 272, QP_RS = 264, KB_RS = 272, KPP_RS = 320, V_RS = 320;
constexpr int T_QA = 0, T_QP = T_QA + 32 * QA_RS, T_KB = T_QP + 32 * QP_RS, T_KPP = T_KB + 32 * KB_RS, T_V = T_KPP + 32 * KPP_RS, T_EL = T_V + 32 * V_RS, DIR_BYTES = T_EL + 512;
constexpr int OBUF_OFF = 2 * DIR_BYTES, OBUF_BYTES = 256 * 256;
static_assert(OBUF_OFF + OBUF_BYTES <= 160 * 1024 - 512 && (DIR_BYTES % 16) == 0 && (T_QP % 16) == 0 && (T_KB % 16) == 0 && (T_KPP % 16) == 0 && (T_V % 16) == 0 && (T_EL % 16) == 0, "scan LDS map");
constexpr int SLOT_ELEMS = 128 * 128;
#ifndef SCAN_STAGGER
#define SCAN_STAGGER 0
#endif

struct ScanT { const bf16_t* q; const bf16_t* lffw; const bf16_t* lfbw; const bf16_t* v; bf16_t* sg; bf16_t* slots; float* dvec; const float* gnorm; const float* state_in; float* new_state; };

__device__ __forceinline__ bf16x8 tr_pair(const LAS unsigned char* p0, const LAS unsigned char* p1) {
    const v4i16_t lo = __builtin_amdgcn_ds_read_tr16_b64_v4i16((LAS v4i16_t*)p0), hi = __builtin_amdgcn_ds_read_tr16_b64_v4i16((LAS v4i16_t*)p1);
    return (bf16x8){lo[0], lo[1], lo[2], lo[3], hi[0], hi[1], hi[2], hi[3]};
}
__device__ __forceinline__ bf16x8 pack_acc8(const f32x16& x, int s8) {
    u32x4 w; w.x = cvt_pk_bf16(x[8 * s8 + 0], x[8 * s8 + 1]); w.y = cvt_pk_bf16(x[8 * s8 + 2], x[8 * s8 + 3]); w.z = cvt_pk_bf16(x[8 * s8 + 4], x[8 * s8 + 5]); w.w = cvt_pk_bf16(x[8 * s8 + 6], x[8 * s8 + 7]);
    return __builtin_bit_cast(bf16x8, w);
}
__device__ __forceinline__ float h2f(unsigned short b) { return (float)__builtin_bit_cast(_Float16, b); }

template <bool FULL>
__device__ __forceinline__ void scan_item(LAS unsigned char* lds, const ScanT& T, int tok0, int h, bool act0, bool act1, const bf16_t* init0, const bf16_t* init1,
                                          float* fin0, float* fin1, bf16_t* outs0, bf16_t* outs1, float* outd0, float* outd1) {
    const int tid = threadIdx.x, wave = __builtin_amdgcn_readfirstlane(tid >> 6), dir = wave >> 2, wg = wave & 3;
    LAS unsigned char* prof_lds_ = lds; (void)prof_lds_; PROF_DECL; PROF_BEGIN();
    const bool act = dir ? act1 : act0;
    const bf16_t* init = dir ? init1 : init0;
    LAS unsigned char* D = lds + dir * DIR_BYTES;
    LAS unsigned char* OB = lds + OBUF_OFF;
    const bf16_t* lfp = dir ? T.lfbw : T.lffw;
#define SCAN_LANE(x) int x; asm volatile("v_mbcnt_lo_u32_b32 %0, -1, 0\n\tv_mbcnt_hi_u32_b32 %0, -1, %0" : "=v"(x))
#define SCAN_PREP_ROLE SCAN_LANE(ln_); const int pp = 16 * wg + (ln_ & 15), uu = ln_ >> 4, gt_ = wg * 64 + ln_, vt = gt_ >> 3, vc2 = gt_ & 7
#define SCAN_MFMA_ROLE SCAN_LANE(ln_); const int l31 = ln_ & 31, hh = ln_ >> 5, gq = (ln_ & 15) >> 2, gp = ln_ & 3, vcol = 16 * ((ln_ >> 4) & 1)
    f32x16 S[4];
#pragma unroll
    for (int t4 = 0; t4 < 4; ++t4) {
        if (init && act) { SCAN_LANE(lane0); const int lane = lane0; const u32x4* sp = (const u32x4*)(init + ((size_t)(wg * 4 + t4) * 64 + lane) * 16); const u32x4 a = sp[0], b = sp[1];
            const unsigned w8[8] = {a.x, a.y, a.z, a.w, b.x, b.y, b.z, b.w};
#pragma unroll
            for (int j = 0; j < 8; ++j) { S[t4][2 * j] = __builtin_bit_cast(float, w8[j] << 16); S[t4][2 * j + 1] = __builtin_bit_cast(float, w8[j] & 0xffff0000u); } }
        else {
#pragma unroll
            for (int j = 0; j < 16; ++j) S[t4][j] = 0.f; }
    }
    float dsum0 = 0.f, dsum1 = 0.f;
    unsigned qreg[8], lfreg[8]; u32x4 vreg[2];
#define SCAN_LOAD(i) do { const int jsc_ = dir ? 7 - (i) : (i); \
        _Pragma("unroll") for (int e = 0; e < 8; ++e) { const int tl = 8 * uu + e; const size_t tk = (size_t)(tok0 + 32 * jsc_ + (dir ? 31 - tl : tl)) * 1024 + h * 128 + 2 * pp; \
            if (FULL) qreg[e] = *(const unsigned*)(T.q + tk); lfreg[e] = *(const unsigned*)(lfp + tk); } \
        { const size_t tk = (size_t)(tok0 + 32 * jsc_ + (dir ? 31 - vt : vt)) * 1024 + h * 128 + 16 * vc2; vreg[0] = *(const u32x4*)(T.v + tk); vreg[1] = *(const u32x4*)(T.v + tk + 8); } } while (0)
    SCAN_LANE(ln_); const int lane = ln_;
    const int pp = 16 * wg + (ln_ & 15), uu = ln_ >> 4, gt_ = wg * 64 + ln_, vt = gt_ >> 3, vc2 = gt_ & 7;
    const int l31 = ln_ & 31, hh = ln_ >> 5, gq = (ln_ & 15) >> 2, gp = ln_ & 3, vcol = 16 * ((ln_ >> 4) & 1);
    unsigned pmask[8];
#pragma unroll
    for (int i2 = 0; i2 < 8; ++i2) { const int j0 = 2 * i2, s0 = (j0 & 3) + 8 * (j0 >> 2) + 4 * hh, s1 = s0 + 1; pmask[i2] = (s0 <= l31 ? 0x0000ffffu : 0u) | (s1 <= l31 ? 0xffff0000u : 0u); }
    if (act) { SCAN_LOAD(0); }
    PROF_END(6);
    for (int s = 0; s < 16 + SCAN_STAGGER; ++s) {
        const int ph = s - (SCAN_STAGGER ? dir : 0);
        if (act && ph >= 0 && ph < 16) {
            const int i = ph >> 1;
            if ((ph & 1) == 0) {
#if defined(PROF_ID)
                PROF_BEGIN(); asm volatile("s_waitcnt vmcnt(0)" ::: "memory"); PROF_END(1); PROF_BEGIN();
#endif
                *(LAS u32x4*)(D + T_V + vt * V_RS + vc2 * 32) = vreg[0]; *(LAS u32x4*)(D + T_V + vt * V_RS + vc2 * 32 + 16) = vreg[1];
                f32x2 cc[8]; f32x2 aa = (f32x2){0.f, 0.f};
#pragma unroll
                for (int e = 0; e < 8; ++e) { aa += (f32x2){h2f((unsigned short)(lfreg[e] & 0xffffu)), h2f((unsigned short)(lfreg[e] >> 16))}; cc[e] = aa; }
                f32x2 tq[4];
#pragma unroll
                for (int u2 = 0; u2 < 4; ++u2) { tq[u2].x = __shfl(aa.x, (lane & 15) + 16 * u2); tq[u2].y = __shfl(aa.y, (lane & 15) + 16 * u2); }
                const f32x2 zz = (f32x2){0.f, 0.f};
                const f32x2 pre = (uu > 0 ? tq[0] : zz) + (uu > 1 ? tq[1] : zz) + (uu > 2 ? tq[2] : zz);
                const f32x2 rr = tq[0] + tq[1], bl = rr + tq[2] + tq[3];
#define EX2V(v) ((f32x2){__builtin_amdgcn_exp2f((v).x), __builtin_amdgcn_exp2f((v).y)})
                if (FULL) {
                    const f32x2 er = EX2V(rr), elr = EX2V(bl - rr), base = pre - rr;
#pragma unroll
                    for (int e = 0; e < 8; ++e) {
                        const int tl = 8 * uu + e;
                        const f32x2 d = base + cc[e];
                        const f32x2 ea = EX2V(d), eb = EX2V(-d);
                        const f32x2 lfv = (f32x2){h2f((unsigned short)(lfreg[e] & 0xffffu)), h2f((unsigned short)(lfreg[e] >> 16))};
                        const f32x2 kk = 1.f - EX2V(lfv);
                        const f32x2 qq = (f32x2){__builtin_bit_cast(float, qreg[e] << 16), __builtin_bit_cast(float, qreg[e] & 0xffff0000u)};
                        const f32x2 qa = qq * ea, kb = kk * eb, qp = qa * er, kpp = kb * elr;
                        *(LAS unsigned*)(D + T_QA + tl * QA_RS + 4 * pp) = cvt_pk_bf16(qa.x, qa.y);
                        *(LAS unsigned*)(D + T_QP + tl * QP_RS + 4 * pp) = cvt_pk_bf16(qp.x, qp.y);
                        *(LAS unsigned*)(D + T_KB + tl * KB_RS + 4 * pp) = cvt_pk_bf16(kb.x, kb.y);
                        *(LAS unsigned*)(D + T_KPP + tl * KPP_RS + 4 * pp) = cvt_pk_bf16(kpp.x, kpp.y);
                        if (e & 1) __builtin_amdgcn_sched_barrier(0);
                    }
                } else {
                    const f32x2 base = bl - pre;
#pragma unroll
                    for (int e = 0; e < 8; ++e) {
                        const int tl = 8 * uu + e;
                        const f32x2 d = base - cc[e];
                        const f32x2 lfv = (f32x2){h2f((unsigned short)(lfreg[e] & 0xffffu)), h2f((unsigned short)(lfreg[e] >> 16))};
                        const f32x2 kpp = (1.f - EX2V(lfv)) * EX2V(d);
                        *(LAS unsigned*)(D + T_KPP + tl * KPP_RS + 4 * pp) = cvt_pk_bf16(kpp.x, kpp.y);
                    }
                    dsum0 += bl.x; dsum1 += bl.y;
                }
                if (uu == 0) { *(LAS f32x2*)(D + T_EL + 8 * pp) = EX2V(bl); }
                __builtin_amdgcn_sched_barrier(0);
#if defined(PROF_ID)
                asm volatile("s_waitcnt lgkmcnt(0)" ::: "memory"); PROF_END(2);
#endif
                if (i < 7) SCAN_LOAD(i + 1);
            } else {
                PROF_BEGIN();
                if (FULL) {
                    f32x16 P;
#pragma unroll
                    for (int j = 0; j < 16; ++j) P[j] = 0.f;
#pragma unroll
                    for (int ks = 0; ks < 8; ++ks) {
                        const bf16x8 ka = *(const LAS bf16x8*)(D + T_KB + l31 * KB_RS + (16 * ks + 8 * hh) * 2);
                        const bf16x8 qb = *(const LAS bf16x8*)(D + T_QA + l31 * QA_RS + (16 * ks + 8 * hh) * 2);
                        P = __builtin_amdgcn_mfma_f32_32x32x16_bf16(ka, qb, P, 0, 0, 0);
                    }
                    f32x16 o;
#pragma unroll
                    for (int j = 0; j < 16; ++j) o[j] = 0.f;
#pragma unroll
                    for (int s8 = 0; s8 < 2; ++s8) {
                        const LAS unsigned char* vb = D + T_V + (16 * s8 + 4 * hh + gq) * V_RS + (32 * wg + vcol + 4 * gp) * 2;
                        const bf16x8 vf = tr_pair(vb, vb + 8 * V_RS);
                        u32x4 pw; pw.x = cvt_pk_bf16(P[8 * s8 + 0], P[8 * s8 + 1]) & pmask[4 * s8 + 0]; pw.y = cvt_pk_bf16(P[8 * s8 + 2], P[8 * s8 + 3]) & pmask[4 * s8 + 1];
                        pw.z = cvt_pk_bf16(P[8 * s8 + 4], P[8 * s8 + 5]) & pmask[4 * s8 + 2]; pw.w = cvt_pk_bf16(P[8 * s8 + 6], P[8 * s8 + 7]) & pmask[4 * s8 + 3];
                        o = __builtin_amdgcn_mfma_f32_32x32x16_bf16(__builtin_bit_cast(bf16x8, pw), vf, o, 0, 0, 0);
                    }
#pragma unroll
                    for (int t4 = 0; t4 < 4; ++t4)
#pragma unroll
                        for (int s8 = 0; s8 < 2; ++s8) {
                            const LAS unsigned char* qp = D + T_QP + l31 * QP_RS + (32 * t4 + 16 * s8 + 4 * hh) * 2;
                            const u32x2 lo = *(const LAS u32x2*)qp, hi = *(const LAS u32x2*)(qp + 16);
                            const u32x4 aw = {lo.x, lo.y, hi.x, hi.y};
                            o = __builtin_amdgcn_mfma_f32_32x32x16_bf16(__builtin_bit_cast(bf16x8, aw), pack_acc8(S[t4], s8), o, 0, 0, 0);
                        }
                    const int jsc = dir ? 7 - i : i;
                    LAS unsigned short* ob = (LAS unsigned short*)(OB + (32 * jsc + (dir ? 31 - 4 * hh : 4 * hh)) * 256 + (32 * wg + l31) * 2);
                    const int rs = dir ? -128 : 128;
                    if (i >= 4) {
                        unsigned short pv[16];
#pragma unroll
                        for (int j = 0; j < 16; ++j) pv[j] = ob[((j & 3) + 8 * (j >> 2)) * rs];
#pragma unroll
                        for (int j = 0; j < 16; ++j) o[j] += bf2f(pv[j]);
                    }
#pragma unroll
                    for (int j = 0; j < 16; ++j) ob[((j & 3) + 8 * (j >> 2)) * rs] = (unsigned short)cvt_pk_bf16(o[j], o[j]);
                }
                __builtin_amdgcn_sched_barrier(0);
#pragma unroll
                for (int t4 = 0; t4 < 4; ++t4) {
#pragma unroll
                    for (int g = 0; g < 4; ++g) { const f32x4 f = *(const LAS f32x4*)(D + T_EL + (32 * t4 + 8 * g + 4 * hh) * 4);
                        S[t4][4 * g + 0] *= f[0]; S[t4][4 * g + 1] *= f[1]; S[t4][4 * g + 2] *= f[2]; S[t4][4 * g + 3] *= f[3]; }
#pragma unroll
                    for (int s8 = 0; s8 < 2; ++s8) {
                        const LAS unsigned char* kb = D + T_KPP + (16 * s8 + 8 * hh + gq) * KPP_RS + (32 * t4 + vcol + 4 * gp) * 2;
                        const LAS unsigned char* vb = D + T_V + (16 * s8 + 8 * hh + gq) * V_RS + (32 * wg + vcol + 4 * gp) * 2;
                        const bf16x8 ka = tr_pair(kb, kb + 4 * KPP_RS), vf = tr_pair(vb, vb + 4 * V_RS);
                        S[t4] = __builtin_amdgcn_mfma_f32_32x32x16_bf16(ka, vf, S[t4], 0, 0, 0);
                    }
                    if (t4 == 1) __builtin_amdgcn_sched_barrier(0);
                }
                PROF_END(3);
            }
        }
        PROF_BEGIN();
        __syncthreads();
        PROF_END(4);
    }
#undef SCAN_LOAD
    PROF_BEGIN();
    if (FULL) {
        float* fin = dir ? fin1 : fin0;
        if (fin && act) {
#pragma unroll
            for (int t4 = 0; t4 < 4; ++t4)
#pragma unroll
                for (int j = 0; j < 16; ++j) fin[(size_t)(32 * t4 + (j & 3) + 8 * (j >> 2) + 4 * hh) * 128 + 32 * wg + l31] = S[t4][j];
        }
        const int cv = tid & 15;
        f32x4 gn0 = *(const f32x4*)(T.gnorm + 8 * cv), gn1 = *(const f32x4*)(T.gnorm + 8 * cv + 4);
        u32x4 gwv[8];
#pragma unroll
        for (int pass = 0; pass < 8; ++pass) gwv[pass] = *(const u32x4*)(T.sg + (size_t)(tok0 + 32 * pass + (tid >> 4)) * 1024 + h * 128 + 8 * cv);
#pragma unroll
        for (int pass = 0; pass < 8; ++pass) {
            const int row = 32 * pass + (tid >> 4);
            const u32x4 ow = *(const LAS u32x4*)(OB + row * 256 + cv * 16);
            bf16_t* gp_ = T.sg + (size_t)(tok0 + row) * 1024 + h * 128 + 8 * cv;
            const u32x4 gw = gwv[pass];
            float ov[8], gv[8];
            const unsigned o4[4] = {ow.x, ow.y, ow.z, ow.w}, g4[4] = {gw.x, gw.y, gw.z, gw.w};
            float ss = 0.f;
#pragma unroll
            for (int j = 0; j < 4; ++j) { ov[2 * j] = __builtin_bit_cast(float, o4[j] << 16); ov[2 * j + 1] = __builtin_bit_cast(float, o4[j] & 0xffff0000u);
                gv[2 * j] = __builtin_bit_cast(float, g4[j] << 16); gv[2 * j + 1] = __builtin_bit_cast(float, g4[j] & 0xffff0000u);
                ss += ov[2 * j] * ov[2 * j] + ov[2 * j + 1] * ov[2 * j + 1]; }
            ss += __shfl_xor(ss, 1); ss += __shfl_xor(ss, 2); ss += __shfl_xor(ss, 4); ss += __shfl_xor(ss, 8);
            const float rstd = rsqrtf(ss * (1.f / 128.f) + 1e-6f);
            u32x4 w;
            w.x = cvt_pk_bf16(ov[0] * rstd * gn0[0] * gv[0], ov[1] * rstd * gn0[1] * gv[1]); w.y = cvt_pk_bf16(ov[2] * rstd * gn0[2] * gv[2], ov[3] * rstd * gn0[3] * gv[3]);
            w.z = cvt_pk_bf16(ov[4] * rstd * gn1[0] * gv[4], ov[5] * rstd * gn1[1] * gv[5]); w.w = cvt_pk_bf16(ov[6] * rstd * gn1[2] * gv[6], ov[7] * rstd * gn1[3] * gv[7]);
            *(u32x4*)gp_ = w;
        }
#if defined(PROF_ID)
        asm volatile("s_waitcnt vmcnt(0)" ::: "memory");
#endif
        __syncthreads(); PROF_END(5);
    } else {
        bf16_t* outs = dir ? outs1 : outs0; float* outd = dir ? outd1 : outd0;
        if (act) {
#pragma unroll
            for (int t4 = 0; t4 < 4; ++t4) {
                u32x4 a, b;
                a.x = cvt_pk_bf16(S[t4][0], S[t4][1]); a.y = cvt_pk_bf16(S[t4][2], S[t4][3]); a.z = cvt_pk_bf16(S[t4][4], S[t4][5]); a.w = cvt_pk_bf16(S[t4][6], S[t4][7]);
                b.x = cvt_pk_bf16(S[t4][8], S[t4][9]); b.y = cvt_pk_bf16(S[t4][10], S[t4][11]); b.z = cvt_pk_bf16(S[t4][12], S[t4][13]); b.w = cvt_pk_bf16(S[t4][14], S[t4][15]);
                u32x4* sp = (u32x4*)(outs + ((size_t)(wg * 4 + t4) * 64 + lane) * 16); sp[0] = a; sp[1] = b;
            }
            const int pp = 16 * wg + (lane & 15); if ((lane >> 4) == 0) { outd[2 * pp] = __builtin_amdgcn_exp2f(dsum0); outd[2 * pp + 1] = __builtin_amdgcn_exp2f(dsum1); }
        }
    }
}
__device__ __forceinline__ size_t slot_of(int dir, int b, int h, int sc) { return (size_t)((dir * 4 + b) * 8 + h) * 16 + sc; }

__device__ __forceinline__ void scan_a_item(LAS unsigned char* lds, const ScanT& T, int it) {
    const int sc = it & 15, h = (it >> 4) & 7, b = it >> 7;
    const size_t sf = slot_of(0, b, h, sc < 15 ? sc + 1 : 0), sb = slot_of(1, b, h, sc > 0 ? sc - 1 : 0);
    scan_item<false>(lds, T, 4096 + b * 4096 + sc * 256, h, sc < 15, sc > 0, nullptr, nullptr, nullptr, nullptr, T.slots + sf * SLOT_ELEMS, T.slots + sb * SLOT_ELEMS, T.dvec + sf * 128, T.dvec + sb * 128);
}
__device__ __forceinline__ void scan_ctx_item(LAS unsigned char* lds, const ScanT& T, int ci) {
    const int h = ci & 7, b = ci >> 3;
    float* ns = T.new_state + (size_t)(b * 2) * 8 * 16384 + (size_t)h * 16384;
    scan_item<true>(lds, T, b * 256, h, true, true, nullptr, nullptr, ns, ns + (size_t)8 * 16384, nullptr, nullptr, nullptr, nullptr);
}
__device__ __forceinline__ void scan_phase_a(LAS unsigned char* lds, const ScanT& T, int G, int bx) {
    if (G == 256) {
        if (bx < 128) { scan_ctx_item(lds, T, bx); scan_a_item(lds, T, 384 + bx); }
        else { for (int k = 0; k < 3; ++k) scan_a_item(lds, T, (bx - 128) * 3 + k); }
    } else {
        for (int it = bx; it < 640; it += G) { if (it < 512) scan_a_item(lds, T, it); else scan_ctx_item(lds, T, it - 512); }
    }
}
__device__ __forceinline__ void scan_phase_b(const ScanT& T, int G, int bx, int tid) {
    for (int gid = bx * NTHREADS + tid; gid < 64 * 2048; gid += G * NTHREADS) {
        const int combo = gid >> 11, e = (gid & 2047) * 8, dir = combo >> 5, b = (combo >> 3) & 3, h = combo & 7;
        const int reg0 = e & 15, ln = (e >> 4) & 63, t4 = (e >> 10) & 3, w = (e >> 12) & 3;
        const int v = 32 * w + (ln & 31);
        float s[8]; int kk[8];
#pragma unroll
        for (int j = 0; j < 8; ++j) { const int rg = reg0 + j; kk[j] = 32 * t4 + (rg & 3) + 8 * (rg >> 2) + 4 * (ln >> 5); s[j] = T.state_in[((size_t)((b * 2 + dir) * 8 + h) * 128 + kk[j]) * 128 + v]; }
        u32x4 lwn = (u32x4){0u, 0u, 0u, 0u}; float dn[8];
#pragma unroll
        for (int j = 0; j < 8; ++j) dn[j] = 0.f;
        { const size_t sl1 = slot_of(dir, b, h, dir ? 14 : 1); lwn = *(const u32x4*)(T.slots + sl1 * SLOT_ELEMS + e);
#pragma unroll
          for (int j = 0; j < 8; ++j) dn[j] = T.dvec[sl1 * 128 + kk[j]]; }
        for (int st = 0; st < 16; ++st) {
            const int sc = dir ? 15 - st : st;
            const size_t sl = slot_of(dir, b, h, sc);
            u32x4* sp = (u32x4*)(T.slots + sl * SLOT_ELEMS + e);
            if (st > 0) {
                const u32x4 lw = lwn; float dc[8];
#pragma unroll
                for (int j = 0; j < 8; ++j) dc[j] = dn[j];
                if (st < 15) { const size_t sl2 = slot_of(dir, b, h, dir ? 14 - st : st + 1); lwn = *(const u32x4*)(T.slots + sl2 * SLOT_ELEMS + e);
#pragma unroll
                    for (int j = 0; j < 8; ++j) dn[j] = T.dvec[sl2 * 128 + kk[j]]; }
                const unsigned l4[4] = {lw.x, lw.y, lw.z, lw.w};
#pragma unroll
                for (int j = 0; j < 4; ++j) { s[2 * j] = dc[2 * j] * s[2 * j] + __builtin_bit_cast(float, l4[j] << 16);
                    s[2 * j + 1] = dc[2 * j + 1] * s[2 * j + 1] + __builtin_bit_cast(float, l4[j] & 0xffff0000u); }
            }
            u32x4 o; o.x = cvt_pk_bf16(s[0], s[1]); o.y = cvt_pk_bf16(s[2], s[3]); o.z = cvt_pk_bf16(s[4], s[5]); o.w = cvt_pk_bf16(s[6], s[7]);
            *sp = o;
        }
    }
}
__device__ __forceinline__ void scan_phase_c(LAS unsigned char* lds, const ScanT& T, int G, int bx) {
    for (int it = bx; it < 512; it += G) {
        const int sc = it & 15, h = (it >> 4) & 7, b = it >> 7;
        scan_item<true>(lds, T, 4096 + b * 4096 + sc * 256, h, true, true, T.slots + slot_of(0, b, h, sc) * SLOT_ELEMS, T.slots + slot_of(1, b, h, sc) * SLOT_ELEMS,
                        nullptr, nullptr, nullptr, nullptr, nullptr, nullptr);
    }
}

#define XB_TMO      128
#define XB_XCNT(j)  (256  + 64 * (j))
#define XB_XSUB(j)  (1280 + 64 * (j))
#define XB_XGEN(j)  (2304 + 64 * (j))
#define XB_TOP      3328
#define XB_TOPGEN   3392
#define XCD_BAR_WORDS 3456
#define XB_SPIN_CAP (1u << 18)
__device__ __forceinline__ unsigned xb_ld(unsigned* p)              { return __hip_atomic_load(p, __ATOMIC_RELAXED, __HIP_MEMORY_SCOPE_AGENT); }
__device__ __forceinline__ unsigned xb_add(unsigned* p, unsigned v) { return __hip_atomic_fetch_add(p, v, __ATOMIC_RELAXED, __HIP_MEMORY_SCOPE_AGENT); }
__device__ __forceinline__ unsigned xb_xcc_id() { return (unsigned)__builtin_amdgcn_s_getreg((3 << 11) | 20) & 0xFu; }
#define XB_SPIN(cond, bar) do { unsigned _sp = 0; while (cond) { __builtin_amdgcn_s_sleep(1); \
    if ((++_sp & 255u) == 0u) { if (xb_ld(&(bar)[XB_TMO])) break; if (_sp > XB_SPIN_CAP) { atomicAdd(&(bar)[XB_TMO], 1u); break; } } } } while (0)
struct XcdBarrier { unsigned* bar; unsigned x; volatile LAS unsigned* st; };
__device__ __forceinline__ XcdBarrier xcd_barrier_post(unsigned* bar, volatile LAS unsigned* st) {
    XcdBarrier b; b.bar = bar; b.x = xb_xcc_id(); b.st = st;
    if (threadIdx.x == 0) (void)xb_add(&bar[XB_XCNT(b.x)], 1u);
    return b;
}
__device__ __forceinline__ void xcd_barrier_complete(unsigned* bar, unsigned x, unsigned& nloc, unsigned& nx) {
    const unsigned G = gridDim.x * gridDim.y * gridDim.z;
    unsigned sum, cnt, mine, sp = 0u;
    for (;;) {
        sum = 0u; cnt = 0u; mine = 0u;
#pragma unroll
        for (unsigned j = 0; j < 16; ++j) { const unsigned c = xb_ld(&bar[XB_XCNT(j)]); sum += c; cnt += (c > 0u) ? 1u : 0u; mine = (j == x) ? c : mine; }
        if (sum == G) break;
        __builtin_amdgcn_s_sleep(1);
        if ((++sp & 255u) == 0u) { if (xb_ld(&bar[XB_TMO])) break; if (sp > XB_SPIN_CAP) { atomicAdd(&bar[XB_TMO], 1u); break; } }
    }
    nloc = mine > 0u ? mine : 1u; nx = cnt > 0u ? cnt : 1u;
}
__device__ __forceinline__ void xcd_barrier(const XcdBarrier& b) {
    asm volatile("s_waitcnt vmcnt(0)" ::: "memory");
    __syncthreads();
    if (threadIdx.x == 0) {
        unsigned* bar = b.bar;
        __builtin_amdgcn_s_waitcnt(0);
        unsigned nloc = b.st[0], nx = b.st[1];
        if (nloc == 0u) { xcd_barrier_complete(bar, b.x, nloc, nx); b.st[0] = nloc; b.st[1] = nx; }
        const unsigned old = xb_add(&bar[XB_XSUB(b.x)], 1u);
        const unsigned gen = old / nloc;
        if (old + 1u == (gen + 1u) * nloc) {
            __builtin_amdgcn_fence(__ATOMIC_RELEASE, "agent");
            asm volatile("s_waitcnt vmcnt(0)" ::: "memory");
            const unsigned og = xb_add(&bar[XB_TOP], 1u);
            const unsigned tg = og / nx;
            if (og + 1u == (tg + 1u) * nx) xb_add(&bar[XB_TOPGEN], 1u);
            else XB_SPIN(xb_ld(&bar[XB_TOPGEN]) == tg, bar);
            __builtin_amdgcn_fence(__ATOMIC_ACQUIRE, "agent");
            xb_add(&bar[XB_XGEN(b.x)], 1u);
            asm volatile("s_waitcnt vmcnt(0)" ::: "memory");
        } else {
            XB_SPIN(xb_ld(&bar[XB_XGEN(b.x)]) == gen, bar);
            __builtin_amdgcn_fence(__ATOMIC_ACQUIRE, "agent");
            asm volatile("s_waitcnt vmcnt(0)" ::: "memory");
        }
    }
    __syncthreads();
}

struct Args { const float* in[17]; float* out; unsigned char* ws; int ph_lo, ph_hi; };
enum { PH_PREP = 0, PH_EMBED = 1, PH_FN_CHAN = 2, PH_FN_POS1 = 3, PH_FN_POS2 = 4, PH_FN_WO = 5, PH_NORM_MLP0 = 6, PH_MLP1_0 = 7, PH_MLP2_0 = 8, PH_NORM_MIX1 = 9, PH_WIN = 10,
       PH_SCAN_A = 11, PH_SCAN_B = 12, PH_SCAN_C = 13, PH_HG_WO = 14, PH_NORM_MLP1 = 15, PH_MLP1_1 = 16, PH_MLP2_1 = 17, PH_FINAL = 18, PH_END = 19 };
constexpr int LDS_BYTES = 160 * 1024, MISC_OFF = LDS_BYTES - 512;

__global__ void __launch_bounds__(NTHREADS, 2) fwd(Args a) {
    extern __shared__ __attribute__((aligned(16))) unsigned char lds_raw[];
    LAS unsigned char* lds = (LAS unsigned char*)lds_raw;
    const int tid = threadIdx.x, lane = tid & 63, wave = __builtin_amdgcn_readfirstlane(tid >> 6);
    const int G = gridDim.x, bx = blockIdx.x;
    const int gw = bx * NWAVES + wave, ngw = G * NWAVES;
    unsigned char* ws = a.ws;
    const float* mod = (const float*)(ws + WM.mod);
    bf16_t* Hb = (bf16_t*)(ws + WM.h);
    bf16_t* Big = (bf16_t*)(ws + WM.big[0]); bf16_t* Big1 = (bf16_t*)(ws + WM.big[1]);
    const float* norm_mlp = a.in[8];
    const float* w1 = a.in[14]; const float* w2 = a.in[15];
    const float* norm_mix = a.in[7]; const float* fnet_wo = a.in[9];
    float* modw = (float*)(ws + WM.mod);
#define IN(k) (a.ph_lo <= (k) && (k) < a.ph_hi)
    if (tid < 128) ((LAS unsigned*)(lds + MISC_OFF))[tid] = 0u;
    __syncthreads();
    XcdBarrier bar = xcd_barrier_post((unsigned*)ws, (volatile LAS unsigned*)(lds + MISC_OFF));
#if defined(PROBE_A)
#define STAMP(k) do { if (bx == 0 && tid == 0) ((LAS unsigned long long*)(lds + MISC_OFF + 64))[(k)] = __builtin_amdgcn_s_memrealtime(); } while (0)
#else
#define STAMP(k) do { } while (0)
#endif
    STAMP(0);
#define SEAM(k) do { if (IN(k) && IN((k) + 1)) xcd_barrier(bar); STAMP((k) + 1); } while (0)
    if (IN(PH_PREP)) {
        LAS float* scr = (LAS float*)(lds + wave * 16384);
        constexpr int I_1 = (1024 / 64) * (4096 / 32), I_2 = (4096 / 64) * (1024 / 32);
        constexpr int I_F = (1024 / 64) * (1024 / 32), I_W = (1024 / 64) * (5120 / 32);
        constexpr int NITEMS = I_1 + I_2 + I_F + I_F + I_W;
        LAS unsigned char* prof_lds_ = (LAS unsigned char*)0; (void)prof_lds_; PROF_DECL; PROF_BEGIN();
        for (int un = bx; un < 384; un += G) mod_unit(lds, un, a.in[3], a.in[4], a.in[5], a.in[6], modw, tid, wave, lane);
        if (bx == G - 1) for (int i = tid; i < 2048; i += NTHREADS) { const int dir = i >> 10, ch = i & 1023; const float l0 = a.in[11][(dir * 2 + 0) * 1024 + ch], l1 = a.in[11][(dir * 2 + 1) * 1024 + ch];
            const float mx = fmaxf(l0, l1), e0 = __expf(l0 - mx), e1 = __expf(l1 - mx); ((float*)(ws + WM.lb))[i] = e1 / (e0 + e1); }
        PROF_END(60); PROF_BEGIN();
        gen_tables(ws, (long)bx * NTHREADS + tid, (long)G * NTHREADS);
        PROF_END(61); PROF_BEGIN();
        transpose_stream(gw, NITEMS, ngw, [&](int it) -> TrItem {
            int r = it;
            if (r < I_F) return TrItem{fnet_wo, (bf16_t*)(ws + WM.wfnet), 1024, 1024, r}; r -= I_F;
            if (r < I_F) return TrItem{a.in[13], (bf16_t*)(ws + WM.who), 1024, 1024, r}; r -= I_F;
            if (r < I_W) return TrItem{a.in[10], (bf16_t*)(ws + WM.win), 1024, 5120, r}; r -= I_W;
            if (r < I_1) return TrItem{w1, (bf16_t*)(ws + WM.w1[0]), 1024, 4096, r}; r -= I_1;
            return TrItem{w2, (bf16_t*)(ws + WM.w2[0]), 4096, 1024, r}; }, scr, lane);
        PROF_END(62);
    }
    SEAM(PH_PREP);
    if (IN(PH_EMBED)) embed_rows(a.in[0], a.in[1], (const float*)(ws + WM.pos), (const float*)(ws + WM.pos) + 64 * 512, norm_mix, mod, Hb, gw, ngw, lane);
    SEAM(PH_EMBED);
    if (IN(PH_FN_CHAN)) {
        { ProbChan p; p.init(0, ws + WM.dftc, Hb, (bf16_t*)(ws + WM.yctx), G, bx); gemm_phase<ProbChan, true, true>(lds, p); }
        { ProbChan p; p.init(1, ws + WM.dftc, Hb, (bf16_t*)(ws + WM.ysmp), G, bx); gemm_phase<ProbChan, true, true>(lds, p); }
    }
    SEAM(PH_FN_CHAN);
    if (IN(PH_FN_POS1)) {
        { ProbPosCtx p; p.init(ws + WM.dl256, (const bf16_t*)(ws + WM.yctx), Hb, G, bx); gemm_phase<ProbPosCtx, true, true>(lds, p); }
        { ProbSmpA p; p.init(ws + WM.fa2, (const bf16_t*)(ws + WM.ysmp), (bf16_t*)(ws + WM.u), G, bx); gemm_phase<ProbSmpA, true, true>(lds, p); }
    }
    SEAM(PH_FN_POS1);
    if (IN(PH_FN_POS2)) { ProbSmpB p; p.init(ws + WM.mb, (const bf16_t*)(ws + WM.u), Hb, G, bx); gemm_phase<ProbSmpB, true, true>(lds, p); }
    SEAM(PH_FN_POS2);
    if (IN(PH_FN_WO)) { ProbResidFirst p; p.init_tok(Hb, 1024, ws + WM.wfnet, 1024, 0, 80, 4, G, bx); p.X = (bf16_t*)a.out; p.mod = mod; p.layer = 0; p.gidx = 2; p.init_split(G, bx, (unsigned short*)(ws + SLAB_FN)); p.xp = a.in[0]; p.xs = a.in[1]; p.er = (const float*)(ws + WM.pos); p.ec = p.er + 64 * 512; p.prof_id = 20; gemm_phase<ProbResidFirst, true, true>(lds, p); }
    SEAM(PH_FN_WO);
    if (IN(PH_NORM_MLP0)) { build_split_table(lds, G, tid); norm_rows((bf16_t*)a.out, 0, 20480, norm_mlp, mod, 0, 3, Hb, gw, ngw, lane, lds, (const unsigned short*)(ws + SLAB_FN)); }
    SEAM(PH_NORM_MLP0);
    if (IN(PH_MLP1_0)) { ProbMlp1 p; p.init_tok(Hb, 1024, ws + WM.w1[0], 1024, 0, 80, 4096 / BM, G, bx); p.O = Big; p.ldc = 4096; p.prof_id = 40; gemm_phase<ProbMlp1, true, true>(lds, p); }
    SEAM(PH_MLP1_0);
    if (IN(PH_MLP2_0)) { ProbResid p; p.init_tok(Big, 4096, ws + WM.w2[0], 4096, 0, 80, 1024 / BM, G, bx); p.X = (bf16_t*)a.out; p.mod = mod; p.layer = 0; p.gidx = 5; p.init_split(G, bx, (unsigned short*)(ws + SLAB_M0)); gemm_phase<ProbResid, true, true>(lds, p); }
    SEAM(PH_MLP2_0);
    if (IN(PH_NORM_MIX1)) { build_split_table(lds, G, tid); norm_rows((bf16_t*)a.out, 0, 20480, norm_mix + 1024, mod, 1, 0, Hb, gw, ngw, lane, lds, (const unsigned short*)(ws + SLAB_M0)); }
    SEAM(PH_NORM_MIX1);
    if (IN(PH_WIN)) { ProbWin p; p.init_tok(Hb, 1024, ws + WM.win, 1024, 0, 80, 20, G, bx); p.Oq = (bf16_t*)(ws + WM.q); p.Offw = (bf16_t*)(ws + WM.lffw); p.Ofbw = (bf16_t*)(ws + WM.lfbw);
        p.Ov = (bf16_t*)(ws + WM.v); p.Osg = (bf16_t*)(ws + WM.sg); p.lb = (const float*)(ws + WM.lb); p.prof_id = 50; gemm_phase<ProbWin, true, true>(lds, p); }
    SEAM(PH_WIN);
    if (IN(PH_SCAN_A) || IN(PH_SCAN_B) || IN(PH_SCAN_C)) {
        ScanT st; st.q = (const bf16_t*)(ws + WM.q); st.lffw = (const bf16_t*)(ws + WM.lffw); st.lfbw = (const bf16_t*)(ws + WM.lfbw); st.v = (const bf16_t*)(ws + WM.v); st.sg = (bf16_t*)(ws + WM.sg);
        st.slots = (bf16_t*)(ws + WM.slots); st.dvec = (float*)(ws + WM.dvec); st.gnorm = a.in[12]; st.state_in = a.in[2]; st.new_state = a.out + (size_t)20480 * 1024;
        if (IN(PH_SCAN_A)) scan_phase_a(lds, st, G, bx);
        SEAM(PH_SCAN_A);
        if (IN(PH_SCAN_B)) scan_phase_b(st, G, bx, tid);
        SEAM(PH_SCAN_B);
        if (IN(PH_SCAN_C)) scan_phase_c(lds, st, G, bx);
    }
    SEAM(PH_SCAN_C);
    if (IN(PH_HG_WO)) {
        { LAS float* scr = (LAS float*)(lds + wave * 16384);
          constexpr int I_1 = (1024 / 64) * (4096 / 32), I_2 = (4096 / 64) * (1024 / 32);
          transpose_stream(gw, I_1 + I_2, ngw, [&](int it) -> TrItem {
              if (it < I_1) return TrItem{w1 + (size_t)1024 * 4096, (bf16_t*)(ws + WM.w1[1]), 1024, 4096, it};
              return TrItem{w2 + (size_t)4096 * 1024, (bf16_t*)(ws + WM.w2[1]), 4096, 1024, it - I_1}; }, scr, lane);
          __syncthreads(); }
        ProbResid p; p.init_tok((bf16_t*)(ws + WM.sg), 1024, ws + WM.who, 1024, 0, 80, 4, G, bx); p.X = (bf16_t*)a.out; p.mod = mod; p.layer = 1; p.gidx = 2; p.init_split(G, bx, (unsigned short*)(ws + SLAB_HG)); gemm_phase<ProbResid, true, true>(lds, p); }
    SEAM(PH_HG_WO);
    if (IN(PH_NORM_MLP1)) { build_split_table(lds, G, tid); norm_rows((bf16_t*)a.out, 0, 20480, norm_mlp + 1024, mod, 1, 3, Hb, gw, ngw, lane, lds, (const unsigned short*)(ws + SLAB_HG)); }
    SEAM(PH_NORM_MLP1);
    if (IN(PH_MLP1_1)) { ProbMlp1 p; p.init_tok(Hb, 1024, ws + WM.w1[1], 1024, 0, 80, 4096 / BM, G, bx); p.O = Big1; p.ldc = 4096; gemm_phase<ProbMlp1, true, true>(lds, p); }
    SEAM(PH_MLP1_1);
    if (IN(PH_MLP2_1)) { ProbResid p; p.init_tok(Big1, 4096, ws + WM.w2[1], 4096, 0, 80, 1024 / BM, G, bx); p.X = (bf16_t*)a.out; p.mod = mod; p.layer = 1; p.gidx = 5; p.init_split(G, bx, (unsigned short*)(ws + SLAB_M1)); gemm_phase<ProbResid, true, true>(lds, p); }
    SEAM(PH_MLP2_1);
    if (IN(PH_FINAL)) { build_split_table(lds, G, tid); final_rows(a.out, 0, 20480, a.in[16], gw, ngw, lane, lds, (const unsigned short*)(ws + SLAB_M1)); }
#if defined(PROF_ID)
    if (bx == 0 && tid == 0) { const unsigned long long d = *(LAS unsigned long long*)(lds + LDS_BYTES - 512 + 256); const unsigned long long t0 = __builtin_amdgcn_s_memrealtime(); while (__builtin_amdgcn_s_memrealtime() - t0 < 16ull * d) __builtin_amdgcn_s_sleep(8); }
#endif
#if defined(PROBE_A)
    if (bx == 0 && tid == 0) { asm volatile("s_waitcnt vmcnt(0)" ::: "memory"); STAMP(PH_END); const unsigned long long d = ((LAS unsigned long long*)(lds + MISC_OFF + 64))[PROBE_B] - ((LAS unsigned long long*)(lds + MISC_OFF + 64))[PROBE_A];
        const unsigned long long t0 = __builtin_amdgcn_s_memrealtime(); while (__builtin_amdgcn_s_memrealtime() - t0 < 4ull * d) __builtin_amdgcn_s_sleep(8); }
#endif
#undef IN
}
}
#ifndef MK_N_LAUNCHES
#define MK_N_LAUNCHES 1
#endif
extern "C" void kernel_launch(void* const* d_in, const int* in_sizes, int n_in, void* d_out, int out_size, void* d_ws, size_t ws_size, hipStream_t stream) {
    static int grid = 0;
    if (grid == 0) {
        int dev = 0, cus = 0;
        if (hipGetDevice(&dev) != hipSuccess || hipDeviceGetAttribute(&cus, hipDeviceAttributeMultiprocessorCount, dev) != hipSuccess || cus <= 0) cus = 256;
        hipFuncSetAttribute((const void*)fk::fwd, hipFuncAttributeMaxDynamicSharedMemorySize, fk::LDS_BYTES);
        int per_cu = 0;
        if (hipOccupancyMaxActiveBlocksPerMultiprocessor(&per_cu, (const void*)fk::fwd, fk::NTHREADS, fk::LDS_BYTES) != hipSuccess || per_cu < 1)
            fprintf(stderr, "kernel_launch: occupancy query reports %d workgroups per CU\n", per_cu);
        (void)hipGetLastError();
        grid = cus;
    }
    hipMemsetAsync(d_ws, 0, fk::CTL_BYTES, stream);
    fk::Args a{};
    for (int i = 0; i < 17; ++i) a.in[i] = (const float*)d_in[i];
    a.out = (float*)d_out; a.ws = (unsigned char*)d_ws;
#if MK_N_LAUNCHES == 1
    a.ph_lo = 0; a.ph_hi = fk::PH_END;
    hipLaunchKernelGGL(fk::fwd, dim3(grid), dim3(fk::NTHREADS), fk::LDS_BYTES, stream, a);
#else
    for (int ph = 0; ph < fk::PH_END; ++ph) { a.ph_lo = ph; a.ph_hi = ph + 1; hipLaunchKernelGGL(fk::fwd, dim3(grid), dim3(fk::NTHREADS), fk::LDS_BYTES, stream, a); }
#endif
}
```

```cpp
#include <hip/hip_runtime.h>
#include <cstdint>
#include <cstdio>
namespace fk {
#define LAS __attribute__((address_space(3)))
#define GAS __attribute__((address_space(1)))
typedef unsigned short bf16_t;
typedef short bf16x8 __attribute__((ext_vector_type(8)));
typedef float f32x4 __attribute__((ext_vector_type(4)));
typedef float f32x2 __attribute__((ext_vector_type(2)));
typedef unsigned u32x4 __attribute__((ext_vector_type(4)));
typedef unsigned u32x2 __attribute__((ext_vector_type(2)));
constexpr int BM = 256, BK = 64, HALF = 128, HTB = HALF * BK * 2, STAGE_BYTES = 8 * HTB, NXCD = 8, WGM = 8;
constexpr int NWAVES = 8, NTHREADS = 512;

__device__ __forceinline__ int lds_byte(int r, int c) { const int st = (r >> 4) * 2 + (c >> 5), rr = r & 15, cc = c & 31, ob = rr * 64 + cc * 2; return st * 1024 + (ob ^ (((ob >> 9) & 1) << 5)); }
__device__ __forceinline__ void stage_rc(int b, int& R, int& C) { const int st = b / 1024, sb = b % 1024, swz = sb ^ (((sb >> 9) & 1) << 5); R = (st >> 1) * 16 + swz / 64; C = (st & 1) * 32 + (swz % 64) / 2; }
__device__ __forceinline__ int perm32(int rho) { const int n = rho >> 4, i = rho & 15; return 8 * (i >> 2) + 4 * n + (i & 3); }
typedef __bf16 bf16x2_cv __attribute__((ext_vector_type(2)));
__device__ __forceinline__ unsigned cvt_pk_bf16(float lo, float hi) { const f32x2 v = {lo, hi}; const bf16x2_cv b = __builtin_convertvector(v, bf16x2_cv); return __builtin_bit_cast(unsigned, b); }
__device__ __forceinline__ unsigned f2bf(float f) { unsigned u = __builtin_bit_cast(unsigned, f); return (u + 0x7fffu + ((u >> 16) & 1u)) >> 16; }
__device__ __forceinline__ unsigned pk2(float lo, float hi) { return f2bf(lo) | (f2bf(hi) << 16); }
__device__ __forceinline__ float bf2f(unsigned short b) { return __builtin_bit_cast(float, (unsigned)b << 16); }
__device__ __forceinline__ unsigned pk2h(float lo, float hi) { const _Float16 a = (_Float16)lo, b = (_Float16)hi; return (unsigned)__builtin_bit_cast(unsigned short, a) | ((unsigned)__builtin_bit_cast(unsigned short, b) << 16); }
__device__ __forceinline__ float h2f_(unsigned short b) { return (float)__builtin_bit_cast(_Float16, b); }
__device__ __forceinline__ f32x4 ld_bf4(const void* p) { const u32x2 w = *(const u32x2*)p; return (f32x4){__builtin_bit_cast(float, w.x << 16), __builtin_bit_cast(float, w.x & 0xffff0000u), __builtin_bit_cast(float, w.y << 16), __builtin_bit_cast(float, w.y & 0xffff0000u)}; }
__device__ __forceinline__ void st_bf4(void* p, const f32x4& v) { u32x2 w; w.x = cvt_pk_bf16(v[0], v[1]); w.y = cvt_pk_bf16(v[2], v[3]); *(u32x2*)p = w; }
__device__ __forceinline__ float silu(float x) { return x / (1.f + __expf(-x)); }
__device__ __forceinline__ float wave_sum(float v) {
#pragma unroll
    for (int o = 1; o < 64; o <<= 1) v += __shfl_xor(v, o);
    return v;
}

constexpr unsigned long long KiB = 1024ull, MiB = 1ull << 20;
struct WsMapT { unsigned long long slots, dvec, lb, q, lffw, lfbw, v, sg, mod, pos, dftc, dl256, fa2, mb, wfnet, who, win, w1[2], w2[2], h, yctx, ysmp, u, big[2]; };
constexpr WsMapT WM = {   13 * MiB,   45 * MiB,   320 * KiB,   53 * MiB,   93 * MiB,   133 * MiB,   173 * MiB,   213 * MiB,   64 * KiB,   512 * KiB,
      53 * MiB,   53 * MiB + 256 * KiB,   53 * MiB + 512 * KiB,   54 * MiB,   59 * MiB,   1 * MiB,   3 * MiB,   {61 * MiB, 53 * MiB},   {237 * MiB, 61 * MiB},
      13 * MiB,   77 * MiB,   93 * MiB,   157 * MiB,   {77 * MiB, 69 * MiB} };
constexpr unsigned long long SLAB_FN = 77 * MiB, SLAB_M0 = 53 * MiB, SLAB_HG = 69 * MiB, SLAB_M1 = 13 * MiB;
constexpr unsigned long long CTL_BYTES = 16 * KiB;
#if defined(PROF_ID)
#define PROF_DECL unsigned long long prof_t0_ = 0ull; const bool prof_on_ = (blockIdx.x == 0) && (__builtin_amdgcn_readfirstlane(threadIdx.x >> 6) == 0)
#define PROF_BEGIN() do { if (prof_on_) prof_t0_ = __builtin_amdgcn_s_memrealtime(); } while (0)
#define PROF_END(id) do { if (prof_on_ && (id) == PROF_ID) { const unsigned long long d_ = __builtin_amdgcn_s_memrealtime() - prof_t0_; if (threadIdx.x == 0) *(LAS unsigned long long*)(prof_lds_ + 160 * 1024 - 512 + 256) += d_; } } while (0)
#else
#define PROF_DECL
#define PROF_BEGIN() do { } while (0)
#define PROF_END(id) do { } while (0)
#endif

struct Unit { size_t offA, offB; int p0, p1, p2, p3, nt; };
struct OpMap { int rm; unsigned s1, s2; };
__device__ __forceinline__ unsigned rowoff(const OpMap& m, int R) { return (unsigned)(R % m.rm) * m.s1 + (unsigned)(R / m.rm) * m.s2; }

template <class P, bool ALIGN_EPI, bool SP2>
__device__ __forceinline__ void gemm_phase(LAS unsigned char* lds, const P& pb) {
    const int tid = threadIdx.x, wid = __builtin_amdgcn_readfirstlane(tid >> 6), lane = tid & 63, wr = wid >> 2, wc = wid & 3, fr = lane & 15, fq = lane >> 4;
    unsigned voffA[2], voffB[2];
#pragma unroll
    for (int i = 0; i < 2; ++i) { int R, C; stage_rc(tid * 16 + i * 8192, R, C); const int Rb = P::PERM ? ((R & ~31) + perm32(R & 31)) : R;
        voffA[i] = rowoff(pb.ma, R) + (unsigned)C * 2u; voffB[i] = rowoff(pb.mb, Rb) + (unsigned)C * 2u; }
    const size_t kstepA = pb.kstepA, kstepB = pb.kstepB, hstepA = pb.hstepA, hstepB = pb.hstepB;
    const unsigned ldsw = (unsigned)wid * 1024u;
    const int aoff = lds_byte(wr * 64 + fr, fq * 8), boff = lds_byte(wc * 32 + fr, fq * 8);
#define PG8_SA(b, h) (((b) * 2 + (h)) * HTB)
#define PG8_SB(b, h) ((4 + (b) * 2 + (h)) * HTB)
#define PG8_STAGE(bufoff, gbase, voff) do { _Pragma("unroll") for (int _i = 0; _i < 2; ++_i) \
        __builtin_amdgcn_global_load_lds((const unsigned*)((const char*)(gbase) + (voff)[_i]), (LAS unsigned*)(lds + (bufoff) + ldsw + _i * 8192), 16, 0, 0); } while (0)
#define PG8_LDA(dst, b, h) do { _Pragma("unroll") for (int m = 0; m < 4; ++m) _Pragma("unroll") for (int k = 0; k < 2; ++k) dst[m][k] = *(const LAS bf16x8*)(lds + PG8_SA(b, h) + aoff + m * 2048 + k * 1024); } while (0)
#define PG8_LDB(dst, b, h) do { _Pragma("unroll") for (int n = 0; n < 2; ++n) _Pragma("unroll") for (int k = 0; k < 2; ++k) dst[n][k] = *(const LAS bf16x8*)(lds + PG8_SB(b, h) + boff + n * 2048 + k * 1024); } while (0)
#define PG8_MMA(ai, bj, At, Bt) do { __builtin_amdgcn_s_setprio(1); _Pragma("unroll") for (int m = 0; m < 4; ++m) _Pragma("unroll") for (int n = 0; n < 2; ++n) _Pragma("unroll") for (int k = 0; k < 2; ++k) \
        acc[ai][bj][m][n] = __builtin_amdgcn_mfma_f32_16x16x32_bf16(Bt[n][k], At[m][k], acc[ai][bj][m][n], 0, 0, 0); __builtin_amdgcn_s_setprio(0); } while (0)
#define PG8_WAIT_V(n) asm volatile("s_waitcnt vmcnt(" #n ")" ::: "memory")
#define PG8_WAIT_L(n) asm volatile("s_waitcnt lgkmcnt(" #n ")" ::: "memory")
#define PG8_BAR __builtin_amdgcn_s_barrier()
#define PG8_SCHED __builtin_amdgcn_sched_barrier(0)
    LAS unsigned char* prof_lds_ = (LAS unsigned char*)0; (void)prof_lds_; PROF_DECL; PROF_BEGIN();
    Unit cur, nxt; int ui = 0;
    if (!pb.next(0, cur)) return;
    f32x4 acc[2][2][4][2];
#pragma unroll
    for (int a = 0; a < 2; ++a)
#pragma unroll
        for (int b = 0; b < 2; ++b)
#pragma unroll
            for (int m = 0; m < 4; ++m)
#pragma unroll
                for (int n = 0; n < 2; ++n) acc[a][b][m][n] = (f32x4){0.f, 0.f, 0.f, 0.f};
    bf16x8 At[4][2], B0[2][2], B1[2][2];
    const char* cA = pb.A + cur.offA; const char* cB = pb.B + cur.offB;
    if constexpr (SP2) {
        PG8_STAGE(PG8_SB(0, 0), cB, voffB); PG8_STAGE(PG8_SB(0, 1), cB + hstepB, voffB); PG8_STAGE(PG8_SA(0, 0), cA, voffA); PG8_STAGE(PG8_SA(0, 1), cA + hstepA, voffA);
        if (wr == 1) PG8_BAR;
        PG8_WAIT_V(2); PG8_BAR;
        PG8_STAGE(PG8_SB(1, 0), cB + kstepB, voffB); PG8_STAGE(PG8_SA(1, 0), cA + kstepA, voffA); PG8_STAGE(PG8_SB(1, 1), cB + hstepB + kstepB, voffB);
        PG8_WAIT_V(6); PG8_BAR;
    } else {
        PG8_STAGE(PG8_SB(0, 0), cB, voffB); PG8_STAGE(PG8_SA(0, 0), cA, voffA); PG8_STAGE(PG8_SB(0, 1), cB + hstepB, voffB); PG8_STAGE(PG8_SA(0, 1), cA + hstepA, voffA);
        if (wr == 1) PG8_BAR;
        PG8_WAIT_V(4); PG8_BAR;
        PG8_STAGE(PG8_SB(1, 0), cB + kstepB, voffB); PG8_STAGE(PG8_SA(1, 0), cA + kstepA, voffA); PG8_STAGE(PG8_SB(1, 1), cB + hstepB + kstepB, voffB);
        PG8_WAIT_V(6); PG8_BAR;
    }
    for (;;) {
        const bool has_next = pb.next(ui + 1, nxt);
        const char* nA = has_next ? pb.A + nxt.offA : cA; const char* nB = has_next ? pb.B + nxt.offB : cB;
        const int nt = cur.nt;
        for (int t = 0; t < nt; t += 2) {
            const bool last = (t == nt - 2);
            const char* a1 = cA + (size_t)(t + 1) * kstepA;
            const char* a2 = last ? nA : cA + (size_t)(t + 2) * kstepA; const char* b2 = last ? nB : cB + (size_t)(t + 2) * kstepB;
            const char* a3 = a2 + kstepA; const char* b3 = b2 + kstepB;
            if constexpr (SP2) {
            PG8_LDB(B0, 0, 0); PG8_LDB(B1, 0, 1); PG8_SCHED; PG8_LDA(At, 0, 0); PG8_STAGE(PG8_SA(1, 1), a1 + hstepA, voffA);
            PG8_WAIT_V(8); PG8_WAIT_L(0); PG8_BAR; PG8_MMA(0, 0, At, B0); PG8_MMA(0, 1, At, B1); PG8_BAR; PG8_SCHED;
            PG8_LDA(At, 0, 1); PG8_STAGE(PG8_SB(0, 0), b2, voffB); PG8_STAGE(PG8_SB(0, 1), b2 + hstepB, voffB); PG8_STAGE(PG8_SA(0, 0), a2, voffA);
            PG8_WAIT_V(8); PG8_WAIT_L(0); PG8_BAR; PG8_MMA(1, 0, At, B0); PG8_MMA(1, 1, At, B1); PG8_BAR; PG8_SCHED;
            PG8_LDB(B0, 1, 0); PG8_LDB(B1, 1, 1); PG8_SCHED; PG8_LDA(At, 1, 0); PG8_STAGE(PG8_SA(0, 1), a2 + hstepA, voffA);
            PG8_WAIT_V(8); PG8_WAIT_L(0); PG8_BAR; PG8_MMA(0, 0, At, B0); PG8_MMA(0, 1, At, B1); PG8_BAR; PG8_SCHED;
            PG8_LDA(At, 1, 1); PG8_STAGE(PG8_SB(1, 0), b3, voffB); PG8_STAGE(PG8_SB(1, 1), b3 + hstepB, voffB); PG8_STAGE(PG8_SA(1, 0), a3, voffA);
            PG8_WAIT_V(8); PG8_WAIT_L(0); PG8_BAR; PG8_MMA(1, 0, At, B0); PG8_MMA(1, 1, At, B1); PG8_BAR; PG8_SCHED;
            } else {
            PG8_LDB(B0, 0, 0); PG8_SCHED; PG8_LDA(At, 0, 0); PG8_STAGE(PG8_SA(1, 1), a1 + hstepA, voffA);
            PG8_WAIT_L(8); PG8_BAR; PG8_WAIT_L(0); PG8_MMA(0, 0, At, B0); PG8_BAR; PG8_SCHED;
            PG8_LDB(B1, 0, 1); PG8_STAGE(PG8_SB(0, 0), b2, voffB);
            PG8_BAR; PG8_WAIT_L(0); PG8_MMA(0, 1, At, B1); PG8_BAR;
            PG8_LDA(At, 0, 1); PG8_STAGE(PG8_SA(0, 0), a2, voffA);
            PG8_BAR; PG8_WAIT_L(0); PG8_MMA(1, 0, At, B0); PG8_BAR; PG8_SCHED;
            PG8_STAGE(PG8_SB(0, 1), b2 + hstepB, voffB);
            PG8_WAIT_V(6); PG8_BAR; PG8_MMA(1, 1, At, B1); PG8_BAR;
            PG8_LDB(B0, 1, 0); PG8_SCHED; PG8_LDA(At, 1, 0); PG8_STAGE(PG8_SA(0, 1), a2 + hstepA, voffA);
            PG8_WAIT_L(8); PG8_BAR; PG8_WAIT_L(0); PG8_MMA(0, 0, At, B0); PG8_BAR; PG8_SCHED;
            PG8_LDB(B1, 1, 1); PG8_STAGE(PG8_SB(1, 0), b3, voffB);
            PG8_BAR; PG8_WAIT_L(0); PG8_MMA(0, 1, At, B1); PG8_BAR;
            PG8_LDA(At, 1, 1); PG8_STAGE(PG8_SA(1, 0), a3, voffA);
            PG8_BAR; PG8_WAIT_L(0); PG8_MMA(1, 0, At, B0); PG8_BAR; PG8_SCHED;
            PG8_STAGE(PG8_SB(1, 1), b3 + hstepB, voffB);
            PG8_WAIT_V(6); PG8_BAR; PG8_MMA(1, 1, At, B1); PG8_BAR;
            }
        }
        if constexpr (ALIGN_EPI) { if (wr == 0) PG8_BAR; }
        PROF_END(pb.prof_id); PROF_BEGIN();
        pb.epi(acc, cur, wr, wc, fr, fq);
#if defined(PROF_ID)
        asm volatile("s_waitcnt vmcnt(0)" ::: "memory");
#endif
        PROF_END(pb.prof_id + 1); PROF_BEGIN();
        if (!has_next) break;
#pragma unroll
        for (int a = 0; a < 2; ++a)
#pragma unroll
            for (int b = 0; b < 2; ++b)
#pragma unroll
                for (int m = 0; m < 4; ++m)
#pragma unroll
                    for (int n = 0; n < 2; ++n) acc[a][b][m][n] = (f32x4){0.f, 0.f, 0.f, 0.f};
        cur = nxt; cA = nA; cB = nB; ++ui;
        if constexpr (ALIGN_EPI) { if (wr == 1) PG8_BAR; }
    }
    PG8_WAIT_V(0);
    if constexpr (!ALIGN_EPI) { if (wr == 0) PG8_BAR; }
    PG8_BAR;
#undef PG8_SA
#undef PG8_SB
#undef PG8_STAGE
#undef PG8_LDA
#undef PG8_LDB
#undef PG8_MMA
#undef PG8_WAIT_V
#undef PG8_WAIT_L
#undef PG8_BAR
#undef PG8_SCHED
}

struct StaticOrder {
    int nM, nN, nwg, G, c;
    __device__ void init(int nM_, int nN_, int G_, int c_) { nM = nM_; nN = nN_; nwg = nM * nN; G = G_; c = c_; }
    __device__ bool next(int i, int& pm, int& pn) const { const long L = (long)i * G + c; if (L >= nwg) return false; map((int)L, pm, pn); return true; }
    __device__ void map(int L, int& pm, int& pn) const {
        int wgid = L; { const int q = nwg / NXCD, r = nwg % NXCD, xcd = wgid % NXCD, off = wgid / NXCD; wgid = (xcd < r ? xcd * (q + 1) : r * (q + 1) + (xcd - r) * q) + off; }
        const int nig = WGM * nN, gid = wgid / nig, fm = gid * WGM, gsz = (nM - fm) < WGM ? (nM - fm) : WGM;
        pm = fm + ((wgid % nig) % gsz); pn = (wgid % nig) / gsz;
    }
};

struct ProbBase {
    const char* A; const char* B; OpMap ma, mb; size_t hstepA, hstepB, kstepA, kstepB; int nt; int prof_id = -100;
    __device__ void std_operands(const void* A_, int lda, const void* B_, int ldb, int K) {
        A = (const char*)A_; B = (const char*)B_; ma = OpMap{128, (unsigned)lda * 2u, 0u}; mb = OpMap{128, (unsigned)ldb * 2u, 0u};
        hstepA = (size_t)HALF * lda * 2; hstepB = (size_t)HALF * ldb * 2; kstepA = kstepB = BK * 2; nt = K / BK;
    }
};

template <class F> __device__ __forceinline__ void epi_rows_perm(const f32x4 (&acc)[2][2][4][2], int wr, int wc, int fr, int fq, F f) {
    asm volatile("" : "+v"(fr), "+v"(fq));
#pragma unroll
    for (int ai = 0; ai < 2; ++ai)
#pragma unroll
        for (int m = 0; m < 4; ++m)
#pragma unroll
            for (int bj = 0; bj < 2; ++bj) f(ai * HALF + wr * 64 + m * 16 + fr, bj * HALF + wc * 32 + 8 * fq, acc[ai][bj][m][0], acc[ai][bj][m][1]);
}
template <class F> __device__ __forceinline__ void epi_rows_f32(const f32x4 (&acc)[2][2][4][2], int wr, int wc, int fr, int fq, F f) {
    asm volatile("" : "+v"(fr), "+v"(fq));
#pragma unroll
    for (int ai = 0; ai < 2; ++ai)
#pragma unroll
        for (int m = 0; m < 4; ++m)
#pragma unroll
            for (int bj = 0; bj < 2; ++bj)
#pragma unroll
                for (int n = 0; n < 2; ++n) f(ai * HALF + wr * 64 + m * 16 + fr, bj * HALF + wc * 32 + 16 * n + 4 * fq, acc[ai][bj][m][n]);
}
__device__ __forceinline__ u32x4 pack8(const f32x4& v0, const f32x4& v1) { u32x4 w; w.x = cvt_pk_bf16(v0[0], v0[1]); w.y = cvt_pk_bf16(v0[2], v0[3]); w.z = cvt_pk_bf16(v1[0], v1[1]); w.w = cvt_pk_bf16(v1[2], v1[3]); return w; }

struct TokOrder : ProbBase {
    StaticOrder so; int row0, lda, ldb;
    __device__ void init_tok(const void* Act, int lda_, const void* Wt, int K, int row0_, int nM, int nN, int G, int c) { std_operands(Act, lda_, Wt, K, K); row0 = row0_; lda = lda_; ldb = K; so.init(nM, nN, G, c); }
    __device__ bool next(int i, Unit& u) const { int pm, pn; if (!so.next(i, pm, pn)) return false; u.p0 = pm; u.p1 = pn; u.p2 = -1; u.nt = nt; u.offA = (size_t)(row0 + pm * BM) * lda * 2; u.offB = (size_t)pn * BM * ldb * 2; return true; }
};
struct ProbMlp1 : TokOrder {
    static constexpr bool PERM = true;
    bf16_t* O; int ldc;
    __device__ __forceinline__ void epi(const f32x4 (&acc)[2][2][4][2], const Unit& u, int wr, int wc, int fr, int fq) const {
        bf16_t* base = O + (size_t)(row0 + u.p0 * BM) * ldc + u.p1 * BM;
        epi_rows_perm(acc, wr, wc, fr, fq, [&](int r, int c, f32x4 v0, f32x4 v1) {
#pragma unroll
            for (int j = 0; j < 4; ++j) { const float a = fmaxf(v0[j], 0.f), b = fmaxf(v1[j], 0.f); v0[j] = a * a; v1[j] = b * b; }
            *(u32x4*)(base + (size_t)r * ldc + c) = pack8(v0, v1); });
    }
};
template <bool FIRST> struct ProbResidT : TokOrder {
    static constexpr bool PERM = false;
    bf16_t* X; const float* mod; int layer, gidx; unsigned short* slab; int G2, c2;
    const float* xp; const float* xs; const float* er; const float* ec;
    __device__ void init_split(int G_, int c_, unsigned short* slab_) { G2 = G_; c2 = c_; slab = slab_; xp = nullptr; xs = nullptr; er = nullptr; ec = nullptr; }
    __device__ bool next(int i, Unit& u) const {
        if (G2 != 256) return TokOrder::next(i, u);
        int pm, pn;
        if (i > 1) return false;
        const int which = (c2 & 1) ? 1 - i : i;
        if (which == 0) { so.map(c2, pm, pn); u.p2 = -1; u.p3 = 0; u.nt = nt; u.offA = (size_t)(row0 + pm * BM) * lda * 2; u.offB = (size_t)pn * BM * ldb * 2; }
        else { const int L = 256 + (c2 >> 2), kq = c2 & 3, ntq = nt >> 2; so.map(L, pm, pn); u.p2 = kq; u.p3 = L - 256; u.nt = ntq;
            u.offA = (size_t)(row0 + pm * BM) * lda * 2 + (size_t)kq * ntq * BK * 2; u.offB = (size_t)pn * BM * ldb * 2 + (size_t)kq * ntq * BK * 2; }
        u.p0 = pm; u.p1 = pn; return true;
    }
    __device__ __forceinline__ void epi(const f32x4 (&acc)[2][2][4][2], const Unit& u, int wr, int wc, int fr, int fq) const {
        asm volatile("" : "+v"(fr), "+v"(fq));
        const int rowt = row0 + u.p0 * BM, cond = rowt >> 12, colt = u.p1 * BM;
        const float* gate = mod + ((size_t)(cond * 2 + layer) * 6 + gidx) * 1024 + colt + wc * 32 + 4 * fq;
        f32x4 gt[2][2];
#pragma unroll
        for (int bj = 0; bj < 2; ++bj)
#pragma unroll
            for (int n = 0; n < 2; ++n) gt[bj][n] = *(const f32x4*)(gate + bj * HALF + 16 * n);
        if (u.p2 <= 0) {
            bf16_t* base = X + (size_t)(rowt + wr * 64 + fr) * 2048 + (fr & 1) * 1024 + colt + wc * 32 + 4 * fq;
            if constexpr (FIRST) {
                const bool smp = rowt >= 4096, use_er = colt < 512; const int t0 = (rowt & 4095) + wr * 64 + fr;
                const float* xsrc = (smp ? xs + (size_t)(rowt - 4096) * 1024 : xp + (size_t)rowt * 1024) + (size_t)(wr * 64 + fr) * 1024 + colt + wc * 32 + 4 * fq;
                const float* pbase = (use_er ? er + colt : ec + colt - 512) + wc * 32 + 4 * fq;
#pragma unroll
                for (int ai = 0; ai < 2; ++ai)
#pragma unroll
                    for (int mp = 0; mp < 2; ++mp) {
                        f32x4 xv[2][2][2], pv[2][2][2];
#pragma unroll
                        for (int mm = 0; mm < 2; ++mm) { const int ro = ai * HALF + (2 * mp + mm) * 16; const int t = t0 + ro;
#pragma unroll
                            for (int bj = 0; bj < 2; ++bj)
#pragma unroll
                                for (int n = 0; n < 2; ++n) { xv[mm][bj][n] = *(const f32x4*)(xsrc + (size_t)ro * 1024 + bj * HALF + 16 * n);
                                    pv[mm][bj][n] = smp ? *(const f32x4*)(pbase + (use_er ? (t >> 6) : (t & 63)) * 512 + bj * HALF + 16 * n) : (f32x4){0.f, 0.f, 0.f, 0.f}; } }
#pragma unroll
                        for (int mm = 0; mm < 2; ++mm) { const int ro = ai * HALF + (2 * mp + mm) * 16;
#pragma unroll
                            for (int bj = 0; bj < 2; ++bj)
#pragma unroll
                                for (int n = 0; n < 2; ++n) st_bf4(base + (size_t)ro * 2048 + bj * HALF + 16 * n, xv[mm][bj][n] + pv[mm][bj][n] + gt[bj][n] * acc[ai][bj][2 * mp + mm][n]); }
                    }
            } else {
#pragma unroll
                for (int ai = 0; ai < 2; ++ai) {
                    u32x2 xw[4][2][2];
#pragma unroll
                    for (int m = 0; m < 4; ++m)
#pragma unroll
                        for (int bj = 0; bj < 2; ++bj)
#pragma unroll
                            for (int n = 0; n < 2; ++n) xw[m][bj][n] = *(const u32x2*)(base + (size_t)(ai * HALF + m * 16) * 2048 + bj * HALF + 16 * n);
#pragma unroll
                    for (int m = 0; m < 4; ++m)
#pragma unroll
                        for (int bj = 0; bj < 2; ++bj)
#pragma unroll
                            for (int n = 0; n < 2; ++n) { const u32x2 w = xw[m][bj][n];
                                const f32x4 x0 = (f32x4){__builtin_bit_cast(float, w.x << 16), __builtin_bit_cast(float, w.x & 0xffff0000u), __builtin_bit_cast(float, w.y << 16), __builtin_bit_cast(float, w.y & 0xffff0000u)};
                                st_bf4(base + (size_t)(ai * HALF + m * 16) * 2048 + bj * HALF + 16 * n, x0 + gt[bj][n] * acc[ai][bj][m][n]); }
                }
            }
        } else {
            unsigned short* base = slab + (size_t)(u.p3 * 3 + u.p2 - 1) * 65536 + (size_t)(wr * 64 + fr) * 256 + wc * 32 + 4 * fq;
#pragma unroll
            for (int ai = 0; ai < 2; ++ai)
#pragma unroll
                for (int m = 0; m < 4; ++m)
#pragma unroll
                    for (int bj = 0; bj < 2; ++bj)
#pragma unroll
                        for (int n = 0; n < 2; ++n) { const f32x4 w = gt[bj][n] * acc[ai][bj][m][n]; u32x2 o; o.x = pk2h(w[0], w[1]); o.y = pk2h(w[2], w[3]); *(u32x2*)(base + (size_t)(ai * HALF + m * 16) * 256 + bj * HALF + 16 * n) = o; }
        }
    }
};
typedef ProbResidT<false> ProbResid; typedef ProbResidT<true> ProbResidFirst;
__device__ __forceinline__ void build_split_table(LAS unsigned char* tab, int G, int tid) {
    for (int i = tid; i < 320; i += NTHREADS) tab[i] = 255;
    __syncthreads();
    if (G == 256) { StaticOrder so; so.init(80, 4, G, 0); for (int L = 256 + tid; L < 320; L += NTHREADS) { int pm, pn; so.map(L, pm, pn); tab[pm * 4 + pn] = (unsigned char)(L - 256); } }
    __syncthreads();
}
struct SlabRaw { u32x2 w[3]; };
__device__ __forceinline__ SlabRaw slab_load(const unsigned short* slab, int idx, int r255, int col) { SlabRaw s;
#pragma unroll
    for (int q = 0; q < 3; ++q) s.w[q] = *(const u32x2*)(slab + (size_t)(idx * 3 + q) * 65536 + (size_t)r255 * 256 + col);
    return s; }
__device__ __forceinline__ f32x4 slab_add(const SlabRaw& r) { f32x4 s = (f32x4){0.f, 0.f, 0.f, 0.f};
#pragma unroll
    for (int q = 0; q < 3; ++q) { s[0] += h2f_((unsigned short)(r.w[q].x & 0xffffu)); s[1] += h2f_((unsigned short)(r.w[q].x >> 16)); s[2] += h2f_((unsigned short)(r.w[q].y & 0xffffu)); s[3] += h2f_((unsigned short)(r.w[q].y >> 16)); }
    return s; }
__device__ __forceinline__ f32x4 slab_sum(const unsigned short* slab, int idx, int r255, int col) {
    f32x4 s = (f32x4){0.f, 0.f, 0.f, 0.f};
#pragma unroll
    for (int q = 0; q < 3; ++q) { const u32x2 w = *(const u32x2*)(slab + (size_t)(idx * 3 + q) * 65536 + (size_t)r255 * 256 + col);
        s[0] += h2f_((unsigned short)(w.x & 0xffffu)); s[1] += h2f_((unsigned short)(w.x >> 16)); s[2] += h2f_((unsigned short)(w.y & 0xffffu)); s[3] += h2f_((unsigned short)(w.y >> 16)); }
    return s;
}

struct ProbWin : TokOrder {
    static constexpr bool PERM = true;
    bf16_t* Oq; bf16_t* Offw; bf16_t* Ofbw; bf16_t* Ov; bf16_t* Osg; const float* lb;
    __device__ __forceinline__ void epi(const f32x4 (&acc)[2][2][4][2], const Unit& u, int wr, int wc, int fr, int fq) const {
        const int t = u.p1 >> 2, col0 = (u.p1 & 3) * BM;
        bf16_t* O = t == 0 ? Oq : t == 1 ? Offw : t == 2 ? Ofbw : t == 3 ? Ov : Osg;
        bf16_t* base = O + (size_t)(row0 + u.p0 * BM) * 1024 + col0;
        if (t == 1 || t == 2) {
            const float* lbp = lb + (t - 1) * 1024 + col0 + wc * 32 + 8 * fq;
            f32x4 lbv[2][2];
#pragma unroll
            for (int bj = 0; bj < 2; ++bj) { lbv[bj][0] = *(const f32x4*)(lbp + bj * HALF); lbv[bj][1] = *(const f32x4*)(lbp + bj * HALF + 4); }
            epi_rows_perm(acc, wr, wc, fr, fq, [&](int r, int c, f32x4 v0, f32x4 v1) {
                const f32x4 l0 = lbv[c >> 7][0], l1 = lbv[c >> 7][1];
#pragma unroll
                for (int j = 0; j < 4; ++j) { v0[j] = __builtin_amdgcn_logf(l0[j] + (1.f - l0[j]) * __builtin_amdgcn_rcpf(1.f + __builtin_amdgcn_exp2f(-1.44269504f * v0[j]))); v1[j] = __builtin_amdgcn_logf(l1[j] + (1.f - l1[j]) * __builtin_amdgcn_rcpf(1.f + __builtin_amdgcn_exp2f(-1.44269504f * v1[j]))); }
                u32x4 w; w.x = pk2h(v0[0], v0[1]); w.y = pk2h(v0[2], v0[3]); w.z = pk2h(v1[0], v1[1]); w.w = pk2h(v1[2], v1[3]);
                *(u32x4*)(base + (size_t)r * 1024 + c) = w; });
        } else if (t == 3) {
            epi_rows_perm(acc, wr, wc, fr, fq, [&](int r, int c, f32x4 v0, f32x4 v1) { *(u32x4*)(base + (size_t)r * 1024 + c) = pack8(v0, v1); });
        } else {
            epi_rows_perm(acc, wr, wc, fr, fq, [&](int r, int c, f32x4 v0, f32x4 v1) {
#pragma unroll
                for (int j = 0; j < 4; ++j) { v0[j] = silu(v0[j]); v1[j] = silu(v1[j]); }
                *(u32x4*)(base + (size_t)r * 1024 + c) = pack8(v0, v1); });
        }
    }
};

struct ProbChan : ProbBase {
    static constexpr bool PERM = true;
    int mode, G, c, nunits; bf16_t* Y;
    __device__ void init(int mode_, const void* dftc, const bf16_t* h0, bf16_t* Y_, int G_, int c_) {
        mode = mode_; G = G_; c = c_; Y = Y_; A = (const char*)dftc; B = (const char*)h0; ma = OpMap{128, 512u, 0u}; hstepA = (size_t)HALF * 512; kstepA = kstepB = BK * 2; nt = 4;
        if (mode == 0) { mb = OpMap{128, 2048u, 0u}; hstepB = (size_t)HALF * 2048; nunits = 16 * 4 * 2; }
        else { mb = OpMap{64, 64u * 2048u, 2048u}; hstepB = 2 * 2048; nunits = 4 * 4 * 16 * 2; }
    }
    __device__ bool next(int i, Unit& u) const {
        const int L = i * G + c; if (L >= nunits) return false;
        const int mt = L & 1; u.p0 = mt; u.nt = nt; u.offA = (size_t)mt * 256 * 512;
        if (mode == 0) { const int g = (L >> 1) & 3, b = L >> 3; u.p1 = b * 2048 + g * 512; u.p2 = 0; u.offB = ((size_t)(b * 256) * 1024 + g * 256) * 2; }
        else { const int j = (L >> 1) & 15, g = (L >> 5) & 3, b = L >> 7; u.p1 = b * 2048 + g * 512; u.p2 = j * 256; u.offB = ((size_t)(4096 + b * 4096 + 4 * j) * 1024 + g * 256) * 2; }
        return true;
    }
    __device__ __forceinline__ void epi(const f32x4 (&acc)[2][2][4][2], const Unit& u, int wr, int wc, int fr, int fq) const {
        const int ldc = mode == 0 ? 256 : 4096;
        bf16_t* base = Y + (size_t)(u.p1 + u.p0 * 256) * ldc + u.p2;
        epi_rows_perm(acc, wr, wc, fr, fq, [&](int r, int cc, f32x4 v0, f32x4 v1) { *(u32x4*)(base + (size_t)r * ldc + cc) = pack8(v0, v1); });
    }
};
struct ProbPosCtx : ProbBase {
    static constexpr bool PERM = true;
    int G, c; bf16_t* Z;
    __device__ void init(const void* dl, const bf16_t* yctx, bf16_t* Z_, int G_, int c_) { std_operands(dl, 512, yctx, 512, 512); G = G_; c = c_; Z = Z_; }
    __device__ bool next(int i, Unit& u) const {
        const int L = i * G + c; if (L >= 64) return false;
        const int pn = L & 3, b = L >> 2; u.p0 = b; u.p1 = pn; u.nt = nt; u.offA = 0; u.offB = ((size_t)b * 2048 * 256 + (size_t)pn * 256 * 512) * 2; return true;
    }
    __device__ __forceinline__ void epi(const f32x4 (&acc)[2][2][4][2], const Unit& u, int wr, int wc, int fr, int fq) const {
        bf16_t* base = Z + (size_t)(u.p0 * 256) * 1024 + u.p1 * 256;
        epi_rows_perm(acc, wr, wc, fr, fq, [&](int r, int cc, f32x4 v0, f32x4 v1) { *(u32x4*)(base + (size_t)r * 1024 + cc) = pack8(v0, v1); });
    }
};
struct ProbSmpA : ProbBase {
    static constexpr bool PERM = true;
    int G, c; bf16_t* U;
    __device__ void init(const void* fa2, const bf16_t* yt, bf16_t* U_, int G_, int c_) {
        A = (const char*)fa2; B = (const char*)yt; ma = OpMap{128, 512u, 0u}; hstepA = (size_t)HALF * 512; kstepA = BK * 2;
        mb = OpMap{32, 128u, 16384u}; hstepB = 4 * 16384; kstepB = 4096; nt = 4; G = G_; c = c_; U = U_;
    }
    __device__ bool next(int i, Unit& u) const {
        const int L = i * G + c; if (L >= 512) return false;
        const int tau = L & 127, b = L >> 7; u.p0 = b; u.p1 = tau; u.nt = nt; u.offA = 0; u.offB = ((size_t)(b * 2048 + 16 * tau) * 4096) * 2; return true;
    }
    __device__ __forceinline__ void epi(const f32x4 (&acc)[2][2][4][2], const Unit& u, int wr, int wc, int fr, int fq) const {
        bf16_t* base = U + (size_t)(u.p0 * 1024 + 8 * u.p1) * 8192;
        epi_rows_perm(acc, wr, wc, fr, fq, [&](int r, int cc, f32x4 v0, f32x4 v1) {
            *(u32x4*)(base + (size_t)(cc >> 5) * 8192 + (r & 127) * 64 + (r >> 7) * 32 + (cc & 31)) = pack8(v0, v1); });
    }
};
struct ProbSmpB : ProbBase {
    static constexpr bool PERM = true;
    int G, c; bf16_t* Z;
    __device__ void init(const void* mbm, const bf16_t* Uin, bf16_t* Z_, int G_, int c_) { std_operands(mbm, 512, Uin, 8192, 512); G = G_; c = c_; Z = Z_; }
    __device__ bool next(int i, Unit& u) const {
        const int L = i * G + c; if (L >= 256) return false;
        const int pn = L & 3, q = (L >> 2) & 15, b = L >> 6; u.p0 = b; u.p1 = q; u.p2 = pn; u.nt = nt;
        u.offA = (size_t)q * 256 * 512 * 2; u.offB = ((size_t)(b * 1024 + pn * 256) * 8192 + q * 512) * 2; return true;
    }
    __device__ __forceinline__ void epi(const f32x4 (&acc)[2][2][4][2], const Unit& u, int wr, int wc, int fr, int fq) const {
        bf16_t* base = Z + (size_t)(4096 + u.p0 * 4096 + 4 * u.p1) * 1024 + u.p2 * 256;
        epi_rows_perm(acc, wr, wc, fr, fq, [&](int r, int cc, f32x4 v0, f32x4 v1) {
            const int l = (r >> 6) + 64 * (r & 63); *(u32x4*)(base + (size_t)l * 1024 + cc) = pack8(v0, v1); });
    }
};

__device__ __forceinline__ void norm_rows(bf16_t* X, int row0, int nrows, const float* g, const float* mod, int layer, int ish, bf16_t* H, int gw, int ngw, int lane, const LAS unsigned char* stab, const unsigned short* slab) {
    constexpr int NB = 5;
    LAS unsigned char* prof_lds_ = (LAS unsigned char*)0; (void)prof_lds_; PROF_DECL; PROF_BEGIN();
    f32x4 gv[4], gm[4], shv[4];
#pragma unroll
    for (int j = 0; j < 4; ++j) gv[j] = *(const f32x4*)(g + 4 * lane + 256 * j);
    const int rpw = (nrows + ngw - 1) / ngw, rbeg = row0 + gw * rpw, rend = (rbeg + rpw < row0 + nrows) ? rbeg + rpw : row0 + nrows;
    int ccur = -1;
    for (int rb = rbeg; rb < rend; rb += NB) {
        u32x2 nx[NB][4];
#pragma unroll
        for (int b = 0; b < NB; ++b) { const int r = rb + b; if (r < rend) { const u32x2* p = (const u32x2*)(X + (size_t)r * 2048 + (r & 1) * 1024) + lane;
#pragma unroll
            for (int j = 0; j < 4; ++j) nx[b][j] = p[64 * j]; } }
#pragma unroll
        for (int b = 0; b < NB; ++b) {
            const int r = rb + b; if (r >= rend) break;
            if ((r >> 12) != ccur) { ccur = r >> 12; const float* mrow = mod + ((size_t)(ccur * 2 + layer) * 6) * 1024;
#pragma unroll
                for (int j = 0; j < 4; ++j) { shv[j] = *(const f32x4*)(mrow + (size_t)ish * 1024 + 4 * lane + 256 * j); gm[j] = gv[j] * (*(const f32x4*)(mrow + (size_t)(ish + 1) * 1024 + 4 * lane + 256 * j) + 1.f); } }
            u32x2* xr = (u32x2*)(X + (size_t)r * 2048 + (r & 1) * 1024) + lane;
            f32x4 v[4]; float s = 0.f;
            int si4[4]; SlabRaw sr[4];
#pragma unroll
            for (int j = 0; j < 4; ++j) { si4[j] = stab[(r >> 8) * 4 + j]; if (si4[j] != 255) sr[j] = slab_load(slab, si4[j], r & 255, 4 * lane); }
#pragma unroll
            for (int j = 0; j < 4; ++j) { v[j] = (f32x4){__builtin_bit_cast(float, nx[b][j].x << 16), __builtin_bit_cast(float, nx[b][j].x & 0xffff0000u), __builtin_bit_cast(float, nx[b][j].y << 16), __builtin_bit_cast(float, nx[b][j].y & 0xffff0000u)}; if (si4[j] != 255) { v[j] = v[j] + slab_add(sr[j]); st_bf4(xr + 64 * j, v[j]); }
                s += (v[j].x * v[j].x + v[j].y * v[j].y) + (v[j].z * v[j].z + v[j].w * v[j].w); }
            const float rstd = rsqrtf(wave_sum(s) * (1.f / 1024.f) + 1e-6f);
            unsigned long long* o8 = (unsigned long long*)(H + (size_t)r * 1024) + lane;
#pragma unroll
            for (int j = 0; j < 4; ++j) { const f32x4 o = v[j] * rstd * gm[j] + shv[j]; o8[64 * j] = (unsigned long long)cvt_pk_bf16(o.x, o.y) | ((unsigned long long)cvt_pk_bf16(o.z, o.w) << 32); }
        }
    }
    PROF_END(11);
}


__device__ __forceinline__ void embed_rows(const float* xp, const float* xs, const float* er, const float* ec, const float* g, const float* mod, bf16_t* H, int gw, int ngw, int lane) {
    constexpr int NB = 4;
    f32x4 gv[4], gm[4], shv[4];
#pragma unroll
    for (int j = 0; j < 4; ++j) gv[j] = *(const f32x4*)(g + 4 * lane + 256 * j);
    const int rpw = (20480 + ngw - 1) / ngw, rbeg = gw * rpw, rend = (rbeg + rpw < 20480) ? rbeg + rpw : 20480;
    int ccur = -1;
    int prow = -1; f32x4 pr0 = (f32x4){0.f, 0.f, 0.f, 0.f}, pr1 = pr0;
    for (int rb = rbeg; rb < rend; rb += NB) {
        f32x4 nx[NB][4], pc[NB][2];
#pragma unroll
        for (int b = 0; b < NB; ++b) { const int r = rb + b; if (r < rend) { const f32x4* xr = (const f32x4*)(r < 4096 ? xp + (size_t)r * 1024 : xs + (size_t)(r - 4096) * 1024) + lane;
#pragma unroll
            for (int j = 0; j < 4; ++j) nx[b][j] = xr[64 * j];
            if (r >= 4096) { const int col = r & 63; pc[b][0] = *(const f32x4*)(ec + col * 512 + 4 * lane); pc[b][1] = *(const f32x4*)(ec + col * 512 + 256 + 4 * lane); } } }
#pragma unroll
        for (int b = 0; b < NB; ++b) {
            const int r = rb + b; if (r >= rend) break;
            if ((r >> 12) != ccur) { ccur = r >> 12; const float* mrow = mod + ((size_t)(ccur * 2 + 0) * 6) * 1024;
#pragma unroll
                for (int j = 0; j < 4; ++j) { shv[j] = *(const f32x4*)(mrow + 4 * lane + 256 * j); gm[j] = gv[j] * (*(const f32x4*)(mrow + 1024 + 4 * lane + 256 * j) + 1.f); } }
            f32x4 v[4]; float s = 0.f;
#pragma unroll
            for (int j = 0; j < 4; ++j) v[j] = nx[b][j];
            if (r >= 4096) { const int row = (r & 4095) >> 6;
                if (row != prow) { prow = row; pr0 = *(const f32x4*)(er + row * 512 + 4 * lane); pr1 = *(const f32x4*)(er + row * 512 + 256 + 4 * lane); }
                v[0] = v[0] + pr0; v[1] = v[1] + pr1; v[2] = v[2] + pc[b][0]; v[3] = v[3] + pc[b][1]; }
#pragma unroll
            for (int j = 0; j < 4; ++j) s += (v[j].x * v[j].x + v[j].y * v[j].y) + (v[j].z * v[j].z + v[j].w * v[j].w);
            const float rstd = rsqrtf(wave_sum(s) * (1.f / 1024.f) + 1e-6f);
            unsigned long long* o8 = (unsigned long long*)(H + (size_t)r * 1024) + lane;
#pragma unroll
            for (int j = 0; j < 4; ++j) { const f32x4 o = v[j] * rstd * gm[j] + shv[j]; o8[64 * j] = (unsigned long long)cvt_pk_bf16(o.x, o.y) | ((unsigned long long)cvt_pk_bf16(o.z, o.w) << 32); }
        }
    }
}
__device__ __forceinline__ void gen_tables(unsigned char* ws, long e0, long estride) {
    bf16_t* dftc = (bf16_t*)(ws + WM.dftc); bf16_t* dl = (bf16_t*)(ws + WM.dl256); bf16_t* fa2 = (bf16_t*)(ws + WM.fa2); bf16_t* mbm = (bf16_t*)(ws + WM.mb);
    float* er = (float*)(ws + WM.pos); float* ec = er + 64 * 512;
    constexpr long N0 = 512 * 256, N1 = 256 * 512, N2 = 256 * 256, N3 = 16L * 256 * 512, N4 = 2 * 64 * 512;
    for (long e = e0; e < N0 + N1 + N2 + N3 + N4; e += estride) {
        long r = e;
        if (r < N0) { const int mrow = (int)(r >> 8), cp = (int)(r & 255), cc = mrow >> 1, ri = mrow & 1; const float x = 2.f * (float)((cc * cp) & 255) / 256.f;
            dftc[r] = (bf16_t)f2bf(ri == 0 ? cospif(x) : -sinpif(x)); continue; } r -= N0;
        if (r < N1) { const int l = (int)(r >> 9), k = (int)(r & 511), ri = k >> 8, lp = k & 255; const float x = 2.f * (float)((l * lp) & 255) / 256.f;
            dl[r] = (bf16_t)f2bf((ri == 0 ? cospif(x) : sinpif(x)) * (1.f / 256.f)); continue; } r -= N1;
        if (r < N2) { const int mrow = (int)(r >> 8), k = (int)(r & 255), sA = mrow >> 7, k1 = (mrow >> 1) & 63, ro = mrow & 1, ri = k >> 7, sB = (k >> 6) & 1, l1 = k & 63;
            const float x = 2.f * (float)((k1 * l1) & 63) / 64.f; float v = 0.f;
            if (sA == sB) v = (ro == ri) ? cospif(x) : (ro == 0 ? sinpif(x) : -sinpif(x));
            fa2[r] = (bf16_t)f2bf(v); continue; } r -= N2;
        if (r < N3) { const int q = (int)(r >> 17), mrow = (int)(r >> 9) & 255, k = (int)(r & 511), ko = mrow >> 6, k2 = mrow & 63, kop = k >> 7, ro = (k >> 6) & 1, l2 = k & 63;
            const int l = 4 * q + ko + 64 * k2; const float x = 2.f * (float)((l * l2) & 4095) / 4096.f; float v = 0.f;
            if (ko == kop) v = (ro == 0 ? cospif(x) : sinpif(x)) * (1.f / 1024.f);
            mbm[r] = (bf16_t)f2bf(v); continue; } r -= N3;
        { const int which = (int)(r >> 15), p = (int)(r >> 9) & 63, j = (int)(r & 511), i = j & 255;
            const float omega = 1.0f / powf(10000.0f, (float)i / 256.0f); const float ang = (float)p * omega;
            (which == 0 ? er : ec)[p * 512 + j] = (j < 256) ? sinf(ang) : cosf(ang); }
    }
}


__device__ __forceinline__ void final_rows(float* X, int row0, int nrows, const float* g, int gw, int ngw, int lane, const LAS unsigned char* stab, const unsigned short* slab) {
    constexpr int NB = 5;
    f32x4 gv[4];
#pragma unroll
    for (int j = 0; j < 4; ++j) gv[j] = *(const f32x4*)(g + 4 * lane + 256 * j);
    for (int rb = row0 + gw; rb < row0 + nrows; rb += NB * ngw) {
        u32x2 nx[NB][4];
#pragma unroll
        for (int b = 0; b < NB; ++b) { const int r = rb + b * ngw; if (r < row0 + nrows) { const u32x2* p = (const u32x2*)(X + (size_t)r * 1024) + (r & 1) * 256 + lane;
#pragma unroll
            for (int j = 0; j < 4; ++j) nx[b][j] = p[64 * j]; } }
#pragma unroll
        for (int b = 0; b < NB; ++b) {
            const int r = rb + b * ngw; if (r >= row0 + nrows) break;
            f32x4* xr = (f32x4*)(X + (size_t)r * 1024) + lane;
            f32x4 v[4]; float s = 0.f;
            int si4[4]; SlabRaw sr[4];
#pragma unroll
            for (int j = 0; j < 4; ++j) { si4[j] = stab[(r >> 8) * 4 + j]; if (si4[j] != 255) sr[j] = slab_load(slab, si4[j], r & 255, 4 * lane); }
#pragma unroll
            for (int j = 0; j < 4; ++j) { v[j] = (f32x4){__builtin_bit_cast(float, nx[b][j].x << 16), __builtin_bit_cast(float, nx[b][j].x & 0xffff0000u), __builtin_bit_cast(float, nx[b][j].y << 16), __builtin_bit_cast(float, nx[b][j].y & 0xffff0000u)}; if (si4[j] != 255) v[j] = v[j] + slab_add(sr[j]);
                s += (v[j].x * v[j].x + v[j].y * v[j].y) + (v[j].z * v[j].z + v[j].w * v[j].w); }
            const float rstd = rsqrtf(wave_sum(s) * (1.f / 1024.f) + 1e-6f);
#pragma unroll
            for (int j = 0; j < 4; ++j) xr[64 * j] = v[j] * rstd * gv[j];
        }
    }
}
__device__ __forceinline__ void mod_unit(LAS unsigned char* lds, int unit, const float* c, const float* c_ctx, const float* ada_w, const float* ada_b, float* mod, int tid, int wave, int lane) {
    LAS float* sc = (LAS float*)lds;
    LAS float* red = (LAS float*)(lds + 20480);
    const int layer = unit / 192, n0 = (unit % 192) * 32, col = lane & 31, kh = lane >> 5;
    for (int i = tid; i < 5 * 1024; i += NTHREADS) { const int cond = i >> 10, k = i & 1023; const float x = cond == 0 ? c_ctx[k] : c[(cond - 1) * 1024 + k]; sc[i] = silu(x); }
    __syncthreads();
    const float* w = ada_w + ((size_t)layer * 1024 + wave * 128 + kh) * 6144 + n0 + col;
    float acc[5];
#pragma unroll
    for (int q = 0; q < 5; ++q) acc[q] = 0.f;
#pragma unroll 1
    for (int kb = 0; kb < 64; kb += 32) {
        float wv[32];
#pragma unroll
        for (int k = 0; k < 32; ++k) wv[k] = w[(size_t)(2 * (kb + k)) * 6144];
#pragma unroll
        for (int k = 0; k < 32; ++k) {
#pragma unroll
            for (int q = 0; q < 5; ++q) acc[q] += wv[k] * sc[q * 1024 + wave * 128 + 2 * (kb + k) + kh];
        }
    }
#pragma unroll
    for (int q = 0; q < 5; ++q) { acc[q] += __shfl_xor(acc[q], 32); if (kh == 0) red[(wave * 5 + q) * 32 + col] = acc[q]; }
    __syncthreads();
    for (int i = tid; i < 5 * 32; i += NTHREADS) { const int q = i >> 5, n = i & 31; float s = 0.f;
#pragma unroll
        for (int ww = 0; ww < 8; ++ww) s += red[(ww * 5 + q) * 32 + n];
        mod[((size_t)q * 2 + layer) * 6144 + n0 + n] = s + ada_b[(size_t)layer * 6144 + n0 + n]; }
    __syncthreads();
}

struct TrItem { const float* W; bf16_t* WT; int K, N, item; };
__device__ __forceinline__ void transpose_load(const TrItem& t, f32x4 (&ld)[8], int lane) {
    const int nblk = t.N / 32, kb = t.item / nblk, nb = t.item % nblk, k0 = 64 * kb, n0 = 32 * nb;
#pragma unroll
    for (int i = 0; i < 8; ++i) ld[i] = *(const f32x4*)(t.W + (size_t)(k0 + 8 * i + (lane >> 3)) * t.N + n0 + 4 * (lane & 7));
}
__device__ __forceinline__ void transpose_finish(const TrItem& t, const f32x4 (&ld)[8], LAS float* scr, int lane) {
    const int nblk = t.N / 32, kb = t.item / nblk, nb = t.item % nblk, k0 = 64 * kb, n0 = 32 * nb;
#pragma unroll
    for (int i = 0; i < 8; ++i) { LAS float* d = scr + (8 * i + (lane >> 3)) * 33 + 4 * (lane & 7); d[0] = ld[i][0]; d[1] = ld[i][1]; d[2] = ld[i][2]; d[3] = ld[i][3]; }
    asm volatile("s_waitcnt lgkmcnt(0)" ::: "memory");
    const int c = lane & 7;
#pragma unroll
    for (int j = 0; j < 4; ++j) { const int n = (lane >> 3) + 8 * j; const LAS float* s = scr + (8 * c) * 33 + n;
        u32x4 o; o.x = pk2(s[0 * 33], s[1 * 33]); o.y = pk2(s[2 * 33], s[3 * 33]); o.z = pk2(s[4 * 33], s[5 * 33]); o.w = pk2(s[6 * 33], s[7 * 33]);
        *(u32x4*)(t.WT + (size_t)(n0 + n) * t.K + k0 + 8 * c) = o; }
    asm volatile("s_waitcnt lgkmcnt(0)" ::: "memory");
}
template <class Dec> __device__ __forceinline__ void transpose_stream(int first, int count, int stride, Dec dec, LAS float* scr, int lane) {
    if (first >= count) return;
    f32x4 cur[8], nxt[8]; TrItem tc = dec(first), tn = tc;
    transpose_load(tc, cur, lane);
    for (int it = first; it < count; it += stride) {
        const bool more = it + stride < count;
        if (more) { tn = dec(it + stride); transpose_load(tn, nxt, lane); }
        transpose_finish(tc, cur, scr, lane);
        if (more) { tc = tn;
#pragma unroll
            for (int i = 0; i < 8; ++i) cur[i] = nxt[i]; }
    }
}


typedef float f32x16 __attribute__((ext_vector_type(16)));
typedef short v4i16_t __attribute__((ext_vector_type(4)));
constexpr int QA_RS = 272, QP_RS = 264, KB_RS = 272, KPP_RS = 320, V_RS = 320;
constexpr int T_QA = 0, T_QP = T_QA + 32 * QA_RS, T_KB = T_QP + 32 * QP_RS, T_KPP = T_KB + 32 * KB_RS, T_V = T_KPP + 32 * KPP_RS, T_EL = T_V + 32 * V_RS, DIR_BYTES = T_EL + 512;
constexpr int OBUF_OFF = 2 * DIR_BYTES, OBUF_BYTES = 256 * 256;
static_assert(OBUF_OFF + OBUF_BYTES <= 160 * 1024 - 512 && (DIR_BYTES % 16) == 0 && (T_QP % 16) == 0 && (T_KB % 16) == 0 && (T_KPP % 16) == 0 && (T_V % 16) == 0 && (T_EL % 16) == 0, "scan LDS map");
constexpr int SLOT_ELEMS = 128 * 128;
#ifndef SCAN_STAGGER
#define SCAN_STAGGER 0
#endif

struct ScanT { const bf16_t* q; const bf16_t* lffw; const bf16_t* lfbw; const bf16_t* v; bf16_t* sg; bf16_t* slots; float* dvec; const float* gnorm; const float* state_in; float* new_state; };

__device__ __forceinline__ bf16x8 tr_pair(const LAS unsigned char* p0, const LAS unsigned char* p1) {
    const v4i16_t lo = __builtin_amdgcn_ds_read_tr16_b64_v4i16((LAS v4i16_t*)p0), hi = __builtin_amdgcn_ds_read_tr16_b64_v4i16((LAS v4i16_t*)p1);
    return (bf16x8){lo[0], lo[1], lo[2], lo[3], hi[0], hi[1], hi[2], hi[3]};
}
__device__ __forceinline__ bf16x8 pack_acc8(const f32x16& x, int s8) {
    u32x4 w; w.x = cvt_pk_bf16(x[8 * s8 + 0], x[8 * s8 + 1]); w.y = cvt_pk_bf16(x[8 * s8 + 2], x[8 * s8 + 3]); w.z = cvt_pk_bf16(x[8 * s8 + 4], x[8 * s8 + 5]); w.w = cvt_pk_bf16(x[8 * s8 + 6], x[8 * s8 + 7]);
    return __builtin_bit_cast(bf16x8, w);
}
__device__ __forceinline__ float h2f(unsigned short b) { return (float)__builtin_bit_cast(_Float16, b); }

template <bool FULL>
__device__ __forceinline__ void scan_item(LAS unsigned char* lds, const ScanT& T, int tok0, int h, bool act0, bool act1, const bf16_t* init0, const bf16_t* init1,
                                          float* fin0, float* fin1, bf16_t* outs0, bf16_t* outs1, float* outd0, float* outd1) {
    const int tid = threadIdx.x, wave = __builtin_amdgcn_readfirstlane(tid >> 6), dir = wave >> 2, wg = wave & 3;
    LAS unsigned char* prof_lds_ = lds; (void)prof_lds_; PROF_DECL; PROF_BEGIN();
    const bool act = dir ? act1 : act0;
    const bf16_t* init = dir ? init1 : init0;
    LAS unsigned char* D = lds + dir * DIR_BYTES;
    LAS unsigned char* OB = lds + OBUF_OFF;
    const bf16_t* lfp = dir ? T.lfbw : T.lffw;
#define SCAN_LANE(x) int x; asm volatile("v_mbcnt_lo_u32_b32 %0, -1, 0\n\tv_mbcnt_hi_u32_b32 %0, -1, %0" : "=v"(x))
#define SCAN_PREP_ROLE SCAN_LANE(ln_); const int pp = 16 * wg + (ln_ & 15), uu = ln_ >> 4, gt_ = wg * 64 + ln_, vt = gt_ >> 3, vc2 = gt_ & 7
#define SCAN_MFMA_ROLE SCAN_LANE(ln_); const int l31 = ln_ & 31, hh = ln_ >> 5, gq = (ln_ & 15) >> 2, gp = ln_ & 3, vcol = 16 * ((ln_ >> 4) & 1)
    f32x16 S[4];
#pragma unroll
    for (int t4 = 0; t4 < 4; ++t4) {
        if (init && act) { SCAN_LANE(lane0); const int lane = lane0; const u32x4* sp = (const u32x4*)(init + ((size_t)(wg * 4 + t4) * 64 + lane) * 16); const u32x4 a = sp[0], b = sp[1];
            const unsigned w8[8] = {a.x, a.y, a.z, a.w, b.x, b.y, b.z, b.w};
#pragma unroll
            for (int j = 0; j < 8; ++j) { S[t4][2 * j] = __builtin_bit_cast(float, w8[j] << 16); S[t4][2 * j + 1] = __builtin_bit_cast(float, w8[j] & 0xffff0000u); } }
        else {
#pragma unroll
            for (int j = 0; j < 16; ++j) S[t4][j] = 0.f; }
    }
    float dsum0 = 0.f, dsum1 = 0.f;
    unsigned qreg[8], lfreg[8]; u32x4 vreg[2];
#define SCAN_LOAD(i) do { const int jsc_ = dir ? 7 - (i) : (i); \
        _Pragma("unroll") for (int e = 0; e < 8; ++e) { const int tl = 8 * uu + e; const size_t tk = (size_t)(tok0 + 32 * jsc_ + (dir ? 31 - tl : tl)) * 1024 + h * 128 + 2 * pp; \
            if (FULL) qreg[e] = *(const unsigned*)(T.q + tk); lfreg[e] = *(const unsigned*)(lfp + tk); } \
        { const size_t tk = (size_t)(tok0 + 32 * jsc_ + (dir ? 31 - vt : vt)) * 1024 + h * 128 + 16 * vc2; vreg[0] = *(const u32x4*)(T.v + tk); vreg[1] = *(const u32x4*)(T.v + tk + 8); } } while (0)
    SCAN_LANE(ln_); const int lane = ln_;
    const int pp = 16 * wg + (ln_ & 15), uu = ln_ >> 4, gt_ = wg * 64 + ln_, vt = gt_ >> 3, vc2 = gt_ & 7;
    const int l31 = ln_ & 31, hh = ln_ >> 5, gq = (ln_ & 15) >> 2, gp = ln_ & 3, vcol = 16 * ((ln_ >> 4) & 1);
    unsigned pmask[8];
#pragma unroll
    for (int i2 = 0; i2 < 8; ++i2) { const int j0 = 2 * i2, s0 = (j0 & 3) + 8 * (j0 >> 2) + 4 * hh, s1 = s0 + 1; pmask[i2] = (s0 <= l31 ? 0x0000ffffu : 0u) | (s1 <= l31 ? 0xffff0000u : 0u); }
    if (act) { SCAN_LOAD(0); }
    PROF_END(6);
    for (int s = 0; s < 16 + SCAN_STAGGER; ++s) {
        const int ph = s - (SCAN_STAGGER ? dir : 0);
        if (act && ph >= 0 && ph < 16) {
            const int i = ph >> 1;
            if ((ph & 1) == 0) {
#if defined(PROF_ID)
                PROF_BEGIN(); asm volatile("s_waitcnt vmcnt(0)" ::: "memory"); PROF_END(1); PROF_BEGIN();
#endif
                *(LAS u32x4*)(D + T_V + vt * V_RS + vc2 * 32) = vreg[0]; *(LAS u32x4*)(D + T_V + vt * V_RS + vc2 * 32 + 16) = vreg[1];
                f32x2 cc[8]; f32x2 aa = (f32x2){0.f, 0.f};
#pragma unroll
                for (int e = 0; e < 8; ++e) { aa += (f32x2){h2f((unsigned short)(lfreg[e] & 0xffffu)), h2f((unsigned short)(lfreg[e] >> 16))}; cc[e] = aa; }
                f32x2 tq[4];
#pragma unroll
                for (int u2 = 0; u2 < 4; ++u2) { tq[u2].x = __shfl(aa.x, (lane & 15) + 16 * u2); tq[u2].y = __shfl(aa.y, (lane & 15) + 16 * u2); }
                const f32x2 zz = (f32x2){0.f, 0.f};
                const f32x2 pre = (uu > 0 ? tq[0] : zz) + (uu > 1 ? tq[1] : zz) + (uu > 2 ? tq[2] : zz);
                const f32x2 rr = tq[0] + tq[1], bl = rr + tq[2] + tq[3];
#define EX2V(v) ((f32x2){__builtin_amdgcn_exp2f((v).x), __builtin_amdgcn_exp2f((v).y)})
                if (FULL) {
                    const f32x2 er = EX2V(rr), elr = EX2V(bl - rr), base = pre - rr;
#pragma unroll
                    for (int e = 0; e < 8; ++e) {
                        const int tl = 8 * uu + e;
                        const f32x2 d = base + cc[e];
                        const f32x2 ea = EX2V(d), eb = EX2V(-d);
                        const f32x2 lfv = (f32x2){h2f((unsigned short)(lfreg[e] & 0xffffu)), h2f((unsigned short)(lfreg[e] >> 16))};
                        const f32x2 kk = 1.f - EX2V(lfv);
                        const f32x2 qq = (f32x2){__builtin_bit_cast(float, qreg[e] << 16), __builtin_bit_cast(float, qreg[e] & 0xffff0000u)};
                        const f32x2 qa = qq * ea, kb = kk * eb, qp = qa * er, kpp = kb * elr;
                        *(LAS unsigned*)(D + T_QA + tl * QA_RS + 4 * pp) = cvt_pk_bf16(qa.x, qa.y);
                        *(LAS unsigned*)(D + T_QP + tl * QP_RS + 4 * pp) = cvt_pk_bf16(qp.x, qp.y);
                        *(LAS unsigned*)(D + T_KB + tl * KB_RS + 4 * pp) = cvt_pk_bf16(kb.x, kb.y);
                        *(LAS unsigned*)(D + T_KPP + tl * KPP_RS + 4 * pp) = cvt_pk_bf16(kpp.x, kpp.y);
                        if (e & 1) __builtin_amdgcn_sched_barrier(0);
                    }
                } else {
                    const f32x2 base = bl - pre;
#pragma unroll
                    for (int e = 0; e < 8; ++e) {
                        const int tl = 8 * uu + e;
                        const f32x2 d = base - cc[e];
                        const f32x2 lfv = (f32x2){h2f((unsigned short)(lfreg[e] & 0xffffu)), h2f((unsigned short)(lfreg[e] >> 16))};
                        const f32x2 kpp = (1.f - EX2V(lfv)) * EX2V(d);
                        *(LAS unsigned*)(D + T_KPP + tl * KPP_RS + 4 * pp) = cvt_pk_bf16(kpp.x, kpp.y);
                    }
                    dsum0 += bl.x; dsum1 += bl.y;
                }
                if (uu == 0) { *(LAS f32x2*)(D + T_EL + 8 * pp) = EX2V(bl); }
                __builtin_amdgcn_sched_barrier(0);
#if defined(PROF_ID)
                asm volatile("s_waitcnt lgkmcnt(0)" ::: "memory"); PROF_END(2);
#endif
                if (i < 7) SCAN_LOAD(i + 1);
            } else {
                PROF_BEGIN();
                if (FULL) {
                    f32x16 P;
#pragma unroll
                    for (int j = 0; j < 16; ++j) P[j] = 0.f;
#pragma unroll
                    for (int ks = 0; ks < 8; ++ks) {
                        const bf16x8 ka = *(const LAS bf16x8*)(D + T_KB + l31 * KB_RS + (16 * ks + 8 * hh) * 2);
                        const bf16x8 qb = *(const LAS bf16x8*)(D + T_QA + l31 * QA_RS + (16 * ks + 8 * hh) * 2);
                        P = __builtin_amdgcn_mfma_f32_32x32x16_bf16(ka, qb, P, 0, 0, 0);
                    }
                    f32x16 o;
#pragma unroll
                    for (int j = 0; j < 16; ++j) o[j] = 0.f;
#pragma unroll
                    for (int s8 = 0; s8 < 2; ++s8) {
                        const LAS unsigned char* vb = D + T_V + (16 * s8 + 4 * hh + gq) * V_RS + (32 * wg + vcol + 4 * gp) * 2;
                        const bf16x8 vf = tr_pair(vb, vb + 8 * V_RS);
                        u32x4 pw; pw.x = cvt_pk_bf16(P[8 * s8 + 0], P[8 * s8 + 1]) & pmask[4 * s8 + 0]; pw.y = cvt_pk_bf16(P[8 * s8 + 2], P[8 * s8 + 3]) & pmask[4 * s8 + 1];
                        pw.z = cvt_pk_bf16(P[8 * s8 + 4], P[8 * s8 + 5]) & pmask[4 * s8 + 2]; pw.w = cvt_pk_bf16(P[8 * s8 + 6], P[8 * s8 + 7]) & pmask[4 * s8 + 3];
                        o = __builtin_amdgcn_mfma_f32_32x32x16_bf16(__builtin_bit_cast(bf16x8, pw), vf, o, 0, 0, 0);
                    }
#pragma unroll
                    for (int t4 = 0; t4 < 4; ++t4)
#pragma unroll
                        for (int s8 = 0; s8 < 2; ++s8) {
                            const LAS unsigned char* qp = D + T_QP + l31 * QP_RS + (32 * t4 + 16 * s8 + 4 * hh) * 2;
                            const u32x2 lo = *(const LAS u32x2*)qp, hi = *(const LAS u32x2*)(qp + 16);
                            const u32x4 aw = {lo.x, lo.y, hi.x, hi.y};
                            o = __builtin_amdgcn_mfma_f32_32x32x16_bf16(__builtin_bit_cast(bf16x8, aw), pack_acc8(S[t4], s8), o, 0, 0, 0);
                        }
                    const int jsc = dir ? 7 - i : i;
                    LAS unsigned short* ob = (LAS unsigned short*)(OB + (32 * jsc + (dir ? 31 - 4 * hh : 4 * hh)) * 256 + (32 * wg + l31) * 2);
                    const int rs = dir ? -128 : 128;
                    if (i >= 4) {
                        unsigned short pv[16];
#pragma unroll
                        for (int j = 0; j < 16; ++j) pv[j] = ob[((j & 3) + 8 * (j >> 2)) * rs];
#pragma unroll
                        for (int j = 0; j < 16; ++j) o[j] += bf2f(pv[j]);
                    }
#pragma unroll
                    for (int j = 0; j < 16; ++j) ob[((j & 3) + 8 * (j >> 2)) * rs] = (unsigned short)cvt_pk_bf16(o[j], o[j]);
                }
                __builtin_amdgcn_sched_barrier(0);
#pragma unroll
                for (int t4 = 0; t4 < 4; ++t4) {
#pragma unroll
                    for (int g = 0; g < 4; ++g) { const f32x4 f = *(const LAS f32x4*)(D + T_EL + (32 * t4 + 8 * g + 4 * hh) * 4);
                        S[t4][4 * g + 0] *= f[0]; S[t4][4 * g + 1] *= f[1]; S[t4][4 * g + 2] *= f[2]; S[t4][4 * g + 3] *= f[3]; }
#pragma unroll
                    for (int s8 = 0; s8 < 2; ++s8) {
                        const LAS unsigned char* kb = D + T_KPP + (16 * s8 + 8 * hh + gq) * KPP_RS + (32 * t4 + vcol + 4 * gp) * 2;
                        const LAS unsigned char* vb = D + T_V + (16 * s8 + 8 * hh + gq) * V_RS + (32 * wg + vcol + 4 * gp) * 2;
                        const bf16x8 ka = tr_pair(kb, kb + 4 * KPP_RS), vf = tr_pair(vb, vb + 4 * V_RS);
                        S[t4] = __builtin_amdgcn_mfma_f32_32x32x16_bf16(ka, vf, S[t4], 0, 0, 0);
                    }
                }
                PROF_END(3);
            }
        }
        PROF_BEGIN();
        __syncthreads();
        PROF_END(4);
    }
#undef SCAN_LOAD
    PROF_BEGIN();
    if (FULL) {
        float* fin = dir ? fin1 : fin0;
        if (fin && act) {
#pragma unroll
            for (int t4 = 0; t4 < 4; ++t4)
#pragma unroll
                for (int j = 0; j < 16; ++j) fin[(size_t)(32 * t4 + (j & 3) + 8 * (j >> 2) + 4 * hh) * 128 + 32 * wg + l31] = S[t4][j];
        }
        const int cv = tid & 15;
        f32x4 gn0 = *(const f32x4*)(T.gnorm + 8 * cv), gn1 = *(const f32x4*)(T.gnorm + 8 * cv + 4);
        u32x4 gwv[8];
#pragma unroll
        for (int pass = 0; pass < 8; ++pass) gwv[pass] = *(const u32x4*)(T.sg + (size_t)(tok0 + 32 * pass + (tid >> 4)) * 1024 + h * 128 + 8 * cv);
#pragma unroll
        for (int pass = 0; pass < 8; ++pass) {
            const int row = 32 * pass + (tid >> 4);
            const u32x4 ow = *(const LAS u32x4*)(OB + row * 256 + cv * 16);
            bf16_t* gp_ = T.sg + (size_t)(tok0 + row) * 1024 + h * 128 + 8 * cv;
            const u32x4 gw = gwv[pass];
            float ov[8], gv[8];
            const unsigned o4[4] = {ow.x, ow.y, ow.z, ow.w}, g4[4] = {gw.x, gw.y, gw.z, gw.w};
            float ss = 0.f;
#pragma unroll
            for (int j = 0; j < 4; ++j) { ov[2 * j] = __builtin_bit_cast(float, o4[j] << 16); ov[2 * j + 1] = __builtin_bit_cast(float, o4[j] & 0xffff0000u);
                gv[2 * j] = __builtin_bit_cast(float, g4[j] << 16); gv[2 * j + 1] = __builtin_bit_cast(float, g4[j] & 0xffff0000u);
                ss += ov[2 * j] * ov[2 * j] + ov[2 * j + 1] * ov[2 * j + 1]; }
            ss += __shfl_xor(ss, 1); ss += __shfl_xor(ss, 2); ss += __shfl_xor(ss, 4); ss += __shfl_xor(ss, 8);
            const float rstd = rsqrtf(ss * (1.f / 128.f) + 1e-6f);
            u32x4 w;
            w.x = cvt_pk_bf16(ov[0] * rstd * gn0[0] * gv[0], ov[1] * rstd * gn0[1] * gv[1]); w.y = cvt_pk_bf16(ov[2] * rstd * gn0[2] * gv[2], ov[3] * rstd * gn0[3] * gv[3]);
            w.z = cvt_pk_bf16(ov[4] * rstd * gn1[0] * gv[4], ov[5] * rstd * gn1[1] * gv[5]); w.w = cvt_pk_bf16(ov[6] * rstd * gn1[2] * gv[6], ov[7] * rstd * gn1[3] * gv[7]);
            *(u32x4*)gp_ = w;
        }
#if defined(PROF_ID)
        asm volatile("s_waitcnt vmcnt(0)" ::: "memory");
#endif
        __syncthreads(); PROF_END(5);
    } else {
        bf16_t* outs = dir ? outs1 : outs0; float* outd = dir ? outd1 : outd0;
        if (act) {
#pragma unroll
            for (int t4 = 0; t4 < 4; ++t4) {
                u32x4 a, b;
                a.x = cvt_pk_bf16(S[t4][0], S[t4][1]); a.y = cvt_pk_bf16(S[t4][2], S[t4][3]); a.z = cvt_pk_bf16(S[t4][4], S[t4][5]); a.w = cvt_pk_bf16(S[t4][6], S[t4][7]);
                b.x = cvt_pk_bf16(S[t4][8], S[t4][9]); b.y = cvt_pk_bf16(S[t4][10], S[t4][11]); b.z = cvt_pk_bf16(S[t4][12], S[t4][13]); b.w = cvt_pk_bf16(S[t4][14], S[t4][15]);
                u32x4* sp = (u32x4*)(outs + ((size_t)(wg * 4 + t4) * 64 + lane) * 16); sp[0] = a; sp[1] = b;
            }
            const int pp = 16 * wg + (lane & 15); if ((lane >> 4) == 0) { outd[2 * pp] = __builtin_amdgcn_exp2f(dsum0); outd[2 * pp + 1] = __builtin_amdgcn_exp2f(dsum1); }
        }
    }
}
__device__ __forceinline__ size_t slot_of(int dir, int b, int h, int sc) { return (size_t)((dir * 4 + b) * 8 + h) * 16 + sc; }

__device__ __forceinline__ void scan_a_item(LAS unsigned char* lds, const ScanT& T, int it) {
    const int sc = it & 15, h = (it >> 4) & 7, b = it >> 7;
    const size_t sf = slot_of(0, b, h, sc < 15 ? sc + 1 : 0), sb = slot_of(1, b, h, sc > 0 ? sc - 1 : 0);
    scan_item<false>(lds, T, 4096 + b * 4096 + sc * 256, h, sc < 15, sc > 0, nullptr, nullptr, nullptr, nullptr, T.slots + sf * SLOT_ELEMS, T.slots + sb * SLOT_ELEMS, T.dvec + sf * 128, T.dvec + sb * 128);
}
__device__ __forceinline__ void scan_ctx_item(LAS unsigned char* lds, const ScanT& T, int ci) {
    const int h = ci & 7, b = ci >> 3;
    float* ns = T.new_state + (size_t)(b * 2) * 8 * 16384 + (size_t)h * 16384;
    scan_item<true>(lds, T, b * 256, h, true, true, nullptr, nullptr, ns, ns + (size_t)8 * 16384, nullptr, nullptr, nullptr, nullptr);
}
__device__ __forceinline__ void scan_phase_a(LAS unsigned char* lds, const ScanT& T, int G, int bx) {
    if (G == 256) {
        if (bx < 128) { scan_ctx_item(lds, T, bx); scan_a_item(lds, T, 384 + bx); }
        else { for (int k = 0; k < 3; ++k) scan_a_item(lds, T, (bx - 128) * 3 + k); }
    } else {
        for (int it = bx; it < 640; it += G) { if (it < 512) scan_a_item(lds, T, it); else scan_ctx_item(lds, T, it - 512); }
    }
}
__device__ __forceinline__ void scan_phase_b(const ScanT& T, int G, int bx, int tid) {
    for (int gid = bx * NTHREADS + tid; gid < 64 * 2048; gid += G * NTHREADS) {
        const int combo = gid >> 11, e = (gid & 2047) * 8, dir = combo >> 5, b = (combo >> 3) & 3, h = combo & 7;
        const int reg0 = e & 15, ln = (e >> 4) & 63, t4 = (e >> 10) & 3, w = (e >> 12) & 3;
        const int v = 32 * w + (ln & 31);
        float s[8]; int kk[8];
#pragma unroll
        for (int j = 0; j < 8; ++j) { const int rg = reg0 + j; kk[j] = 32 * t4 + (rg & 3) + 8 * (rg >> 2) + 4 * (ln >> 5); s[j] = T.state_in[((size_t)((b * 2 + dir) * 8 + h) * 128 + kk[j]) * 128 + v]; }
        u32x4 lwn = (u32x4){0u, 0u, 0u, 0u}; float dn[8];
#pragma unroll
        for (int j = 0; j < 8; ++j) dn[j] = 0.f;
        { const size_t sl1 = slot_of(dir, b, h, dir ? 14 : 1); lwn = *(const u32x4*)(T.slots + sl1 * SLOT_ELEMS + e);
#pragma unroll
          for (int j = 0; j < 8; ++j) dn[j] = T.dvec[sl1 * 128 + kk[j]]; }
        for (int st = 0; st < 16; ++st) {
            const int sc = dir ? 15 - st : st;
            const size_t sl = slot_of(dir, b, h, sc);
            u32x4* sp = (u32x4*)(T.slots + sl * SLOT_ELEMS + e);
            if (st > 0) {
                const u32x4 lw = lwn; float dc[8];
#pragma unroll
                for (int j = 0; j < 8; ++j) dc[j] = dn[j];
                if (st < 15) { const size_t sl2 = slot_of(dir, b, h, dir ? 14 - st : st + 1); lwn = *(const u32x4*)(T.slots + sl2 * SLOT_ELEMS + e);
#pragma unroll
                    for (int j = 0; j < 8; ++j) dn[j] = T.dvec[sl2 * 128 + kk[j]]; }
                const unsigned l4[4] = {lw.x, lw.y, lw.z, lw.w};
#pragma unroll
                for (int j = 0; j < 4; ++j) { s[2 * j] = dc[2 * j] * s[2 * j] + __builtin_bit_cast(float, l4[j] << 16);
                    s[2 * j + 1] = dc[2 * j + 1] * s[2 * j + 1] + __builtin_bit_cast(float, l4[j] & 0xffff0000u); }
            }
            u32x4 o; o.x = cvt_pk_bf16(s[0], s[1]); o.y = cvt_pk_bf16(s[2], s[3]); o.z = cvt_pk_bf16(s[4], s[5]); o.w = cvt_pk_bf16(s[6], s[7]);
            *sp = o;
        }
    }
}
__device__ __forceinline__ void scan_phase_c(LAS unsigned char* lds, const ScanT& T, int G, int bx) {
    for (int it = bx; it < 512; it += G) {
        const int sc = it & 15, h = (it >> 4) & 7, b = it >> 7;
        scan_item<true>(lds, T, 4096 + b * 4096 + sc * 256, h, true, true, T.slots + slot_of(0, b, h, sc) * SLOT_ELEMS, T.slots + slot_of(1, b, h, sc) * SLOT_ELEMS,
                        nullptr, nullptr, nullptr, nullptr, nullptr, nullptr);
    }
}

#define XB_TMO      128
#define XB_XCNT(j)  (256  + 64 * (j))
#define XB_XSUB(j)  (1280 + 64 * (j))
#define XB_XGEN(j)  (2304 + 64 * (j))
#define XB_TOP      3328
#define XB_TOPGEN   3392
#define XCD_BAR_WORDS 3456
#define XB_SPIN_CAP (1u << 18)
__device__ __forceinline__ unsigned xb_ld(unsigned* p)              { return __hip_atomic_load(p, __ATOMIC_RELAXED, __HIP_MEMORY_SCOPE_AGENT); }
__device__ __forceinline__ unsigned xb_add(unsigned* p, unsigned v) { return __hip_atomic_fetch_add(p, v, __ATOMIC_RELAXED, __HIP_MEMORY_SCOPE_AGENT); }
__device__ __forceinline__ unsigned xb_xcc_id() { return (unsigned)__builtin_amdgcn_s_getreg((3 << 11) | 20) & 0xFu; }
#define XB_SPIN(cond, bar) do { unsigned _sp = 0; while (cond) { __builtin_amdgcn_s_sleep(1); \
    if ((++_sp & 255u) == 0u) { if (xb_ld(&(bar)[XB_TMO])) break; if (_sp > XB_SPIN_CAP) { atomicAdd(&(bar)[XB_TMO], 1u); break; } } } } while (0)
struct XcdBarrier { unsigned* bar; unsigned x; volatile LAS unsigned* st; };
__device__ __forceinline__ XcdBarrier xcd_barrier_post(unsigned* bar, volatile LAS unsigned* st) {
    XcdBarrier b; b.bar = bar; b.x = xb_xcc_id(); b.st = st;
    if (threadIdx.x == 0) (void)xb_add(&bar[XB_XCNT(b.x)], 1u);
    return b;
}
__device__ __forceinline__ void xcd_barrier_complete(unsigned* bar, unsigned x, unsigned& nloc, unsigned& nx) {
    const unsigned G = gridDim.x * gridDim.y * gridDim.z;
    unsigned sum, cnt, mine, sp = 0u;
    for (;;) {
        sum = 0u; cnt = 0u; mine = 0u;
#pragma unroll
        for (unsigned j = 0; j < 16; ++j) { const unsigned c = xb_ld(&bar[XB_XCNT(j)]); sum += c; cnt += (c > 0u) ? 1u : 0u; mine = (j == x) ? c : mine; }
        if (sum == G) break;
        __builtin_amdgcn_s_sleep(1);
        if ((++sp & 255u) == 0u) { if (xb_ld(&bar[XB_TMO])) break; if (sp > XB_SPIN_CAP) { atomicAdd(&bar[XB_TMO], 1u); break; } }
    }
    nloc = mine > 0u ? mine : 1u; nx = cnt > 0u ? cnt : 1u;
}
__device__ __forceinline__ void xcd_barrier(const XcdBarrier& b) {
    asm volatile("s_waitcnt vmcnt(0)" ::: "memory");
    __syncthreads();
    if (threadIdx.x == 0) {
        unsigned* bar = b.bar;
        __builtin_amdgcn_s_waitcnt(0);
        unsigned nloc = b.st[0], nx = b.st[1];
        if (nloc == 0u) { xcd_barrier_complete(bar, b.x, nloc, nx); b.st[0] = nloc; b.st[1] = nx; }
        const unsigned old = xb_add(&bar[XB_XSUB(b.x)], 1u);
        const unsigned gen = old / nloc;
        if (old + 1u == (gen + 1u) * nloc) {
            __builtin_amdgcn_fence(__ATOMIC_RELEASE, "agent");
            asm volatile("s_waitcnt vmcnt(0)" ::: "memory");
            const unsigned og = xb_add(&bar[XB_TOP], 1u);
            const unsigned tg = og / nx;
            if (og + 1u == (tg + 1u) * nx) xb_add(&bar[XB_TOPGEN], 1u);
            else XB_SPIN(xb_ld(&bar[XB_TOPGEN]) == tg, bar);
            __builtin_amdgcn_fence(__ATOMIC_ACQUIRE, "agent");
            xb_add(&bar[XB_XGEN(b.x)], 1u);
            asm volatile("s_waitcnt vmcnt(0)" ::: "memory");
        } else {
            XB_SPIN(xb_ld(&bar[XB_XGEN(b.x)]) == gen, bar);
            __builtin_amdgcn_fence(__ATOMIC_ACQUIRE, "agent");
            asm volatile("s_waitcnt vmcnt(0)" ::: "memory");
        }
    }
    __syncthreads();
}

struct Args { const float* in[17]; float* out; unsigned char* ws; int ph_lo, ph_hi; };
enum { PH_PREP = 0, PH_EMBED = 1, PH_FN_CHAN = 2, PH_FN_POS1 = 3, PH_FN_POS2 = 4, PH_FN_WO = 5, PH_NORM_MLP0 = 6, PH_MLP1_0 = 7, PH_MLP2_0 = 8, PH_NORM_MIX1 = 9, PH_WIN = 10,
       PH_SCAN_A = 11, PH_SCAN_B = 12, PH_SCAN_C = 13, PH_HG_WO = 14, PH_NORM_MLP1 = 15, PH_MLP1_1 = 16, PH_MLP2_1 = 17, PH_FINAL = 18, PH_END = 19 };
constexpr int LDS_BYTES = 160 * 1024, MISC_OFF = LDS_BYTES - 512;

__global__ void __launch_bounds__(NTHREADS, 2) fwd(Args a) {
    extern __shared__ __attribute__((aligned(16))) unsigned char lds_raw[];
    LAS unsigned char* lds = (LAS unsigned char*)lds_raw;
    const int tid = threadIdx.x, lane = tid & 63, wave = __builtin_amdgcn_readfirstlane(tid >> 6);
    const int G = gridDim.x, bx = blockIdx.x;
    const int gw = bx * NWAVES + wave, ngw = G * NWAVES;
    unsigned char* ws = a.ws;
    const float* mod = (const float*)(ws + WM.mod);
    bf16_t* Hb = (bf16_t*)(ws + WM.h);
    bf16_t* Big = (bf16_t*)(ws + WM.big[0]); bf16_t* Big1 = (bf16_t*)(ws + WM.big[1]);
    const float* norm_mlp = a.in[8];
    const float* w1 = a.in[14]; const float* w2 = a.in[15];
    const float* norm_mix = a.in[7]; const float* fnet_wo = a.in[9];
    float* modw = (float*)(ws + WM.mod);
#define IN(k) (a.ph_lo <= (k) && (k) < a.ph_hi)
    if (tid < 128) ((LAS unsigned*)(lds + MISC_OFF))[tid] = 0u;
    __syncthreads();
    XcdBarrier bar = xcd_barrier_post((unsigned*)ws, (volatile LAS unsigned*)(lds + MISC_OFF));
#if defined(PROBE_A)
#define STAMP(k) do { if (bx == 0 && tid == 0) ((LAS unsigned long long*)(lds + MISC_OFF + 64))[(k)] = __builtin_amdgcn_s_memrealtime(); } while (0)
#else
#define STAMP(k) do { } while (0)
#endif
    STAMP(0);
#define SEAM(k) do { if (IN(k) && IN((k) + 1)) xcd_barrier(bar); STAMP((k) + 1); } while (0)
    if (IN(PH_PREP)) {
        LAS float* scr = (LAS float*)(lds + wave * 16384);
        constexpr int I_1 = (1024 / 64) * (4096 / 32), I_2 = (4096 / 64) * (1024 / 32);
        constexpr int I_F = (1024 / 64) * (1024 / 32), I_W = (1024 / 64) * (5120 / 32);
        constexpr int NITEMS = I_1 + I_2 + I_F + I_F + I_W;
        LAS unsigned char* prof_lds_ = (LAS unsigned char*)0; (void)prof_lds_; PROF_DECL; PROF_BEGIN();
        for (int un = bx; un < 384; un += G) mod_unit(lds, un, a.in[3], a.in[4], a.in[5], a.in[6], modw, tid, wave, lane);
        if (bx == G - 1) for (int i = tid; i < 2048; i += NTHREADS) { const int dir = i >> 10, ch = i & 1023; const float l0 = a.in[11][(dir * 2 + 0) * 1024 + ch], l1 = a.in[11][(dir * 2 + 1) * 1024 + ch];
            const float mx = fmaxf(l0, l1), e0 = __expf(l0 - mx), e1 = __expf(l1 - mx); ((float*)(ws + WM.lb))[i] = e1 / (e0 + e1); }
        PROF_END(60); PROF_BEGIN();
        gen_tables(ws, (long)bx * NTHREADS + tid, (long)G * NTHREADS);
        PROF_END(61); PROF_BEGIN();
        transpose_stream(gw, NITEMS, ngw, [&](int it) -> TrItem {
            int r = it;
            if (r < I_F) return TrItem{fnet_wo, (bf16_t*)(ws + WM.wfnet), 1024, 1024, r}; r -= I_F;
            if (r < I_F) return TrItem{a.in[13], (bf16_t*)(ws + WM.who), 1024, 1024, r}; r -= I_F;
            if (r < I_W) return TrItem{a.in[10], (bf16_t*)(ws + WM.win), 1024, 5120, r}; r -= I_W;
            if (r < I_1) return TrItem{w1, (bf16_t*)(ws + WM.w1[0]), 1024, 4096, r}; r -= I_1;
            return TrItem{w2, (bf16_t*)(ws + WM.w2[0]), 4096, 1024, r}; }, scr, lane);
        PROF_END(62);
    }
    SEAM(PH_PREP);
    if (IN(PH_EMBED)) embed_rows(a.in[0], a.in[1], (const float*)(ws + WM.pos), (const float*)(ws + WM.pos) + 64 * 512, norm_mix, mod, Hb, gw, ngw, lane);
    SEAM(PH_EMBED);
    if (IN(PH_FN_CHAN)) {
        { ProbChan p; p.init(0, ws + WM.dftc, Hb, (bf16_t*)(ws + WM.yctx), G, bx); gemm_phase<ProbChan, true, true>(lds, p); }
        { ProbChan p; p.init(1, ws + WM.dftc, Hb, (bf16_t*)(ws + WM.ysmp), G, bx); gemm_phase<ProbChan, true, true>(lds, p); }
    }
    SEAM(PH_FN_CHAN);
    if (IN(PH_FN_POS1)) {
        { ProbPosCtx p; p.init(ws + WM.dl256, (const bf16_t*)(ws + WM.yctx), Hb, G, bx); gemm_phase<ProbPosCtx, true, true>(lds, p); }
        { ProbSmpA p; p.init(ws + WM.fa2, (const bf16_t*)(ws + WM.ysmp), (bf16_t*)(ws + WM.u), G, bx); gemm_phase<ProbSmpA, true, true>(lds, p); }
    }
    SEAM(PH_FN_POS1);
    if (IN(PH_FN_POS2)) { ProbSmpB p; p.init(ws + WM.mb, (const bf16_t*)(ws + WM.u), Hb, G, bx); gemm_phase<ProbSmpB, true, true>(lds, p); }
    SEAM(PH_FN_POS2);
    if (IN(PH_FN_WO)) { ProbResidFirst p; p.init_tok(Hb, 1024, ws + WM.wfnet, 1024, 0, 80, 4, G, bx); p.X = (bf16_t*)a.out; p.mod = mod; p.layer = 0; p.gidx = 2; p.init_split(G, bx, (unsigned short*)(ws + SLAB_FN)); p.xp = a.in[0]; p.xs = a.in[1]; p.er = (const float*)(ws + WM.pos); p.ec = p.er + 64 * 512; p.prof_id = 20; gemm_phase<ProbResidFirst, true, true>(lds, p); }
    SEAM(PH_FN_WO);
    if (IN(PH_NORM_MLP0)) { build_split_table(lds, G, tid); norm_rows((bf16_t*)a.out, 0, 20480, norm_mlp, mod, 0, 3, Hb, gw, ngw, lane, lds, (const unsigned short*)(ws + SLAB_FN)); }
    SEAM(PH_NORM_MLP0);
    if (IN(PH_MLP1_0)) { ProbMlp1 p; p.init_tok(Hb, 1024, ws + WM.w1[0], 1024, 0, 80, 4096 / BM, G, bx); p.O = Big; p.ldc = 4096; p.prof_id = 40; gemm_phase<ProbMlp1, true, true>(lds, p); }
    SEAM(PH_MLP1_0);
    if (IN(PH_MLP2_0)) { ProbResid p; p.init_tok(Big, 4096, ws + WM.w2[0], 4096, 0, 80, 1024 / BM, G, bx); p.X = (bf16_t*)a.out; p.mod = mod; p.layer = 0; p.gidx = 5; p.init_split(G, bx, (unsigned short*)(ws + SLAB_M0)); gemm_phase<ProbResid, true, true>(lds, p); }
    SEAM(PH_MLP2_0);
    if (IN(PH_NORM_MIX1)) { build_split_table(lds, G, tid); norm_rows((bf16_t*)a.out, 0, 20480, norm_mix + 1024, mod, 1, 0, Hb, gw, ngw, lane, lds, (const unsigned short*)(ws + SLAB_M0)); }
    SEAM(PH_NORM_MIX1);
    if (IN(PH_WIN)) { ProbWin p; p.init_tok(Hb, 1024, ws + WM.win, 1024, 0, 80, 20, G, bx); p.Oq = (bf16_t*)(ws + WM.q); p.Offw = (bf16_t*)(ws + WM.lffw); p.Ofbw = (bf16_t*)(ws + WM.lfbw);
        p.Ov = (bf16_t*)(ws + WM.v); p.Osg = (bf16_t*)(ws + WM.sg); p.lb = (const float*)(ws + WM.lb); p.prof_id = 50; gemm_phase<ProbWin, true, true>(lds, p); }
    SEAM(PH_WIN);
    if (IN(PH_SCAN_A) || IN(PH_SCAN_B) || IN(PH_SCAN_C)) {
        ScanT st; st.q = (const bf16_t*)(ws + WM.q); st.lffw = (const bf16_t*)(ws + WM.lffw); st.lfbw = (const bf16_t*)(ws + WM.lfbw); st.v = (const bf16_t*)(ws + WM.v); st.sg = (bf16_t*)(ws + WM.sg);
        st.slots = (bf16_t*)(ws + WM.slots); st.dvec = (float*)(ws + WM.dvec); st.gnorm = a.in[12]; st.state_in = a.in[2]; st.new_state = a.out + (size_t)20480 * 1024;
        if (IN(PH_SCAN_A)) scan_phase_a(lds, st, G, bx);
        SEAM(PH_SCAN_A);
        if (IN(PH_SCAN_B)) scan_phase_b(st, G, bx, tid);
        SEAM(PH_SCAN_B);
        if (IN(PH_SCAN_C)) scan_phase_c(lds, st, G, bx);
    }
    SEAM(PH_SCAN_C);
    if (IN(PH_HG_WO)) {
        { LAS float* scr = (LAS float*)(lds + wave * 16384);
          constexpr int I_1 = (1024 / 64) * (4096 / 32), I_2 = (4096 / 64) * (1024 / 32);
          transpose_stream(gw, I_1 + I_2, ngw, [&](int it) -> TrItem {
              if (it < I_1) return TrItem{w1 + (size_t)1024 * 4096, (bf16_t*)(ws + WM.w1[1]), 1024, 4096, it};
              return TrItem{w2 + (size_t)4096 * 1024, (bf16_t*)(ws + WM.w2[1]), 4096, 1024, it - I_1}; }, scr, lane);
          __syncthreads(); }
        ProbResid p; p.init_tok((bf16_t*)(ws + WM.sg), 1024, ws + WM.who, 1024, 0, 80, 4, G, bx); p.X = (bf16_t*)a.out; p.mod = mod; p.layer = 1; p.gidx = 2; p.init_split(G, bx, (unsigned short*)(ws + SLAB_HG)); gemm_phase<ProbResid, true, true>(lds, p); }
    SEAM(PH_HG_WO);
    if (IN(PH_NORM_MLP1)) { build_split_table(lds, G, tid); norm_rows((bf16_t*)a.out, 0, 20480, norm_mlp + 1024, mod, 1, 3, Hb, gw, ngw, lane, lds, (const unsigned short*)(ws + SLAB_HG)); }
    SEAM(PH_NORM_MLP1);
    if (IN(PH_MLP1_1)) { ProbMlp1 p; p.init_tok(Hb, 1024, ws + WM.w1[1], 1024, 0, 80, 4096 / BM, G, bx); p.O = Big1; p.ldc = 4096; gemm_phase<ProbMlp1, true, true>(lds, p); }
    SEAM(PH_MLP1_1);
    if (IN(PH_MLP2_1)) { ProbResid p; p.init_tok(Big1, 4096, ws + WM.w2[1], 4096, 0, 80, 1024 / BM, G, bx); p.X = (bf16_t*)a.out; p.mod = mod; p.layer = 1; p.gidx = 5; p.init_split(G, bx, (unsigned short*)(ws + SLAB_M1)); gemm_phase<ProbResid, true, true>(lds, p); }
    SEAM(PH_MLP2_1);
    if (IN(PH_FINAL)) { build_split_table(lds, G, tid); final_rows(a.out, 0, 20480, a.in[16], gw, ngw, lane, lds, (const unsigned short*)(ws + SLAB_M1)); }
#if defined(PROF_ID)
    if (bx == 0 && tid == 0) { const unsigned long long d = *(LAS unsigned long long*)(lds + LDS_BYTES - 512 + 256); const unsigned long long t0 = __builtin_amdgcn_s_memrealtime(); while (__builtin_amdgcn_s_memrealtime() - t0 < 16ull * d) __builtin_amdgcn_s_sleep(8); }
#endif
#if defined(PROBE_A)
    if (bx == 0 && tid == 0) { asm volatile("s_waitcnt vmcnt(0)" ::: "memory"); STAMP(PH_END); const unsigned long long d = ((LAS unsigned long long*)(lds + MISC_OFF + 64))[PROBE_B] - ((LAS unsigned long long*)(lds + MISC_OFF + 64))[PROBE_A];
        const unsigned long long t0 = __builtin_amdgcn_s_memrealtime(); while (__builtin_amdgcn_s_memrealtime() - t0 < 4ull * d) __builtin_amdgcn_s_sleep(8); }
#endif
#undef IN
}
}
#ifndef MK_N_LAUNCHES
#define MK_N_LAUNCHES 1
#endif
extern "C" void kernel_launch(void* const* d_in, const int* in_sizes, int n_in, void* d_out, int out_size, void* d_ws, size_t ws_size, hipStream_t stream) {
    static int grid = 0;
    if (grid == 0) {
        int dev = 0, cus = 0;
        if (hipGetDevice(&dev) != hipSuccess || hipDeviceGetAttribute(&cus, hipDeviceAttributeMultiprocessorCount, dev) != hipSuccess || cus <= 0) cus = 256;
        hipFuncSetAttribute((const void*)fk::fwd, hipFuncAttributeMaxDynamicSharedMemorySize, fk::LDS_BYTES);
        int per_cu = 0;
        if (hipOccupancyMaxActiveBlocksPerMultiprocessor(&per_cu, (const void*)fk::fwd, fk::NTHREADS, fk::LDS_BYTES) != hipSuccess || per_cu < 1)
            fprintf(stderr, "kernel_launch: occupancy query reports %d workgroups per CU\n", per_cu);
        (void)hipGetLastError();
        grid = cus;
    }
    hipMemsetAsync(d_ws, 0, fk::CTL_BYTES, stream);
    fk::Args a{};
    for (int i = 0; i < 17; ++i) a.in[i] = (const float*)d_in[i];
    a.out = (float*)d_out; a.ws = (unsigned char*)d_ws;
#if MK_N_LAUNCHES == 1
    a.ph_lo = 0; a.ph_hi = fk::PH_END;
    hipLaunchKernelGGL(fk::fwd, dim3(grid), dim3(fk::NTHREADS), fk::LDS_BYTES, stream, a);
#else
    for (int ph = 0; ph < fk::PH_END; ++ph) { a.ph_lo = ph; a.ph_hi = ph + 1; hipLaunchKernelGGL(fk::fwd, dim3(grid), dim3(fk::NTHREADS), fk::LDS_BYTES, stream, a); }
#endif
}
```

```cpp
#include <hip/hip_runtime.h>
#include <cstdint>
#include <cstdio>
namespace fk {
#define LAS __attribute__((address_space(3)))
#define GAS __attribute__((address_space(1)))
typedef unsigned short bf16_t;
typedef short bf16x8 __attribute__((ext_vector_type(8)));
typedef float f32x4 __attribute__((ext_vector_type(4)));
typedef float f32x2 __attribute__((ext_vector_type(2)));
typedef unsigned u32x4 __attribute__((ext_vector_type(4)));
typedef unsigned u32x2 __attribute__((ext_vector_type(2)));
constexpr int BM = 256, BK = 64, HALF = 128, HTB = HALF * BK * 2, STAGE_BYTES = 8 * HTB, NXCD = 8, WGM = 8;
constexpr int NWAVES = 8, NTHREADS = 512;

__device__ __forceinline__ int lds_byte(int r, int c) { const int st = (r >> 4) * 2 + (c >> 5), rr = r & 15, cc = c & 31, ob = rr * 64 + cc * 2; return st * 1024 + (ob ^ (((ob >> 9) & 1) << 5)); }
__device__ __forceinline__ void stage_rc(int b, int& R, int& C) { const int st = b / 1024, sb = b % 1024, swz = sb ^ (((sb >> 9) & 1) << 5); R = (st >> 1) * 16 + swz / 64; C = (st & 1) * 32 + (swz % 64) / 2; }
__device__ __forceinline__ int perm32(int rho) { const int n = rho >> 4, i = rho & 15; return 8 * (i >> 2) + 4 * n + (i & 3); }
typedef __bf16 bf16x2_cv __attribute__((ext_vector_type(2)));
__device__ __forceinline__ unsigned cvt_pk_bf16(float lo, float hi) { const f32x2 v = {lo, hi}; const bf16x2_cv b = __builtin_convertvector(v, bf16x2_cv); return __builtin_bit_cast(unsigned, b); }
__device__ __forceinline__ unsigned f2bf(float f) { unsigned u = __builtin_bit_cast(unsigned, f); return (u + 0x7fffu + ((u >> 16) & 1u)) >> 16; }
__device__ __forceinline__ unsigned pk2(float lo, float hi) { return f2bf(lo) | (f2bf(hi) << 16); }
__device__ __forceinline__ float bf2f(unsigned short b) { return __builtin_bit_cast(float, (unsigned)b << 16); }
__device__ __forceinline__ unsigned pk2h(float lo, float hi) { const _Float16 a = (_Float16)lo, b = (_Float16)hi; return (unsigned)__builtin_bit_cast(unsigned short, a) | ((unsigned)__builtin_bit_cast(unsigned short, b) << 16); }
__device__ __forceinline__ float h2f_(unsigned short b) { return (float)__builtin_bit_cast(_Float16, b); }
__device__ __forceinline__ f32x4 ld_bf4(const void* p) { const u32x2 w = *(const u32x2*)p; return (f32x4){__builtin_bit_cast(float, w.x << 16), __builtin_bit_cast(float, w.x & 0xffff0000u), __builtin_bit_cast(float, w.y << 16), __builtin_bit_cast(float, w.y & 0xffff0000u)}; }
__device__ __forceinline__ void st_bf4(void* p, const f32x4& v) { u32x2 w; w.x = cvt_pk_bf16(v[0], v[1]); w.y = cvt_pk_bf16(v[2], v[3]); *(u32x2*)p = w; }
__device__ __forceinline__ void bf8_to_f32(const u32x4& w, f32x4& a, f32x4& b) {
    a = (f32x4){__builtin_bit_cast(float, w.x << 16), __builtin_bit_cast(float, w.x & 0xffff0000u), __builtin_bit_cast(float, w.y << 16), __builtin_bit_cast(float, w.y & 0xffff0000u)};
    b = (f32x4){__builtin_bit_cast(float, w.z << 16), __builtin_bit_cast(float, w.z & 0xffff0000u), __builtin_bit_cast(float, w.w << 16), __builtin_bit_cast(float, w.w & 0xffff0000u)}; }
__device__ __forceinline__ float silu(float x) { return x / (1.f + __expf(-x)); }
__device__ __forceinline__ float wave_sum(float v) {
#pragma unroll
    for (int o = 1; o < 64; o <<= 1) v += __shfl_xor(v, o);
    return v;
}

constexpr unsigned long long KiB = 1024ull, MiB = 1ull << 20;
struct WsMapT { unsigned long long slots, dvec, lb, q, lffw, lfbw, v, sg, mod, pos, dftc, dl256, fa2, mb, wfnet, who, win, w1[2], w2[2], h, yctx, ysmp, u, big[2]; };
constexpr WsMapT WM = {   13 * MiB,   45 * MiB,   320 * KiB,   53 * MiB,   93 * MiB,   133 * MiB,   173 * MiB,   213 * MiB,   64 * KiB,   512 * KiB,
      53 * MiB,   53 * MiB + 256 * KiB,   53 * MiB + 512 * KiB,   54 * MiB,   59 * MiB,   1 * MiB,   3 * MiB,   {61 * MiB, 53 * MiB},   {237 * MiB, 61 * MiB},
      13 * MiB,   77 * MiB,   93 * MiB,   157 * MiB,   {77 * MiB, 69 * MiB} };
constexpr unsigned long long SLAB_FN = 77 * MiB, SLAB_M0 = 53 * MiB, SLAB_HG = 69 * MiB, SLAB_M1 = 13 * MiB;
constexpr unsigned long long CNT_OFF = 768 * KiB;
constexpr unsigned long long CTL_BYTES = 16 * KiB;
#if defined(PROF_ID)
#define PROF_DECL unsigned long long prof_t0_ = 0ull; const bool prof_on_ = (blockIdx.x == 0) && (__builtin_amdgcn_readfirstlane(threadIdx.x >> 6) == 0)
#define PROF_BEGIN() do { if (prof_on_) prof_t0_ = __builtin_amdgcn_s_memrealtime(); } while (0)
#define PROF_END(id) do { if (prof_on_ && (id) == PROF_ID) { const unsigned long long d_ = __builtin_amdgcn_s_memrealtime() - prof_t0_; if (threadIdx.x == 0) *(LAS unsigned long long*)(prof_lds_ + 160 * 1024 - 512 + 256) += d_; } } while (0)
#else
#define PROF_DECL
#define PROF_BEGIN() do { } while (0)
#define PROF_END(id) do { } while (0)
#endif

struct Unit { size_t offA, offB; int p0, p1, p2, p3, nt; };
struct OpMap { int rm; unsigned s1, s2; };
__device__ __forceinline__ unsigned rowoff(const OpMap& m, int R) { return (unsigned)(R % m.rm) * m.s1 + (unsigned)(R / m.rm) * m.s2; }

template <class P, bool ALIGN_EPI, bool SP2>
__device__ __forceinline__ void gemm_phase(LAS unsigned char* lds, const P& pb) {
    const int tid = threadIdx.x, wid = __builtin_amdgcn_readfirstlane(tid >> 6), lane = tid & 63, wr = wid >> 2, wc = wid & 3, fr = lane & 15, fq = lane >> 4;
    unsigned voffA[2], voffB[2];
#pragma unroll
    for (int i = 0; i < 2; ++i) { int R, C; stage_rc(tid * 16 + i * 8192, R, C); const int Rb = P::PERM ? ((R & ~31) + perm32(R & 31)) : R;
        voffA[i] = rowoff(pb.ma, R) + (unsigned)C * 2u; voffB[i] = rowoff(pb.mb, Rb) + (unsigned)C * 2u; }
    const size_t kstepA = pb.kstepA, kstepB = pb.kstepB, hstepA = pb.hstepA, hstepB = pb.hstepB;
    const unsigned ldsw = (unsigned)wid * 1024u;
    const int aoff = lds_byte(wr * 64 + fr, fq * 8), boff = lds_byte(wc * 32 + fr, fq * 8);
#define PG8_SA(b, h) (((b) * 2 + (h)) * HTB)
#define PG8_SB(b, h) ((4 + (b) * 2 + (h)) * HTB)
#define PG8_STAGE(bufoff, gbase, voff) do { _Pragma("unroll") for (int _i = 0; _i < 2; ++_i) \
        __builtin_amdgcn_global_load_lds((const unsigned*)((const char*)(gbase) + (voff)[_i]), (LAS unsigned*)(lds + (bufoff) + ldsw + _i * 8192), 16, 0, 0); } while (0)
#define PG8_LDA(dst, b, h) do { _Pragma("unroll") for (int m = 0; m < 4; ++m) _Pragma("unroll") for (int k = 0; k < 2; ++k) dst[m][k] = *(const LAS bf16x8*)(lds + PG8_SA(b, h) + aoff + m * 2048 + k * 1024); } while (0)
#define PG8_LDB(dst, b, h) do { _Pragma("unroll") for (int n = 0; n < 2; ++n) _Pragma("unroll") for (int k = 0; k < 2; ++k) dst[n][k] = *(const LAS bf16x8*)(lds + PG8_SB(b, h) + boff + n * 2048 + k * 1024); } while (0)
#define PG8_MMA(ai, bj, At, Bt) do { __builtin_amdgcn_s_setprio(1); _Pragma("unroll") for (int m = 0; m < 4; ++m) _Pragma("unroll") for (int n = 0; n < 2; ++n) _Pragma("unroll") for (int k = 0; k < 2; ++k) \
        acc[ai][bj][m][n] = __builtin_amdgcn_mfma_f32_16x16x32_bf16(Bt[n][k], At[m][k], acc[ai][bj][m][n], 0, 0, 0); __builtin_amdgcn_s_setprio(0); } while (0)
#define PG8_WAIT_V(n) asm volatile("s_waitcnt vmcnt(" #n ")" ::: "memory")
#define PG8_WAIT_L(n) asm volatile("s_waitcnt lgkmcnt(" #n ")" ::: "memory")
#define PG8_BAR __builtin_amdgcn_s_barrier()
#define PG8_SCHED __builtin_amdgcn_sched_barrier(0)
    LAS unsigned char* prof_lds_ = (LAS unsigned char*)0; (void)prof_lds_; PROF_DECL; PROF_BEGIN();
    Unit cur, nxt; int ui = 0;
    if (!pb.next(0, cur)) return;
    f32x4 acc[2][2][4][2];
#pragma unroll
    for (int a = 0; a < 2; ++a)
#pragma unroll
        for (int b = 0; b < 2; ++b)
#pragma unroll
            for (int m = 0; m < 4; ++m)
#pragma unroll
                for (int n = 0; n < 2; ++n) acc[a][b][m][n] = (f32x4){0.f, 0.f, 0.f, 0.f};
    bf16x8 At[4][2], B0[2][2], B1[2][2];
    const char* cA = pb.A + cur.offA; const char* cB = pb.B + cur.offB;
    if constexpr (SP2) {
        PG8_STAGE(PG8_SB(0, 0), cB, voffB); PG8_STAGE(PG8_SB(0, 1), cB + hstepB, voffB); PG8_STAGE(PG8_SA(0, 0), cA, voffA); PG8_STAGE(PG8_SA(0, 1), cA + hstepA, voffA);
        if (wr == 1) PG8_BAR;
        PG8_WAIT_V(2); PG8_BAR;
        PG8_STAGE(PG8_SB(1, 0), cB + kstepB, voffB); PG8_STAGE(PG8_SA(1, 0), cA + kstepA, voffA); PG8_STAGE(PG8_SB(1, 1), cB + hstepB + kstepB, voffB);
        PG8_WAIT_V(6); PG8_BAR;
    } else {
        PG8_STAGE(PG8_SB(0, 0), cB, voffB); PG8_STAGE(PG8_SA(0, 0), cA, voffA); PG8_STAGE(PG8_SB(0, 1), cB + hstepB, voffB); PG8_STAGE(PG8_SA(0, 1), cA + hstepA, voffA);
        if (wr == 1) PG8_BAR;
        PG8_WAIT_V(4); PG8_BAR;
        PG8_STAGE(PG8_SB(1, 0), cB + kstepB, voffB); PG8_STAGE(PG8_SA(1, 0), cA + kstepA, voffA); PG8_STAGE(PG8_SB(1, 1), cB + hstepB + kstepB, voffB);
        PG8_WAIT_V(6); PG8_BAR;
    }
    for (;;) {
        const bool has_next = pb.next(ui + 1, nxt);
        const char* nA = has_next ? pb.A + nxt.offA : cA; const char* nB = has_next ? pb.B + nxt.offB : cB;
        const int nt = cur.nt;
        for (int t = 0; t < nt; t += 2) {
            const bool last = (t == nt - 2);
            const char* a1 = cA + (size_t)(t + 1) * kstepA;
            const char* a2 = last ? nA : cA + (size_t)(t + 2) * kstepA; const char* b2 = last ? nB : cB + (size_t)(t + 2) * kstepB;
            const char* a3 = a2 + kstepA; const char* b3 = b2 + kstepB;
            if constexpr (SP2) {
            PG8_LDB(B0, 0, 0); PG8_LDB(B1, 0, 1); PG8_SCHED; PG8_LDA(At, 0, 0); PG8_STAGE(PG8_SA(1, 1), a1 + hstepA, voffA);
            PG8_WAIT_V(8); PG8_WAIT_L(0); PG8_BAR; PG8_MMA(0, 0, At, B0); PG8_MMA(0, 1, At, B1); PG8_BAR; PG8_SCHED;
            PG8_LDA(At, 0, 1); PG8_STAGE(PG8_SB(0, 0), b2, voffB); PG8_STAGE(PG8_SB(0, 1), b2 + hstepB, voffB); PG8_STAGE(PG8_SA(0, 0), a2, voffA);
            PG8_WAIT_V(8); PG8_WAIT_L(0); PG8_BAR; PG8_MMA(1, 0, At, B0); PG8_MMA(1, 1, At, B1); PG8_BAR; PG8_SCHED;
            PG8_LDB(B0, 1, 0); PG8_LDB(B1, 1, 1); PG8_SCHED; PG8_LDA(At, 1, 0); PG8_STAGE(PG8_SA(0, 1), a2 + hstepA, voffA);
            PG8_WAIT_V(8); PG8_WAIT_L(0); PG8_BAR; PG8_MMA(0, 0, At, B0); PG8_MMA(0, 1, At, B1); PG8_BAR; PG8_SCHED;
            PG8_LDA(At, 1, 1); PG8_STAGE(PG8_SB(1, 0), b3, voffB); PG8_STAGE(PG8_SB(1, 1), b3 + hstepB, voffB); PG8_STAGE(PG8_SA(1, 0), a3, voffA);
            PG8_WAIT_V(8); PG8_WAIT_L(0); PG8_BAR; PG8_MMA(1, 0, At, B0); PG8_MMA(1, 1, At, B1); PG8_BAR; PG8_SCHED;
            } else {
            PG8_LDB(B0, 0, 0); PG8_SCHED; PG8_LDA(At, 0, 0); PG8_STAGE(PG8_SA(1, 1), a1 + hstepA, voffA);
            PG8_WAIT_L(8); PG8_BAR; PG8_WAIT_L(0); PG8_MMA(0, 0, At, B0); PG8_BAR; PG8_SCHED;
            PG8_LDB(B1, 0, 1); PG8_STAGE(PG8_SB(0, 0), b2, voffB);
            PG8_BAR; PG8_WAIT_L(0); PG8_MMA(0, 1, At, B1); PG8_BAR;
            PG8_LDA(At, 0, 1); PG8_STAGE(PG8_SA(0, 0), a2, voffA);
            PG8_BAR; PG8_WAIT_L(0); PG8_MMA(1, 0, At, B0); PG8_BAR; PG8_SCHED;
            PG8_STAGE(PG8_SB(0, 1), b2 + hstepB, voffB);
            PG8_WAIT_V(6); PG8_BAR; PG8_MMA(1, 1, At, B1); PG8_BAR;
            PG8_LDB(B0, 1, 0); PG8_SCHED; PG8_LDA(At, 1, 0); PG8_STAGE(PG8_SA(0, 1), a2 + hstepA, voffA);
            PG8_WAIT_L(8); PG8_BAR; PG8_WAIT_L(0); PG8_MMA(0, 0, At, B0); PG8_BAR; PG8_SCHED;
            PG8_LDB(B1, 1, 1); PG8_STAGE(PG8_SB(1, 0), b3, voffB);
            PG8_BAR; PG8_WAIT_L(0); PG8_MMA(0, 1, At, B1); PG8_BAR;
            PG8_LDA(At, 1, 1); PG8_STAGE(PG8_SA(1, 0), a3, voffA);
            PG8_BAR; PG8_WAIT_L(0); PG8_MMA(1, 0, At, B0); PG8_BAR; PG8_SCHED;
            PG8_STAGE(PG8_SB(1, 1), b3 + hstepB, voffB);
            PG8_WAIT_V(6); PG8_BAR; PG8_MMA(1, 1, At, B1); PG8_BAR;
            }
        }
        if constexpr (ALIGN_EPI) { if (wr == 0) PG8_BAR; }
        PROF_END(pb.prof_id); PROF_BEGIN();
        pb.epi(acc, cur, wr, wc, fr, fq);
#if defined(PROF_ID)
        asm volatile("s_waitcnt vmcnt(0)" ::: "memory");
#endif
        PROF_END(pb.prof_id + 1); PROF_BEGIN();
        if (!has_next) break;
#pragma unroll
        for (int a = 0; a < 2; ++a)
#pragma unroll
            for (int b = 0; b < 2; ++b)
#pragma unroll
                for (int m = 0; m < 4; ++m)
#pragma unroll
                    for (int n = 0; n < 2; ++n) acc[a][b][m][n] = (f32x4){0.f, 0.f, 0.f, 0.f};
        cur = nxt; cA = nA; cB = nB; ++ui;
        if constexpr (ALIGN_EPI) { if (wr == 1) PG8_BAR; }
    }
    PG8_WAIT_V(0);
    if constexpr (!ALIGN_EPI) { if (wr == 0) PG8_BAR; }
    PG8_BAR;
#undef PG8_SA
#undef PG8_SB
#undef PG8_STAGE
#undef PG8_LDA
#undef PG8_LDB
#undef PG8_MMA
#undef PG8_WAIT_V
#undef PG8_WAIT_L
#undef PG8_BAR
#undef PG8_SCHED
}

struct StaticOrder {
    int nM, nN, nwg, G, c;
    __device__ void init(int nM_, int nN_, int G_, int c_) { nM = nM_; nN = nN_; nwg = nM * nN; G = G_; c = c_; }
    __device__ bool next(int i, int& pm, int& pn) const { const long L = (long)i * G + c; if (L >= nwg) return false; map((int)L, pm, pn); return true; }
    __device__ void map(int L, int& pm, int& pn) const {
        int wgid = L; { const int q = nwg / NXCD, r = nwg % NXCD, xcd = wgid % NXCD, off = wgid / NXCD; wgid = (xcd < r ? xcd * (q + 1) : r * (q + 1) + (xcd - r) * q) + off; }
        const int nig = WGM * nN, gid = wgid / nig, fm = gid * WGM, gsz = (nM - fm) < WGM ? (nM - fm) : WGM;
        pm = fm + ((wgid % nig) % gsz); pn = (wgid % nig) / gsz;
    }
};

struct ProbBase {
    const char* A; const char* B; OpMap ma, mb; size_t hstepA, hstepB, kstepA, kstepB; int nt; int prof_id = -100;
    __device__ void std_operands(const void* A_, int lda, const void* B_, int ldb, int K) {
        A = (const char*)A_; B = (const char*)B_; ma = OpMap{128, (unsigned)lda * 2u, 0u}; mb = OpMap{128, (unsigned)ldb * 2u, 0u};
        hstepA = (size_t)HALF * lda * 2; hstepB = (size_t)HALF * ldb * 2; kstepA = kstepB = BK * 2; nt = K / BK;
    }
};

template <class F> __device__ __forceinline__ void epi_rows_perm(const f32x4 (&acc)[2][2][4][2], int wr, int wc, int fr, int fq, F f) {
    asm volatile("" : "+v"(fr), "+v"(fq));
#pragma unroll
    for (int ai = 0; ai < 2; ++ai)
#pragma unroll
        for (int m = 0; m < 4; ++m)
#pragma unroll
            for (int bj = 0; bj < 2; ++bj) f(ai * HALF + wr * 64 + m * 16 + fr, bj * HALF + wc * 32 + 8 * fq, acc[ai][bj][m][0], acc[ai][bj][m][1]);
}
template <class F> __device__ __forceinline__ void epi_rows_f32(const f32x4 (&acc)[2][2][4][2], int wr, int wc, int fr, int fq, F f) {
    asm volatile("" : "+v"(fr), "+v"(fq));
#pragma unroll
    for (int ai = 0; ai < 2; ++ai)
#pragma unroll
        for (int m = 0; m < 4; ++m)
#pragma unroll
            for (int bj = 0; bj < 2; ++bj)
#pragma unroll
                for (int n = 0; n < 2; ++n) f(ai * HALF + wr * 64 + m * 16 + fr, bj * HALF + wc * 32 + 16 * n + 4 * fq, acc[ai][bj][m][n]);
}
__device__ __forceinline__ u32x4 pack8(const f32x4& v0, const f32x4& v1) { u32x4 w; w.x = cvt_pk_bf16(v0[0], v0[1]); w.y = cvt_pk_bf16(v0[2], v0[3]); w.z = cvt_pk_bf16(v1[0], v1[1]); w.w = cvt_pk_bf16(v1[2], v1[3]); return w; }

struct TokOrder : ProbBase {
    StaticOrder so; int row0, lda, ldb;
    __device__ void init_tok(const void* Act, int lda_, const void* Wt, int K, int row0_, int nM, int nN, int G, int c) { std_operands(Act, lda_, Wt, K, K); row0 = row0_; lda = lda_; ldb = K; so.init(nM, nN, G, c); }
    __device__ bool next(int i, Unit& u) const { int pm, pn; if (!so.next(i, pm, pn)) return false; u.p0 = pm; u.p1 = pn; u.p2 = -1; u.nt = nt; u.offA = (size_t)(row0 + pm * BM) * lda * 2; u.offB = (size_t)pn * BM * ldb * 2; return true; }
};
struct ProbMlp1 : TokOrder {
    static constexpr bool PERM = true;
    bf16_t* O; int ldc;
    __device__ __forceinline__ void epi(const f32x4 (&acc)[2][2][4][2], const Unit& u, int wr, int wc, int fr, int fq) const {
        bf16_t* base = O + (size_t)(row0 + u.p0 * BM) * ldc + u.p1 * BM;
        epi_rows_perm(acc, wr, wc, fr, fq, [&](int r, int c, f32x4 v0, f32x4 v1) {
#pragma unroll
            for (int j = 0; j < 4; ++j) { const float a = fmaxf(v0[j], 0.f), b = fmaxf(v1[j], 0.f); v0[j] = a * a; v1[j] = b * b; }
            *(u32x4*)(base + (size_t)r * ldc + c) = pack8(v0, v1); });
    }
};
template <bool FIRST> struct ProbResidT : TokOrder {
    static constexpr bool PERM = true;
    bf16_t* X; const float* mod; int layer, gidx; unsigned short* slab; int G2, c2;
    unsigned* pcnt;
    const float* xp; const float* xs; const float* er; const float* ec;
    __device__ void init_split(int G_, int c_, unsigned short* slab_) { G2 = G_; c2 = c_; slab = slab_; xp = nullptr; xs = nullptr; er = nullptr; ec = nullptr; }
    __device__ bool next(int i, Unit& u) const {
        if (G2 != 256) return TokOrder::next(i, u);
        int pm, pn;
        if (i > 1) return false;
        const int which = (c2 & 1) ? 1 - i : i;
        if (which == 0) { so.map(c2, pm, pn); u.p2 = -1; u.p3 = 0; u.nt = nt; u.offA = (size_t)(row0 + pm * BM) * lda * 2; u.offB = (size_t)pn * BM * ldb * 2; }
        else { const int L = 256 + (c2 >> 2), kq = c2 & 3, ntq = nt >> 2; so.map(L, pm, pn); u.p2 = kq; u.p3 = L - 256; u.nt = ntq;
            u.offA = (size_t)(row0 + pm * BM) * lda * 2 + (size_t)kq * ntq * BK * 2; u.offB = (size_t)pn * BM * ldb * 2 + (size_t)kq * ntq * BK * 2; }
        u.p0 = pm; u.p1 = pn; return true;
    }
    __device__ __forceinline__ void epi(const f32x4 (&acc)[2][2][4][2], const Unit& u, int wr, int wc, int fr, int fq) const {
        asm volatile("" : "+v"(fr), "+v"(fq));
        const int rowt = row0 + u.p0 * BM, cond = rowt >> 12, colt = u.p1 * BM, lc = wc * 32 + 8 * fq;
        const float* gate = mod + ((size_t)(cond * 2 + layer) * 6 + gidx) * 1024 + colt + lc;
        f32x4 gt[2][2];
#pragma unroll
        for (int bj = 0; bj < 2; ++bj)
#pragma unroll
            for (int n = 0; n < 2; ++n) gt[bj][n] = *(const f32x4*)(gate + bj * HALF + 4 * n);
        if (u.p2 <= 0) {
            bf16_t* base = X + (size_t)(rowt + wr * 64 + fr) * 2048 + (fr & 1) * 1024 + colt + lc;
            const __amdgpu_buffer_rsrc_t rX = __builtin_amdgcn_make_buffer_rsrc(X, 0, 0x7fffffff, 0x00020000);
            const int xoff = (int)(((size_t)(rowt + wr * 64 + fr) * 2048 + (fr & 1) * 1024 + colt + lc) * 2);
            if constexpr (FIRST) {
                const bool smp = rowt >= 4096, use_er = colt < 512; const int t0 = (rowt & 4095) + wr * 64 + fr;
                const float* xsrc = (smp ? xs + (size_t)(rowt - 4096) * 1024 : xp + (size_t)rowt * 1024) + (size_t)(wr * 64 + fr) * 1024 + colt + lc;
                const float* pbase = (use_er ? er + colt : ec + colt - 512) + lc;
#pragma unroll
                for (int ai = 0; ai < 2; ++ai)
#pragma unroll
                    for (int mp = 0; mp < 2; ++mp) {
                        f32x4 xv[2][2][2], pv[2][2][2];
#pragma unroll
                        for (int mm = 0; mm < 2; ++mm) { const int ro = ai * HALF + (2 * mp + mm) * 16; const int t = t0 + ro;
#pragma unroll
                            for (int bj = 0; bj < 2; ++bj)
#pragma unroll
                                for (int n = 0; n < 2; ++n) { xv[mm][bj][n] = *(const f32x4*)(xsrc + (size_t)ro * 1024 + bj * HALF + 4 * n);
                                    pv[mm][bj][n] = smp ? *(const f32x4*)(pbase + (use_er ? (t >> 6) : (t & 63)) * 512 + bj * HALF + 4 * n) : (f32x4){0.f, 0.f, 0.f, 0.f}; } }
#pragma unroll
                        for (int mm = 0; mm < 2; ++mm) { const int ro = ai * HALF + (2 * mp + mm) * 16;
#pragma unroll
                            for (int bj = 0; bj < 2; ++bj) { const int m = 2 * mp + mm;
                                __builtin_amdgcn_raw_buffer_store_b128(pack8(xv[mm][bj][0] + pv[mm][bj][0] + gt[bj][0] * acc[ai][bj][m][0], xv[mm][bj][1] + pv[mm][bj][1] + gt[bj][1] * acc[ai][bj][m][1]), rX, xoff + (ro * 2048 + bj * HALF) * 2, 0, 16); } }
                    }
            } else {
#pragma unroll
                for (int ai = 0; ai < 2; ++ai) {
                    u32x4 xw[4][2];
#pragma unroll
                    for (int m = 0; m < 4; ++m)
#pragma unroll
                        for (int bj = 0; bj < 2; ++bj) xw[m][bj] = *(const u32x4*)(base + (size_t)(ai * HALF + m * 16) * 2048 + bj * HALF);
#pragma unroll
                    for (int m = 0; m < 4; ++m)
#pragma unroll
                        for (int bj = 0; bj < 2; ++bj) { const u32x4 w = xw[m][bj];
                            const f32x4 x0 = (f32x4){__builtin_bit_cast(float, w.x << 16), __builtin_bit_cast(float, w.x & 0xffff0000u), __builtin_bit_cast(float, w.y << 16), __builtin_bit_cast(float, w.y & 0xffff0000u)};
                            const f32x4 x1 = (f32x4){__builtin_bit_cast(float, w.z << 16), __builtin_bit_cast(float, w.z & 0xffff0000u), __builtin_bit_cast(float, w.w << 16), __builtin_bit_cast(float, w.w & 0xffff0000u)};
                            __builtin_amdgcn_raw_buffer_store_b128(pack8(x0 + gt[bj][0] * acc[ai][bj][m][0], x1 + gt[bj][1] * acc[ai][bj][m][1]), rX, xoff + ((ai * HALF + m * 16) * 2048 + bj * HALF) * 2, 0, 16); }
                }
            }
        } else {
            const __amdgpu_buffer_rsrc_t rS = __builtin_amdgcn_make_buffer_rsrc(slab, 0, 0x7fffffff, 0x00020000);
            const int soff = (int)(((size_t)(u.p3 * 3 + u.p2 - 1) * 65536 + (size_t)(wr * 64 + fr) * 256 + lc) * 2);
#pragma unroll
            for (int ai = 0; ai < 2; ++ai)
#pragma unroll
                for (int m = 0; m < 4; ++m)
#pragma unroll
                    for (int bj = 0; bj < 2; ++bj) { const f32x4 w0 = gt[bj][0] * acc[ai][bj][m][0], w1 = gt[bj][1] * acc[ai][bj][m][1];
                        u32x4 o; o.x = pk2h(w0[0], w0[1]); o.y = pk2h(w0[2], w0[3]); o.z = pk2h(w1[0], w1[1]); o.w = pk2h(w1[2], w1[3]);
                        __builtin_amdgcn_raw_buffer_store_b128(o, rS, soff + ((ai * HALF + m * 16) * 256 + bj * HALF) * 2, 0, 16); }
        }
        asm volatile("s_waitcnt vmcnt(0)" ::: "memory");
        if (fr == 0 && fq == 0) __hip_atomic_fetch_add(pcnt + 64 * u.p0, 1u, __ATOMIC_RELAXED, __HIP_MEMORY_SCOPE_AGENT);
    }
};
typedef ProbResidT<false> ProbResid; typedef ProbResidT<true> ProbResidFirst;
__device__ __forceinline__ void build_split_table(LAS unsigned char* tab, int G, int tid) {
    for (int i = tid; i < 320; i += NTHREADS) tab[i] = 255;
    __syncthreads();
    if (G == 256) { StaticOrder so; so.init(80, 4, G, 0); for (int L = 256 + tid; L < 320; L += NTHREADS) { int pm, pn; so.map(L, pm, pn); tab[pm * 4 + pn] = (unsigned char)(L - 256); } }
    __syncthreads();
}
struct SlabRaw { u32x2 w[3]; };
__device__ __forceinline__ SlabRaw slab_load(const unsigned short* slab, int idx, int r255, int col) { SlabRaw s;
#pragma unroll
    for (int q = 0; q < 3; ++q) s.w[q] = *(const u32x2*)(slab + (size_t)(idx * 3 + q) * 65536 + (size_t)r255 * 256 + col);
    return s; }
__device__ __forceinline__ f32x4 slab_add(const SlabRaw& r) { f32x4 s = (f32x4){0.f, 0.f, 0.f, 0.f};
#pragma unroll
    for (int q = 0; q < 3; ++q) { s[0] += h2f_((unsigned short)(r.w[q].x & 0xffffu)); s[1] += h2f_((unsigned short)(r.w[q].x >> 16)); s[2] += h2f_((unsigned short)(r.w[q].y & 0xffffu)); s[3] += h2f_((unsigned short)(r.w[q].y >> 16)); }
    return s; }
struct SlabRaw8 { u32x4 w[3]; };
__device__ __forceinline__ SlabRaw8 slab_load8(const unsigned short* slab, int idx, int r255, int col) { SlabRaw8 s;
#pragma unroll
    for (int q = 0; q < 3; ++q) s.w[q] = *(const u32x4*)(slab + (size_t)(idx * 3 + q) * 65536 + (size_t)r255 * 256 + col);
    return s; }
__device__ __forceinline__ void slab_add8(const SlabRaw8& r, f32x4& a, f32x4& b) {
#pragma unroll
    for (int q = 0; q < 3; ++q) { const unsigned ww[4] = {r.w[q].x, r.w[q].y, r.w[q].z, r.w[q].w};
        a[0] += h2f_((unsigned short)(ww[0] & 0xffffu)); a[1] += h2f_((unsigned short)(ww[0] >> 16)); a[2] += h2f_((unsigned short)(ww[1] & 0xffffu)); a[3] += h2f_((unsigned short)(ww[1] >> 16));
        b[0] += h2f_((unsigned short)(ww[2] & 0xffffu)); b[1] += h2f_((unsigned short)(ww[2] >> 16)); b[2] += h2f_((unsigned short)(ww[3] & 0xffffu)); b[3] += h2f_((unsigned short)(ww[3] >> 16)); } }
__device__ __forceinline__ void wait_panels(unsigned* pcnt, const LAS unsigned char* stab, int p0, int p1, unsigned* tmo, int wave, int lane) {
    if (wave == 0) {
        for (int p = p0; p <= p1; ++p) {
            unsigned want = 0;
#pragma unroll
            for (int pn = 0; pn < 4; ++pn) want += (stab[p * 4 + pn] != 255) ? 32u : 8u;
            unsigned sp = 0;
            while ((unsigned)__builtin_amdgcn_readfirstlane(__hip_atomic_load(pcnt + 64 * p, __ATOMIC_RELAXED, __HIP_MEMORY_SCOPE_AGENT)) < want) {
                __builtin_amdgcn_s_sleep(2);
                if ((++sp & 255u) == 0u) { if (__hip_atomic_load(tmo, __ATOMIC_RELAXED, __HIP_MEMORY_SCOPE_AGENT)) break; if (sp > (1u << 18)) { if (lane == 0) atomicAdd(tmo, 1u); break; } }
            }
        }
        __builtin_amdgcn_fence(__ATOMIC_ACQUIRE, "agent");
        asm volatile("s_waitcnt vmcnt(0)" ::: "memory");
    }
    __syncthreads();
}
__device__ __forceinline__ f32x4 slab_sum(const unsigned short* slab, int idx, int r255, int col) {
    f32x4 s = (f32x4){0.f, 0.f, 0.f, 0.f};
#pragma unroll
    for (int q = 0; q < 3; ++q) { const u32x2 w = *(const u32x2*)(slab + (size_t)(idx * 3 + q) * 65536 + (size_t)r255 * 256 + col);
        s[0] += h2f_((unsigned short)(w.x & 0xffffu)); s[1] += h2f_((unsigned short)(w.x >> 16)); s[2] += h2f_((unsigned short)(w.y & 0xffffu)); s[3] += h2f_((unsigned short)(w.y >> 16)); }
    return s;
}

struct ProbWin : TokOrder {
    static constexpr bool PERM = true;
    bf16_t* Oq; bf16_t* Offw; bf16_t* Ofbw; bf16_t* Ov; bf16_t* Osg; const float* lb;
    __device__ __forceinline__ void epi(const f32x4 (&acc)[2][2][4][2], const Unit& u, int wr, int wc, int fr, int fq) const {
        const int t = u.p1 >> 2, col0 = (u.p1 & 3) * BM;
        bf16_t* O = t == 0 ? Oq : t == 1 ? Offw : t == 2 ? Ofbw : t == 3 ? Ov : Osg;
        bf16_t* base = O + (size_t)(row0 + u.p0 * BM) * 1024 + col0;
        const bool qnt = (t == 0) && (row0 + u.p0 * BM >= 4096);
        if (t == 1 || t == 2) {
            const float* lbp = lb + (t - 1) * 1024 + col0 + wc * 32 + 8 * fq;
            f32x4 lbv[2][2];
#pragma unroll
            for (int bj = 0; bj < 2; ++bj) { lbv[bj][0] = *(const f32x4*)(lbp + bj * HALF); lbv[bj][1] = *(const f32x4*)(lbp + bj * HALF + 4); }
            epi_rows_perm(acc, wr, wc, fr, fq, [&](int r, int c, f32x4 v0, f32x4 v1) {
                const f32x4 l0 = lbv[c >> 7][0], l1 = lbv[c >> 7][1];
#pragma unroll
                for (int j = 0; j < 4; ++j) { v0[j] = __builtin_amdgcn_logf(l0[j] + (1.f - l0[j]) * __builtin_amdgcn_rcpf(1.f + __builtin_amdgcn_exp2f(-1.44269504f * v0[j]))); v1[j] = __builtin_amdgcn_logf(l1[j] + (1.f - l1[j]) * __builtin_amdgcn_rcpf(1.f + __builtin_amdgcn_exp2f(-1.44269504f * v1[j]))); }
                u32x4 w; w.x = pk2h(v0[0], v0[1]); w.y = pk2h(v0[2], v0[3]); w.z = pk2h(v1[0], v1[1]); w.w = pk2h(v1[2], v1[3]);
                *(u32x4*)(base + (size_t)r * 1024 + c) = w; });
        } else if (t == 3) {
            epi_rows_perm(acc, wr, wc, fr, fq, [&](int r, int c, f32x4 v0, f32x4 v1) { *(u32x4*)(base + (size_t)r * 1024 + c) = pack8(v0, v1); });
        } else {
            epi_rows_perm(acc, wr, wc, fr, fq, [&](int r, int c, f32x4 v0, f32x4 v1) {
#pragma unroll
                for (int j = 0; j < 4; ++j) { v0[j] = silu(v0[j]); v1[j] = silu(v1[j]); }
                if (qnt) __builtin_nontemporal_store(pack8(v0, v1), (u32x4*)(base + (size_t)r * 1024 + c));
                else *(u32x4*)(base + (size_t)r * 1024 + c) = pack8(v0, v1); });
        }
    }
};

struct ProbChan : ProbBase {
    static constexpr bool PERM = true;
    int mode, G, c, nunits; bf16_t* Y;
    __device__ void init(int mode_, const void* dftc, const bf16_t* h0, bf16_t* Y_, int G_, int c_) {
        mode = mode_; G = G_; c = c_; Y = Y_; A = (const char*)dftc; B = (const char*)h0; ma = OpMap{128, 512u, 0u}; hstepA = (size_t)HALF * 512; kstepA = kstepB = BK * 2; nt = 4;
        if (mode == 0) { mb = OpMap{128, 2048u, 0u}; hstepB = (size_t)HALF * 2048; nunits = 16 * 4 * 2; }
        else { mb = OpMap{64, 64u * 2048u, 2048u}; hstepB = 2 * 2048; nunits = 4 * 4 * 16 * 2; }
    }
    __device__ bool next(int i, Unit& u) const {
        const int L = i * G + c; if (L >= nunits) return false;
        const int mt = L & 1; u.p0 = mt; u.nt = nt; u.offA = (size_t)mt * 256 * 512;
        if (mode == 0) { const int g = (L >> 1) & 3, b = L >> 3; u.p1 = b * 2048 + g * 512; u.p2 = 0; u.offB = ((size_t)(b * 256) * 1024 + g * 256) * 2; }
        else { const int j = (L >> 1) & 15, g = (L >> 5) & 3, b = L >> 7; u.p1 = b * 2048 + g * 512; u.p2 = j * 256; u.offB = ((size_t)(4096 + b * 4096 + 4 * j) * 1024 + g * 256) * 2; }
        return true;
    }
    __device__ __forceinline__ void epi(const f32x4 (&acc)[2][2][4][2], const Unit& u, int wr, int wc, int fr, int fq) const {
        const int ldc = mode == 0 ? 256 : 4096;
        bf16_t* base = Y + (size_t)(u.p1 + u.p0 * 256) * ldc + u.p2;
        epi_rows_perm(acc, wr, wc, fr, fq, [&](int r, int cc, f32x4 v0, f32x4 v1) { *(u32x4*)(base + (size_t)r * ldc + cc) = pack8(v0, v1); });
    }
};
struct ProbPosCtx : ProbBase {
    static constexpr bool PERM = true;
    int G, c; bf16_t* Z;
    __device__ void init(const void* dl, const bf16_t* yctx, bf16_t* Z_, int G_, int c_) { std_operands(dl, 512, yctx, 512, 512); G = G_; c = c_; Z = Z_; }
    __device__ bool next(int i, Unit& u) const {
        const int L = i * G + c; if (L >= 64) return false;
        const int pn = L & 3, b = L >> 2; u.p0 = b; u.p1 = pn; u.nt = nt; u.offA = 0; u.offB = ((size_t)b * 2048 * 256 + (size_t)pn * 256 * 512) * 2; return true;
    }
    __device__ __forceinline__ void epi(const f32x4 (&acc)[2][2][4][2], const Unit& u, int wr, int wc, int fr, int fq) const {
        bf16_t* base = Z + (size_t)(u.p0 * 256) * 1024 + u.p1 * 256;
        epi_rows_perm(acc, wr, wc, fr, fq, [&](int r, int cc, f32x4 v0, f32x4 v1) { *(u32x4*)(base + (size_t)r * 1024 + cc) = pack8(v0, v1); });
    }
};
struct ProbSmpA : ProbBase {
    static constexpr bool PERM = true;
    int G, c; bf16_t* U;
    __device__ void init(const void* fa2, const bf16_t* yt, bf16_t* U_, int G_, int c_) {
        A = (const char*)fa2; B = (const char*)yt; ma = OpMap{128, 512u, 0u}; hstepA = (size_t)HALF * 512; kstepA = BK * 2;
        mb = OpMap{32, 128u, 16384u}; hstepB = 4 * 16384; kstepB = 4096; nt = 4; G = G_; c = c_; U = U_;
    }
    __device__ bool next(int i, Unit& u) const {
        int L;
        if (G == 256) {
            if (i == 0) L = c; else if (i == 1 && c >= 128) L = 256 + (c - 128); else if (i >= 1 && i <= 2 && c >= 64 && c < 128) L = 384 + (i - 1) * 64 + (c - 64); else return false;
        } else { L = i * G + c; if (L >= 512) return false; }
        const int tau = L & 127, b = L >> 7; u.p0 = b; u.p1 = tau; u.nt = nt; u.offA = 0; u.offB = ((size_t)(b * 2048 + 16 * tau) * 4096) * 2; return true;
    }
    __device__ __forceinline__ void epi(const f32x4 (&acc)[2][2][4][2], const Unit& u, int wr, int wc, int fr, int fq) const {
        bf16_t* base = U + (size_t)(u.p0 * 1024 + 8 * u.p1) * 8192;
        epi_rows_perm(acc, wr, wc, fr, fq, [&](int r, int cc, f32x4 v0, f32x4 v1) {
            *(u32x4*)(base + (size_t)(cc >> 5) * 8192 + (r & 127) * 64 + (r >> 7) * 32 + (cc & 31)) = pack8(v0, v1); });
    }
};
struct ProbSmpB : ProbBase {
    static constexpr bool PERM = true;
    int G, c; bf16_t* Z;
    __device__ void init(const void* mbm, const bf16_t* Uin, bf16_t* Z_, int G_, int c_) { std_operands(mbm, 512, Uin, 8192, 512); G = G_; c = c_; Z = Z_; }
    __device__ bool next(int i, Unit& u) const {
        const int L = i * G + c; if (L >= 256) return false;
        const int pn = L & 3, q = (L >> 2) & 15, b = L >> 6; u.p0 = b; u.p1 = q; u.p2 = pn; u.nt = nt;
        u.offA = (size_t)q * 256 * 512 * 2; u.offB = ((size_t)(b * 1024 + pn * 256) * 8192 + q * 512) * 2; return true;
    }
    __device__ __forceinline__ void epi(const f32x4 (&acc)[2][2][4][2], const Unit& u, int wr, int wc, int fr, int fq) const {
        bf16_t* base = Z + (size_t)(4096 + u.p0 * 4096 + 4 * u.p1) * 1024 + u.p2 * 256;
        epi_rows_perm(acc, wr, wc, fr, fq, [&](int r, int cc, f32x4 v0, f32x4 v1) {
            const int l = (r >> 6) + 64 * (r & 63); *(u32x4*)(base + (size_t)l * 1024 + cc) = pack8(v0, v1); });
    }
};

__device__ __forceinline__ void norm_rows(bf16_t* X, int row0, int nrows, const float* g, const float* mod, int layer, int ish, bf16_t* H, int gw, int ngw, int lane, const LAS unsigned char* stab, const unsigned short* slab) {
    constexpr int NB = 5;
    LAS unsigned char* prof_lds_ = (LAS unsigned char*)0; (void)prof_lds_; PROF_DECL; PROF_BEGIN();
    f32x4 gv[2][2], gm[2][2], shv[2][2];
#pragma unroll
    for (int jj = 0; jj < 2; ++jj) { gv[jj][0] = *(const f32x4*)(g + 8 * lane + 512 * jj); gv[jj][1] = *(const f32x4*)(g + 8 * lane + 512 * jj + 4); }
    const int rpw = (nrows + ngw - 1) / ngw, rbeg = row0 + gw * rpw, rend = (rbeg + rpw < row0 + nrows) ? rbeg + rpw : row0 + nrows;
    int ccur = -1;
    for (int rb = rbeg; rb < rend; rb += NB) {
        u32x4 nx[NB][2];
#pragma unroll
        for (int b = 0; b < NB; ++b) { const int r = rb + b; if (r < rend) { const bf16_t* p = X + (size_t)r * 2048 + (r & 1) * 1024 + 8 * lane;
            nx[b][0] = *(const u32x4*)p; nx[b][1] = *(const u32x4*)(p + 512); } }
#pragma unroll
        for (int b = 0; b < NB; ++b) {
            const int r = rb + b; if (r >= rend) break;
            if ((r >> 12) != ccur) { ccur = r >> 12; const float* mrow = mod + ((size_t)(ccur * 2 + layer) * 6) * 1024 + 8 * lane;
#pragma unroll
                for (int jj = 0; jj < 2; ++jj)
#pragma unroll
                    for (int n = 0; n < 2; ++n) { shv[jj][n] = *(const f32x4*)(mrow + (size_t)ish * 1024 + 512 * jj + 4 * n); gm[jj][n] = gv[jj][n] * (*(const f32x4*)(mrow + (size_t)(ish + 1) * 1024 + 512 * jj + 4 * n) + 1.f); } }
            bf16_t* xr = X + (size_t)r * 2048 + (r & 1) * 1024 + 8 * lane;
            f32x4 v[2][2]; float s = 0.f;
            int si2[2]; SlabRaw8 sr[2];
#pragma unroll
            for (int jj = 0; jj < 2; ++jj) { si2[jj] = stab[(r >> 8) * 4 + 2 * jj + (lane >> 5)]; if (si2[jj] != 255) sr[jj] = slab_load8(slab, si2[jj], r & 255, (8 * lane) & 255); }
#pragma unroll
            for (int jj = 0; jj < 2; ++jj) { bf8_to_f32(nx[b][jj], v[jj][0], v[jj][1]);
                if (si2[jj] != 255) { slab_add8(sr[jj], v[jj][0], v[jj][1]); *(u32x4*)(xr + 512 * jj) = pack8(v[jj][0], v[jj][1]); }
#pragma unroll
                for (int n = 0; n < 2; ++n) s += (v[jj][n].x * v[jj][n].x + v[jj][n].y * v[jj][n].y) + (v[jj][n].z * v[jj][n].z + v[jj][n].w * v[jj][n].w); }
            const float rstd = rsqrtf(wave_sum(s) * (1.f / 1024.f) + 1e-6f);
            bf16_t* ho = H + (size_t)r * 1024 + 8 * lane;
#pragma unroll
            for (int jj = 0; jj < 2; ++jj) *(u32x4*)(ho + 512 * jj) = pack8(v[jj][0] * rstd * gm[jj][0] + shv[jj][0], v[jj][1] * rstd * gm[jj][1] + shv[jj][1]);
        }
    }
    PROF_END(11);
}


__device__ __forceinline__ void embed_rows(const float* xp, const float* xs, const float* er, const float* ec, const float* g, const float* mod, bf16_t* H, bf16_t* X, int gw, int ngw, int lane) {
    constexpr int NB = 4;
    f32x4 gv[2][2], gm[2][2], shv[2][2];
#pragma unroll
    for (int jj = 0; jj < 2; ++jj) { gv[jj][0] = *(const f32x4*)(g + 8 * lane + 512 * jj); gv[jj][1] = *(const f32x4*)(g + 8 * lane + 512 * jj + 4); }
    const int rpw = (20480 + ngw - 1) / ngw, rbeg = gw * rpw, rend = (rbeg + rpw < 20480) ? rbeg + rpw : 20480;
    int ccur = -1;
    int prow = -1; f32x4 pr0 = (f32x4){0.f, 0.f, 0.f, 0.f}, pr1 = pr0;
    for (int rb = rbeg; rb < rend; rb += NB) {
        f32x4 nx[NB][2][2], pc[NB][2];
#pragma unroll
        for (int b = 0; b < NB; ++b) { const int r = rb + b; if (r < rend) { const float* xr = (r < 4096 ? xp + (size_t)r * 1024 : xs + (size_t)(r - 4096) * 1024) + 8 * lane;
#pragma unroll
            for (int jj = 0; jj < 2; ++jj) { nx[b][jj][0] = __builtin_nontemporal_load((const f32x4*)(xr + 512 * jj)); nx[b][jj][1] = __builtin_nontemporal_load((const f32x4*)(xr + 512 * jj + 4)); }
            if (r >= 4096) { const int col = r & 63; pc[b][0] = *(const f32x4*)(ec + col * 512 + 8 * lane); pc[b][1] = *(const f32x4*)(ec + col * 512 + 8 * lane + 4); } } }
#pragma unroll
        for (int b = 0; b < NB; ++b) {
            const int r = rb + b; if (r >= rend) break;
            if ((r >> 12) != ccur) { ccur = r >> 12; const float* mrow = mod + ((size_t)(ccur * 2 + 0) * 6) * 1024 + 8 * lane;
#pragma unroll
                for (int jj = 0; jj < 2; ++jj)
#pragma unroll
                    for (int n = 0; n < 2; ++n) { shv[jj][n] = *(const f32x4*)(mrow + 512 * jj + 4 * n); gm[jj][n] = gv[jj][n] * (*(const f32x4*)(mrow + 1024 + 512 * jj + 4 * n) + 1.f); } }
            f32x4 v[2][2]; float s = 0.f;
#pragma unroll
            for (int jj = 0; jj < 2; ++jj) { v[jj][0] = nx[b][jj][0]; v[jj][1] = nx[b][jj][1]; }
            if (r >= 4096) { const int row = (r & 4095) >> 6;
                if (row != prow) { prow = row; pr0 = *(const f32x4*)(er + row * 512 + 8 * lane); pr1 = *(const f32x4*)(er + row * 512 + 8 * lane + 4); }
                v[0][0] = v[0][0] + pr0; v[0][1] = v[0][1] + pr1; v[1][0] = v[1][0] + pc[b][0]; v[1][1] = v[1][1] + pc[b][1]; }
#pragma unroll
            for (int jj = 0; jj < 2; ++jj)
#pragma unroll
                for (int n = 0; n < 2; ++n) s += (v[jj][n].x * v[jj][n].x + v[jj][n].y * v[jj][n].y) + (v[jj][n].z * v[jj][n].z + v[jj][n].w * v[jj][n].w);
            const float rstd = rsqrtf(wave_sum(s) * (1.f / 1024.f) + 1e-6f);
            bf16_t* ho = H + (size_t)r * 1024 + 8 * lane;
            bf16_t* xo = X + (size_t)r * 2048 + (r & 1) * 1024 + 8 * lane;
#pragma unroll
            for (int jj = 0; jj < 2; ++jj) { *(u32x4*)(ho + 512 * jj) = pack8(v[jj][0] * rstd * gm[jj][0] + shv[jj][0], v[jj][1] * rstd * gm[jj][1] + shv[jj][1]); __builtin_nontemporal_store(pack8(v[jj][0], v[jj][1]), (u32x4*)(xo + 512 * jj)); }
        }
    }
}
__device__ __forceinline__ void gen_tables(unsigned char* ws, long e0, long estride) {
    bf16_t* dftc = (bf16_t*)(ws + WM.dftc); bf16_t* dl = (bf16_t*)(ws + WM.dl256); bf16_t* fa2 = (bf16_t*)(ws + WM.fa2); bf16_t* mbm = (bf16_t*)(ws + WM.mb);
    float* er = (float*)(ws + WM.pos); float* ec = er + 64 * 512;
    constexpr long N0 = 512 * 256, N1 = 256 * 512, N2 = 256 * 256, N3 = 16L * 256 * 512, N4 = 2 * 64 * 512;
    for (long e = e0; e < N0 + N1 + N2 + N3 + N4; e += estride) {
        long r = e;
        if (r < N0) { const int mrow = (int)(r >> 8), cp = (int)(r & 255), cc = mrow >> 1, ri = mrow & 1; const float x = 2.f * (float)((cc * cp) & 255) / 256.f;
            dftc[r] = (bf16_t)f2bf(ri == 0 ? cospif(x) : -sinpif(x)); continue; } r -= N0;
        if (r < N1) { const int l = (int)(r >> 9), k = (int)(r & 511), ri = k >> 8, lp = k & 255; const float x = 2.f * (float)((l * lp) & 255) / 256.f;
            dl[r] = (bf16_t)f2bf((ri == 0 ? cospif(x) : sinpif(x)) * (1.f / 256.f)); continue; } r -= N1;
        if (r < N2) { const int mrow = (int)(r >> 8), k = (int)(r & 255), sA = mrow >> 7, k1 = (mrow >> 1) & 63, ro = mrow & 1, ri = k >> 7, sB = (k >> 6) & 1, l1 = k & 63;
            const float x = 2.f * (float)((k1 * l1) & 63) / 64.f; float v = 0.f;
            if (sA == sB) v = (ro == ri) ? cospif(x) : (ro == 0 ? sinpif(x) : -sinpif(x));
            fa2[r] = (bf16_t)f2bf(v); continue; } r -= N2;
        if (r < N3) { const int q = (int)(r >> 17), mrow = (int)(r >> 9) & 255, k = (int)(r & 511), ko = mrow >> 6, k2 = mrow & 63, kop = k >> 7, ro = (k >> 6) & 1, l2 = k & 63;
            const int l = 4 * q + ko + 64 * k2; const float x = 2.f * (float)((l * l2) & 4095) / 4096.f; float v = 0.f;
            if (ko == kop) v = (ro == 0 ? cospif(x) : sinpif(x)) * (1.f / 1024.f);
            mbm[r] = (bf16_t)f2bf(v); continue; } r -= N3;
        { const int which = (int)(r >> 15), p = (int)(r >> 9) & 63, j = (int)(r & 511), i = j & 255;
            const float omega = 1.0f / powf(10000.0f, (float)i / 256.0f); const float ang = (float)p * omega;
            (which == 0 ? er : ec)[p * 512 + j] = (j < 256) ? sinf(ang) : cosf(ang); }
    }
}


__device__ __forceinline__ void final_rows(float* X, int row0, int nrows, const float* g, int gw, int ngw, int lane, const LAS unsigned char* stab, const unsigned short* slab) {
    constexpr int NB = 5;
    f32x4 gv[2][2];
#pragma unroll
    for (int jj = 0; jj < 2; ++jj) { gv[jj][0] = *(const f32x4*)(g + 8 * lane + 512 * jj); gv[jj][1] = *(const f32x4*)(g + 8 * lane + 512 * jj + 4); }
    const int rpw = (nrows + ngw - 1) / ngw, rbeg = row0 + gw * rpw, rend = (rbeg + rpw < row0 + nrows) ? rbeg + rpw : row0 + nrows;
    for (int rb = rbeg; rb < rend; rb += NB) {
        u32x4 nx[NB][2];
#pragma unroll
        for (int b = 0; b < NB; ++b) { const int r = rb + b; if (r < rend) { const bf16_t* p = (const bf16_t*)(X + (size_t)r * 1024) + (r & 1) * 1024 + 8 * lane;
            nx[b][0] = __builtin_nontemporal_load((const u32x4*)p); nx[b][1] = __builtin_nontemporal_load((const u32x4*)(p + 512)); } }
#pragma unroll
        for (int b = 0; b < NB; ++b) {
            const int r = rb + b; if (r >= rend) break;
            float* xr = X + (size_t)r * 1024 + 8 * lane;
            f32x4 v[2][2]; float s = 0.f;
            int si2[2]; SlabRaw8 sr[2];
#pragma unroll
            for (int jj = 0; jj < 2; ++jj) { si2[jj] = stab[(r >> 8) * 4 + 2 * jj + (lane >> 5)]; if (si2[jj] != 255) sr[jj] = slab_load8(slab, si2[jj], r & 255, (8 * lane) & 255); }
#pragma unroll
            for (int jj = 0; jj < 2; ++jj) { bf8_to_f32(nx[b][jj], v[jj][0], v[jj][1]); if (si2[jj] != 255) slab_add8(sr[jj], v[jj][0], v[jj][1]);
#pragma unroll
                for (int n = 0; n < 2; ++n) s += (v[jj][n].x * v[jj][n].x + v[jj][n].y * v[jj][n].y) + (v[jj][n].z * v[jj][n].z + v[jj][n].w * v[jj][n].w); }
            const float rstd = rsqrtf(wave_sum(s) * (1.f / 1024.f) + 1e-6f);
#pragma unroll
            for (int jj = 0; jj < 2; ++jj)
#pragma unroll
                for (int n = 0; n < 2; ++n) __builtin_nontemporal_store(v[jj][n] * rstd * gv[jj][n], (f32x4*)(xr + 512 * jj + 4 * n));
        }
    }
}
__device__ __forceinline__ void mod_units(LAS unsigned char* lds, int first, int stride, int count, const float* c, const float* c_ctx, const float* ada_w, const float* ada_b, float* mod, int tid, int wave, int lane) {
    LAS float* sc = (LAS float*)lds;
    LAS float* red = (LAS float*)(lds + 20480);
    if (first >= count) return;
    const int c4 = lane & 7, kg = lane >> 3;
    for (int i = tid; i < 5 * 1024; i += NTHREADS) { const int cond = i >> 10, k = i & 1023; const float x = cond == 0 ? c_ctx[k] : c[(cond - 1) * 1024 + k]; sc[i] = silu(x); }
    __syncthreads();
    const LAS float* scl = sc + wave * 128 + kg * 16;
#pragma unroll 1
    for (int un = first; un < count; un += stride) {
        const int layer = un / 192, n0 = (un % 192) * 32;
        const float* w = ada_w + ((size_t)layer * 1024 + wave * 128 + kg * 16) * 6144 + n0 + 4 * c4;
        f32x4 wv[16];
#pragma unroll
        for (int j = 0; j < 16; ++j) wv[j] = __builtin_nontemporal_load((const f32x4*)(w + (size_t)j * 6144));
        f32x4 acc[5];
#pragma unroll
        for (int q = 0; q < 5; ++q) acc[q] = (f32x4){0.f, 0.f, 0.f, 0.f};
#pragma unroll
        for (int j4 = 0; j4 < 4; ++j4)
#pragma unroll
            for (int q = 0; q < 5; ++q) { const f32x4 sv = *(const LAS f32x4*)(scl + q * 1024 + 4 * j4);
                acc[q] += (wv[4 * j4] * sv.x + wv[4 * j4 + 1] * sv.y) + (wv[4 * j4 + 2] * sv.z + wv[4 * j4 + 3] * sv.w); }
#pragma unroll
        for (int q = 0; q < 5; ++q) {
#pragma unroll
            for (int e = 0; e < 4; ++e) { float v = acc[q][e]; v += __shfl_xor(v, 8); v += __shfl_xor(v, 16); v += __shfl_xor(v, 32); acc[q][e] = v; }
            if (kg == 0) *(LAS f32x4*)(red + (wave * 5 + q) * 32 + 4 * c4) = acc[q]; }
        __syncthreads();
        for (int i = tid; i < 5 * 32; i += NTHREADS) { const int q = i >> 5, n = i & 31; float s2 = 0.f;
#pragma unroll
            for (int ww = 0; ww < 8; ++ww) s2 += red[(ww * 5 + q) * 32 + n];
            mod[((size_t)q * 2 + layer) * 6144 + n0 + n] = s2 + ada_b[(size_t)layer * 6144 + n0 + n]; }
        __syncthreads();
    }
}

struct TrItem { const float* W; bf16_t* WT; int K, N, item; };
__device__ __forceinline__ void transpose_load(const TrItem& t, f32x4 (&ld)[8], int lane) {
    const int nblk = t.N / 32, kb = t.item / nblk, nb = t.item % nblk, k0 = 64 * kb, n0 = 32 * nb;
#pragma unroll
    for (int i = 0; i < 8; ++i) ld[i] = __builtin_nontemporal_load((const f32x4*)(t.W + (size_t)(k0 + 8 * i + (lane >> 3)) * t.N + n0 + 4 * (lane & 7)));
}
__device__ __forceinline__ void transpose_finish(const TrItem& t, const f32x4 (&ld)[8], LAS float* scr, int lane) {
    const int nblk = t.N / 32, kb = t.item / nblk, nb = t.item % nblk, k0 = 64 * kb, n0 = 32 * nb;
#pragma unroll
    for (int i = 0; i < 8; ++i) { LAS float* d = scr + (8 * i + (lane >> 3)) * 33 + 4 * (lane & 7); d[0] = ld[i][0]; d[1] = ld[i][1]; d[2] = ld[i][2]; d[3] = ld[i][3]; }
    asm volatile("s_waitcnt lgkmcnt(0)" ::: "memory");
    const int c = lane & 7;
#pragma unroll
    for (int j = 0; j < 4; ++j) { const int n = (lane >> 3) + 8 * j; const LAS float* s = scr + (8 * c) * 33 + n;
        u32x4 o; o.x = pk2(s[0 * 33], s[1 * 33]); o.y = pk2(s[2 * 33], s[3 * 33]); o.z = pk2(s[4 * 33], s[5 * 33]); o.w = pk2(s[6 * 33], s[7 * 33]);
        *(u32x4*)(t.WT + (size_t)(n0 + n) * t.K + k0 + 8 * c) = o; }
    asm volatile("s_waitcnt lgkmcnt(0)" ::: "memory");
}
template <class Dec> __device__ __forceinline__ void transpose_stream(int first, int count, int stride, Dec dec, LAS float* scr, int lane) {
    if (first >= count) return;
    f32x4 cur[8], nxt[8]; TrItem tc = dec(first), tn = tc;
    transpose_load(tc, cur, lane);
    for (int it = first; it < count; it += stride) {
        const bool more = it + stride < count;
        if (more) { tn = dec(it + stride); transpose_load(tn, nxt, lane); }
        transpose_finish(tc, cur, scr, lane);
        if (more) { tc = tn;
#pragma unroll
            for (int i = 0; i < 8; ++i) cur[i] = nxt[i]; }
    }
}


typedef float f32x16 __attribute__((ext_vector_type(16)));
typedef short v4i16_t __attribute__((ext_vector_type(4)));
constexpr int QA_RS = 272, QP_RS = 264, KB_RS = 272, KPP_RS = 320, V_RS = 320;
constexpr int T_QA = 0, T_QP = T_QA + 32 * QA_RS, T_KB = T_QP + 32 * QP_RS, T_KPP = T_KB + 32 * KB_RS, T_V = T_KPP + 32 * KPP_RS, T_EL = T_V + 32 * V_RS, DIR_BYTES = T_EL + 512;
constexpr int OBUF_OFF = 2 * DIR_BYTES, OBUF_BYTES = 256 * 256;
static_assert(OBUF_OFF + OBUF_BYTES <= 160 * 1024 - 512 && (DIR_BYTES % 16) == 0 && (T_QP % 16) == 0 && (T_KB % 16) == 0 && (T_KPP % 16) == 0 && (T_V % 16) == 0 && (T_EL % 16) == 0, "scan LDS map");
constexpr int SLOT_ELEMS = 128 * 128;
#ifndef SCAN_STAGGER
#define SCAN_STAGGER 0
#endif

struct ScanT { const bf16_t* q; const bf16_t* lffw; const bf16_t* lfbw; const bf16_t* v; bf16_t* sg; bf16_t* slots; float* dvec; const float* gnorm; const float* state_in; float* new_state; };

__device__ __forceinline__ bf16x8 tr_pair(const LAS unsigned char* p0, const LAS unsigned char* p1) {
    const v4i16_t lo = __builtin_amdgcn_ds_read_tr16_b64_v4i16((LAS v4i16_t*)p0), hi = __builtin_amdgcn_ds_read_tr16_b64_v4i16((LAS v4i16_t*)p1);
    return (bf16x8){lo[0], lo[1], lo[2], lo[3], hi[0], hi[1], hi[2], hi[3]};
}
__device__ __forceinline__ bf16x8 pack_acc8(const f32x16& x, int s8) {
    u32x4 w; w.x = cvt_pk_bf16(x[8 * s8 + 0], x[8 * s8 + 1]); w.y = cvt_pk_bf16(x[8 * s8 + 2], x[8 * s8 + 3]); w.z = cvt_pk_bf16(x[8 * s8 + 4], x[8 * s8 + 5]); w.w = cvt_pk_bf16(x[8 * s8 + 6], x[8 * s8 + 7]);
    return __builtin_bit_cast(bf16x8, w);
}
__device__ __forceinline__ float h2f(unsigned short b) { return (float)__builtin_bit_cast(_Float16, b); }

template <bool FULL>
__device__ __forceinline__ void scan_item(LAS unsigned char* lds, const ScanT& T, int tok0, int h, bool act0, bool act1, const bf16_t* init0, const bf16_t* init1,
                                          float* fin0, float* fin1, bf16_t* outs0, bf16_t* outs1, float* outd0, float* outd1) {
    const int tid = threadIdx.x, wave = __builtin_amdgcn_readfirstlane(tid >> 6), dir = wave >> 2, wg = wave & 3;
    LAS unsigned char* prof_lds_ = lds; (void)prof_lds_; PROF_DECL; PROF_BEGIN();
    const bool act = dir ? act1 : act0;
    const bf16_t* init = dir ? init1 : init0;
    LAS unsigned char* D = lds + dir * DIR_BYTES;
    LAS unsigned char* OB = lds + OBUF_OFF;
    const bf16_t* lfp = dir ? T.lfbw : T.lffw;
#define SCAN_LANE(x) int x; asm volatile("v_mbcnt_lo_u32_b32 %0, -1, 0\n\tv_mbcnt_hi_u32_b32 %0, -1, %0" : "=v"(x))
#define SCAN_PREP_ROLE SCAN_LANE(ln_); const int pp = 16 * wg + (ln_ & 15), uu = ln_ >> 4, gt_ = wg * 64 + ln_, vt = gt_ >> 3, vc2 = gt_ & 7
#define SCAN_MFMA_ROLE SCAN_LANE(ln_); const int l31 = ln_ & 31, hh = ln_ >> 5, gq = (ln_ & 15) >> 2, gp = ln_ & 3, vcol = 16 * ((ln_ >> 4) & 1)
    f32x16 S[4];
#pragma unroll
    for (int t4 = 0; t4 < 4; ++t4) {
        if (init && act) { SCAN_LANE(lane0); const int lane = lane0; const u32x4* sp = (const u32x4*)(init + ((size_t)(wg * 4 + t4) * 64 + lane) * 16); const u32x4 a = sp[0], b = sp[1];
            const unsigned w8[8] = {a.x, a.y, a.z, a.w, b.x, b.y, b.z, b.w};
#pragma unroll
            for (int j = 0; j < 8; ++j) { S[t4][2 * j] = __builtin_bit_cast(float, w8[j] << 16); S[t4][2 * j + 1] = __builtin_bit_cast(float, w8[j] & 0xffff0000u); } }
        else {
#pragma unroll
            for (int j = 0; j < 16; ++j) S[t4][j] = 0.f; }
    }
    float dsum0 = 0.f, dsum1 = 0.f;
    unsigned qreg[8], lfreg[8]; u32x4 vreg[2];
#define SCAN_LOAD(i) do { \
        _Pragma("unroll") for (int e = 0; e < 8; ++e) { const size_t ub_ = ((size_t)(tok0 + (dir ? 231 - 32 * (i) - e : 32 * (i) + e)) * 1024 + h * 128) * 2; \
            if (FULL) qreg[e] = *(const unsigned*)((const char*)T.q + ub_ + lo_q); lfreg[e] = *(const unsigned*)((const char*)lfp + ub_ + lo_q); } \
        { const size_t ub_ = ((size_t)(tok0 + (dir ? 224 - 32 * (i) : 32 * (i))) * 1024 + h * 128) * 2; vreg[0] = *(const u32x4*)((const char*)T.v + ub_ + lo_v); vreg[1] = *(const u32x4*)((const char*)T.v + ub_ + lo_v + 16); } } while (0)
    SCAN_LANE(ln_); const int lane = ln_;
    const int pp = 16 * wg + (ln_ & 15), uu = ln_ >> 4, gt_ = wg * 64 + ln_, vt = gt_ >> 3, vc2 = gt_ & 7;
    const int l31 = ln_ & 31, hh = ln_ >> 5, gq = (ln_ & 15) >> 2, gp = ln_ & 3, vcol = 16 * ((ln_ >> 4) & 1);
    const unsigned lo_q = (unsigned)(((dir ? 3 - uu : uu) * 8 * 1024 + 2 * pp) * 2), lo_v = (unsigned)(((dir ? 31 - vt : vt) * 1024 + 16 * vc2) * 2);
    unsigned pmask[8];
#pragma unroll
    for (int i2 = 0; i2 < 8; ++i2) { const int j0 = 2 * i2, s0 = (j0 & 3) + 8 * (j0 >> 2) + 4 * hh, s1 = s0 + 1; pmask[i2] = (s0 <= l31 ? 0x0000ffffu : 0u) | (s1 <= l31 ? 0xffff0000u : 0u); }
    if (act) { SCAN_LOAD(0); }
    PROF_END(6);
    for (int s = 0; s < 16 + SCAN_STAGGER; ++s) {
        const int ph = s - (SCAN_STAGGER ? dir : 0);
        if (act && ph >= 0 && ph < 16) {
            const int i = ph >> 1;
            if ((ph & 1) == 0) {
#if defined(PROF_ID)
                PROF_BEGIN(); asm volatile("s_waitcnt vmcnt(0)" ::: "memory"); PROF_END(1); PROF_BEGIN();
#endif
                *(LAS u32x4*)(D + T_V + vt * V_RS + vc2 * 32) = vreg[0]; *(LAS u32x4*)(D + T_V + vt * V_RS + vc2 * 32 + 16) = vreg[1];
                f32x2 cc[8]; f32x2 aa = (f32x2){0.f, 0.f};
#pragma unroll
                for (int e = 0; e < 8; ++e) { aa += (f32x2){h2f((unsigned short)(lfreg[e] & 0xffffu)), h2f((unsigned short)(lfreg[e] >> 16))}; cc[e] = aa; }
                f32x2 tq[4];
#pragma unroll
                for (int u2 = 0; u2 < 4; ++u2) { tq[u2].x = __shfl(aa.x, (lane & 15) + 16 * u2); tq[u2].y = __shfl(aa.y, (lane & 15) + 16 * u2); }
                const f32x2 zz = (f32x2){0.f, 0.f};
                const f32x2 pre = (uu > 0 ? tq[0] : zz) + (uu > 1 ? tq[1] : zz) + (uu > 2 ? tq[2] : zz);
                const f32x2 rr = tq[0] + tq[1], bl = rr + tq[2] + tq[3];
#define EX2V(v) ((f32x2){__builtin_amdgcn_exp2f((v).x), __builtin_amdgcn_exp2f((v).y)})
                if (FULL) {
                    const f32x2 er = EX2V(rr), elr = EX2V(bl - rr), base = pre - rr;
#pragma unroll
                    for (int e = 0; e < 8; ++e) {
                        const int tl = 8 * uu + e;
                        const f32x2 d = base + cc[e];
                        const f32x2 ea = EX2V(d), eb = EX2V(-d);
                        const f32x2 lfv = (f32x2){h2f((unsigned short)(lfreg[e] & 0xffffu)), h2f((unsigned short)(lfreg[e] >> 16))};
                        const f32x2 kk = 1.f - EX2V(lfv);
                        const f32x2 qq = (f32x2){__builtin_bit_cast(float, qreg[e] << 16), __builtin_bit_cast(float, qreg[e] & 0xffff0000u)};
                        const f32x2 qa = qq * ea, kb = kk * eb, qp = qa * er, kpp = kb * elr;
                        *(LAS unsigned*)(D + T_QA + tl * QA_RS + 4 * pp) = cvt_pk_bf16(qa.x, qa.y);
                        *(LAS unsigned*)(D + T_QP + tl * QP_RS + 4 * pp) = cvt_pk_bf16(qp.x, qp.y);
                        *(LAS unsigned*)(D + T_KB + tl * KB_RS + 4 * pp) = cvt_pk_bf16(kb.x, kb.y);
                        *(LAS unsigned*)(D + T_KPP + tl * KPP_RS + 4 * pp) = cvt_pk_bf16(kpp.x, kpp.y);
                        if (e & 1) __builtin_amdgcn_sched_barrier(0);
                    }
                } else {
                    const f32x2 base = bl - pre;
#pragma unroll
                    for (int e = 0; e < 8; ++e) {
                        const int tl = 8 * uu + e;
                        const f32x2 d = base - cc[e];
                        const f32x2 lfv = (f32x2){h2f((unsigned short)(lfreg[e] & 0xffffu)), h2f((unsigned short)(lfreg[e] >> 16))};
                        const f32x2 kpp = (1.f - EX2V(lfv)) * EX2V(d);
                        *(LAS unsigned*)(D + T_KPP + tl * KPP_RS + 4 * pp) = cvt_pk_bf16(kpp.x, kpp.y);
                    }
                    dsum0 += bl.x; dsum1 += bl.y;
                }
                if (uu == 0) { *(LAS f32x2*)(D + T_EL + 8 * pp) = EX2V(bl); }
                __builtin_amdgcn_sched_barrier(0);
#if defined(PROF_ID)
                asm volatile("s_waitcnt lgkmcnt(0)" ::: "memory"); PROF_END(2);
#endif
                if (i < 7) SCAN_LOAD(i + 1);
            } else {
                PROF_BEGIN();
                if (FULL) {
                    f32x16 P;
#pragma unroll
                    for (int j = 0; j < 16; ++j) P[j] = 0.f;
#pragma unroll
                    for (int ks = 0; ks < 8; ++ks) {
                        const bf16x8 ka = *(const LAS bf16x8*)(D + T_KB + l31 * KB_RS + (16 * ks + 8 * hh) * 2);
                        const bf16x8 qb = *(const LAS bf16x8*)(D + T_QA + l31 * QA_RS + (16 * ks + 8 * hh) * 2);
                        P = __builtin_amdgcn_mfma_f32_32x32x16_bf16(ka, qb, P, 0, 0, 0);
                    }
                    f32x16 o;
#pragma unroll
                    for (int j = 0; j < 16; ++j) o[j] = 0.f;
#pragma unroll
                    for (int s8 = 0; s8 < 2; ++s8) {
                        const LAS unsigned char* vb = D + T_V + (16 * s8 + 4 * hh + gq) * V_RS + (32 * wg + vcol + 4 * gp) * 2;
                        const bf16x8 vf = tr_pair(vb, vb + 8 * V_RS);
                        u32x4 pw; pw.x = cvt_pk_bf16(P[8 * s8 + 0], P[8 * s8 + 1]) & pmask[4 * s8 + 0]; pw.y = cvt_pk_bf16(P[8 * s8 + 2], P[8 * s8 + 3]) & pmask[4 * s8 + 1];
                        pw.z = cvt_pk_bf16(P[8 * s8 + 4], P[8 * s8 + 5]) & pmask[4 * s8 + 2]; pw.w = cvt_pk_bf16(P[8 * s8 + 6], P[8 * s8 + 7]) & pmask[4 * s8 + 3];
                        o = __builtin_amdgcn_mfma_f32_32x32x16_bf16(__builtin_bit_cast(bf16x8, pw), vf, o, 0, 0, 0);
                    }
#pragma unroll
                    for (int t4 = 0; t4 < 4; ++t4)
#pragma unroll
                        for (int s8 = 0; s8 < 2; ++s8) {
                            const LAS unsigned char* qp = D + T_QP + l31 * QP_RS + (32 * t4 + 16 * s8 + 4 * hh) * 2;
                            const u32x2 lo = *(const LAS u32x2*)qp, hi = *(const LAS u32x2*)(qp + 16);
                            const u32x4 aw = {lo.x, lo.y, hi.x, hi.y};
                            o = __builtin_amdgcn_mfma_f32_32x32x16_bf16(__builtin_bit_cast(bf16x8, aw), pack_acc8(S[t4], s8), o, 0, 0, 0);
                        }
                    const int jsc = dir ? 7 - i : i;
                    LAS unsigned short* ob = (LAS unsigned short*)(OB + (32 * jsc + (dir ? 31 - 4 * hh : 4 * hh)) * 256 + (32 * wg + l31) * 2);
                    const int rs = dir ? -128 : 128;
                    if (i >= 4) {
                        unsigned short pv[16];
#pragma unroll
                        for (int j = 0; j < 16; ++j) pv[j] = ob[((j & 3) + 8 * (j >> 2)) * rs];
#pragma unroll
                        for (int j = 0; j < 16; ++j) o[j] += bf2f(pv[j]);
                    }
#pragma unroll
                    for (int j = 0; j < 16; ++j) ob[((j & 3) + 8 * (j >> 2)) * rs] = (unsigned short)cvt_pk_bf16(o[j], o[j]);
                }
                __builtin_amdgcn_sched_barrier(0);
#pragma unroll
                for (int t4 = 0; t4 < 4; ++t4) {
#pragma unroll
                    for (int g = 0; g < 4; ++g) { const f32x4 f = *(const LAS f32x4*)(D + T_EL + (32 * t4 + 8 * g + 4 * hh) * 4);
                        S[t4][4 * g + 0] *= f[0]; S[t4][4 * g + 1] *= f[1]; S[t4][4 * g + 2] *= f[2]; S[t4][4 * g + 3] *= f[3]; }
#pragma unroll
                    for (int s8 = 0; s8 < 2; ++s8) {
                        const LAS unsigned char* kb = D + T_KPP + (16 * s8 + 8 * hh + gq) * KPP_RS + (32 * t4 + vcol + 4 * gp) * 2;
                        const LAS unsigned char* vb = D + T_V + (16 * s8 + 8 * hh + gq) * V_RS + (32 * wg + vcol + 4 * gp) * 2;
                        const bf16x8 ka = tr_pair(kb, kb + 4 * KPP_RS), vf = tr_pair(vb, vb + 4 * V_RS);
                        S[t4] = __builtin_amdgcn_mfma_f32_32x32x16_bf16(ka, vf, S[t4], 0, 0, 0);
                    }
                }
                PROF_END(3);
            }
        }
        PROF_BEGIN();
        __syncthreads();
        PROF_END(4);
    }
#undef SCAN_LOAD
    PROF_BEGIN();
    if (FULL) {
        float* fin = dir ? fin1 : fin0;
        if (fin && act) {
#pragma unroll
            for (int t4 = 0; t4 < 4; ++t4)
#pragma unroll
                for (int j = 0; j < 16; ++j) __builtin_nontemporal_store(S[t4][j], fin + (size_t)(32 * t4 + (j & 3) + 8 * (j >> 2) + 4 * hh) * 128 + 32 * wg + l31);
        }
        const int cv = tid & 15;
        f32x4 gn0 = *(const f32x4*)(T.gnorm + 8 * cv), gn1 = *(const f32x4*)(T.gnorm + 8 * cv + 4);
        u32x4 gwv[8];
#pragma unroll
        for (int pass = 0; pass < 8; ++pass) gwv[pass] = __builtin_nontemporal_load((const u32x4*)(T.sg + (size_t)(tok0 + 32 * pass + (tid >> 4)) * 1024 + h * 128 + 8 * cv));
#pragma unroll
        for (int pass = 0; pass < 8; ++pass) {
            const int row = 32 * pass + (tid >> 4);
            const u32x4 ow = *(const LAS u32x4*)(OB + row * 256 + cv * 16);
            bf16_t* gp_ = T.sg + (size_t)(tok0 + row) * 1024 + h * 128 + 8 * cv;
            const u32x4 gw = gwv[pass];
            float ov[8], gv[8];
            const unsigned o4[4] = {ow.x, ow.y, ow.z, ow.w}, g4[4] = {gw.x, gw.y, gw.z, gw.w};
            float ss = 0.f;
#pragma unroll
            for (int j = 0; j < 4; ++j) { ov[2 * j] = __builtin_bit_cast(float, o4[j] << 16); ov[2 * j + 1] = __builtin_bit_cast(float, o4[j] & 0xffff0000u);
                gv[2 * j] = __builtin_bit_cast(float, g4[j] << 16); gv[2 * j + 1] = __builtin_bit_cast(float, g4[j] & 0xffff0000u);
                ss += ov[2 * j] * ov[2 * j] + ov[2 * j + 1] * ov[2 * j + 1]; }
            ss += __shfl_xor(ss, 1); ss += __shfl_xor(ss, 2); ss += __shfl_xor(ss, 4); ss += __shfl_xor(ss, 8);
            const float rstd = rsqrtf(ss * (1.f / 128.f) + 1e-6f);
            u32x4 w;
            w.x = cvt_pk_bf16(ov[0] * rstd * gn0[0] * gv[0], ov[1] * rstd * gn0[1] * gv[1]); w.y = cvt_pk_bf16(ov[2] * rstd * gn0[2] * gv[2], ov[3] * rstd * gn0[3] * gv[3]);
            w.z = cvt_pk_bf16(ov[4] * rstd * gn1[0] * gv[4], ov[5] * rstd * gn1[1] * gv[5]); w.w = cvt_pk_bf16(ov[6] * rstd * gn1[2] * gv[6], ov[7] * rstd * gn1[3] * gv[7]);
            *(u32x4*)gp_ = w;
        }
#if defined(PROF_ID)
        asm volatile("s_waitcnt vmcnt(0)" ::: "memory");
#endif
        __syncthreads(); PROF_END(5);
    } else {
        bf16_t* outs = dir ? outs1 : outs0; float* outd = dir ? outd1 : outd0;
        if (act) {
#pragma unroll
            for (int t4 = 0; t4 < 4; ++t4) {
                u32x4 a, b;
                a.x = cvt_pk_bf16(S[t4][0], S[t4][1]); a.y = cvt_pk_bf16(S[t4][2], S[t4][3]); a.z = cvt_pk_bf16(S[t4][4], S[t4][5]); a.w = cvt_pk_bf16(S[t4][6], S[t4][7]);
                b.x = cvt_pk_bf16(S[t4][8], S[t4][9]); b.y = cvt_pk_bf16(S[t4][10], S[t4][11]); b.z = cvt_pk_bf16(S[t4][12], S[t4][13]); b.w = cvt_pk_bf16(S[t4][14], S[t4][15]);
                u32x4* sp = (u32x4*)(outs + ((size_t)(wg * 4 + t4) * 64 + lane) * 16); sp[0] = a; sp[1] = b;
            }
            const int pp = 16 * wg + (lane & 15); if ((lane >> 4) == 0) { outd[2 * pp] = __builtin_amdgcn_exp2f(dsum0); outd[2 * pp + 1] = __builtin_amdgcn_exp2f(dsum1); }
        }
    }
}

constexpr int A_KPP = 0, A_V = 32 * KPP_RS, A_SET = A_V + 32 * V_RS;
static_assert(2 * A_SET <= DIR_BYTES && (A_SET % 16) == 0 && (A_V % 16) == 0, "phase-A LDS map");
__device__ __forceinline__ void scan_a_fast(LAS unsigned char* lds, const ScanT& T, int tok0, int h, bool act0, bool act1, bf16_t* outs0, bf16_t* outs1, float* outd0, float* outd1) {
    const int tid = threadIdx.x, wave = __builtin_amdgcn_readfirstlane(tid >> 6), dir = wave >> 2, wg = wave & 3;
    const bool act = dir ? act1 : act0;
    LAS unsigned char* D = lds + dir * DIR_BYTES;
    const bf16_t* lfp = dir ? T.lfbw : T.lffw;
    SCAN_LANE(ln_); const int lane = ln_;
    const int pp = 16 * wg + (ln_ & 15), uu = ln_ >> 4, gt_ = wg * 64 + ln_, vt = gt_ >> 3, vc2 = gt_ & 7;
    const int hh = ln_ >> 5, gq = (ln_ & 15) >> 2, gp = ln_ & 3, vcol = 16 * ((ln_ >> 4) & 1);
    f32x16 S[4];
#pragma unroll
    for (int t4 = 0; t4 < 4; ++t4)
#pragma unroll
        for (int j = 0; j < 16; ++j) S[t4][j] = 0.f;
    f32x2 off = (f32x2){0.f, 0.f};
    unsigned lfreg[2][8]; u32x4 vreg[2][2];
#define A_LOAD(i, B) do { const int jsc_ = dir ? (i) : 7 - (i); \
        _Pragma("unroll") for (int e = 0; e < 8; ++e) { const int tl = 8 * uu + e; lfreg[B][e] = *(const unsigned*)(lfp + (size_t)(tok0 + 32 * jsc_ + (dir ? 31 - tl : tl)) * 1024 + h * 128 + 2 * pp); } \
        { const size_t tk = (size_t)(tok0 + 32 * jsc_ + (dir ? 31 - vt : vt)) * 1024 + h * 128 + 16 * vc2; vreg[B][0] = *(const u32x4*)(T.v + tk); vreg[B][1] = *(const u32x4*)(T.v + tk + 8); } } while (0)
#define A_PREP(i, B) do { LAS unsigned char* Ds = D + (B) * A_SET; \
        *(LAS u32x4*)(Ds + A_V + vt * V_RS + vc2 * 32) = vreg[B][0]; *(LAS u32x4*)(Ds + A_V + vt * V_RS + vc2 * 32 + 16) = vreg[B][1]; \
        f32x2 cc[8]; f32x2 aa = (f32x2){0.f, 0.f}; \
        _Pragma("unroll") for (int e = 0; e < 8; ++e) { aa += (f32x2){h2f((unsigned short)(lfreg[B][e] & 0xffffu)), h2f((unsigned short)(lfreg[B][e] >> 16))}; cc[e] = aa; } \
        f32x2 tq[4]; \
        _Pragma("unroll") for (int u2 = 0; u2 < 4; ++u2) { tq[u2].x = __shfl(aa.x, (lane & 15) + 16 * u2); tq[u2].y = __shfl(aa.y, (lane & 15) + 16 * u2); } \
        const f32x2 zz = (f32x2){0.f, 0.f}; \
        const f32x2 pre = (uu > 0 ? tq[0] : zz) + (uu > 1 ? tq[1] : zz) + (uu > 2 ? tq[2] : zz); \
        const f32x2 bl = (tq[0] + tq[1]) + (tq[2] + tq[3]); \
        const f32x2 base = (bl - pre) + off; \
        _Pragma("unroll") for (int e = 0; e < 8; ++e) { const int tl = 8 * uu + e; const f32x2 d = base - cc[e]; \
            const f32x2 lfv = (f32x2){h2f((unsigned short)(lfreg[B][e] & 0xffffu)), h2f((unsigned short)(lfreg[B][e] >> 16))}; \
            const f32x2 kpp = (1.f - EX2V(lfv)) * EX2V(d); \
            *(LAS unsigned*)(Ds + A_KPP + tl * KPP_RS + 4 * pp) = cvt_pk_bf16(kpp.x, kpp.y); } \
        off += bl; \
        if ((i) + 2 < 8) A_LOAD((i) + 2, B); } while (0)
#define A_MFMA(B) do { const LAS unsigned char* Ds = D + (B) * A_SET; bf16x8 vf[2]; \
        _Pragma("unroll") for (int s8 = 0; s8 < 2; ++s8) { const LAS unsigned char* vb = Ds + A_V + (16 * s8 + 8 * hh + gq) * V_RS + (32 * wg + vcol + 4 * gp) * 2; vf[s8] = tr_pair(vb, vb + 4 * V_RS); } \
        _Pragma("unroll") for (int t4 = 0; t4 < 4; ++t4) \
            _Pragma("unroll") for (int s8 = 0; s8 < 2; ++s8) { const LAS unsigned char* kb = Ds + A_KPP + (16 * s8 + 8 * hh + gq) * KPP_RS + (32 * t4 + vcol + 4 * gp) * 2; \
                S[t4] = __builtin_amdgcn_mfma_f32_32x32x16_bf16(tr_pair(kb, kb + 4 * KPP_RS), vf[s8], S[t4], 0, 0, 0); } } while (0)
    if (act) { A_LOAD(0, 0); A_LOAD(1, 1); A_PREP(0, 0); }
#pragma unroll
    for (int i2 = 0; i2 < 4; ++i2) {
        __syncthreads();
        if (act) { A_PREP(2 * i2 + 1, 1); A_MFMA(0); }
        __syncthreads();
        if (act) { if (i2 < 3) A_PREP(2 * i2 + 2, 0); A_MFMA(1); }
    }
#undef A_LOAD
#undef A_PREP
#undef A_MFMA
    bf16_t* outs = dir ? outs1 : outs0; float* outd = dir ? outd1 : outd0;
    if (act) {
#pragma unroll
        for (int t4 = 0; t4 < 4; ++t4) {
            u32x4 a, b;
            a.x = cvt_pk_bf16(S[t4][0], S[t4][1]); a.y = cvt_pk_bf16(S[t4][2], S[t4][3]); a.z = cvt_pk_bf16(S[t4][4], S[t4][5]); a.w = cvt_pk_bf16(S[t4][6], S[t4][7]);
            b.x = cvt_pk_bf16(S[t4][8], S[t4][9]); b.y = cvt_pk_bf16(S[t4][10], S[t4][11]); b.z = cvt_pk_bf16(S[t4][12], S[t4][13]); b.w = cvt_pk_bf16(S[t4][14], S[t4][15]);
            u32x4* sp = (u32x4*)(outs + ((size_t)(wg * 4 + t4) * 64 + lane) * 16); sp[0] = a; sp[1] = b;
        }
        if (uu == 0) { outd[2 * pp] = __builtin_amdgcn_exp2f(off.x); outd[2 * pp + 1] = __builtin_amdgcn_exp2f(off.y); }
    }
    __syncthreads();
}
__device__ __forceinline__ size_t slot_of(int dir, int b, int h, int sc) { return (size_t)((dir * 4 + b) * 8 + h) * 16 + sc; }

__device__ __forceinline__ void scan_a_item(LAS unsigned char* lds, const ScanT& T, int it) {
    const int sc = it & 15, h = (it >> 4) & 7, b = it >> 7;
    const size_t sf = slot_of(0, b, h, sc < 15 ? sc + 1 : 0), sb = slot_of(1, b, h, sc > 0 ? sc - 1 : 0);
    scan_a_fast(lds, T, 4096 + b * 4096 + sc * 256, h, sc < 15, sc > 0, T.slots + sf * SLOT_ELEMS, T.slots + sb * SLOT_ELEMS, T.dvec + sf * 128, T.dvec + sb * 128);
}
__device__ __forceinline__ void scan_ctx_item(LAS unsigned char* lds, const ScanT& T, int ci) {
    const int h = ci & 7, b = ci >> 3;
    float* ns = T.new_state + (size_t)(b * 2) * 8 * 16384 + (size_t)h * 16384;
    scan_item<true>(lds, T, b * 256, h, true, true, nullptr, nullptr, ns, ns + (size_t)8 * 16384, nullptr, nullptr, nullptr, nullptr);
}
__device__ __forceinline__ void scan_phase_a(LAS unsigned char* lds, const ScanT& T, int G, int bx) {
    if (G == 256) {
        if (bx < 128) { scan_ctx_item(lds, T, bx); scan_a_item(lds, T, 384 + bx); }
        else { for (int k = 0; k < 3; ++k) scan_a_item(lds, T, (bx - 128) * 3 + k); }
    } else {
        for (int it = bx; it < 640; it += G) { if (it < 512) scan_a_item(lds, T, it); else scan_ctx_item(lds, T, it - 512); }
    }
}
__device__ __forceinline__ void scan_phase_b(const ScanT& T, int G, int bx, int tid) {
    for (int gid = bx * NTHREADS + tid; gid < 64 * 2048; gid += G * NTHREADS) {
        const int combo = gid >> 11, e = (gid & 2047) * 8, dir = combo >> 5, b = (combo >> 3) & 3, h = combo & 7;
        const int reg0 = e & 15, ln = (e >> 4) & 63, t4 = (e >> 10) & 3, w = (e >> 12) & 3;
        const int v = 32 * w + (ln & 31);
        float s[8]; int kk[8];
#pragma unroll
        for (int j = 0; j < 8; ++j) { const int rg = reg0 + j; kk[j] = 32 * t4 + (rg & 3) + 8 * (rg >> 2) + 4 * (ln >> 5); s[j] = __builtin_nontemporal_load(T.state_in + ((size_t)((b * 2 + dir) * 8 + h) * 128 + kk[j]) * 128 + v); }
        u32x4 lwn = (u32x4){0u, 0u, 0u, 0u}; float dn[8];
#pragma unroll
        for (int j = 0; j < 8; ++j) dn[j] = 0.f;
        { const size_t sl1 = slot_of(dir, b, h, dir ? 14 : 1); lwn = *(const u32x4*)(T.slots + sl1 * SLOT_ELEMS + e);
#pragma unroll
          for (int j = 0; j < 8; ++j) dn[j] = T.dvec[sl1 * 128 + kk[j]]; }
        for (int st = 0; st < 16; ++st) {
            const int sc = dir ? 15 - st : st;
            const size_t sl = slot_of(dir, b, h, sc);
            u32x4* sp = (u32x4*)(T.slots + sl * SLOT_ELEMS + e);
            if (st > 0) {
                const u32x4 lw = lwn; float dc[8];
#pragma unroll
                for (int j = 0; j < 8; ++j) dc[j] = dn[j];
                if (st < 15) { const size_t sl2 = slot_of(dir, b, h, dir ? 14 - st : st + 1); lwn = *(const u32x4*)(T.slots + sl2 * SLOT_ELEMS + e);
#pragma unroll
                    for (int j = 0; j < 8; ++j) dn[j] = T.dvec[sl2 * 128 + kk[j]]; }
                const unsigned l4[4] = {lw.x, lw.y, lw.z, lw.w};
#pragma unroll
                for (int j = 0; j < 4; ++j) { s[2 * j] = dc[2 * j] * s[2 * j] + __builtin_bit_cast(float, l4[j] << 16);
                    s[2 * j + 1] = dc[2 * j + 1] * s[2 * j + 1] + __builtin_bit_cast(float, l4[j] & 0xffff0000u); }
            }
            u32x4 o; o.x = cvt_pk_bf16(s[0], s[1]); o.y = cvt_pk_bf16(s[2], s[3]); o.z = cvt_pk_bf16(s[4], s[5]); o.w = cvt_pk_bf16(s[6], s[7]);
            *sp = o;
        }
    }
}
__device__ __forceinline__ void scan_phase_c(LAS unsigned char* lds, const ScanT& T, int G, int bx) {
    for (int it = bx; it < 512; it += G) {
        const int sc = it & 15, h = (it >> 4) & 7, b = it >> 7;
        scan_item<true>(lds, T, 4096 + b * 4096 + sc * 256, h, true, true, T.slots + slot_of(0, b, h, sc) * SLOT_ELEMS, T.slots + slot_of(1, b, h, sc) * SLOT_ELEMS,
                        nullptr, nullptr, nullptr, nullptr, nullptr, nullptr);
    }
}

#define XB_TMO      128
#define XB_XCNT(j)  (256  + 64 * (j))
#define XB_XSUB(j)  (1280 + 64 * (j))
#define XB_XGEN(j)  (2304 + 64 * (j))
#define XB_TOP      3328
#define XB_TOPGEN   3392
#define XCD_BAR_WORDS 3456
#define XB_SPIN_CAP (1u << 18)
__device__ __forceinline__ unsigned xb_ld(unsigned* p)              { return __hip_atomic_load(p, __ATOMIC_RELAXED, __HIP_MEMORY_SCOPE_AGENT); }
__device__ __forceinline__ unsigned xb_add(unsigned* p, unsigned v) { return __hip_atomic_fetch_add(p, v, __ATOMIC_RELAXED, __HIP_MEMORY_SCOPE_AGENT); }
__device__ __forceinline__ unsigned xb_xcc_id() { return (unsigned)__builtin_amdgcn_s_getreg((3 << 11) | 20) & 0xFu; }
#define XB_SPIN(cond, bar) do { unsigned _sp = 0; while (cond) { __builtin_amdgcn_s_sleep(1); \
    if ((++_sp & 255u) == 0u) { if (xb_ld(&(bar)[XB_TMO])) break; if (_sp > XB_SPIN_CAP) { atomicAdd(&(bar)[XB_TMO], 1u); break; } } } } while (0)
struct XcdBarrier { unsigned* bar; unsigned x; volatile LAS unsigned* st; };
__device__ __forceinline__ XcdBarrier xcd_barrier_post(unsigned* bar, volatile LAS unsigned* st) {
    XcdBarrier b; b.bar = bar; b.x = xb_xcc_id(); b.st = st;
    if (threadIdx.x == 0) (void)xb_add(&bar[XB_XCNT(b.x)], 1u);
    return b;
}
__device__ __forceinline__ void xcd_barrier_complete(unsigned* bar, unsigned x, unsigned& nloc, unsigned& nx) {
    const unsigned G = gridDim.x * gridDim.y * gridDim.z;
    unsigned sum, cnt, mine, sp = 0u;
    for (;;) {
        sum = 0u; cnt = 0u; mine = 0u;
#pragma unroll
        for (unsigned j = 0; j < 16; ++j) { const unsigned c = xb_ld(&bar[XB_XCNT(j)]); sum += c; cnt += (c > 0u) ? 1u : 0u; mine = (j == x) ? c : mine; }
        if (sum == G) break;
        __builtin_amdgcn_s_sleep(1);
        if ((++sp & 255u) == 0u) { if (xb_ld(&bar[XB_TMO])) break; if (sp > XB_SPIN_CAP) { atomicAdd(&bar[XB_TMO], 1u); break; } }
    }
    nloc = mine > 0u ? mine : 1u; nx = cnt > 0u ? cnt : 1u;
}
__device__ __forceinline__ void xcd_barrier(const XcdBarrier& b) {
    asm volatile("s_waitcnt vmcnt(0)" ::: "memory");
    __syncthreads();
    if (threadIdx.x == 0) {
        unsigned* bar = b.bar;
        __builtin_amdgcn_s_waitcnt(0);
        unsigned nloc = b.st[0], nx = b.st[1];
        if (nloc == 0u) { xcd_barrier_complete(bar, b.x, nloc, nx); b.st[0] = nloc; b.st[1] = nx; }
        const unsigned old = xb_add(&bar[XB_XSUB(b.x)], 1u);
        const unsigned gen = old / nloc;
        if (old + 1u == (gen + 1u) * nloc) {
            __builtin_amdgcn_fence(__ATOMIC_RELEASE, "agent");
            asm volatile("s_waitcnt vmcnt(0)" ::: "memory");
            const unsigned og = xb_add(&bar[XB_TOP], 1u);
            const unsigned tg = og / nx;
            if (og + 1u == (tg + 1u) * nx) xb_add(&bar[XB_TOPGEN], 1u);
            else XB_SPIN(xb_ld(&bar[XB_TOPGEN]) == tg, bar);
            __builtin_amdgcn_fence(__ATOMIC_ACQUIRE, "agent");
            xb_add(&bar[XB_XGEN(b.x)], 1u);
            asm volatile("s_waitcnt vmcnt(0)" ::: "memory");
        } else {
            XB_SPIN(xb_ld(&bar[XB_XGEN(b.x)]) == gen, bar);
            __builtin_amdgcn_fence(__ATOMIC_ACQUIRE, "agent");
            asm volatile("s_waitcnt vmcnt(0)" ::: "memory");
        }
    }
    __syncthreads();
}

struct Args { const float* in[17]; float* out; unsigned char* ws; int ph_lo, ph_hi; };
enum { PH_PREP = 0, PH_EMBED = 1, PH_FN_CHAN = 2, PH_FN_POS1 = 3, PH_FN_POS2 = 4, PH_FN_WO = 5, PH_NORM_MLP0 = 6, PH_MLP1_0 = 7, PH_MLP2_0 = 8, PH_NORM_MIX1 = 9, PH_WIN = 10,
       PH_SCAN_A = 11, PH_SCAN_B = 12, PH_SCAN_C = 13, PH_HG_WO = 14, PH_NORM_MLP1 = 15, PH_MLP1_1 = 16, PH_MLP2_1 = 17, PH_FINAL = 18, PH_END = 19 };
constexpr int LDS_BYTES = 160 * 1024, MISC_OFF = LDS_BYTES - 512;

__global__ void __launch_bounds__(NTHREADS, 2) fwd(Args a) {
    extern __shared__ __attribute__((aligned(16))) unsigned char lds_raw[];
    LAS unsigned char* lds = (LAS unsigned char*)lds_raw;
    const int tid = threadIdx.x, lane = tid & 63, wave = __builtin_amdgcn_readfirstlane(tid >> 6);
    const int G = gridDim.x, bx = blockIdx.x;
    const int gw = bx * NWAVES + wave, ngw = G * NWAVES;
    unsigned char* ws = a.ws;
    const float* mod = (const float*)(ws + WM.mod);
    bf16_t* Hb = (bf16_t*)(ws + WM.h);
    bf16_t* Big = (bf16_t*)(ws + WM.big[0]); bf16_t* Big1 = (bf16_t*)(ws + WM.big[1]);
    const float* norm_mlp = a.in[8];
    const float* w1 = a.in[14]; const float* w2 = a.in[15];
    const float* norm_mix = a.in[7]; const float* fnet_wo = a.in[9];
    float* modw = (float*)(ws + WM.mod);
#define IN(k) (a.ph_lo <= (k) && (k) < a.ph_hi)
    if (tid < 128) ((LAS unsigned*)(lds + MISC_OFF))[tid] = 0u;
    __syncthreads();
    XcdBarrier bar = xcd_barrier_post((unsigned*)ws, (volatile LAS unsigned*)(lds + MISC_OFF));
#if defined(PROBE_A)
#define STAMP(k) do { if (bx == 0 && tid == 0) ((LAS unsigned long long*)(lds + MISC_OFF + 64))[(k)] = __builtin_amdgcn_s_memrealtime(); } while (0)
#else
#define STAMP(k) do { } while (0)
#endif
    STAMP(0);
#define SEAM(k) do { if (IN(k) && IN((k) + 1)) xcd_barrier(bar); STAMP((k) + 1); } while (0)
    if (IN(PH_PREP)) {
        LAS float* scr = (LAS float*)(lds + wave * 16384);
        constexpr int I_1 = (1024 / 64) * (4096 / 32), I_2 = (4096 / 64) * (1024 / 32);
        constexpr int I_F = (1024 / 64) * (1024 / 32), I_W = (1024 / 64) * (5120 / 32);
        constexpr int NITEMS = I_1 + I_2 + I_F + I_F + I_W;
        LAS unsigned char* prof_lds_ = (LAS unsigned char*)0; (void)prof_lds_; PROF_DECL; PROF_BEGIN();
        if (bx == (G > 1 ? 1 : 0)) for (int i = tid; i < 4 * 80 * 64; i += NTHREADS) ((unsigned*)(ws + CNT_OFF))[i] = 0u;
        mod_units(lds, bx, G, 384, a.in[3], a.in[4], a.in[5], a.in[6], modw, tid, wave, lane);
        if (bx == G - 1) for (int i = tid; i < 2048; i += NTHREADS) { const int dir = i >> 10, ch = i & 1023; const float l0 = a.in[11][(dir * 2 + 0) * 1024 + ch], l1 = a.in[11][(dir * 2 + 1) * 1024 + ch];
            const float mx = fmaxf(l0, l1), e0 = __expf(l0 - mx), e1 = __expf(l1 - mx); ((float*)(ws + WM.lb))[i] = e1 / (e0 + e1); }
        PROF_END(60); PROF_BEGIN();
        gen_tables(ws, (long)bx * NTHREADS + tid, (long)G * NTHREADS);
        PROF_END(61); PROF_BEGIN();
        transpose_stream(gw, NITEMS, ngw, [&](int it) -> TrItem {
            int r = it;
            if (r < I_F) return TrItem{fnet_wo, (bf16_t*)(ws + WM.wfnet), 1024, 1024, r}; r -= I_F;
            if (r < I_F) return TrItem{a.in[13], (bf16_t*)(ws + WM.who), 1024, 1024, r}; r -= I_F;
            if (r < I_W) return TrItem{a.in[10], (bf16_t*)(ws + WM.win), 1024, 5120, r}; r -= I_W;
            if (r < I_1) return TrItem{w1, (bf16_t*)(ws + WM.w1[0]), 1024, 4096, r}; r -= I_1;
            return TrItem{w2, (bf16_t*)(ws + WM.w2[0]), 4096, 1024, r}; }, scr, lane);
        PROF_END(62);
    }
    SEAM(PH_PREP);
    if (IN(PH_EMBED)) embed_rows(a.in[0], a.in[1], (const float*)(ws + WM.pos), (const float*)(ws + WM.pos) + 64 * 512, norm_mix, mod, Hb, (bf16_t*)a.out, gw, ngw, lane);
    SEAM(PH_EMBED);
    if (IN(PH_FN_CHAN)) {
        { ProbChan p; p.init(0, ws + WM.dftc, Hb, (bf16_t*)(ws + WM.yctx), G, bx); gemm_phase<ProbChan, true, true>(lds, p); }
        { ProbChan p; p.init(1, ws + WM.dftc, Hb, (bf16_t*)(ws + WM.ysmp), G, bx); gemm_phase<ProbChan, true, true>(lds, p); }
    }
    SEAM(PH_FN_CHAN);
    if (IN(PH_FN_POS1)) {
        { ProbPosCtx p; p.init(ws + WM.dl256, (const bf16_t*)(ws + WM.yctx), Hb, G, bx); gemm_phase<ProbPosCtx, true, true>(lds, p); }
        { ProbSmpA p; p.init(ws + WM.fa2, (const bf16_t*)(ws + WM.ysmp), (bf16_t*)(ws + WM.u), G, bx); gemm_phase<ProbSmpA, true, true>(lds, p); }
    }
    SEAM(PH_FN_POS1);
    if (IN(PH_FN_POS2)) { ProbSmpB p; p.init(ws + WM.mb, (const bf16_t*)(ws + WM.u), Hb, G, bx); gemm_phase<ProbSmpB, true, true>(lds, p); }
    SEAM(PH_FN_POS2);
    if (IN(PH_FN_WO)) { ProbResid p; p.init_tok(Hb, 1024, ws + WM.wfnet, 1024, 0, 80, 4, G, bx); p.X = (bf16_t*)a.out; p.mod = mod; p.layer = 0; p.gidx = 2; p.init_split(G, bx, (unsigned short*)(ws + SLAB_FN)); p.pcnt = (unsigned*)(ws + CNT_OFF) + 0 * 80 * 64; p.prof_id = 20; gemm_phase<ProbResid, true, true>(lds, p); }
    STAMP((PH_FN_WO) + 1);
    if (IN(PH_NORM_MLP0)) { __syncthreads(); build_split_table(lds, G, tid); { const int rpw_ = (20480 + ngw - 1) / ngw, rlo_ = bx * NWAVES * rpw_, rhi_ = rlo_ + NWAVES * rpw_ - 1; if (rlo_ < 20480) wait_panels((unsigned*)(ws + CNT_OFF) + 0 * 80 * 64, lds, rlo_ >> 8, (rhi_ < 20480 ? rhi_ : 20479) >> 8, (unsigned*)ws + XB_TMO, wave, lane); else __syncthreads(); } norm_rows((bf16_t*)a.out, 0, 20480, norm_mlp, mod, 0, 3, Hb, gw, ngw, lane, lds, (const unsigned short*)(ws + SLAB_FN)); }
    SEAM(PH_NORM_MLP0);
    if (IN(PH_MLP1_0)) { ProbMlp1 p; p.init_tok(Hb, 1024, ws + WM.w1[0], 1024, 0, 80, 4096 / BM, G, bx); p.O = Big; p.ldc = 4096; p.prof_id = 40; gemm_phase<ProbMlp1, true, true>(lds, p); }
    SEAM(PH_MLP1_0);
    if (IN(PH_MLP2_0)) { ProbResid p; p.init_tok(Big, 4096, ws + WM.w2[0], 4096, 0, 80, 1024 / BM, G, bx); p.X = (bf16_t*)a.out; p.mod = mod; p.layer = 0; p.gidx = 5; p.init_split(G, bx, (unsigned short*)(ws + SLAB_M0)); p.pcnt = (unsigned*)(ws + CNT_OFF) + 1 * 80 * 64; gemm_phase<ProbResid, true, true>(lds, p); }
    STAMP((PH_MLP2_0) + 1);
    if (IN(PH_NORM_MIX1)) { __syncthreads(); build_split_table(lds, G, tid); { const int rpw_ = (20480 + ngw - 1) / ngw, rlo_ = bx * NWAVES * rpw_, rhi_ = rlo_ + NWAVES * rpw_ - 1; if (rlo_ < 20480) wait_panels((unsigned*)(ws + CNT_OFF) + 1 * 80 * 64, lds, rlo_ >> 8, (rhi_ < 20480 ? rhi_ : 20479) >> 8, (unsigned*)ws + XB_TMO, wave, lane); else __syncthreads(); } norm_rows((bf16_t*)a.out, 0, 20480, norm_mix + 1024, mod, 1, 0, Hb, gw, ngw, lane, lds, (const unsigned short*)(ws + SLAB_M0)); }
    SEAM(PH_NORM_MIX1);
    if (IN(PH_WIN)) { ProbWin p; p.init_tok(Hb, 1024, ws + WM.win, 1024, 0, 80, 20, G, bx); p.Oq = (bf16_t*)(ws + WM.q); p.Offw = (bf16_t*)(ws + WM.lffw); p.Ofbw = (bf16_t*)(ws + WM.lfbw);
        p.Ov = (bf16_t*)(ws + WM.v); p.Osg = (bf16_t*)(ws + WM.sg); p.lb = (const float*)(ws + WM.lb); p.prof_id = 50; gemm_phase<ProbWin, true, true>(lds, p); }
    SEAM(PH_WIN);
    if (IN(PH_SCAN_A) || IN(PH_SCAN_B) || IN(PH_SCAN_C)) {
        ScanT st; st.q = (const bf16_t*)(ws + WM.q); st.lffw = (const bf16_t*)(ws + WM.lffw); st.lfbw = (const bf16_t*)(ws + WM.lfbw); st.v = (const bf16_t*)(ws + WM.v); st.sg = (bf16_t*)(ws + WM.sg);
        st.slots = (bf16_t*)(ws + WM.slots); st.dvec = (float*)(ws + WM.dvec); st.gnorm = a.in[12]; st.state_in = a.in[2]; st.new_state = a.out + (size_t)20480 * 1024;
        if (IN(PH_SCAN_A)) scan_phase_a(lds, st, G, bx);
        SEAM(PH_SCAN_A);
        if (IN(PH_SCAN_B)) scan_phase_b(st, G, bx, tid);
        SEAM(PH_SCAN_B);
        if (IN(PH_SCAN_C)) scan_phase_c(lds, st, G, bx);
    }
    SEAM(PH_SCAN_C);
    if (IN(PH_HG_WO)) {
#pragma unroll 1
        for (int step = 0; step < 2; ++step) {
            if ((step == 0) == ((bx & 1) == 0)) {
                LAS float* scr = (LAS float*)(lds + wave * 16384);
                constexpr int I_1 = (1024 / 64) * (4096 / 32), I_2 = (4096 / 64) * (1024 / 32);
                __syncthreads();
                transpose_stream(gw, I_1 + I_2, ngw, [&](int it) -> TrItem {
                    if (it < I_1) return TrItem{w1 + (size_t)1024 * 4096, (bf16_t*)(ws + WM.w1[1]), 1024, 4096, it};
                    return TrItem{w2 + (size_t)4096 * 1024, (bf16_t*)(ws + WM.w2[1]), 4096, 1024, it - I_1}; }, scr, lane);
                __syncthreads();
            } else {
                ProbResid p; p.init_tok((bf16_t*)(ws + WM.sg), 1024, ws + WM.who, 1024, 0, 80, 4, G, bx); p.X = (bf16_t*)a.out; p.mod = mod; p.layer = 1; p.gidx = 2; p.init_split(G, bx, (unsigned short*)(ws + SLAB_HG)); p.pcnt = (unsigned*)(ws + CNT_OFF) + 2 * 80 * 64; gemm_phase<ProbResid, true, true>(lds, p);
            }
        }
    }
    STAMP((PH_HG_WO) + 1);
    if (IN(PH_NORM_MLP1)) { __syncthreads(); build_split_table(lds, G, tid); { const int rpw_ = (20480 + ngw - 1) / ngw, rlo_ = bx * NWAVES * rpw_, rhi_ = rlo_ + NWAVES * rpw_ - 1; if (rlo_ < 20480) wait_panels((unsigned*)(ws + CNT_OFF) + 2 * 80 * 64, lds, rlo_ >> 8, (rhi_ < 20480 ? rhi_ : 20479) >> 8, (unsigned*)ws + XB_TMO, wave, lane); else __syncthreads(); } norm_rows((bf16_t*)a.out, 0, 20480, norm_mlp + 1024, mod, 1, 3, Hb, gw, ngw, lane, lds, (const unsigned short*)(ws + SLAB_HG)); }
    SEAM(PH_NORM_MLP1);
    if (IN(PH_MLP1_1)) { ProbMlp1 p; p.init_tok(Hb, 1024, ws + WM.w1[1], 1024, 0, 80, 4096 / BM, G, bx); p.O = Big1; p.ldc = 4096; gemm_phase<ProbMlp1, true, true>(lds, p); }
    SEAM(PH_MLP1_1);
    if (IN(PH_MLP2_1)) { ProbResid p; p.init_tok(Big1, 4096, ws + WM.w2[1], 4096, 0, 80, 1024 / BM, G, bx); p.X = (bf16_t*)a.out; p.mod = mod; p.layer = 1; p.gidx = 5; p.init_split(G, bx, (unsigned short*)(ws + SLAB_M1)); p.pcnt = (unsigned*)(ws + CNT_OFF) + 3 * 80 * 64; gemm_phase<ProbResid, true, true>(lds, p); }
    STAMP((PH_MLP2_1) + 1);
    if (IN(PH_FINAL)) { __syncthreads(); build_split_table(lds, G, tid); { const int rpw_ = (20480 + ngw - 1) / ngw, rlo_ = bx * NWAVES * rpw_, rhi_ = rlo_ + NWAVES * rpw_ - 1; if (rlo_ < 20480) wait_panels((unsigned*)(ws + CNT_OFF) + 3 * 80 * 64, lds, rlo_ >> 8, (rhi_ < 20480 ? rhi_ : 20479) >> 8, (unsigned*)ws + XB_TMO, wave, lane); else __syncthreads(); } final_rows(a.out, 0, 20480, a.in[16], gw, ngw, lane, lds, (const unsigned short*)(ws + SLAB_M1)); }
#if defined(PROF_ID)
    if (bx == 0 && tid == 0) { const unsigned long long d = *(LAS unsigned long long*)(lds + LDS_BYTES - 512 + 256); const unsigned long long t0 = __builtin_amdgcn_s_memrealtime(); while (__builtin_amdgcn_s_memrealtime() - t0 < 16ull * d) __builtin_amdgcn_s_sleep(8); }
#endif
#if defined(PROBE_A)
    if (bx == 0 && tid == 0) { asm volatile("s_waitcnt vmcnt(0)" ::: "memory"); STAMP(PH_END); const unsigned long long d = ((LAS unsigned long long*)(lds + MISC_OFF + 64))[PROBE_B] - ((LAS unsigned long long*)(lds + MISC_OFF + 64))[PROBE_A];
        const unsigned long long t0 = __builtin_amdgcn_s_memrealtime(); while (__builtin_amdgcn_s_memrealtime() - t0 < 4ull * d) __builtin_amdgcn_s_sleep(8); }
#endif
#undef IN
}
}
#ifndef MK_N_LAUNCHES
#define MK_N_LAUNCHES 1
#endif
extern "C" void kernel_launch(void* const* d_in, const int* in_sizes, int n_in, void* d_out, int out_size, void* d_ws, size_t ws_size, hipStream_t stream) {
    static int grid = 0;
    if (grid == 0) {
        int dev = 0, cus = 0;
        if (hipGetDevice(&dev) != hipSuccess || hipDeviceGetAttribute(&cus, hipDeviceAttributeMultiprocessorCount, dev) != hipSuccess || cus <= 0) cus = 256;
        hipFuncSetAttribute((const void*)fk::fwd, hipFuncAttributeMaxDynamicSharedMemorySize, fk::LDS_BYTES);
        int per_cu = 0;
        if (hipOccupancyMaxActiveBlocksPerMultiprocessor(&per_cu, (const void*)fk::fwd, fk::NTHREADS, fk::LDS_BYTES) != hipSuccess || per_cu < 1)
            fprintf(stderr, "kernel_launch: occupancy query reports %d workgroups per CU\n", per_cu);
        (void)hipGetLastError();
        grid = cus;
    }
    hipMemsetAsync(d_ws, 0, fk::CTL_BYTES, stream);
    fk::Args a{};
    for (int i = 0; i < 17; ++i) a.in[i] = (const float*)d_in[i];
    a.out = (float*)d_out; a.ws = (unsigned char*)d_ws;
#if MK_N_LAUNCHES == 1
    a.ph_lo = 0; a.ph_hi = fk::PH_END;
    hipLaunchKernelGGL(fk::fwd, dim3(grid), dim3(fk::NTHREADS), fk::LDS_BYTES, stream, a);
#else
    for (int ph = 0; ph < fk::PH_END; ++ph) { a.ph_lo = ph; a.ph_hi = ph + 1; hipLaunchKernelGGL(fk::fwd, dim3(grid), dim3(fk::NTHREADS), fk::LDS_BYTES, stream, a); }
#endif
}
```
